# Optimizing an MI355X kernel written in HIP

```python
import jax, jax.numpy as jnp
from jax import lax
import numpy as np

D_MODEL = 1024
BATCH = 4
SEQ = 8192
DEPTH = 1
DEC_BATCH = 128
DEC_SEQ = 4
PAST_LEN = 16384
PAGE_SIZE = 128

MIX_WIDTH = D_MODEL
LRU_WIDTH = MIX_WIDTH // 2
LRU_BLOCKS = 8
LRU_BLOCK_W = LRU_WIDTH // LRU_BLOCKS
LRU_C = 8.0
CONV_W = 4
HEAD_DIM = 64
N_HEADS = (MIX_WIDTH - LRU_WIDTH) // HEAD_DIM
N_KV_HEADS = 2
GROUP = N_HEADS // N_KV_HEADS
ATTN_WIDTH = N_HEADS * HEAD_DIM
KV_WIDTH = N_KV_HEADS * HEAD_DIM
WINDOW = 128
ATTN_BLOCK = WINDOW
ROPE_THETA = 10000.0
D_FF = 2816
NORM_EPS = 1e-6
IN_WIDTH = 2 * LRU_WIDTH + ATTN_WIDTH + 2 * KV_WIDTH
SPLITS = [LRU_WIDTH, 2 * LRU_WIDTH, 2 * LRU_WIDTH + ATTN_WIDTH, 2 * LRU_WIDTH + ATTN_WIDTH + KV_WIDTH]

kernel_name = 'hymba_rglru_swa_sink_macaron_step'


def rms_norm(x, g):
    xf = x.astype(jnp.float32)
    y = xf * lax.rsqrt(jnp.mean(xf * xf, axis=-1, keepdims=True) + NORM_EPS)
    return (y * g.astype(jnp.float32)).astype(x.dtype)


def swiglu_ffn(x, w_gate, w_up, w_down):
    return (jax.nn.silu(x @ w_gate) * (x @ w_up)) @ w_down


def rope(x, pos):
    half = HEAD_DIM // 2
    inv_freq = ROPE_THETA ** (-jnp.arange(half, dtype=jnp.float32) / half)
    ang = pos.astype(jnp.float32)[:, None] * inv_freq[None, :]
    cos = jnp.cos(ang)[:, None, :]
    sin = jnp.sin(ang)[:, None, :]
    xf = x.astype(jnp.float32)
    x1, x2 = xf[..., :half], xf[..., half:]
    return jnp.concatenate([x1 * cos - x2 * sin, x2 * cos + x1 * sin], axis=-1).astype(x.dtype)


def causal_conv(x, buf, w, b):
    T = x.shape[1]
    xc = jnp.concatenate([buf.astype(x.dtype), x], axis=1)
    y = b
    for j in range(CONV_W):
        y = y + xc[:, j:j + T] * w[j]
    return y, xc[:, xc.shape[1] - (CONV_W - 1):]


def _lin_combine(left, right):
    a1, b1 = left
    a2, b2 = right
    return a1 * a2, a2 * b1 + b2


def rg_lru(x, h0, wa, ba, wx, bx, lam):
    B, T, C = x.shape
    xb = x.reshape(B, T, LRU_BLOCKS, LRU_BLOCK_W)
    r = jax.nn.sigmoid(jnp.einsum('btnc,ncd->btnd', xb, wa).reshape(B, T, C) + ba).astype(jnp.float32)
    i = jax.nn.sigmoid(jnp.einsum('btnc,ncd->btnd', xb, wx).reshape(B, T, C) + bx).astype(jnp.float32)
    log_a = -LRU_C * jax.nn.softplus(-lam.astype(jnp.float32)) * r
    a = jnp.exp(log_a)
    u = jnp.sqrt(-jnp.expm1(2.0 * log_a)) * (i * x.astype(jnp.float32))
    u = u.at[:, 0].add(a[:, 0] * h0.astype(jnp.float32))
    _, h = lax.associative_scan(_lin_combine, (a, u), axis=1)
    return h, h[:, -1]


def sink_attention(q, k, v, mask, sinks):
    s = jnp.einsum('...qkgd,...jkd->...kgqj', q, k, preferred_element_type=jnp.float32) * (HEAD_DIM ** -0.5)
    s = jnp.where(mask[..., None, None, :, :], s, -jnp.inf)
    sk = sinks.astype(jnp.float32).reshape(N_KV_HEADS, GROUP, 1, 1)
    mx = jnp.maximum(jnp.max(s, axis=-1, keepdims=True), sk)
    p = jnp.exp(s - mx)
    p = p / (jnp.sum(p, axis=-1, keepdims=True) + jnp.exp(sk - mx))
    o = jnp.einsum('...kgqj,...jkd->...qkgd', p, v.astype(jnp.float32))
    return o.astype(q.dtype)


def swa_banded(q, k, v, sinks):
    B, S = q.shape[0], q.shape[1]
    nb = S // ATTN_BLOCK
    qb = q.reshape(B, nb, ATTN_BLOCK, N_KV_HEADS, GROUP, HEAD_DIM)

    def band(t):
        cur = t.reshape(B, nb, ATTN_BLOCK, N_KV_HEADS, HEAD_DIM)
        prev = jnp.concatenate([jnp.zeros_like(cur[:, :1]), cur[:, :-1]], axis=1)
        return jnp.concatenate([prev, cur], axis=2)

    kb, vb = band(k), band(v)
    qi = jnp.arange(ATTN_BLOCK)[:, None]
    kj = jnp.arange(2 * ATTN_BLOCK)[None, :]
    d = qi + ATTN_BLOCK - kj
    blk = jnp.arange(nb)[:, None, None]
    mask = (d >= 0) & (d < WINDOW) & ((blk > 0) | (kj >= ATTN_BLOCK))
    o = sink_attention(qb, kb, vb, mask, sinks)
    return o.reshape(B, S, N_HEADS, HEAD_DIM)


def swa_cached(q, k, v, k_cache, v_cache, sinks):
    B, T = q.shape[0], q.shape[1]
    W = k_cache.shape[1]
    kk = jnp.concatenate([k_cache.astype(k.dtype), k], axis=1)
    vv = jnp.concatenate([v_cache.astype(v.dtype), v], axis=1)
    d = (jnp.arange(T)[:, None] + W) - jnp.arange(W + T)[None, :]
    mask = (d >= 0) & (d < WINDOW)
    qg = q.reshape(B, T, N_KV_HEADS, GROUP, HEAD_DIM)
    o = sink_attention(qg, kk, vv, mask, sinks)
    return o.reshape(B, T, N_HEADS, HEAD_DIM), kk[:, T:], vv[:, T:]


def token_mixer(hn, pos, h0, conv_buf, k_cache, v_cache, win, mp):
    (w_in, conv_w, conv_b, wa, ba, wx, bx, lam, qn, kn, sinks, lru_on, attn_on, w_out) = mp
    B, T, _ = hn.shape
    proj = hn @ w_in
    x_lru, gate, q, k, v = jnp.split(proj, SPLITS, axis=-1)
    xc, new_conv = causal_conv(x_lru, conv_buf, conv_w, conv_b)
    h, h_last = rg_lru(xc, h0, wa, ba, wx, bx, lam)
    lru_out = rms_norm((h * jax.nn.gelu(gate.astype(jnp.float32))).astype(hn.dtype), lru_on)
    q = rope(rms_norm(q.reshape(B, T, N_HEADS, HEAD_DIM), qn), pos)
    k = rope(rms_norm(k.reshape(B, T, N_KV_HEADS, HEAD_DIM), kn), pos)
    v = v.reshape(B, T, N_KV_HEADS, HEAD_DIM)
    if k_cache is None:
        o = swa_banded(q, k, v, sinks)
        new_k, new_v = k[:, T - win:], v[:, T - win:]
    else:
        o, new_k, new_v = swa_cached(q, k, v, k_cache, v_cache, sinks)
    attn_out = rms_norm(o.reshape(B, T, ATTN_WIDTH), attn_on)
    y = jnp.concatenate([lru_out, attn_out], axis=-1) @ w_out
    return y, h_last.astype(hn.dtype), new_conv, new_k, new_v


def decoder_layer(x, pos, h0, conv_buf, k_cache, v_cache, win, ffn1, mix, ffn2):
    x = x + 0.5 * swiglu_ffn(rms_norm(x, ffn1[0]), ffn1[1], ffn1[2], ffn1[3])
    y, h_last, new_conv, new_k, new_v = token_mixer(rms_norm(x, mix[0]), pos, h0, conv_buf,
                                                    k_cache, v_cache, win, mix[1:])
    x = x + y
    x = x + 0.5 * swiglu_ffn(rms_norm(x, ffn2[0]), ffn2[1], ffn2[2], ffn2[3])
    return x, h_last, new_conv, new_k, new_v


def setup_inputs(seed: int = 0) -> dict:
    key = jax.random.key(seed)
    ks = jax.random.split(key, 32)
    f32 = jnp.float32
    L = DEPTH
    win = min(WINDOW, PAST_LEN)

    def nrm(k, shape, s):
        return jax.random.normal(k, shape, f32) * s

    def gain(k, shape):
        return 1.0 + 0.01 * jax.random.normal(k, shape, f32)

    u = jax.random.uniform(ks[18], (L, LRU_WIDTH), f32, 0.9, 0.999)
    sg = u ** (1.0 / LRU_C)
    lam = jnp.log(sg) - jnp.log1p(-sg)
    return {
        'x_prompt': nrm(ks[0], (BATCH, SEQ, D_MODEL), 1.0),
        'x_sample': nrm(ks[1], (DEC_BATCH, DEC_SEQ, D_MODEL), 1.0),
        'state_lru_h': nrm(ks[2], (L, DEC_BATCH, LRU_WIDTH), 0.5),
        'state_conv': nrm(ks[3], (L, DEC_BATCH, CONV_W - 1, LRU_WIDTH), 1.0),
        'cache_k': nrm(ks[4], (L, DEC_BATCH, win, N_KV_HEADS, HEAD_DIM), 1.0),
        'cache_v': nrm(ks[5], (L, DEC_BATCH, win, N_KV_HEADS, HEAD_DIM), 1.0),
        'ffn1_norm': gain(ks[6], (L, D_MODEL)),
        'ffn1_w_gate': nrm(ks[7], (L, D_MODEL, D_FF), D_MODEL ** -0.5),
        'ffn1_w_up': nrm(ks[8], (L, D_MODEL, D_FF), D_MODEL ** -0.5),
        'ffn1_w_down': nrm(ks[9], (L, D_FF, D_MODEL), D_FF ** -0.5),
        'mix_norm': gain(ks[10], (L, D_MODEL)),
        'w_in': nrm(ks[11], (L, D_MODEL, IN_WIDTH), D_MODEL ** -0.5),
        'conv_w': nrm(ks[12], (L, CONV_W, LRU_WIDTH), CONV_W ** -0.5),
        'conv_b': nrm(ks[13], (L, LRU_WIDTH), 0.01),
        'lru_wa': nrm(ks[14], (L, LRU_BLOCKS, LRU_BLOCK_W, LRU_BLOCK_W), LRU_BLOCK_W ** -0.5),
        'lru_ba': nrm(ks[15], (L, LRU_WIDTH), 0.01),
        'lru_wx': nrm(ks[16], (L, LRU_BLOCKS, LRU_BLOCK_W, LRU_BLOCK_W), LRU_BLOCK_W ** -0.5),
        'lru_bx': nrm(ks[17], (L, LRU_WIDTH), 0.01),
        'lru_lambda': lam,
        'q_norm': gain(ks[19], (L, HEAD_DIM)),
        'k_norm': gain(ks[20], (L, HEAD_DIM)),
        'attn_sinks': nrm(ks[21], (L, N_HEADS), 0.5),
        'lru_out_norm': gain(ks[22], (L, LRU_WIDTH)),
        'attn_out_norm': gain(ks[23], (L, ATTN_WIDTH)),
        'w_out': nrm(ks[24], (L, MIX_WIDTH, D_MODEL), MIX_WIDTH ** -0.5),
        'ffn2_norm': gain(ks[25], (L, D_MODEL)),
        'ffn2_w_gate': nrm(ks[26], (L, D_MODEL, D_FF), D_MODEL ** -0.5),
        'ffn2_w_up': nrm(ks[27], (L, D_MODEL, D_FF), D_MODEL ** -0.5),
        'ffn2_w_down': nrm(ks[28], (L, D_FF, D_MODEL), D_FF ** -0.5),
    }


def reference(x_prompt, x_sample, state_lru_h, state_conv, cache_k, cache_v,
              ffn1_norm, ffn1_w_gate, ffn1_w_up, ffn1_w_down,
              mix_norm, w_in, conv_w, conv_b, lru_wa, lru_ba, lru_wx, lru_bx, lru_lambda,
              q_norm, k_norm, attn_sinks, lru_out_norm, attn_out_norm, w_out,
              ffn2_norm, ffn2_w_gate, ffn2_w_up, ffn2_w_down):
    win = min(WINDOW, PAST_LEN)
    pos_p = jnp.arange(SEQ, dtype=jnp.int32)
    pos_s = PAST_LEN + jnp.arange(DEC_SEQ, dtype=jnp.int32)
    yp, ys = x_prompt, x_sample
    p_h, p_c, p_k, p_v = [], [], [], []
    s_h, s_c, s_k, s_v = [], [], [], []
    for l in range(DEPTH):
        ffn1 = (ffn1_norm[l], ffn1_w_gate[l], ffn1_w_up[l], ffn1_w_down[l])
        mix = (mix_norm[l], w_in[l], conv_w[l], conv_b[l], lru_wa[l], lru_ba[l], lru_wx[l], lru_bx[l],
               lru_lambda[l], q_norm[l], k_norm[l], attn_sinks[l], lru_out_norm[l], attn_out_norm[l], w_out[l])
        ffn2 = (ffn2_norm[l], ffn2_w_gate[l], ffn2_w_up[l], ffn2_w_down[l])
        h0 = jnp.zeros((BATCH, LRU_WIDTH), x_prompt.dtype)
        c0 = jnp.zeros((BATCH, CONV_W - 1, LRU_WIDTH), x_prompt.dtype)
        yp, h, c, k, v = decoder_layer(yp, pos_p, h0, c0, None, None, win, ffn1, mix, ffn2)
        p_h.append(h); p_c.append(c); p_k.append(k); p_v.append(v)
        ys, h, c, k, v = decoder_layer(ys, pos_s, state_lru_h[l], state_conv[l], cache_k[l], cache_v[l],
                                       win, ffn1, mix, ffn2)
        s_h.append(h); s_c.append(c); s_k.append(k); s_v.append(v)
    prompt_lru_h, prompt_conv = jnp.stack(p_h), jnp.stack(p_c)
    prompt_k, prompt_v = jnp.stack(p_k), jnp.stack(p_v)
    sample_lru_h, sample_conv = jnp.stack(s_h), jnp.stack(s_c)
    sample_k, sample_v = jnp.stack(s_k), jnp.stack(s_v)
    return (yp, ys, prompt_lru_h, prompt_conv, prompt_k, prompt_v, sample_lru_h, sample_conv, sample_k, sample_v)
```

```cpp
#include <hip/hip_runtime.h>
#include <cstdio>
#include <cstdint>
#include <cmath>
namespace pg8 {
#define PG8_LAS __attribute__((address_space(3)))
typedef unsigned short bf16_t;
typedef short bf16x8 __attribute__((ext_vector_type(8)));
typedef float f32x4 __attribute__((ext_vector_type(4)));
typedef unsigned u32x4 __attribute__((ext_vector_type(4)));
constexpr int BM = 256, BK = 64, HALF = 128, HTB = HALF * BK * 2  , STAGE_BYTES = 8 * HTB, NXCD = 8, WGM = 8;

__host__ __device__ __forceinline__ int lds_byte(int r, int c) { const int st = (r >> 4) * 2 + (c >> 5), rr = r & 15, cc = c & 31, ob = rr * 64 + cc * 2; return st * 1024 + (ob ^ (((ob >> 9) & 1) << 5)); }
__host__ __device__ __forceinline__ void stage_rc(int b, int& R, int& C) { const int st = b / 1024, sb = b % 1024, swz = sb ^ (((sb >> 9) & 1) << 5); R = (st >> 1) * 16 + swz / 64; C = (st & 1) * 32 + (swz % 64) / 2; }
__host__ __device__ __forceinline__ int perm32(int rho) { const int n = rho >> 4, i = rho & 15; return 8 * (i >> 2) + 4 * n + (i & 3); }

struct Unit { int pm, pn; };
struct Gemm { const bf16_t* A; const bf16_t* Bt; int M, N, K; };

struct StaticOrder {
    int nM, nN, nwg, G, c;
    __host__ __device__ void init(int M, int N, int G_, int c_) { nM = M / BM; nN = N / BM; nwg = nM * nN; G = G_; c = c_; }
    __host__ __device__ bool next(int i, Unit& u) const {
        const long L = (long)i * G + c; if (L >= nwg) return false;
        int wgid = (int)L; { const int q = nwg / NXCD, r = nwg % NXCD, xcd = wgid % NXCD, off = wgid / NXCD; wgid = (xcd < r ? xcd * (q + 1) : r * (q + 1) + (xcd - r) * q) + off; }
        const int nig = WGM * nN, gid = wgid / nig, fm = gid * WGM, gsz = (nM - fm) < WGM ? (nM - fm) : WGM;
        u.pm = fm + ((wgid % nig) % gsz); u.pn = (wgid % nig) / gsz; return true;
    }
    __device__ __forceinline__ void a_ready(const Unit&) const {}
    __device__ __forceinline__ void done(const Unit&) const {}
};

__device__ __forceinline__ unsigned cvt_pk_bf16(float lo, float hi) { unsigned r; asm volatile("v_cvt_pk_bf16_f32 %0, %1, %2" : "=v"(r) : "v"(lo), "v"(hi)); return r; }
typedef float f32x2 __attribute__((ext_vector_type(2)));
typedef unsigned u32x2 __attribute__((ext_vector_type(2)));
constexpr float RMS_EPS = 1e-6f;
__device__ __forceinline__ float row_rs(const float* ssq, int r) {
    const f32x4* p = (const f32x4*)(ssq + (size_t)r * 16);
    const f32x4 a = p[0], b = p[1], c = p[2], d = p[3];
    const float s = ((a[0] + a[1]) + (a[2] + a[3])) + ((b[0] + b[1]) + (b[2] + b[3])) + ((c[0] + c[1]) + (c[2] + c[3])) + ((d[0] + d[1]) + (d[2] + d[3]));
    return __builtin_amdgcn_rsqf(s * (1.0f / 1024.0f) + RMS_EPS);
}
__device__ __forceinline__ float silu_f(float g) { return g * __builtin_amdgcn_rcpf(1.0f + __builtin_amdgcn_exp2f(g * -1.4426950408889634f)); }

struct EpiSwiglu {
    static constexpr bool PERM = true, AFTER_DRAIN = false;
    bf16_t* H; int ldh; const float* ssq;
    __device__ __forceinline__ void operator()(const f32x4 (&acc)[2][2][4][2], const Unit& u, int wr, int wc, int fr, int fq) const {
        const int row0 = u.pm * BM + wr * 64 + fr, col0 = u.pn * HALF + wc * 32 + 8 * fq;
#pragma unroll
        for (int ai = 0; ai < 2; ++ai)
#pragma unroll
            for (int m = 0; m < 4; ++m) {
                const int r = row0 + ai * HALF + m * 16; const float rs = row_rs(ssq, r);
                float hv[8];
#pragma unroll
                for (int n = 0; n < 2; ++n)
#pragma unroll
                    for (int e = 0; e < 4; ++e) hv[n * 4 + e] = silu_f(acc[ai][0][m][n][e] * rs) * (acc[ai][1][m][n][e] * rs);
                u32x4 w; w.x = cvt_pk_bf16(hv[0], hv[1]); w.y = cvt_pk_bf16(hv[2], hv[3]); w.z = cvt_pk_bf16(hv[4], hv[5]); w.w = cvt_pk_bf16(hv[6], hv[7]);
                *(u32x4*)(H + (size_t)r * ldh + col0) = w;
            }
    }
};
struct EpiScaleBf16 {
    static constexpr bool PERM = true, AFTER_DRAIN = false;
    bf16_t* O; int ldc; const float* ssq;
    __device__ __forceinline__ void operator()(const f32x4 (&acc)[2][2][4][2], const Unit& u, int wr, int wc, int fr, int fq) const {
        const int row0 = u.pm * BM + wr * 64 + fr, col0 = u.pn * BM + wc * 32 + 8 * fq;
#pragma unroll
        for (int ai = 0; ai < 2; ++ai)
#pragma unroll
            for (int m = 0; m < 4; ++m) {
                const int r = row0 + ai * HALF + m * 16; const float rs = row_rs(ssq, r);
#pragma unroll
                for (int bj = 0; bj < 2; ++bj) {
                    const f32x4 v0 = acc[ai][bj][m][0] * rs, v1 = acc[ai][bj][m][1] * rs;
                    u32x4 w; w.x = cvt_pk_bf16(v0[0], v0[1]); w.y = cvt_pk_bf16(v0[2], v0[3]); w.z = cvt_pk_bf16(v1[0], v1[1]); w.w = cvt_pk_bf16(v1[2], v1[3]);
                    *(u32x4*)(O + (size_t)r * ldc + col0 + bj * HALF) = w;
                }
            }
    }
};
template <bool WITH_XB> struct EpiResid {
    static constexpr bool PERM = false, AFTER_DRAIN = false;
    const float* base0; const float* base1; int split; float* out; bf16_t* xb; float* ssq; float scale;
    __device__ __forceinline__ void operator()(const f32x4 (&acc)[2][2][4][2], const Unit& u, int wr, int wc, int fr, int fq) const {
        const int row0 = u.pm * BM + wr * 64 + fr, col0 = u.pn * BM + wc * 32 + 4 * fq;
        const float* bp = (u.pm * BM < split) ? base0 : base1 - (size_t)split * 1024;
#pragma unroll
        for (int ai = 0; ai < 2; ++ai)
#pragma unroll
            for (int m = 0; m < 4; ++m) {
                const int r = row0 + ai * HALF + m * 16; const size_t off = (size_t)r * 1024 + col0; float s = 0.f;
#pragma unroll
                for (int bj = 0; bj < 2; ++bj)
#pragma unroll
                    for (int n = 0; n < 2; ++n) {
                        const f32x4 b = *(const f32x4*)(bp + off + bj * HALF + n * 16);
                        const f32x4 o = b + acc[ai][bj][m][n] * scale;
                        *(f32x4*)(out + off + bj * HALF + n * 16) = o;
                        if (WITH_XB) { s += (o[0] * o[0] + o[1] * o[1]) + (o[2] * o[2] + o[3] * o[3]);
                            u32x2 w; w.x = cvt_pk_bf16(o[0], o[1]); w.y = cvt_pk_bf16(o[2], o[3]); *(u32x2*)(xb + off + bj * HALF + n * 16) = w; }
                    }
                if (WITH_XB) { s += __shfl_xor(s, 16); s += __shfl_xor(s, 32); if (fq == 0) ssq[(size_t)r * 16 + u.pn * 4 + wc] = s; }
            }
    }
};
template <class Epi, class Sched, bool ALIGN_EPI = false, bool SP2 = false>
__device__ __forceinline__ void gemm_phase(PG8_LAS unsigned char* lds, const Gemm g, const Sched& S, const Epi& E) {
    const int tid = threadIdx.x, wid = __builtin_amdgcn_readfirstlane(tid >> 6), lane = tid & 63, wr = wid >> 2, wc = wid & 3, fr = lane & 15, fq = lane >> 4;
    const int K = g.K, nt = K / BK;
    unsigned voffA[2], voffB[2];
#pragma unroll
    for (int i = 0; i < 2; ++i) { int R, C; stage_rc(tid * 16 + i * 8192, R, C); const int Rb = Epi::PERM ? ((R & ~31) + perm32(R & 31)) : R;
        voffA[i] = (unsigned)(R * K + C) * 2u; voffB[i] = (unsigned)(Rb * K + C) * 2u; }
    const size_t kstep = (size_t)(BK * 2);
    const size_t hstep = (size_t)HALF * K * 2;
    const size_t tstep = 2 * hstep;
    const unsigned ldsw = (unsigned)wid * 1024u;
    const int aoff = lds_byte(wr * 64 + fr, fq * 8), boff = lds_byte(wc * 32 + fr, fq * 8);
#define PG8_SA(b, h) (((b) * 2 + (h)) * HTB)
#define PG8_SB(b, h) ((4 + (b) * 2 + (h)) * HTB)
#define PG8_STAGE(bufoff, gbase, voff) do { _Pragma("unroll") for (int _i = 0; _i < 2; ++_i) \
        __builtin_amdgcn_global_load_lds((const unsigned*)((const char*)(gbase) + (voff)[_i]), (PG8_LAS unsigned*)(lds + (bufoff) + ldsw + _i * 8192), 16, 0, 0); } while (0)
#define PG8_LDA(dst, b, h) do { _Pragma("unroll") for (int m = 0; m < 4; ++m) _Pragma("unroll") for (int k = 0; k < 2; ++k) dst[m][k] = *(const PG8_LAS bf16x8*)(lds + PG8_SA(b, h) + aoff + m * 2048 + k * 1024); } while (0)
#define PG8_LDB(dst, b, h) do { _Pragma("unroll") for (int n = 0; n < 2; ++n) _Pragma("unroll") for (int k = 0; k < 2; ++k) dst[n][k] = *(const PG8_LAS bf16x8*)(lds + PG8_SB(b, h) + boff + n * 2048 + k * 1024); } while (0)
#define PG8_MMA(ai, bj, At, Bt) do { __builtin_amdgcn_s_setprio(1); _Pragma("unroll") for (int m = 0; m < 4; ++m) _Pragma("unroll") for (int n = 0; n < 2; ++n) _Pragma("unroll") for (int k = 0; k < 2; ++k) \
        acc[ai][bj][m][n] = __builtin_amdgcn_mfma_f32_16x16x32_bf16(Bt[n][k], At[m][k], acc[ai][bj][m][n], 0, 0, 0); __builtin_amdgcn_s_setprio(0); } while (0)
#define PG8_WAIT_V(n) asm volatile("s_waitcnt vmcnt(" #n ")" ::: "memory")
#define PG8_WAIT_L(n) asm volatile("s_waitcnt lgkmcnt(" #n ")" ::: "memory")
#define PG8_BAR __builtin_amdgcn_s_barrier()
#define PG8_SCHED __builtin_amdgcn_sched_barrier(0)
    Unit cur, nxt; int ui = 0;
    if (!S.next(0, cur)) return;
    f32x4 acc[2][2][4][2];
#pragma unroll
    for (int a = 0; a < 2; ++a)
#pragma unroll
        for (int b = 0; b < 2; ++b)
#pragma unroll
            for (int m = 0; m < 4; ++m)
#pragma unroll
                for (int n = 0; n < 2; ++n) acc[a][b][m][n] = (f32x4){0.f, 0.f, 0.f, 0.f};
    bf16x8 At[4][2], B0[2][2], B1[2][2];
    const char* cA = (const char*)g.A + (size_t)cur.pm * tstep; const char* cB = (const char*)g.Bt + (size_t)cur.pn * tstep;
    S.a_ready(cur);
    if constexpr (SP2) {
        PG8_STAGE(PG8_SB(0, 0), cB, voffB); PG8_STAGE(PG8_SB(0, 1), cB + hstep, voffB); PG8_STAGE(PG8_SA(0, 0), cA, voffA); PG8_STAGE(PG8_SA(0, 1), cA + hstep, voffA);
        if (wr == 1) PG8_BAR;
        PG8_WAIT_V(2); PG8_BAR;
        PG8_STAGE(PG8_SB(1, 0), cB + kstep, voffB); PG8_STAGE(PG8_SA(1, 0), cA + kstep, voffA); PG8_STAGE(PG8_SB(1, 1), cB + hstep + kstep, voffB);
        PG8_WAIT_V(6); PG8_BAR;
    } else {
        PG8_STAGE(PG8_SB(0, 0), cB, voffB); PG8_STAGE(PG8_SA(0, 0), cA, voffA); PG8_STAGE(PG8_SB(0, 1), cB + hstep, voffB); PG8_STAGE(PG8_SA(0, 1), cA + hstep, voffA);
        if (wr == 1) PG8_BAR;
        PG8_WAIT_V(4); PG8_BAR;
        PG8_STAGE(PG8_SB(1, 0), cB + kstep, voffB); PG8_STAGE(PG8_SA(1, 0), cA + kstep, voffA); PG8_STAGE(PG8_SB(1, 1), cB + hstep + kstep, voffB);
        PG8_WAIT_V(6); PG8_BAR;
    }
    for (;;) {
        const bool has_next = S.next(ui + 1, nxt);
        const char* nA = has_next ? (const char*)g.A + (size_t)nxt.pm * tstep : cA; const char* nB = has_next ? (const char*)g.Bt + (size_t)nxt.pn * tstep : cB;
        for (int t = 0; t < nt; t += 2) {
            const bool last = (t == nt - 2);
            const char* a1 = cA + (size_t)(t + 1) * kstep;
            const char* a2 = last ? nA : cA + (size_t)(t + 2) * kstep; const char* b2 = last ? nB : cB + (size_t)(t + 2) * kstep;
            const char* a3 = a2 + kstep; const char* b3 = b2 + kstep;
            if (last && has_next) S.a_ready(nxt);
            if constexpr (SP2) {
            PG8_LDB(B0, 0, 0); PG8_LDB(B1, 0, 1); PG8_SCHED; PG8_LDA(At, 0, 0); PG8_STAGE(PG8_SA(1, 1), a1 + hstep, voffA);
            PG8_WAIT_V(8); PG8_WAIT_L(0); PG8_BAR; PG8_MMA(0, 0, At, B0); PG8_MMA(0, 1, At, B1); PG8_BAR; PG8_SCHED;
            PG8_LDA(At, 0, 1); PG8_STAGE(PG8_SB(0, 0), b2, voffB); PG8_STAGE(PG8_SB(0, 1), b2 + hstep, voffB); PG8_STAGE(PG8_SA(0, 0), a2, voffA);
            PG8_WAIT_V(8); PG8_WAIT_L(0); PG8_BAR; PG8_MMA(1, 0, At, B0); PG8_MMA(1, 1, At, B1); PG8_BAR; PG8_SCHED;
            PG8_LDB(B0, 1, 0); PG8_LDB(B1, 1, 1); PG8_SCHED; PG8_LDA(At, 1, 0); PG8_STAGE(PG8_SA(0, 1), a2 + hstep, voffA);
            PG8_WAIT_V(8); PG8_WAIT_L(0); PG8_BAR; PG8_MMA(0, 0, At, B0); PG8_MMA(0, 1, At, B1); PG8_BAR; PG8_SCHED;
            PG8_LDA(At, 1, 1); PG8_STAGE(PG8_SB(1, 0), b3, voffB); PG8_STAGE(PG8_SB(1, 1), b3 + hstep, voffB); PG8_STAGE(PG8_SA(1, 0), a3, voffA);
            PG8_WAIT_V(8); PG8_WAIT_L(0); PG8_BAR; PG8_MMA(1, 0, At, B0); PG8_MMA(1, 1, At, B1); PG8_BAR; PG8_SCHED;
            } else {
            PG8_LDB(B0, 0, 0); PG8_SCHED; PG8_LDA(At, 0, 0); PG8_STAGE(PG8_SA(1, 1), a1 + hstep, voffA);
            PG8_WAIT_L(8); PG8_BAR; PG8_WAIT_L(0); PG8_MMA(0, 0, At, B0); PG8_BAR; PG8_SCHED;
            PG8_LDB(B1, 0, 1); PG8_STAGE(PG8_SB(0, 0), b2, voffB);
            PG8_BAR; PG8_WAIT_L(0); PG8_MMA(0, 1, At, B1); PG8_BAR;
            PG8_LDA(At, 0, 1); PG8_STAGE(PG8_SA(0, 0), a2, voffA);
            PG8_BAR; PG8_WAIT_L(0); PG8_MMA(1, 0, At, B0); PG8_BAR; PG8_SCHED;
            PG8_STAGE(PG8_SB(0, 1), b2 + hstep, voffB);
            PG8_WAIT_V(6); PG8_BAR; PG8_MMA(1, 1, At, B1); PG8_BAR;
            PG8_LDB(B0, 1, 0); PG8_SCHED; PG8_LDA(At, 1, 0); PG8_STAGE(PG8_SA(0, 1), a2 + hstep, voffA);
            PG8_WAIT_L(8); PG8_BAR; PG8_WAIT_L(0); PG8_MMA(0, 0, At, B0); PG8_BAR; PG8_SCHED;
            PG8_LDB(B1, 1, 1); PG8_STAGE(PG8_SB(1, 0), b3, voffB);
            PG8_BAR; PG8_WAIT_L(0); PG8_MMA(0, 1, At, B1); PG8_BAR;
            PG8_LDA(At, 1, 1); PG8_STAGE(PG8_SA(1, 0), a3, voffA);
            PG8_BAR; PG8_WAIT_L(0); PG8_MMA(1, 0, At, B0); PG8_BAR; PG8_SCHED;
            PG8_STAGE(PG8_SB(1, 1), b3 + hstep, voffB);
            PG8_WAIT_V(6); PG8_BAR; PG8_MMA(1, 1, At, B1); PG8_BAR;
            }
        }
        if constexpr (ALIGN_EPI) { if (wr == 0) PG8_BAR; }
        if constexpr (!Epi::AFTER_DRAIN) { E(acc, cur, wr, wc, fr, fq); S.done(cur); }
        if (!has_next) break;
#pragma unroll
        for (int a = 0; a < 2; ++a)
#pragma unroll
            for (int b = 0; b < 2; ++b)
#pragma unroll
                for (int m = 0; m < 4; ++m)
#pragma unroll
                    for (int n = 0; n < 2; ++n) acc[a][b][m][n] = (f32x4){0.f, 0.f, 0.f, 0.f};
        cur = nxt; cA = nA; cB = nB; ++ui;
        if constexpr (ALIGN_EPI) { if (wr == 1) PG8_BAR; }
    }
    PG8_WAIT_V(0);
    if constexpr (!ALIGN_EPI) { if (wr == 0) PG8_BAR; }
    PG8_BAR;
    if constexpr (Epi::AFTER_DRAIN) { E.fused(acc, cur, wr, wc, fr, fq, lds, wid, lane); S.done(cur); }
#undef PG8_SA
#undef PG8_SB
#undef PG8_STAGE
#undef PG8_LDA
#undef PG8_LDB
#undef PG8_MMA
#undef PG8_WAIT_V
#undef PG8_WAIT_L
#undef PG8_BAR
#undef PG8_SCHED
}
}

constexpr int NWAVES = 8;
constexpr int DM = 1024, BATCH = 4, SEQ = 8192, MP = BATCH * SEQ, DEC_B = 128, DEC_T = 4, MS = DEC_B * DEC_T, MT = MP + MS;
constexpr int LRU_W = 512, NH = 8, NKV = 2, HD = 64, DFF = 2816, INW = 1792, WIN = 128, PAST = 16384;
constexpr int C_XL = 0, C_GATE = 512, C_Q = 1024, C_K = 1536, C_V = 1664;
constexpr int NCHUNK = 64, CHUNK = SEQ / NCHUNK;
constexpr float EPS = 1e-6f, LOG2E = 1.4426950408889634f;
constexpr size_t O_YP = 0, O_YS = 33554432, O_PH = 34078720, O_PC = 34080768, O_PK = 34086912, O_PV = 34152448, O_SH = 34217984, O_SC = 34283520, O_SK = 34480128, O_SV = 36577280, O_END = 38674432;
constexpr size_t MiB = 1u << 20;
constexpr size_t WS_CTL = 0, CTL_ZERO_BYTES = 1 * MiB;
constexpr size_t WS_WGU1 = 2 * MiB, WS_WD1 = 13 * MiB, WS_WIN = 19 * MiB, WS_WOUT = 23 * MiB, WS_WGU2 = 25 * MiB, WS_WD2 = 36 * MiB;
constexpr size_t WS_ROPE = 42 * MiB;
constexpr size_t WS_SSQ = 45 * MiB;
constexpr size_t WS_LSUM = 48 * MiB;
constexpr size_t WS_XB = 50 * MiB;
constexpr size_t WS_CAT = 115 * MiB;
constexpr size_t WS_PROJ = 180 * MiB;
constexpr size_t WS_H = 294 * MiB;
constexpr size_t WS_END = 473 * MiB;
constexpr int ROPE_ROWS = SEQ + DEC_T;
constexpr int CW_TMO = 0, CW_BAR = 4096;
constexpr int RING_OFF = 0, RING_BYTES = 131072;
constexpr int SCR_BYTES = 147456;
constexpr int LDSCTL_OFF = SCR_BYTES, MISC_OFF = LDSCTL_OFF + 64;
constexpr int LDS_BYTES = SCR_BYTES + 512;

#define GAS __attribute__((address_space(1)))
#define LAS __attribute__((address_space(3)))
typedef unsigned short bf16;
typedef unsigned v4u __attribute__((ext_vector_type(4)));
typedef unsigned v2u __attribute__((ext_vector_type(2)));
typedef float f32x4 __attribute__((ext_vector_type(4)));
typedef float f32x16 __attribute__((ext_vector_type(16)));
typedef short bf16x8 __attribute__((ext_vector_type(8)));
typedef GAS unsigned gu32;
#define RLX_AGENT __ATOMIC_RELAXED, __HIP_MEMORY_SCOPE_AGENT
#define LDS_WAIT() asm volatile("s_waitcnt lgkmcnt(0)" ::: "memory")
#define VM_WAIT() asm volatile("s_waitcnt vmcnt(0)" ::: "memory")
__device__ __forceinline__ unsigned f2bf(float f) { unsigned u = __builtin_bit_cast(unsigned, f); return (u + 0x7fffu + ((u >> 16) & 1u)) >> 16; }
__device__ __forceinline__ unsigned pk2(float lo, float hi) { return f2bf(lo) | (f2bf(hi) << 16); }
__device__ __forceinline__ float bflo(unsigned w) { return __builtin_bit_cast(float, w << 16); }
__device__ __forceinline__ float bfhi(unsigned w) { return __builtin_bit_cast(float, w & 0xffff0000u); }
__device__ __forceinline__ float bf1(bf16 v) { return __builtin_bit_cast(float, (unsigned)v << 16); }
typedef float f32x2_t __attribute__((ext_vector_type(2))); typedef __bf16 bf16x2_t __attribute__((ext_vector_type(2)));
__device__ __forceinline__ unsigned cvtpk(float lo, float hi) { f32x2_t v = {lo, hi}; bf16x2_t b = __builtin_convertvector(v, bf16x2_t); return __builtin_bit_cast(unsigned, b); }
__device__ __forceinline__ float wave_sum(float v) {
#pragma unroll
    for (int o = 1; o < 64; o <<= 1) v += __shfl_xor(v, o);
    return v;
}
__device__ __forceinline__ float wave_max(float v) {
#pragma unroll
    for (int o = 1; o < 64; o <<= 1) v = fmaxf(v, __shfl_xor(v, o));
    return v;
}
__device__ __forceinline__ float sigmoid_f(float x) { return __builtin_amdgcn_rcpf(1.0f + __builtin_amdgcn_exp2f(-x * LOG2E)); }
__device__ __forceinline__ float gelu_tanh(float x) {
    const float y = 0.7978845608028654f * (x + 0.044715f * x * x * x);
    const float e = __builtin_amdgcn_exp2f(2.0f * LOG2E * y);
    const float th = 1.0f - 2.0f * __builtin_amdgcn_rcpf(e + 1.0f);
    return 0.5f * x * (1.0f + th);
}
__device__ __forceinline__ float one_minus_exp(float t) {
    const float ser = -t * (1.0f + t * (0.5f + t * (0.16666667f + t * (0.041666668f + t * 0.0083333338f))));
    const float dir = 1.0f - __builtin_amdgcn_exp2f(t * LOG2E);
    return t > -0.25f ? ser : dir;
}
__device__ __forceinline__ float dot2bf(unsigned a, unsigned b, float c) { return __builtin_amdgcn_fdot2_f32_bf16(__builtin_bit_cast(bf16x2_t, a), __builtin_bit_cast(bf16x2_t, b), c, false); }
#define XB_TMO      128
#define XB_XCNT(j)  (256  + 64 * (j))
#define XB_XSUB(j)  (1280 + 64 * (j))
#define XB_XGEN(j)  (2304 + 64 * (j))
#define XB_TOP      3328
#define XB_TOPGEN   3392
#define XCD_BAR_WORDS 3456
#define XB_SPIN_CAP (1u << 18)

__device__ __forceinline__ unsigned xb_ld(unsigned* p)              { return __hip_atomic_load(p, __ATOMIC_RELAXED, __HIP_MEMORY_SCOPE_AGENT); }
__device__ __forceinline__ unsigned xb_add(unsigned* p, unsigned v) { return __hip_atomic_fetch_add(p, v, __ATOMIC_RELAXED, __HIP_MEMORY_SCOPE_AGENT); }
__device__ __forceinline__ unsigned xb_xcc_id() { return (unsigned)__builtin_amdgcn_s_getreg((3 << 11) | 20) & 0xFu; }
#define XB_SPIN(cond, bar) do { unsigned _sp = 0; while (cond) { __builtin_amdgcn_s_sleep(1); \
    if ((++_sp & 255u) == 0u) { if (xb_ld(&(bar)[XB_TMO])) break; if (_sp > XB_SPIN_CAP) { atomicAdd(&(bar)[XB_TMO], 1u); break; } } } } while (0)

struct XcdBarrier {
    unsigned* bar; unsigned x;
    volatile LAS unsigned* st;
};

__device__ __forceinline__ XcdBarrier xcd_barrier_post(unsigned* bar, volatile LAS unsigned* st) {
    XcdBarrier b; b.bar = bar; b.x = xb_xcc_id(); b.st = st;
    if (threadIdx.x == 0) (void)xb_add(&bar[XB_XCNT(b.x)], 1u);
    return b;
}
__device__ __forceinline__ void xcd_barrier_complete(unsigned* bar, unsigned x, unsigned& nloc, unsigned& nx) {
    const unsigned G = gridDim.x * gridDim.y * gridDim.z;
    unsigned sum, cnt, mine, sp = 0u;
    for (;;) {
        sum = 0u; cnt = 0u; mine = 0u;
#pragma unroll
        for (unsigned j = 0; j < 16; ++j) { const unsigned c = xb_ld(&bar[XB_XCNT(j)]); sum += c; cnt += (c > 0u) ? 1u : 0u; mine = (j == x) ? c : mine; }
        if (sum == G) break;
        __builtin_amdgcn_s_sleep(1);
        if ((++sp & 255u) == 0u) { if (xb_ld(&bar[XB_TMO])) break; if (sp > XB_SPIN_CAP) { atomicAdd(&bar[XB_TMO], 1u); break; } }
    }
    nloc = mine > 0u ? mine : 1u; nx = cnt > 0u ? cnt : 1u;
}

__device__ __forceinline__ void xcd_barrier(const XcdBarrier& b) {
    asm volatile("s_waitcnt vmcnt(0)" ::: "memory");
    __syncthreads();
    if (threadIdx.x == 0) {
        unsigned* bar = b.bar;
        __builtin_amdgcn_s_waitcnt(0);
        unsigned nloc = b.st[0], nx = b.st[1];
        if (nloc == 0u) { xcd_barrier_complete(bar, b.x, nloc, nx); b.st[0] = nloc; b.st[1] = nx; }
        const unsigned old = xb_add(&bar[XB_XSUB(b.x)], 1u);
        const unsigned gen = old / nloc;
        if (old + 1u == (gen + 1u) * nloc) {
            __builtin_amdgcn_fence(__ATOMIC_RELEASE, "agent");
            asm volatile("s_waitcnt vmcnt(0)" ::: "memory");
            const unsigned og = xb_add(&bar[XB_TOP], 1u);
            const unsigned tg = og / nx;
            if (og + 1u == (tg + 1u) * nx) xb_add(&bar[XB_TOPGEN], 1u);
            else XB_SPIN(xb_ld(&bar[XB_TOPGEN]) == tg, bar);
            __builtin_amdgcn_fence(__ATOMIC_ACQUIRE, "agent");
            xb_add(&bar[XB_XGEN(b.x)], 1u);
            asm volatile("s_waitcnt vmcnt(0)" ::: "memory");
        } else {
            XB_SPIN(xb_ld(&bar[XB_XGEN(b.x)]) == gen, bar);
            __builtin_amdgcn_fence(__ATOMIC_ACQUIRE, "agent");
            asm volatile("s_waitcnt vmcnt(0)" ::: "memory");
        }
    }
    __syncthreads();
}

struct Frame {
    LAS unsigned char* lds;
    volatile LAS unsigned* MISC;
    gu32* ctl;
    int tid, lane, wave;
    int vcu, G;
    const float* in[29];
    float* out;
    bf16 *WGU1, *WD1, *WINT, *WOUT, *WGU2, *WD2;
    float *ROPEC, *ROPES, *SSQ, *LSUM;
    bf16 *XB, *CAT, *PROJ, *HB;
};
enum { I_XP = 0, I_XS, I_SH, I_SC, I_CK, I_CV, I_F1N, I_F1G, I_F1U, I_F1D, I_MN, I_WIN, I_CW, I_CB, I_WA, I_BA, I_WX, I_BX, I_LAM, I_QN, I_KN, I_SINK, I_LON, I_AON, I_WOUT, I_F2N, I_F2G, I_F2U, I_F2D };

template <int MODE> __device__ __forceinline__ void p0_transpose_item(const float* W, const float* gain, int K, int N, bf16* WT, LAS float* scr, int item, int lane) {
    const int nblk = N / 32, kb = item / nblk, nb = item % nblk, k0 = 64 * kb, n0 = 32 * nb;
#pragma unroll 8
    for (int i = 0; i < 32; ++i) { const int kk = 2 * i + (lane >> 5); float v = W[(size_t)(k0 + kk) * N + n0 + (lane & 31)]; if (gain) v *= gain[k0 + kk]; scr[kk * 33 + (lane & 31)] = v; }
    LDS_WAIT(); asm volatile("" ::: "memory");
    const int c = lane & 7;
    const int rb = (MODE == 0) ? n0 : ((n0 >> 7) * 256 + (MODE - 1) * 128 + (n0 & 127));
#pragma unroll
    for (int j = 0; j < 4; ++j) { const int n = (lane >> 3) + 8 * j; const LAS float* s = scr + (8 * c) * 33 + n;
        v4u o; o.x = pk2(s[0 * 33], s[1 * 33]); o.y = pk2(s[2 * 33], s[3 * 33]); o.z = pk2(s[4 * 33], s[5 * 33]); o.w = pk2(s[6 * 33], s[7 * 33]);
        *(GAS v4u*)(WT + (size_t)(rb + n) * K + k0 + 8 * c) = o; }
    LDS_WAIT(); asm volatile("" ::: "memory");
}
__device__ __forceinline__ void p0_row(Frame& F, const float* xrow, bf16* orow, float* ssq16) {
    const GAS f32x4* xr = (const GAS f32x4*)xrow + F.lane;
    f32x4 v[4]; float s = 0.f;
#pragma unroll
    for (int j = 0; j < 4; ++j) { v[j] = xr[64 * j]; s += (v[j].x * v[j].x + v[j].y * v[j].y) + (v[j].z * v[j].z + v[j].w * v[j].w); }
    s = wave_sum(s);
    GAS unsigned long long* o8 = (GAS unsigned long long*)orow + F.lane;
#pragma unroll
    for (int j = 0; j < 4; ++j) o8[64 * j] = (unsigned long long)pk2(v[j].x, v[j].y) | ((unsigned long long)pk2(v[j].z, v[j].w) << 32);
    if (F.lane < 16) ssq16[F.lane] = (F.lane == 0) ? s : 0.f;
}
__device__ __forceinline__ void p0_prologue(Frame& F) {
    LAS float* scr = (LAS float*)(F.lds + RING_OFF + F.wave * 16384);
    const int gw = F.vcu * NWAVES + F.wave, NGW = F.G * NWAVES;
    constexpr int I_GU = (DM / 64) * (DFF / 32), I_D = (DFF / 64) * (DM / 32), I_IN = (DM / 64) * (INW / 32), I_OUT = (DM / 64) * (DM / 32);
    constexpr int NITEMS = 4 * I_GU + 2 * I_D + I_IN + I_OUT;
    for (int it = gw; it < NITEMS; it += NGW) {
        int r = it;
        if (r < I_GU) { p0_transpose_item<1>(F.in[I_F1G], F.in[I_F1N], DM, DFF, F.WGU1, scr, r, F.lane); continue; } r -= I_GU;
        if (r < I_GU) { p0_transpose_item<2>(F.in[I_F1U], F.in[I_F1N], DM, DFF, F.WGU1, scr, r, F.lane); continue; } r -= I_GU;
        if (r < I_GU) { p0_transpose_item<1>(F.in[I_F2G], F.in[I_F2N], DM, DFF, F.WGU2, scr, r, F.lane); continue; } r -= I_GU;
        if (r < I_GU) { p0_transpose_item<2>(F.in[I_F2U], F.in[I_F2N], DM, DFF, F.WGU2, scr, r, F.lane); continue; } r -= I_GU;
        if (r < I_D) { p0_transpose_item<0>(F.in[I_F1D], nullptr, DFF, DM, F.WD1, scr, r, F.lane); continue; } r -= I_D;
        if (r < I_D) { p0_transpose_item<0>(F.in[I_F2D], nullptr, DFF, DM, F.WD2, scr, r, F.lane); continue; } r -= I_D;
        if (r < I_IN) { p0_transpose_item<0>(F.in[I_WIN], F.in[I_MN], DM, INW, F.WINT, scr, r, F.lane); continue; } r -= I_IN;
        p0_transpose_item<0>(F.in[I_WOUT], nullptr, DM, DM, F.WOUT, scr, r, F.lane);
    }
    for (int m = gw; m < MT; m += NGW) {
        const float* xr = (m < MP) ? F.in[I_XP] + (size_t)m * DM : F.in[I_XS] + (size_t)(m - MP) * DM;
        p0_row(F, xr, F.XB + (size_t)m * DM, F.SSQ + (size_t)m * 16);
    }
    const int gt = F.vcu * (NWAVES * 64) + F.tid, NGT = F.G * NWAVES * 64;
    for (int e = gt; e < ROPE_ROWS * 32; e += NGT) {
        const int pi = e >> 5, i = e & 31; const int pos = pi < SEQ ? pi : PAST + (pi - SEQ);
        const float invf = (float)exp(-(double)i * (9.210340371976184 / 32.0));
        const float ang = (float)pos * invf; const double a = (double)ang;
        F.ROPEC[e] = (float)cos(a); F.ROPES[e] = (float)sin(a);
    }
}

template <int PASS> __device__ __forceinline__ void lru_prompt_item(Frame& F, int item) {
    int c_ = F.tid; asm volatile("" : "+v"(c_));
    const int b = item / NCHUNK, chunk = item % NCHUNK, t0 = chunk * CHUNK, c = c_, blk = F.wave, cj = c & 63;
    LAS bf16* xcs = (LAS bf16*)F.lds;
    LAS float* outs = (LAS float*)(F.lds + 32 * 512 * 2);
    LAS float* rsv = outs + 32 * 512;
    const float cw0 = F.in[I_CW][c], cw1 = F.in[I_CW][512 + c], cw2 = F.in[I_CW][1024 + c], cw3 = F.in[I_CW][1536 + c], cb = F.in[I_CB][c];
    const float ba = F.in[I_BA][c], bx = F.in[I_BX][c];
    const float lam = F.in[I_LAM][c];
    const float c8 = -8.0f * (fmaxf(-lam, 0.f) + log1pf(expf(-fabsf(lam))));
    const float lon = F.in[I_LON][c];
    unsigned wab[32], wxb[32];
#pragma unroll
    for (int k = 0; k < 32; ++k) { wab[k] = pk2(F.in[I_WA][(blk * 64 + 2 * k) * 64 + cj], F.in[I_WA][(blk * 64 + 2 * k + 1) * 64 + cj]); wxb[k] = pk2(F.in[I_WX][(blk * 64 + 2 * k) * 64 + cj], F.in[I_WX][(blk * 64 + 2 * k + 1) * 64 + cj]); if ((k & 3) == 3) asm volatile("" ::: "memory"); }
    const bf16* prow = F.PROJ + (size_t)(b * SEQ + t0) * INW;
    float xm3 = 0.f, xm2 = 0.f, xm1 = 0.f;
    if (chunk > 0) { xm3 = bf1(prow[-3 * INW + c]); xm2 = bf1(prow[-2 * INW + c]); xm1 = bf1(prow[-1 * INW + c]); }
    float h = 0.f, P = 1.f;
    if (PASS == 2) {
        const float* ls = F.LSUM + ((size_t)b * NCHUNK * 512 + c) * 2;
#pragma unroll 8
        for (int j = 0; j < chunk; ++j) { const f32x2_t pe = *(const f32x2_t*)(ls + (size_t)j * 1024); h = pe.x * h + pe.y; }
    }
    for (int sub = 0; sub < CHUNK / 32; ++sub) {
        const bf16* pr = prow + (size_t)(sub * 32) * INW;
#pragma unroll 8
        for (int tt = 0; tt < 32; ++tt) {
            const float x = bf1(pr[(size_t)tt * INW + c]);
            xcs[tt * 512 + c] = (bf16)f2bf(cb + cw0 * xm3 + cw1 * xm2 + cw2 * xm1 + cw3 * x);
            xm3 = xm2; xm2 = xm1; xm1 = x;
        }
        __syncthreads();
        for (int tt = 0; tt < 32; ++tt) {
            float rp = ba, ip = bx;
            const LAS v4u* xb4 = (const LAS v4u*)(xcs + tt * 512 + blk * 64);
#pragma unroll
            for (int k8 = 0; k8 < 8; ++k8) { const v4u xv = xb4[k8];
                rp = dot2bf(xv.x, wab[4 * k8], rp); rp = dot2bf(xv.y, wab[4 * k8 + 1], rp); rp = dot2bf(xv.z, wab[4 * k8 + 2], rp); rp = dot2bf(xv.w, wab[4 * k8 + 3], rp);
                ip = dot2bf(xv.x, wxb[4 * k8], ip); ip = dot2bf(xv.y, wxb[4 * k8 + 1], ip); ip = dot2bf(xv.z, wxb[4 * k8 + 2], ip); ip = dot2bf(xv.w, wxb[4 * k8 + 3], ip); }
            const float r = sigmoid_f(rp), ig = sigmoid_f(ip);
            const float la = c8 * r, a = __builtin_amdgcn_exp2f(la * LOG2E);
            const float mult = __builtin_amdgcn_sqrtf(one_minus_exp(2.0f * la));
            const float u = mult * ig * bf1(xcs[tt * 512 + c]);
            h = a * h + u;
            if (PASS == 1) P *= a;
            if (PASS == 2) { const float g = bf1(pr[(size_t)tt * INW + C_GATE + c]); outs[tt * 512 + c] = h * gelu_tanh(g); }
        }
        if (PASS == 2) {
            __syncthreads();
#pragma unroll
            for (int q = 0; q < 4; ++q) { const int tt = 4 * F.wave + q; const LAS f32x4* o4 = (const LAS f32x4*)(outs + tt * 512) + F.lane;
                const f32x4 a0 = o4[0], a1 = o4[64];
                float s = (a0[0] * a0[0] + a0[1] * a0[1]) + (a0[2] * a0[2] + a0[3] * a0[3]) + (a1[0] * a1[0] + a1[1] * a1[1]) + (a1[2] * a1[2] + a1[3] * a1[3]);
                s = wave_sum(s); if (F.lane == 0) rsv[tt] = __builtin_amdgcn_rsqf(s * (1.0f / 512.0f) + EPS); }
            __syncthreads();
            bf16* crow = F.CAT + (size_t)(b * SEQ + t0 + sub * 32) * DM + c;
#pragma unroll 8
            for (int tt = 0; tt < 32; ++tt) crow[(size_t)tt * DM] = (bf16)f2bf(outs[tt * 512 + c] * rsv[tt] * lon);
        }
        __syncthreads();
    }
    if (PASS == 1) { *(f32x2_t*)(F.LSUM + (((size_t)b * NCHUNK + chunk) * 512 + c) * 2) = (f32x2_t){P, h}; }
    if (PASS == 2 && chunk == NCHUNK - 1) {
        F.out[O_PH + b * 512 + c] = h;
        F.out[O_PC + (b * 3 + 0) * 512 + c] = xm3; F.out[O_PC + (b * 3 + 1) * 512 + c] = xm2; F.out[O_PC + (b * 3 + 2) * 512 + c] = xm1;
    }
}

constexpr int KS_STRIDE = 144, KS_KVH = 256 * KS_STRIDE;
constexpr int VT_STRIDE = 528, VT_KVH = 64 * VT_STRIDE;
constexpr int AT_KS = 0, AT_VT = 2 * KS_KVH, AT_HS = AT_VT + 2 * VT_KVH, AT_END = AT_HS + 4 * 8 * 32 * 4;
static_assert(AT_END <= SCR_BYTES, "attention LDS");
__device__ __forceinline__ int vt_pos(int key) { const int o = key & 15; return (key & ~15) + 8 * ((o >> 2) & 1) + (o & 3) + 4 * (o >> 3); }
__device__ __forceinline__ void attn_prompt_item(Frame& F, int item) {
    const int b = item / (SEQ / WIN), blk = item % (SEQ / WIN);
    int tid_ = F.tid; asm volatile("" : "+v"(tid_));
    const int tid = tid_, lane = tid & 63, w = F.wave;
    LAS unsigned char* Ks = F.lds + AT_KS; LAS unsigned char* Vt = F.lds + AT_VT; LAS float* hs = (LAS float*)(F.lds + AT_HS);
    {
        const int key = tid & 255, kvh = tid >> 8, tb = blk * WIN - WIN + key;
        LAS unsigned char* krow = Ks + kvh * KS_KVH + key * KS_STRIDE;
        LAS bf16* vcol = (LAS bf16*)(Vt + kvh * VT_KVH) + vt_pos(key);
        if (tb >= 0) {
            const bf16* prow = F.PROJ + (size_t)(b * SEQ + tb) * INW;
            v4u kr[8], vr[8];
#pragma unroll
            for (int i = 0; i < 8; ++i) kr[i] = *(const v4u*)(prow + C_K + kvh * 64 + 8 * i);
            float kf[64]; float ss = 0.f;
#pragma unroll
            for (int i = 0; i < 8; ++i) { kf[8 * i + 0] = bflo(kr[i].x); kf[8 * i + 1] = bfhi(kr[i].x); kf[8 * i + 2] = bflo(kr[i].y); kf[8 * i + 3] = bfhi(kr[i].y);
                kf[8 * i + 4] = bflo(kr[i].z); kf[8 * i + 5] = bfhi(kr[i].z); kf[8 * i + 6] = bflo(kr[i].w); kf[8 * i + 7] = bfhi(kr[i].w); }
#pragma unroll
            for (int d = 0; d < 64; ++d) ss += kf[d] * kf[d];
            const float rs = __builtin_amdgcn_rsqf(ss * (1.0f / 64.0f) + EPS);
            const float* cs = F.ROPEC + (size_t)tb * 32; const float* sn = F.ROPES + (size_t)tb * 32; const float* kn = F.in[I_KN];
#pragma unroll
            for (int i = 0; i < 32; ++i) { const float x1 = kf[i] * rs * kn[i], x2 = kf[i + 32] * rs * kn[i + 32], cc = cs[i], sv = sn[i]; kf[i] = x1 * cc - x2 * sv; kf[i + 32] = x2 * cc + x1 * sv; }
#pragma unroll
            for (int i = 0; i < 8; ++i) { v4u o; o.x = cvtpk(kf[8 * i], kf[8 * i + 1]); o.y = cvtpk(kf[8 * i + 2], kf[8 * i + 3]); o.z = cvtpk(kf[8 * i + 4], kf[8 * i + 5]); o.w = cvtpk(kf[8 * i + 6], kf[8 * i + 7]);
                *(LAS v4u*)(krow + 16 * i) = o; }
            const bool lastw = (blk == SEQ / WIN - 1 && key >= WIN);
            if (lastw) { float* ok = F.out + O_PK + ((size_t)(b * WIN + key - WIN) * NKV + kvh) * HD;
#pragma unroll
                for (int i = 0; i < 16; ++i) *(f32x4*)(ok + 4 * i) = (f32x4){kf[4 * i], kf[4 * i + 1], kf[4 * i + 2], kf[4 * i + 3]}; }
            asm volatile("" ::: "memory");
#pragma unroll
            for (int i = 0; i < 8; ++i) vr[i] = *(const v4u*)(prow + C_V + kvh * 64 + 8 * i);
#pragma unroll
            for (int i = 0; i < 8; ++i) { const unsigned q4[4] = {vr[i].x, vr[i].y, vr[i].z, vr[i].w};
#pragma unroll
                for (int e = 0; e < 4; ++e) { vcol[(8 * i + 2 * e) * (VT_STRIDE / 2)] = (bf16)(q4[e] & 0xffffu); vcol[(8 * i + 2 * e + 1) * (VT_STRIDE / 2)] = (bf16)(q4[e] >> 16); } }
            if (lastw) { float* ov = F.out + O_PV + ((size_t)(b * WIN + key - WIN) * NKV + kvh) * HD;
#pragma unroll
                for (int i = 0; i < 8; ++i) { *(f32x4*)(ov + 8 * i) = (f32x4){bflo(vr[i].x), bfhi(vr[i].x), bflo(vr[i].y), bfhi(vr[i].y)}; *(f32x4*)(ov + 8 * i + 4) = (f32x4){bflo(vr[i].z), bfhi(vr[i].z), bflo(vr[i].w), bfhi(vr[i].w)}; }
            }
        } else {
#pragma unroll
            for (int i = 0; i < 8; ++i) *(LAS v4u*)(krow + 16 * i) = (v4u){0u, 0u, 0u, 0u};
#pragma unroll
            for (int d = 0; d < 64; ++d) vcol[d * (VT_STRIDE / 2)] = (bf16)0;
        }
    }
    __syncthreads();
    const int hh = lane >> 5, ql = lane & 31, kvh = w >> 2;
    const float sinkl2 = F.in[I_SINK][w] * LOG2E;
    const float QS = 0.125f * LOG2E;
    const float* qn = F.in[I_QN]; const float* aon = F.in[I_AON] + w * 64;
    for (int s = 0; s < 4; ++s) {
        const int qi = 32 * s + ql, t = blk * WIN + qi; const size_t row = (size_t)b * SEQ + t;
        bf16x8 qf[4];
        {
            const bf16* qp = F.PROJ + row * INW + C_Q + w * 64 + 8 * hh;
            float qv[4][8]; float ss = 0.f;
#pragma unroll
            for (int ds = 0; ds < 4; ++ds) { const v4u r4 = *(const v4u*)(qp + 16 * ds);
                qv[ds][0] = bflo(r4.x); qv[ds][1] = bfhi(r4.x); qv[ds][2] = bflo(r4.y); qv[ds][3] = bfhi(r4.y); qv[ds][4] = bflo(r4.z); qv[ds][5] = bfhi(r4.z); qv[ds][6] = bflo(r4.w); qv[ds][7] = bfhi(r4.w); }
#pragma unroll
            for (int ds = 0; ds < 4; ++ds)
#pragma unroll
                for (int j = 0; j < 8; ++j) ss += qv[ds][j] * qv[ds][j];
            ss += __shfl_xor(ss, 32);
            const float rs = __builtin_amdgcn_rsqf(ss * (1.0f / 64.0f) + EPS);
            const float* cs = F.ROPEC + (size_t)t * 32; const float* sn = F.ROPES + (size_t)t * 32;
#pragma unroll
            for (int ds = 0; ds < 2; ++ds)
#pragma unroll
                for (int j = 0; j < 8; ++j) { const int i = 16 * ds + 8 * hh + j; const float x1 = qv[ds][j] * rs * qn[i], x2 = qv[ds + 2][j] * rs * qn[i + 32], cc = cs[i], sv = sn[i];
                    qv[ds][j] = (x1 * cc - x2 * sv) * QS; qv[ds + 2][j] = (x2 * cc + x1 * sv) * QS; }
#pragma unroll
            for (int ds = 0; ds < 4; ++ds) { v4u o; o.x = cvtpk(qv[ds][0], qv[ds][1]); o.y = cvtpk(qv[ds][2], qv[ds][3]); o.z = cvtpk(qv[ds][4], qv[ds][5]); o.w = cvtpk(qv[ds][6], qv[ds][7]); qf[ds] = __builtin_bit_cast(bf16x8, o); }
        }
        f32x16 p[5];
#pragma unroll
        for (int kt = 0; kt < 5; ++kt) {
            const LAS unsigned char* kp = Ks + kvh * KS_KVH + (32 * (s + kt) + ql) * KS_STRIDE + 16 * hh;
            f32x16 acc = {0.f, 0.f, 0.f, 0.f, 0.f, 0.f, 0.f, 0.f, 0.f, 0.f, 0.f, 0.f, 0.f, 0.f, 0.f, 0.f};
#pragma unroll
            for (int ds = 0; ds < 4; ++ds) { const bf16x8 kfr = *(const LAS bf16x8*)(kp + 32 * ds); acc = __builtin_amdgcn_mfma_f32_32x32x16_bf16(kfr, qf[ds], acc, 0, 0, 0); }
            p[kt] = acc;
        }
        float mx = -INFINITY;
#pragma unroll
        for (int kt = 0; kt < 5; ++kt)
#pragma unroll
            for (int r = 0; r < 16; ++r) { const int kj = 32 * (s + kt) + (r & 3) + 8 * (r >> 2) + 4 * hh;
                const bool valid = (kj > qi) && (kj <= qi + WIN) && (blk > 0 || kj >= WIN);
                const float v = valid ? p[kt][r] : -INFINITY; p[kt][r] = v; mx = fmaxf(mx, v); }
        mx = fmaxf(mx, __shfl_xor(mx, 32)); mx = fmaxf(mx, sinkl2);
        float sum = 0.f;
#pragma unroll
        for (int kt = 0; kt < 5; ++kt)
#pragma unroll
            for (int r = 0; r < 16; ++r) { const float e = __builtin_amdgcn_exp2f(p[kt][r] - mx); p[kt][r] = e; sum += e; }
        sum += __shfl_xor(sum, 32);
        const float inv = __builtin_amdgcn_rcpf(sum + __builtin_amdgcn_exp2f(sinkl2 - mx));
        f32x16 o0 = {0.f, 0.f, 0.f, 0.f, 0.f, 0.f, 0.f, 0.f, 0.f, 0.f, 0.f, 0.f, 0.f, 0.f, 0.f, 0.f}, o1 = o0;
#pragma unroll
        for (int kt = 0; kt < 5; ++kt)
#pragma unroll
            for (int ss2 = 0; ss2 < 2; ++ss2) {
                v4u pw; pw.x = cvtpk(p[kt][8 * ss2 + 0], p[kt][8 * ss2 + 1]); pw.y = cvtpk(p[kt][8 * ss2 + 2], p[kt][8 * ss2 + 3]); pw.z = cvtpk(p[kt][8 * ss2 + 4], p[kt][8 * ss2 + 5]); pw.w = cvtpk(p[kt][8 * ss2 + 6], p[kt][8 * ss2 + 7]);
                const bf16x8 pf = __builtin_bit_cast(bf16x8, pw);
                const LAS unsigned char* vp = Vt + kvh * VT_KVH + ql * VT_STRIDE + (16 * (2 * (s + kt) + ss2) + 8 * hh) * 2;
                const bf16x8 v0 = *(const LAS bf16x8*)(vp), v1 = *(const LAS bf16x8*)(vp + 32 * VT_STRIDE);
                o0 = __builtin_amdgcn_mfma_f32_32x32x16_bf16(v0, pf, o0, 0, 0, 0);
                o1 = __builtin_amdgcn_mfma_f32_32x32x16_bf16(v1, pf, o1, 0, 0, 0);
            }
        float hsq = 0.f;
#pragma unroll
        for (int r = 0; r < 16; ++r) { o0[r] *= inv; o1[r] *= inv; hsq += o0[r] * o0[r] + o1[r] * o1[r]; }
        hsq += __shfl_xor(hsq, 32);
        if (hh == 0) hs[(s * 8 + w) * 32 + ql] = hsq;
        __syncthreads();
        float tot = 0.f;
#pragma unroll
        for (int w2 = 0; w2 < 8; ++w2) tot += hs[(s * 8 + w2) * 32 + ql];
        const float rsn = __builtin_amdgcn_rsqf(tot * (1.0f / 512.0f) + EPS);
        bf16* crow = F.CAT + row * DM + 512 + w * 64;
#pragma unroll
        for (int g = 0; g < 4; ++g) { const int d0 = 8 * g + 4 * hh;
            const f32x4 g0 = *(const f32x4*)(aon + d0), g1 = *(const f32x4*)(aon + 32 + d0);
            v2u a, c2; a.x = cvtpk(o0[4 * g] * rsn * g0[0], o0[4 * g + 1] * rsn * g0[1]); a.y = cvtpk(o0[4 * g + 2] * rsn * g0[2], o0[4 * g + 3] * rsn * g0[3]);
            c2.x = cvtpk(o1[4 * g] * rsn * g1[0], o1[4 * g + 1] * rsn * g1[1]); c2.y = cvtpk(o1[4 * g + 2] * rsn * g1[2], o1[4 * g + 3] * rsn * g1[3]);
            *(v2u*)(crow + d0) = a; *(v2u*)(crow + 32 + d0) = c2; }
    }
    __syncthreads();
}

constexpr int SK_ROW = 136, SK_KVH = 68;
constexpr int SM_KC = 0, SM_VC = 132 * SK_ROW * 4, SM_QS = SM_VC + 132 * 128 * 4, SM_HS = SM_QS + 8 * 64 * 4, SM_END = SM_HS + 64 * 4;
static_assert(SM_END <= SCR_BYTES, "sample LDS");
__device__ __forceinline__ void sample_item(Frame& F, int b) {
    int tid_ = F.tid; asm volatile("" : "+v"(tid_));
    const int tid = tid_, lane = tid & 63, w = F.wave;
    const size_t row0 = (size_t)MP + (size_t)b * DEC_T;
    {
        const int c = tid, blk = w, cj = c & 63;
        LAS float* xcs = (LAS float*)F.lds;
        LAS float* red = xcs + 4 * 512;
        const float cw0 = F.in[I_CW][c], cw1 = F.in[I_CW][512 + c], cw2 = F.in[I_CW][1024 + c], cw3 = F.in[I_CW][1536 + c], cb = F.in[I_CB][c];
        const float lam = F.in[I_LAM][c];
        const float c8 = -8.0f * (fmaxf(-lam, 0.f) + log1pf(expf(-fabsf(lam))));
        float xs[7];
#pragma unroll
        for (int j = 0; j < 3; ++j) xs[j] = F.in[I_SC][((size_t)b * 3 + j) * 512 + c];
#pragma unroll
        for (int t = 0; t < 4; ++t) xs[3 + t] = bf1(F.PROJ[(row0 + t) * INW + c]);
#pragma unroll
        for (int t = 0; t < 4; ++t) xcs[t * 512 + c] = cb + cw0 * xs[t] + cw1 * xs[t + 1] + cw2 * xs[t + 2] + cw3 * xs[t + 3];
        __syncthreads();
        float rp[4], ip[4];
#pragma unroll
        for (int t = 0; t < 4; ++t) { rp[t] = F.in[I_BA][c]; ip[t] = F.in[I_BX][c]; }
        for (int k = 0; k < 64; ++k) { const float wa = F.in[I_WA][(blk * 64 + k) * 64 + cj], wx = F.in[I_WX][(blk * 64 + k) * 64 + cj];
#pragma unroll
            for (int t = 0; t < 4; ++t) { const float xv = xcs[t * 512 + blk * 64 + k]; rp[t] += xv * wa; ip[t] += xv * wx; } }
        float h = F.in[I_SH][(size_t)b * 512 + c]; float ov[4];
#pragma unroll
        for (int t = 0; t < 4; ++t) {
            const float r = sigmoid_f(rp[t]), ig = sigmoid_f(ip[t]);
            const float la = c8 * r, a = __builtin_amdgcn_exp2f(la * LOG2E);
            const float mult = __builtin_amdgcn_sqrtf(one_minus_exp(2.0f * la));
            h = a * h + mult * ig * xcs[t * 512 + c];
            const float g = bf1(F.PROJ[(row0 + t) * INW + C_GATE + c]);
            ov[t] = h * gelu_tanh(g);
            const float s = wave_sum(ov[t] * ov[t]); if (lane == 0) red[t * 8 + w] = s;
        }
        F.out[O_SH + (size_t)b * 512 + c] = h;
#pragma unroll
        for (int j = 0; j < 3; ++j) F.out[O_SC + ((size_t)b * 3 + j) * 512 + c] = xs[4 + j];
        __syncthreads();
        const float lon = F.in[I_LON][c];
#pragma unroll
        for (int t = 0; t < 4; ++t) { float s = 0.f;
#pragma unroll
            for (int w2 = 0; w2 < 8; ++w2) s += red[t * 8 + w2];
            F.CAT[(row0 + t) * DM + c] = (bf16)f2bf(ov[t] * __builtin_amdgcn_rsqf(s * (1.0f / 512.0f) + EPS) * lon); }
        __syncthreads();
    }
    LAS float* Kc = (LAS float*)(F.lds + SM_KC); LAS float* Vc = (LAS float*)(F.lds + SM_VC); LAS float* qs = (LAS float*)(F.lds + SM_QS); LAS float* hs = (LAS float*)(F.lds + SM_HS);
    {
        const float* ck = F.in[I_CK] + (size_t)b * WIN * 128; const float* cv = F.in[I_CV] + (size_t)b * WIN * 128;
        float* ok = F.out + O_SK + (size_t)b * WIN * 128; float* ov = F.out + O_SV + (size_t)b * WIN * 128;
#pragma unroll
        for (int i = 0; i < 8; ++i) { const int idx = tid * 4 + 2048 * i, j = idx >> 7, rem = idx & 127;
            const f32x4 kv = *(const f32x4*)(ck + idx), vv = *(const f32x4*)(cv + idx);
            *(LAS f32x4*)(Kc + j * SK_ROW + (rem >> 6) * SK_KVH + (rem & 63)) = kv; *(LAS f32x4*)(Vc + j * 128 + rem) = vv;
            if (j >= DEC_T) { *(f32x4*)(ok + idx - DEC_T * 128) = kv; *(f32x4*)(ov + idx - DEC_T * 128) = vv; } }
        if (w < DEC_T) {
            const int t = w, kvh = lane >> 5, i = lane & 31;
            const bf16* pr = F.PROJ + (row0 + t) * INW;
            const float k1 = bf1(pr[C_K + kvh * 64 + i]), k2 = bf1(pr[C_K + kvh * 64 + 32 + i]);
            float ss = k1 * k1 + k2 * k2;
#pragma unroll
            for (int o = 1; o < 32; o <<= 1) ss += __shfl_xor(ss, o);
            const float rs = __builtin_amdgcn_rsqf(ss * (1.0f / 64.0f) + EPS);
            const float x1 = k1 * rs * F.in[I_KN][i], x2 = k2 * rs * F.in[I_KN][i + 32];
            const float cc = F.ROPEC[(size_t)(SEQ + t) * 32 + i], sv = F.ROPES[(size_t)(SEQ + t) * 32 + i];
            const float o1 = x1 * cc - x2 * sv, o2 = x2 * cc + x1 * sv;
            Kc[(WIN + t) * SK_ROW + kvh * SK_KVH + i] = o1; Kc[(WIN + t) * SK_ROW + kvh * SK_KVH + 32 + i] = o2;
            const float v1 = bf1(pr[C_V + kvh * 64 + i]), v2 = bf1(pr[C_V + kvh * 64 + 32 + i]);
            Vc[(WIN + t) * 128 + kvh * 64 + i] = v1; Vc[(WIN + t) * 128 + kvh * 64 + 32 + i] = v2;
            const size_t oo = ((size_t)(WIN - DEC_T + t) * NKV + kvh) * HD;
            ok[oo + i] = o1; ok[oo + 32 + i] = o2; ov[oo + i] = v1; ov[oo + 32 + i] = v2;
        }
    }
    __syncthreads();
    const int head = w, kvh = w >> 2;
    const float sinkl2 = F.in[I_SINK][head] * LOG2E;
    float osave[4];
#pragma unroll
    for (int t = 0; t < DEC_T; ++t) {
        {
            const float x = bf1(F.PROJ[(row0 + t) * INW + C_Q + head * 64 + lane]);
            const float ss = wave_sum(x * x);
            const float xn = x * __builtin_amdgcn_rsqf(ss * (1.0f / 64.0f) + EPS) * F.in[I_QN][lane];
            const float other = __shfl_xor(xn, 32);
            const int i = lane & 31; const float cc = F.ROPEC[(size_t)(SEQ + t) * 32 + i], sv = F.ROPES[(size_t)(SEQ + t) * 32 + i];
            const float qo = (lane < 32) ? (xn * cc - other * sv) : (xn * cc + other * sv);
            qs[w * 64 + lane] = qo * (0.125f * LOG2E);
        }
        LDS_WAIT(); asm volatile("" ::: "memory");
        const int j0 = t + 1 + lane, j1 = j0 + 64;
        float s0 = 0.f, s1 = 0.f;
        const LAS f32x4* q4 = (const LAS f32x4*)(qs + w * 64);
        const LAS f32x4* k0 = (const LAS f32x4*)(Kc + j0 * SK_ROW + kvh * SK_KVH); const LAS f32x4* k1 = (const LAS f32x4*)(Kc + j1 * SK_ROW + kvh * SK_KVH);
#pragma unroll
        for (int d4 = 0; d4 < 16; ++d4) { const f32x4 q = q4[d4], a = k0[d4], c = k1[d4];
            s0 += q[0] * a[0] + q[1] * a[1] + q[2] * a[2] + q[3] * a[3]; s1 += q[0] * c[0] + q[1] * c[1] + q[2] * c[2] + q[3] * c[3]; }
        float mx = wave_max(fmaxf(s0, s1)); mx = fmaxf(mx, sinkl2);
        const float p0 = __builtin_amdgcn_exp2f(s0 - mx), p1 = __builtin_amdgcn_exp2f(s1 - mx);
        const float l = wave_sum(p0 + p1) + __builtin_amdgcn_exp2f(sinkl2 - mx);
        float o = 0.f;
        for (int jj = 0; jj < 64; ++jj) {
            const float pa = __shfl(p0, jj), pb = __shfl(p1, jj);
            o += pa * Vc[(t + 1 + jj) * 128 + kvh * 64 + lane] + pb * Vc[(t + 65 + jj) * 128 + kvh * 64 + lane];
        }
        o *= __builtin_amdgcn_rcpf(l);
        osave[t] = o;
        const float hq = wave_sum(o * o); if (lane == 0) hs[t * 8 + w] = hq;
    }
    __syncthreads();
#pragma unroll
    for (int t = 0; t < DEC_T; ++t) { float s = 0.f;
#pragma unroll
        for (int w2 = 0; w2 < 8; ++w2) s += hs[t * 8 + w2];
        F.CAT[(row0 + t) * DM + 512 + head * 64 + lane] = (bf16)f2bf(osave[t] * __builtin_amdgcn_rsqf(s * (1.0f / 512.0f) + EPS) * F.in[I_AON][head * 64 + lane]); }
    __syncthreads();
}

#ifndef MK_N_LAUNCHES
#define MK_N_LAUNCHES 9
#endif
constexpr int N_PHASES = 9;
constexpr int N_LAUNCHES = MK_N_LAUNCHES;
struct Args { const float* in[29]; float* out; unsigned char* ws; int ph_lo, ph_hi, li, pad; };
__global__ void __launch_bounds__(NWAVES * 64, 2) hymba_fwd(Args args) {
    extern __shared__ __attribute__((aligned(16))) unsigned char lds[];
    Frame F;
    F.lds = (LAS unsigned char*)lds;
    F.MISC = (volatile LAS unsigned*)(F.lds + MISC_OFF);
    F.tid = threadIdx.x; F.lane = F.tid & 63; F.wave = __builtin_amdgcn_readfirstlane(F.tid >> 6);
    F.G = gridDim.x; { const int bx = blockIdx.x; F.vcu = (F.G % 8 == 0) ? (bx % 8) * (F.G / 8) + bx / 8 : bx; }
    unsigned char* ws = args.ws;
    F.ctl = (gu32*)(ws + WS_CTL);
#pragma unroll
    for (int i = 0; i < 29; ++i) F.in[i] = args.in[i];
    F.out = args.out;
    F.WGU1 = (bf16*)(ws + WS_WGU1); F.WD1 = (bf16*)(ws + WS_WD1); F.WINT = (bf16*)(ws + WS_WIN); F.WOUT = (bf16*)(ws + WS_WOUT); F.WGU2 = (bf16*)(ws + WS_WGU2); F.WD2 = (bf16*)(ws + WS_WD2);
    F.ROPEC = (float*)(ws + WS_ROPE); F.ROPES = F.ROPEC + ROPE_ROWS * 32; F.SSQ = (float*)(ws + WS_SSQ); F.LSUM = (float*)(ws + WS_LSUM);
    F.XB = (bf16*)(ws + WS_XB); F.CAT = (bf16*)(ws + WS_CAT); F.PROJ = (bf16*)(ws + WS_PROJ); F.HB = (bf16*)(ws + WS_H);
    for (int u = F.tid; u < (LDS_BYTES - LDSCTL_OFF) / 4; u += NWAVES * 64) ((LAS unsigned*)(F.lds + LDSCTL_OFF))[u] = 0u;
    __syncthreads();
    XcdBarrier bar; bar.bar = (unsigned*)(F.ctl + CW_BAR); bar.x = 0; bar.st = nullptr;
    if (N_LAUNCHES == 1) bar = xcd_barrier_post((unsigned*)(F.ctl + CW_BAR), F.MISC + 8);
#define GRID_BAR() do { if (N_LAUNCHES == 1) xcd_barrier(bar); } while (0)
    const int lo = args.ph_lo, hi = args.ph_hi;
#define IN(k) (lo <= (k) && (k) < hi)
#define BOTH(k) (IN(k) && IN((k) + 1))

#ifndef SKIP_P0
    if (IN(0)) { p0_prologue(F); if (BOTH(0)) GRID_BAR(); }
#endif
    if (IN(1)) {
        pg8::Gemm g{F.XB, F.WGU1, MT, 2 * DFF, DM}; pg8::StaticOrder S; S.init(MT, 2 * DFF, F.G, (int)blockIdx.x);
        pg8::EpiSwiglu E{F.HB, DFF, F.SSQ};
        pg8::gemm_phase<pg8::EpiSwiglu, pg8::StaticOrder, true, true>(F.lds + RING_OFF, g, S, E);
        if (BOTH(1)) GRID_BAR();
    }
    if (IN(2)) {
        pg8::Gemm g{F.HB, F.WD1, MT, DM, DFF}; pg8::StaticOrder S; S.init(MT, DM, F.G, (int)blockIdx.x);
        pg8::EpiResid<true> E{F.in[I_XP], F.in[I_XS], MP, F.out, F.XB, F.SSQ, 0.5f};
        pg8::gemm_phase<pg8::EpiResid<true>, pg8::StaticOrder, true, true>(F.lds + RING_OFF, g, S, E);
        if (BOTH(2)) GRID_BAR();
    }
    if (IN(3)) {
        pg8::Gemm g{F.XB, F.WINT, MT, INW, DM}; pg8::StaticOrder S; S.init(MT, INW, F.G, (int)blockIdx.x);
        pg8::EpiScaleBf16 E{F.PROJ, INW, F.SSQ};
        pg8::gemm_phase<pg8::EpiScaleBf16, pg8::StaticOrder, true, true>(F.lds + RING_OFF, g, S, E);
        if (BOTH(3)) GRID_BAR();
    }
    if (IN(4)) {
#ifndef SKIP_ATTN
        for (int it = blockIdx.x; it < BATCH * (SEQ / WIN); it += F.G) attn_prompt_item(F, it);
#endif
#ifndef SKIP_LRU1
        for (int it = blockIdx.x; it < BATCH * NCHUNK; it += F.G) lru_prompt_item<1>(F, it);
#endif
#ifndef SKIP_SAMPLE
        for (int it = blockIdx.x; it < DEC_B; it += F.G) sample_item(F, it);
#endif
        if (BOTH(4)) GRID_BAR();
    }
    if (IN(5)) {
#ifndef SKIP_LRU2
        for (int it = blockIdx.x; it < BATCH * NCHUNK; it += F.G) lru_prompt_item<2>(F, it);
#endif
        if (BOTH(5)) GRID_BAR();
    }
    if (IN(6)) {
        pg8::Gemm g{F.CAT, F.WOUT, MT, DM, DM}; pg8::StaticOrder S; S.init(MT, DM, F.G, (int)blockIdx.x);
        pg8::EpiResid<true> E{F.out, F.out, MT, F.out, F.XB, F.SSQ, 1.0f};
        pg8::gemm_phase<pg8::EpiResid<true>, pg8::StaticOrder, true, true>(F.lds + RING_OFF, g, S, E);
        if (BOTH(6)) GRID_BAR();
    }
    if (IN(7)) {
        pg8::Gemm g{F.XB, F.WGU2, MT, 2 * DFF, DM}; pg8::StaticOrder S; S.init(MT, 2 * DFF, F.G, (int)blockIdx.x);
        pg8::EpiSwiglu E{F.HB, DFF, F.SSQ};
        pg8::gemm_phase<pg8::EpiSwiglu, pg8::StaticOrder, true, true>(F.lds + RING_OFF, g, S, E);
        if (BOTH(7)) GRID_BAR();
    }
    if (IN(8)) {
        pg8::Gemm g{F.HB, F.WD2, MT, DM, DFF}; pg8::StaticOrder S; S.init(MT, DM, F.G, (int)blockIdx.x);
        pg8::EpiResid<false> E{F.out, F.out, MT, F.out, nullptr, nullptr, 0.5f};
        pg8::gemm_phase<pg8::EpiResid<false>, pg8::StaticOrder, true, true>(F.lds + RING_OFF, g, S, E);
    }
#undef IN
#undef BOTH
}

extern "C" void kernel_launch(void* const* d_in, const int* in_sizes, int n_in, void* d_out, int out_size, void* d_ws, size_t ws_size, hipStream_t stream) {
    static int grid = 0;
    if (grid == 0) {
        if (n_in != 29 || in_sizes[0] != MP * DM || (size_t)out_size != O_END || ws_size < WS_END) { fprintf(stderr, "kernel_launch: unexpected shapes (n_in %d in0 %d out %d ws %zu); nothing launched\n", n_in, n_in > 0 ? in_sizes[0] : -1, out_size, ws_size); grid = -1; return; }
        int dev = 0, cus = 0, per_cu = 0;
        if (hipGetDevice(&dev) != hipSuccess || hipDeviceGetAttribute(&cus, hipDeviceAttributeMultiprocessorCount, dev) != hipSuccess) { fprintf(stderr, "kernel_launch: device query failed\n"); grid = -1; return; }
        if (hipFuncSetAttribute((const void*)hymba_fwd, hipFuncAttributeMaxDynamicSharedMemorySize, LDS_BYTES) != hipSuccess) { fprintf(stderr, "kernel_launch: hipFuncSetAttribute failed\n"); grid = -1; return; }
        if (hipOccupancyMaxActiveBlocksPerMultiprocessor(&per_cu, (const void*)hymba_fwd, NWAVES * 64, LDS_BYTES) != hipSuccess || per_cu < 1) { fprintf(stderr, "kernel_launch: occupancy query reports %d workgroups per CU\n", per_cu); per_cu = 1; }
        (void)hipGetLastError();
        grid = cus;
    }
    if (grid < 0) return;
    if (hipMemsetAsync((char*)d_ws + WS_CTL, 0, CTL_ZERO_BYTES, stream) != hipSuccess) { fprintf(stderr, "kernel_launch: memset failed\n"); return; }
    Args a{};
    for (int i = 0; i < 29; ++i) a.in[i] = (const float*)d_in[i];
    a.out = (float*)d_out; a.ws = (unsigned char*)d_ws;
    if (N_LAUNCHES == 1) {
        a.ph_lo = 0; a.ph_hi = N_PHASES; a.li = 0;
        hipLaunchKernelGGL(hymba_fwd, dim3(grid), dim3(NWAVES * 64), LDS_BYTES, stream, a);
    } else {
        for (int li = 0; li < N_PHASES; ++li) { a.ph_lo = li; a.ph_hi = li + 1; a.li = li; hipLaunchKernelGGL(hymba_fwd, dim3(grid), dim3(NWAVES * 64), LDS_BYTES, stream, a); }
    }
    const hipError_t le = hipPeekAtLastError();
    if (le != hipSuccess) fprintf(stderr, "kernel_launch: launch failed: %s\n", hipGetErrorName(le));
}
```

```cpp
#include <hip/hip_runtime.h>
#include <cstdio>
#include <cstdint>
#include <cmath>
namespace pg8 {
#define PG8_LAS __attribute__((address_space(3)))
typedef unsigned short bf16_t;
typedef short bf16x8 __attribute__((ext_vector_type(8)));
typedef float f32x4 __attribute__((ext_vector_type(4)));
typedef unsigned u32x4 __attribute__((ext_vector_type(4)));
constexpr int BM = 256, BK = 64, HALF = 128, HTB = HALF * BK * 2  , STAGE_BYTES = 8 * HTB, NXCD = 8, WGM = 8;

__host__ __device__ __forceinline__ int lds_byte(int r, int c) { const int st = (r >> 4) * 2 + (c >> 5), rr = r & 15, cc = c & 31, ob = rr * 64 + cc * 2; return st * 1024 + (ob ^ (((ob >> 9) & 1) << 5)); }
__host__ __device__ __forceinline__ void stage_rc(int b, int& R, int& C) { const int st = b / 1024, sb = b % 1024, swz = sb ^ (((sb >> 9) & 1) << 5); R = (st >> 1) * 16 + swz / 64; C = (st & 1) * 32 + (swz % 64) / 2; }
__host__ __device__ __forceinline__ int perm32(int rho) { const int n = rho >> 4, i = rho & 15; return 8 * (i >> 2) + 4 * n + (i & 3); }

struct Unit { int pm, pn; };
struct Gemm { const bf16_t* A; const bf16_t* Bt; int M, N, K; };

struct StaticOrder {
    int nM, nN, nwg, G, c;
    __host__ __device__ void init(int M, int N, int G_, int c_) { nM = M / BM; nN = N / BM; nwg = nM * nN; G = G_; c = c_; }
    __host__ __device__ bool next(int i, Unit& u) const {
        const long L = (long)i * G + c; if (L >= nwg) return false;
        int wgid = (int)L; { const int q = nwg / NXCD, r = nwg % NXCD, xcd = wgid % NXCD, off = wgid / NXCD; wgid = (xcd < r ? xcd * (q + 1) : r * (q + 1) + (xcd - r) * q) + off; }
        const int nig = WGM * nN, gid = wgid / nig, fm = gid * WGM, gsz = (nM - fm) < WGM ? (nM - fm) : WGM;
        u.pm = fm + ((wgid % nig) % gsz); u.pn = (wgid % nig) / gsz; return true;
    }
    __device__ __forceinline__ void a_ready(const Unit&) const {}
    __device__ __forceinline__ void done(const Unit&) const {}
};

__device__ __forceinline__ unsigned cvt_pk_bf16(float lo, float hi) { unsigned r; asm volatile("v_cvt_pk_bf16_f32 %0, %1, %2" : "=v"(r) : "v"(lo), "v"(hi)); return r; }
typedef float f32x2 __attribute__((ext_vector_type(2)));
typedef unsigned u32x2 __attribute__((ext_vector_type(2)));
constexpr float RMS_EPS = 1e-6f;
__device__ __forceinline__ float row_rs(const float* ssq, int r) {
    const f32x4* p = (const f32x4*)(ssq + (size_t)r * 16);
    const f32x4 a = p[0], b = p[1], c = p[2], d = p[3];
    const float s = ((a[0] + a[1]) + (a[2] + a[3])) + ((b[0] + b[1]) + (b[2] + b[3])) + ((c[0] + c[1]) + (c[2] + c[3])) + ((d[0] + d[1]) + (d[2] + d[3]));
    return __builtin_amdgcn_rsqf(s * (1.0f / 1024.0f) + RMS_EPS);
}
__device__ __forceinline__ float silu_f(float g) { return g * __builtin_amdgcn_rcpf(1.0f + __builtin_amdgcn_exp2f(g * -1.4426950408889634f)); }

struct EpiSwiglu {
    static constexpr bool PERM = true, AFTER_DRAIN = false;
    bf16_t* H; int ldh; const float* ssq;
    __device__ __forceinline__ void operator()(const f32x4 (&acc)[2][2][4][2], const Unit& u, int wr, int wc, int fr, int fq) const {
        const int row0 = u.pm * BM + wr * 64 + fr, col0 = u.pn * HALF + wc * 32 + 8 * fq;
#pragma unroll
        for (int ai = 0; ai < 2; ++ai)
#pragma unroll
            for (int m = 0; m < 4; ++m) {
                const int r = row0 + ai * HALF + m * 16; const float rs = row_rs(ssq, r);
                float hv[8];
#pragma unroll
                for (int n = 0; n < 2; ++n)
#pragma unroll
                    for (int e = 0; e < 4; ++e) hv[n * 4 + e] = silu_f(acc[ai][0][m][n][e] * rs) * (acc[ai][1][m][n][e] * rs);
                u32x4 w; w.x = cvt_pk_bf16(hv[0], hv[1]); w.y = cvt_pk_bf16(hv[2], hv[3]); w.z = cvt_pk_bf16(hv[4], hv[5]); w.w = cvt_pk_bf16(hv[6], hv[7]);
                *(u32x4*)(H + (size_t)r * ldh + col0) = w;
            }
    }
};
struct EpiScaleBf16 {
    static constexpr bool PERM = true, AFTER_DRAIN = false;
    bf16_t* O; int ldc; const float* ssq;
    __device__ __forceinline__ void operator()(const f32x4 (&acc)[2][2][4][2], const Unit& u, int wr, int wc, int fr, int fq) const {
        const int row0 = u.pm * BM + wr * 64 + fr, col0 = u.pn * BM + wc * 32 + 8 * fq;
#pragma unroll
        for (int ai = 0; ai < 2; ++ai)
#pragma unroll
            for (int m = 0; m < 4; ++m) {
                const int r = row0 + ai * HALF + m * 16; const float rs = row_rs(ssq, r);
#pragma unroll
                for (int bj = 0; bj < 2; ++bj) {
                    const f32x4 v0 = acc[ai][bj][m][0] * rs, v1 = acc[ai][bj][m][1] * rs;
                    u32x4 w; w.x = cvt_pk_bf16(v0[0], v0[1]); w.y = cvt_pk_bf16(v0[2], v0[3]); w.z = cvt_pk_bf16(v1[0], v1[1]); w.w = cvt_pk_bf16(v1[2], v1[3]);
                    *(u32x4*)(O + (size_t)r * ldc + col0 + bj * HALF) = w;
                }
            }
    }
};
template <bool WITH_XB> struct EpiResid {
    static constexpr bool PERM = false, AFTER_DRAIN = false;
    const float* base0; const float* base1; int split; float* out; bf16_t* xb; float* ssq; float scale;
    __device__ __forceinline__ void operator()(const f32x4 (&acc)[2][2][4][2], const Unit& u, int wr, int wc, int fr, int fq) const {
        const int row0 = u.pm * BM + wr * 64 + fr, col0 = u.pn * BM + wc * 32 + 4 * fq;
        const float* bp = (u.pm * BM < split) ? base0 : base1 - (size_t)split * 1024;
#pragma unroll
        for (int ai = 0; ai < 2; ++ai)
#pragma unroll
            for (int m = 0; m < 4; ++m) {
                const int r = row0 + ai * HALF + m * 16; const size_t off = (size_t)r * 1024 + col0; float s = 0.f;
#pragma unroll
                for (int bj = 0; bj < 2; ++bj)
#pragma unroll
                    for (int n = 0; n < 2; ++n) {
                        const f32x4 b = *(const f32x4*)(bp + off + bj * HALF + n * 16);
                        const f32x4 o = b + acc[ai][bj][m][n] * scale;
                        *(f32x4*)(out + off + bj * HALF + n * 16) = o;
                        if (WITH_XB) { s += (o[0] * o[0] + o[1] * o[1]) + (o[2] * o[2] + o[3] * o[3]);
                            u32x2 w; w.x = cvt_pk_bf16(o[0], o[1]); w.y = cvt_pk_bf16(o[2], o[3]); *(u32x2*)(xb + off + bj * HALF + n * 16) = w; }
                    }
                if (WITH_XB) { s += __shfl_xor(s, 16); s += __shfl_xor(s, 32); if (fq == 0) ssq[(size_t)r * 16 + u.pn * 4 + wc] = s; }
            }
    }
};
template <class Epi, class Sched, bool ALIGN_EPI = false, bool SP2 = false>
__device__ __forceinline__ void gemm_phase(PG8_LAS unsigned char* lds, const Gemm g, const Sched& S, const Epi& E) {
    const int tid = threadIdx.x, wid = __builtin_amdgcn_readfirstlane(tid >> 6), lane = tid & 63, wr = wid >> 2, wc = wid & 3, fr = lane & 15, fq = lane >> 4;
    const int K = g.K, nt = K / BK;
    unsigned voffA[2], voffB[2];
#pragma unroll
    for (int i = 0; i < 2; ++i) { int R, C; stage_rc(tid * 16 + i * 8192, R, C); const int Rb = Epi::PERM ? ((R & ~31) + perm32(R & 31)) : R;
        voffA[i] = (unsigned)(R * K + C) * 2u; voffB[i] = (unsigned)(Rb * K + C) * 2u; }
    const size_t kstep = (size_t)(BK * 2);
    const size_t hstep = (size_t)HALF * K * 2;
    const size_t tstep = 2 * hstep;
    const unsigned ldsw = (unsigned)wid * 1024u;
    const int aoff = lds_byte(wr * 64 + fr, fq * 8), boff = lds_byte(wc * 32 + fr, fq * 8);
#define PG8_SA(b, h) (((b) * 2 + (h)) * HTB)
#define PG8_SB(b, h) ((4 + (b) * 2 + (h)) * HTB)
#define PG8_STAGE(bufoff, gbase, voff) do { _Pragma("unroll") for (int _i = 0; _i < 2; ++_i) \
        __builtin_amdgcn_global_load_lds((const unsigned*)((const char*)(gbase) + (voff)[_i]), (PG8_LAS unsigned*)(lds + (bufoff) + ldsw + _i * 8192), 16, 0, 0); } while (0)
#define PG8_LDA(dst, b, h) do { _Pragma("unroll") for (int m = 0; m < 4; ++m) _Pragma("unroll") for (int k = 0; k < 2; ++k) dst[m][k] = *(const PG8_LAS bf16x8*)(lds + PG8_SA(b, h) + aoff + m * 2048 + k * 1024); } while (0)
#define PG8_LDB(dst, b, h) do { _Pragma("unroll") for (int n = 0; n < 2; ++n) _Pragma("unroll") for (int k = 0; k < 2; ++k) dst[n][k] = *(const PG8_LAS bf16x8*)(lds + PG8_SB(b, h) + boff + n * 2048 + k * 1024); } while (0)
#define PG8_MMA(ai, bj, At, Bt) do { __builtin_amdgcn_s_setprio(1); _Pragma("unroll") for (int m = 0; m < 4; ++m) _Pragma("unroll") for (int n = 0; n < 2; ++n) _Pragma("unroll") for (int k = 0; k < 2; ++k) \
        acc[ai][bj][m][n] = __builtin_amdgcn_mfma_f32_16x16x32_bf16(Bt[n][k], At[m][k], acc[ai][bj][m][n], 0, 0, 0); __builtin_amdgcn_s_setprio(0); } while (0)
#define PG8_WAIT_V(n) asm volatile("s_waitcnt vmcnt(" #n ")" ::: "memory")
#define PG8_WAIT_L(n) asm volatile("s_waitcnt lgkmcnt(" #n ")" ::: "memory")
#define PG8_BAR __builtin_amdgcn_s_barrier()
#define PG8_SCHED __builtin_amdgcn_sched_barrier(0)
    Unit cur, nxt; int ui = 0;
    if (!S.next(0, cur)) return;
    f32x4 acc[2][2][4][2];
#pragma unroll
    for (int a = 0; a < 2; ++a)
#pragma unroll
        for (int b = 0; b < 2; ++b)
#pragma unroll
            for (int m = 0; m < 4; ++m)
#pragma unroll
                for (int n = 0; n < 2; ++n) acc[a][b][m][n] = (f32x4){0.f, 0.f, 0.f, 0.f};
    bf16x8 At[4][2], B0[2][2], B1[2][2];
    const char* cA = (const char*)g.A + (size_t)cur.pm * tstep; const char* cB = (const char*)g.Bt + (size_t)cur.pn * tstep;
    S.a_ready(cur);
    if constexpr (SP2) {
        PG8_STAGE(PG8_SB(0, 0), cB, voffB); PG8_STAGE(PG8_SB(0, 1), cB + hstep, voffB); PG8_STAGE(PG8_SA(0, 0), cA, voffA); PG8_STAGE(PG8_SA(0, 1), cA + hstep, voffA);
        if (wr == 1) PG8_BAR;
        PG8_WAIT_V(2); PG8_BAR;
        PG8_STAGE(PG8_SB(1, 0), cB + kstep, voffB); PG8_STAGE(PG8_SA(1, 0), cA + kstep, voffA); PG8_STAGE(PG8_SB(1, 1), cB + hstep + kstep, voffB);
        PG8_WAIT_V(6); PG8_BAR;
    } else {
        PG8_STAGE(PG8_SB(0, 0), cB, voffB); PG8_STAGE(PG8_SA(0, 0), cA, voffA); PG8_STAGE(PG8_SB(0, 1), cB + hstep, voffB); PG8_STAGE(PG8_SA(0, 1), cA + hstep, voffA);
        if (wr == 1) PG8_BAR;
        PG8_WAIT_V(4); PG8_BAR;
        PG8_STAGE(PG8_SB(1, 0), cB + kstep, voffB); PG8_STAGE(PG8_SA(1, 0), cA + kstep, voffA); PG8_STAGE(PG8_SB(1, 1), cB + hstep + kstep, voffB);
        PG8_WAIT_V(6); PG8_BAR;
    }
    for (;;) {
        const bool has_next = S.next(ui + 1, nxt);
        const char* nA = has_next ? (const char*)g.A + (size_t)nxt.pm * tstep : cA; const char* nB = has_next ? (const char*)g.Bt + (size_t)nxt.pn * tstep : cB;
        for (int t = 0; t < nt; t += 2) {
            const bool last = (t == nt - 2);
            const char* a1 = cA + (size_t)(t + 1) * kstep;
            const char* a2 = last ? nA : cA + (size_t)(t + 2) * kstep; const char* b2 = last ? nB : cB + (size_t)(t + 2) * kstep;
            const char* a3 = a2 + kstep; const char* b3 = b2 + kstep;
            if (last && has_next) S.a_ready(nxt);
            if constexpr (SP2) {
            PG8_LDB(B0, 0, 0); PG8_LDB(B1, 0, 1); PG8_SCHED; PG8_LDA(At, 0, 0); PG8_STAGE(PG8_SA(1, 1), a1 + hstep, voffA);
            PG8_WAIT_V(8); PG8_WAIT_L(0); PG8_BAR; PG8_MMA(0, 0, At, B0); PG8_MMA(0, 1, At, B1); PG8_BAR; PG8_SCHED;
            PG8_LDA(At, 0, 1); PG8_STAGE(PG8_SB(0, 0), b2, voffB); PG8_STAGE(PG8_SB(0, 1), b2 + hstep, voffB); PG8_STAGE(PG8_SA(0, 0), a2, voffA);
            PG8_WAIT_V(8); PG8_WAIT_L(0); PG8_BAR; PG8_MMA(1, 0, At, B0); PG8_MMA(1, 1, At, B1); PG8_BAR; PG8_SCHED;
            PG8_LDB(B0, 1, 0); PG8_LDB(B1, 1, 1); PG8_SCHED; PG8_LDA(At, 1, 0); PG8_STAGE(PG8_SA(0, 1), a2 + hstep, voffA);
            PG8_WAIT_V(8); PG8_WAIT_L(0); PG8_BAR; PG8_MMA(0, 0, At, B0); PG8_MMA(0, 1, At, B1); PG8_BAR; PG8_SCHED;
            PG8_LDA(At, 1, 1); PG8_STAGE(PG8_SB(1, 0), b3, voffB); PG8_STAGE(PG8_SB(1, 1), b3 + hstep, voffB); PG8_STAGE(PG8_SA(1, 0), a3, voffA);
            PG8_WAIT_V(8); PG8_WAIT_L(0); PG8_BAR; PG8_MMA(1, 0, At, B0); PG8_MMA(1, 1, At, B1); PG8_BAR; PG8_SCHED;
            } else {
            PG8_LDB(B0, 0, 0); PG8_SCHED; PG8_LDA(At, 0, 0); PG8_STAGE(PG8_SA(1, 1), a1 + hstep, voffA);
            PG8_WAIT_L(8); PG8_BAR; PG8_WAIT_L(0); PG8_MMA(0, 0, At, B0); PG8_BAR; PG8_SCHED;
            PG8_LDB(B1, 0, 1); PG8_STAGE(PG8_SB(0, 0), b2, voffB);
            PG8_BAR; PG8_WAIT_L(0); PG8_MMA(0, 1, At, B1); PG8_BAR;
            PG8_LDA(At, 0, 1); PG8_STAGE(PG8_SA(0, 0), a2, voffA);
            PG8_BAR; PG8_WAIT_L(0); PG8_MMA(1, 0, At, B0); PG8_BAR; PG8_SCHED;
            PG8_STAGE(PG8_SB(0, 1), b2 + hstep, voffB);
            PG8_WAIT_V(6); PG8_BAR; PG8_MMA(1, 1, At, B1); PG8_BAR;
            PG8_LDB(B0, 1, 0); PG8_SCHED; PG8_LDA(At, 1, 0); PG8_STAGE(PG8_SA(0, 1), a2 + hstep, voffA);
            PG8_WAIT_L(8); PG8_BAR; PG8_WAIT_L(0); PG8_MMA(0, 0, At, B0); PG8_BAR; PG8_SCHED;
            PG8_LDB(B1, 1, 1); PG8_STAGE(PG8_SB(1, 0), b3, voffB);
            PG8_BAR; PG8_WAIT_L(0); PG8_MMA(0, 1, At, B1); PG8_BAR;
            PG8_LDA(At, 1, 1); PG8_STAGE(PG8_SA(1, 0), a3, voffA);
            PG8_BAR; PG8_WAIT_L(0); PG8_MMA(1, 0, At, B0); PG8_BAR; PG8_SCHED;
            PG8_STAGE(PG8_SB(1, 1), b3 + hstep, voffB);
            PG8_WAIT_V(6); PG8_BAR; PG8_MMA(1, 1, At, B1); PG8_BAR;
            }
        }
        if constexpr (ALIGN_EPI) { if (wr == 0) PG8_BAR; }
        if constexpr (!Epi::AFTER_DRAIN) { E(acc, cur, wr, wc, fr, fq); S.done(cur); }
        if (!has_next) break;
#pragma unroll
        for (int a = 0; a < 2; ++a)
#pragma unroll
            for (int b = 0; b < 2; ++b)
#pragma unroll
                for (int m = 0; m < 4; ++m)
#pragma unroll
                    for (int n = 0; n < 2; ++n) acc[a][b][m][n] = (f32x4){0.f, 0.f, 0.f, 0.f};
        cur = nxt; cA = nA; cB = nB; ++ui;
        if constexpr (ALIGN_EPI) { if (wr == 1) PG8_BAR; }
    }
    PG8_WAIT_V(0);
    if constexpr (!ALIGN_EPI) { if (wr == 0) PG8_BAR; }
    PG8_BAR;
    if constexpr (Epi::AFTER_DRAIN) { E.fused(acc, cur, wr, wc, fr, fq, lds, wid, lane); S.done(cur); }
#undef PG8_SA
#undef PG8_SB
#undef PG8_STAGE
#undef PG8_LDA
#undef PG8_LDB
#undef PG8_MMA
#undef PG8_WAIT_V
#undef PG8_WAIT_L
#undef PG8_BAR
#undef PG8_SCHED
}
}

constexpr int NWAVES = 8;
constexpr int DM = 1024, BATCH = 4, SEQ = 8192, MP = BATCH * SEQ, DEC_B = 128, DEC_T = 4, MS = DEC_B * DEC_T, MT = MP + MS;
constexpr int LRU_W = 512, NH = 8, NKV = 2, HD = 64, DFF = 2816, INW = 1792, WIN = 128, PAST = 16384;
constexpr int C_XL = 0, C_GATE = 512, C_Q = 1024, C_K = 1536, C_V = 1664;
constexpr int NCHUNK = 64, CHUNK = SEQ / NCHUNK;
constexpr float EPS = 1e-6f, LOG2E = 1.4426950408889634f;
constexpr size_t O_YP = 0, O_YS = 33554432, O_PH = 34078720, O_PC = 34080768, O_PK = 34086912, O_PV = 34152448, O_SH = 34217984, O_SC = 34283520, O_SK = 34480128, O_SV = 36577280, O_END = 38674432;
constexpr size_t MiB = 1u << 20;
constexpr size_t WS_CTL = 0, CTL_ZERO_BYTES = 1 * MiB;
constexpr size_t WS_WGU1 = 2 * MiB, WS_WD1 = 13 * MiB, WS_WIN = 19 * MiB, WS_WOUT = 23 * MiB, WS_WGU2 = 25 * MiB, WS_WD2 = 36 * MiB;
constexpr size_t WS_ROPE = 42 * MiB;
constexpr size_t WS_SSQ = 45 * MiB;
constexpr size_t WS_LSUM = 48 * MiB;
constexpr size_t WS_XB = 50 * MiB;
constexpr size_t WS_CAT = 115 * MiB;
constexpr size_t WS_PROJ = 180 * MiB;
constexpr size_t WS_H = 294 * MiB;
constexpr size_t WS_END = 473 * MiB;
constexpr int ROPE_ROWS = SEQ + DEC_T;
constexpr int CW_TMO = 0, CW_BAR = 4096;
constexpr int RING_OFF = 0, RING_BYTES = 131072;
constexpr int SCR_BYTES = 147456;
constexpr int LDSCTL_OFF = SCR_BYTES, MISC_OFF = LDSCTL_OFF + 64;
constexpr int LDS_BYTES = SCR_BYTES + 512;

#define GAS __attribute__((address_space(1)))
#define LAS __attribute__((address_space(3)))
typedef unsigned short bf16;
typedef unsigned v4u __attribute__((ext_vector_type(4)));
typedef unsigned v2u __attribute__((ext_vector_type(2)));
typedef float f32x4 __attribute__((ext_vector_type(4)));
typedef float f32x16 __attribute__((ext_vector_type(16)));
typedef short bf16x8 __attribute__((ext_vector_type(8)));
typedef GAS unsigned gu32;
#define RLX_AGENT __ATOMIC_RELAXED, __HIP_MEMORY_SCOPE_AGENT
#define LDS_WAIT() asm volatile("s_waitcnt lgkmcnt(0)" ::: "memory")
#define VM_WAIT() asm volatile("s_waitcnt vmcnt(0)" ::: "memory")
__device__ __forceinline__ unsigned f2bf(float f) { unsigned u = __builtin_bit_cast(unsigned, f); return (u + 0x7fffu + ((u >> 16) & 1u)) >> 16; }
__device__ __forceinline__ unsigned pk2(float lo, float hi) { return f2bf(lo) | (f2bf(hi) << 16); }
__device__ __forceinline__ float bflo(unsigned w) { return __builtin_bit_cast(float, w << 16); }
__device__ __forceinline__ float bfhi(unsigned w) { return __builtin_bit_cast(float, w & 0xffff0000u); }
__device__ __forceinline__ float bf1(bf16 v) { return __builtin_bit_cast(float, (unsigned)v << 16); }
typedef float f32x2_t __attribute__((ext_vector_type(2))); typedef __bf16 bf16x2_t __attribute__((ext_vector_type(2)));
__device__ __forceinline__ unsigned cvtpk(float lo, float hi) { f32x2_t v = {lo, hi}; bf16x2_t b = __builtin_convertvector(v, bf16x2_t); return __builtin_bit_cast(unsigned, b); }
__device__ __forceinline__ float wave_sum(float v) {
#pragma unroll
    for (int o = 1; o < 64; o <<= 1) v += __shfl_xor(v, o);
    return v;
}
__device__ __forceinline__ float wave_max(float v) {
#pragma unroll
    for (int o = 1; o < 64; o <<= 1) v = fmaxf(v, __shfl_xor(v, o));
    return v;
}
__device__ __forceinline__ float sigmoid_f(float x) { return __builtin_amdgcn_rcpf(1.0f + __builtin_amdgcn_exp2f(-x * LOG2E)); }
__device__ __forceinline__ float gelu_tanh(float x) {
    const float y = 0.7978845608028654f * (x + 0.044715f * x * x * x);
    const float e = __builtin_amdgcn_exp2f(2.0f * LOG2E * y);
    const float th = 1.0f - 2.0f * __builtin_amdgcn_rcpf(e + 1.0f);
    return 0.5f * x * (1.0f + th);
}
__device__ __forceinline__ float one_minus_exp(float t) {
    const float ser = -t * (1.0f + t * (0.5f + t * (0.16666667f + t * (0.041666668f + t * 0.0083333338f))));
    const float dir = 1.0f - __builtin_amdgcn_exp2f(t * LOG2E);
    return t > -0.25f ? ser : dir;
}
__device__ __forceinline__ float dot2bf(unsigned a, unsigned b, float c) { return __builtin_amdgcn_fdot2_f32_bf16(__builtin_bit_cast(bf16x2_t, a), __builtin_bit_cast(bf16x2_t, b), c, false); }
#define XB_TMO      128
#define XB_XCNT(j)  (256  + 64 * (j))
#define XB_XSUB(j)  (1280 + 64 * (j))
#define XB_XGEN(j)  (2304 + 64 * (j))
#define XB_TOP      3328
#define XB_TOPGEN   3392
#define XCD_BAR_WORDS 3456
#define XB_SPIN_CAP (1u << 18)

__device__ __forceinline__ unsigned xb_ld(unsigned* p)              { return __hip_atomic_load(p, __ATOMIC_RELAXED, __HIP_MEMORY_SCOPE_AGENT); }
__device__ __forceinline__ unsigned xb_add(unsigned* p, unsigned v) { return __hip_atomic_fetch_add(p, v, __ATOMIC_RELAXED, __HIP_MEMORY_SCOPE_AGENT); }
__device__ __forceinline__ unsigned xb_xcc_id() { return (unsigned)__builtin_amdgcn_s_getreg((3 << 11) | 20) & 0xFu; }
#define XB_SPIN(cond, bar) do { unsigned _sp = 0; while (cond) { __builtin_amdgcn_s_sleep(1); \
    if ((++_sp & 255u) == 0u) { if (xb_ld(&(bar)[XB_TMO])) break; if (_sp > XB_SPIN_CAP) { atomicAdd(&(bar)[XB_TMO], 1u); break; } } } } while (0)

struct XcdBarrier {
    unsigned* bar; unsigned x;
    volatile LAS unsigned* st;
};

__device__ __forceinline__ XcdBarrier xcd_barrier_post(unsigned* bar, volatile LAS unsigned* st) {
    XcdBarrier b; b.bar = bar; b.x = xb_xcc_id(); b.st = st;
    if (threadIdx.x == 0) (void)xb_add(&bar[XB_XCNT(b.x)], 1u);
    return b;
}
__device__ __forceinline__ void xcd_barrier_complete(unsigned* bar, unsigned x, unsigned& nloc, unsigned& nx) {
    const unsigned G = gridDim.x * gridDim.y * gridDim.z;
    unsigned sum, cnt, mine, sp = 0u;
    for (;;) {
        sum = 0u; cnt = 0u; mine = 0u;
#pragma unroll
        for (unsigned j = 0; j < 16; ++j) { const unsigned c = xb_ld(&bar[XB_XCNT(j)]); sum += c; cnt += (c > 0u) ? 1u : 0u; mine = (j == x) ? c : mine; }
        if (sum == G) break;
        __builtin_amdgcn_s_sleep(1);
        if ((++sp & 255u) == 0u) { if (xb_ld(&bar[XB_TMO])) break; if (sp > XB_SPIN_CAP) { atomicAdd(&bar[XB_TMO], 1u); break; } }
    }
    nloc = mine > 0u ? mine : 1u; nx = cnt > 0u ? cnt : 1u;
}

__device__ __forceinline__ void xcd_barrier(const XcdBarrier& b) {
    asm volatile("s_waitcnt vmcnt(0)" ::: "memory");
    __syncthreads();
    if (threadIdx.x == 0) {
        unsigned* bar = b.bar;
        __builtin_amdgcn_s_waitcnt(0);
        unsigned nloc = b.st[0], nx = b.st[1];
        if (nloc == 0u) { xcd_barrier_complete(bar, b.x, nloc, nx); b.st[0] = nloc; b.st[1] = nx; }
        const unsigned old = xb_add(&bar[XB_XSUB(b.x)], 1u);
        const unsigned gen = old / nloc;
        if (old + 1u == (gen + 1u) * nloc) {
            __builtin_amdgcn_fence(__ATOMIC_RELEASE, "agent");
            asm volatile("s_waitcnt vmcnt(0)" ::: "memory");
            const unsigned og = xb_add(&bar[XB_TOP], 1u);
            const unsigned tg = og / nx;
            if (og + 1u == (tg + 1u) * nx) xb_add(&bar[XB_TOPGEN], 1u);
            else XB_SPIN(xb_ld(&bar[XB_TOPGEN]) == tg, bar);
            __builtin_amdgcn_fence(__ATOMIC_ACQUIRE, "agent");
            xb_add(&bar[XB_XGEN(b.x)], 1u);
            asm volatile("s_waitcnt vmcnt(0)" ::: "memory");
        } else {
            XB_SPIN(xb_ld(&bar[XB_XGEN(b.x)]) == gen, bar);
            __builtin_amdgcn_fence(__ATOMIC_ACQUIRE, "agent");
            asm volatile("s_waitcnt vmcnt(0)" ::: "memory");
        }
    }
    __syncthreads();
}

struct Frame {
    LAS unsigned char* lds;
    volatile LAS unsigned* MISC;
    gu32* ctl;
    int tid, lane, wave;
    int vcu, G;
    const float* in[29];
    float* out;
    bf16 *WGU1, *WD1, *WINT, *WOUT, *WGU2, *WD2;
    float *ROPEC, *ROPES, *SSQ, *LSUM;
    bf16 *XB, *CAT, *PROJ, *HB;
};
enum { I_XP = 0, I_XS, I_SH, I_SC, I_CK, I_CV, I_F1N, I_F1G, I_F1U, I_F1D, I_MN, I_WIN, I_CW, I_CB, I_WA, I_BA, I_WX, I_BX, I_LAM, I_QN, I_KN, I_SINK, I_LON, I_AON, I_WOUT, I_F2N, I_F2G, I_F2U, I_F2D };

template <int MODE> __device__ __forceinline__ void p0_transpose_item(const float* W, const float* gain, int K, int N, bf16* WT, LAS float* scr, int item, int lane) {
    const int nblk = N / 32, kb = item / nblk, nb = item % nblk, k0 = 64 * kb, n0 = 32 * nb;
#pragma unroll 8
    for (int i = 0; i < 32; ++i) { const int kk = 2 * i + (lane >> 5); float v = W[(size_t)(k0 + kk) * N + n0 + (lane & 31)]; if (gain) v *= gain[k0 + kk]; scr[kk * 33 + (lane & 31)] = v; }
    LDS_WAIT(); asm volatile("" ::: "memory");
    const int c = lane & 7;
    const int rb = (MODE == 0) ? n0 : ((n0 >> 7) * 256 + (MODE - 1) * 128 + (n0 & 127));
#pragma unroll
    for (int j = 0; j < 4; ++j) { const int n = (lane >> 3) + 8 * j; const LAS float* s = scr + (8 * c) * 33 + n;
        v4u o; o.x = pk2(s[0 * 33], s[1 * 33]); o.y = pk2(s[2 * 33], s[3 * 33]); o.z = pk2(s[4 * 33], s[5 * 33]); o.w = pk2(s[6 * 33], s[7 * 33]);
        *(GAS v4u*)(WT + (size_t)(rb + n) * K + k0 + 8 * c) = o; }
    LDS_WAIT(); asm volatile("" ::: "memory");
}
__device__ __forceinline__ void p0_row(Frame& F, const float* xrow, bf16* orow, float* ssq16) {
    const GAS f32x4* xr = (const GAS f32x4*)xrow + F.lane;
    f32x4 v[4]; float s = 0.f;
#pragma unroll
    for (int j = 0; j < 4; ++j) { v[j] = xr[64 * j]; s += (v[j].x * v[j].x + v[j].y * v[j].y) + (v[j].z * v[j].z + v[j].w * v[j].w); }
    s = wave_sum(s);
    GAS unsigned long long* o8 = (GAS unsigned long long*)orow + F.lane;
#pragma unroll
    for (int j = 0; j < 4; ++j) o8[64 * j] = (unsigned long long)pk2(v[j].x, v[j].y) | ((unsigned long long)pk2(v[j].z, v[j].w) << 32);
    if (F.lane < 16) ssq16[F.lane] = (F.lane == 0) ? s : 0.f;
}
__device__ __forceinline__ void p0_prologue(Frame& F) {
    LAS float* scr = (LAS float*)(F.lds + RING_OFF + F.wave * 16384);
    const int gw = F.vcu * NWAVES + F.wave, NGW = F.G * NWAVES;
    constexpr int I_GU = (DM / 64) * (DFF / 32), I_D = (DFF / 64) * (DM / 32), I_IN = (DM / 64) * (INW / 32), I_OUT = (DM / 64) * (DM / 32);
    constexpr int NITEMS = 4 * I_GU + 2 * I_D + I_IN + I_OUT;
    for (int it = gw; it < NITEMS; it += NGW) {
        int r = it;
        if (r < I_GU) { p0_transpose_item<1>(F.in[I_F1G], F.in[I_F1N], DM, DFF, F.WGU1, scr, r, F.lane); continue; } r -= I_GU;
        if (r < I_GU) { p0_transpose_item<2>(F.in[I_F1U], F.in[I_F1N], DM, DFF, F.WGU1, scr, r, F.lane); continue; } r -= I_GU;
        if (r < I_GU) { p0_transpose_item<1>(F.in[I_F2G], F.in[I_F2N], DM, DFF, F.WGU2, scr, r, F.lane); continue; } r -= I_GU;
        if (r < I_GU) { p0_transpose_item<2>(F.in[I_F2U], F.in[I_F2N], DM, DFF, F.WGU2, scr, r, F.lane); continue; } r -= I_GU;
        if (r < I_D) { p0_transpose_item<0>(F.in[I_F1D], nullptr, DFF, DM, F.WD1, scr, r, F.lane); continue; } r -= I_D;
        if (r < I_D) { p0_transpose_item<0>(F.in[I_F2D], nullptr, DFF, DM, F.WD2, scr, r, F.lane); continue; } r -= I_D;
        if (r < I_IN) { p0_transpose_item<0>(F.in[I_WIN], F.in[I_MN], DM, INW, F.WINT, scr, r, F.lane); continue; } r -= I_IN;
        p0_transpose_item<0>(F.in[I_WOUT], nullptr, DM, DM, F.WOUT, scr, r, F.lane);
    }
    for (int m = gw; m < MT; m += NGW) {
        const float* xr = (m < MP) ? F.in[I_XP] + (size_t)m * DM : F.in[I_XS] + (size_t)(m - MP) * DM;
        p0_row(F, xr, F.XB + (size_t)m * DM, F.SSQ + (size_t)m * 16);
    }
    const int gt = F.vcu * (NWAVES * 64) + F.tid, NGT = F.G * NWAVES * 64;
    for (int e = gt; e < ROPE_ROWS * 32; e += NGT) {
        const int pi = e >> 5, i = e & 31; const int pos = pi < SEQ ? pi : PAST + (pi - SEQ);
        const float invf = (float)exp(-(double)i * (9.210340371976184 / 32.0));
        const float ang = (float)pos * invf; const double a = (double)ang;
        F.ROPEC[e] = (float)cos(a); F.ROPES[e] = (float)sin(a);
    }
}

template <int PASS> __device__ __forceinline__ void lru_prompt_item(Frame& F, int item) {
    int c_ = F.tid; asm volatile("" : "+v"(c_));
    const int b = item / NCHUNK, chunk = item % NCHUNK, t0 = chunk * CHUNK, c = c_, blk = F.wave, cj = c & 63;
    LAS bf16* xcs = (LAS bf16*)F.lds;
    LAS float* outs = (LAS float*)(F.lds + 32 * 512 * 2);
    LAS float* rsv = outs + 32 * 512;
    const float cw0 = F.in[I_CW][c], cw1 = F.in[I_CW][512 + c], cw2 = F.in[I_CW][1024 + c], cw3 = F.in[I_CW][1536 + c], cb = F.in[I_CB][c];
    const float ba = F.in[I_BA][c], bx = F.in[I_BX][c];
    const float lam = F.in[I_LAM][c];
    const float c8 = -8.0f * (fmaxf(-lam, 0.f) + log1pf(expf(-fabsf(lam))));
    const float lon = F.in[I_LON][c];
    unsigned wab[32], wxb[32];
#pragma unroll
    for (int k = 0; k < 32; ++k) { wab[k] = pk2(F.in[I_WA][(blk * 64 + 2 * k) * 64 + cj], F.in[I_WA][(blk * 64 + 2 * k + 1) * 64 + cj]); wxb[k] = pk2(F.in[I_WX][(blk * 64 + 2 * k) * 64 + cj], F.in[I_WX][(blk * 64 + 2 * k + 1) * 64 + cj]); if ((k & 3) == 3) asm volatile("" ::: "memory"); }
    const bf16* prow = F.PROJ + (size_t)(b * SEQ + t0) * INW;
    float xm3 = 0.f, xm2 = 0.f, xm1 = 0.f;
    if (chunk > 0) { xm3 = bf1(prow[-3 * INW + c]); xm2 = bf1(prow[-2 * INW + c]); xm1 = bf1(prow[-1 * INW + c]); }
    float h = 0.f, P = 1.f;
    if (PASS == 2) {
        const float* ls = F.LSUM + ((size_t)b * NCHUNK * 512 + c) * 2;
#pragma unroll 8
        for (int j = 0; j < chunk; ++j) { const f32x2_t pe = *(const f32x2_t*)(ls + (size_t)j * 1024); h = pe.x * h + pe.y; }
    }
    for (int sub = 0; sub < CHUNK / 32; ++sub) {
        const bf16* pr = prow + (size_t)(sub * 32) * INW;
#pragma unroll 8
        for (int tt = 0; tt < 32; ++tt) {
            const float x = bf1(pr[(size_t)tt * INW + c]);
            xcs[tt * 512 + c] = (bf16)f2bf(cb + cw0 * xm3 + cw1 * xm2 + cw2 * xm1 + cw3 * x);
            xm3 = xm2; xm2 = xm1; xm1 = x;
        }
        __syncthreads();
        for (int tt = 0; tt < 32; ++tt) {
            float rp = ba, ip = bx;
            const LAS v4u* xb4 = (const LAS v4u*)(xcs + tt * 512 + blk * 64);
#pragma unroll
            for (int k8 = 0; k8 < 8; ++k8) { const v4u xv = xb4[k8];
                rp = dot2bf(xv.x, wab[4 * k8], rp); rp = dot2bf(xv.y, wab[4 * k8 + 1], rp); rp = dot2bf(xv.z, wab[4 * k8 + 2], rp); rp = dot2bf(xv.w, wab[4 * k8 + 3], rp);
                ip = dot2bf(xv.x, wxb[4 * k8], ip); ip = dot2bf(xv.y, wxb[4 * k8 + 1], ip); ip = dot2bf(xv.z, wxb[4 * k8 + 2], ip); ip = dot2bf(xv.w, wxb[4 * k8 + 3], ip); }
            const float r = sigmoid_f(rp), ig = sigmoid_f(ip);
            const float la = c8 * r, a = __builtin_amdgcn_exp2f(la * LOG2E);
            const float mult = __builtin_amdgcn_sqrtf(one_minus_exp(2.0f * la));
            const float u = mult * ig * bf1(xcs[tt * 512 + c]);
            h = a * h + u;
            if (PASS == 1) P *= a;
            if (PASS == 2) { const float g = bf1(pr[(size_t)tt * INW + C_GATE + c]); outs[tt * 512 + c] = h * gelu_tanh(g); }
        }
        if (PASS == 2) {
            __syncthreads();
#pragma unroll
            for (int q = 0; q < 4; ++q) { const int tt = 4 * F.wave + q; const LAS f32x4* o4 = (const LAS f32x4*)(outs + tt * 512) + F.lane;
                const f32x4 a0 = o4[0], a1 = o4[64];
                float s = (a0[0] * a0[0] + a0[1] * a0[1]) + (a0[2] * a0[2] + a0[3] * a0[3]) + (a1[0] * a1[0] + a1[1] * a1[1]) + (a1[2] * a1[2] + a1[3] * a1[3]);
                s = wave_sum(s); if (F.lane == 0) rsv[tt] = __builtin_amdgcn_rsqf(s * (1.0f / 512.0f) + EPS); }
            __syncthreads();
            bf16* crow = F.CAT + (size_t)(b * SEQ + t0 + sub * 32) * DM + c;
#pragma unroll 8
            for (int tt = 0; tt < 32; ++tt) crow[(size_t)tt * DM] = (bf16)f2bf(outs[tt * 512 + c] * rsv[tt] * lon);
        }
        __syncthreads();
    }
    if (PASS == 1) { *(f32x2_t*)(F.LSUM + (((size_t)b * NCHUNK + chunk) * 512 + c) * 2) = (f32x2_t){P, h}; }
    if (PASS == 2 && chunk == NCHUNK - 1) {
        F.out[O_PH + b * 512 + c] = h;
        F.out[O_PC + (b * 3 + 0) * 512 + c] = xm3; F.out[O_PC + (b * 3 + 1) * 512 + c] = xm2; F.out[O_PC + (b * 3 + 2) * 512 + c] = xm1;
    }
}

constexpr int KS_STRIDE = 144, KS_KVH = 256 * KS_STRIDE;
constexpr int VT_STRIDE = 528, VT_KVH = 64 * VT_STRIDE;
constexpr int AT_KS = 0, AT_VT = 2 * KS_KVH, AT_HS = AT_VT + 2 * VT_KVH, AT_END = AT_HS + 4 * 8 * 32 * 4;
static_assert(AT_END <= SCR_BYTES, "attention LDS");
__device__ __forceinline__ int vt_pos(int key) { const int o = key & 15; return (key & ~15) + 8 * ((o >> 2) & 1) + (o & 3) + 4 * (o >> 3); }
__device__ __forceinline__ void attn_prompt_item(Frame& F, int item) {
    const int b = item / (SEQ / WIN), blk = item % (SEQ / WIN);
    int tid_ = F.tid; asm volatile("" : "+v"(tid_));
    const int tid = tid_, lane = tid & 63, w = F.wave;
    LAS unsigned char* Ks = F.lds + AT_KS; LAS unsigned char* Vt = F.lds + AT_VT; LAS float* hs = (LAS float*)(F.lds + AT_HS);
    {
        const int key = tid & 255, kvh = tid >> 8, tb = blk * WIN - WIN + key;
        LAS unsigned char* krow = Ks + kvh * KS_KVH + key * KS_STRIDE;
        LAS bf16* vcol = (LAS bf16*)(Vt + kvh * VT_KVH) + vt_pos(key);
        if (tb >= 0) {
            const bf16* prow = F.PROJ + (size_t)(b * SEQ + tb) * INW;
            v4u kr[8], vr[8];
#pragma unroll
            for (int i = 0; i < 8; ++i) kr[i] = *(const v4u*)(prow + C_K + kvh * 64 + 8 * i);
            float kf[64]; float ss = 0.f;
#pragma unroll
            for (int i = 0; i < 8; ++i) { kf[8 * i + 0] = bflo(kr[i].x); kf[8 * i + 1] = bfhi(kr[i].x); kf[8 * i + 2] = bflo(kr[i].y); kf[8 * i + 3] = bfhi(kr[i].y);
                kf[8 * i + 4] = bflo(kr[i].z); kf[8 * i + 5] = bfhi(kr[i].z); kf[8 * i + 6] = bflo(kr[i].w); kf[8 * i + 7] = bfhi(kr[i].w); }
#pragma unroll
            for (int d = 0; d < 64; ++d) ss += kf[d] * kf[d];
            const float rs = __builtin_amdgcn_rsqf(ss * (1.0f / 64.0f) + EPS);
            const float* cs = F.ROPEC + (size_t)tb * 32; const float* sn = F.ROPES + (size_t)tb * 32; const float* kn = F.in[I_KN];
#pragma unroll
            for (int i = 0; i < 32; ++i) { const float x1 = kf[i] * rs * kn[i], x2 = kf[i + 32] * rs * kn[i + 32], cc = cs[i], sv = sn[i]; kf[i] = x1 * cc - x2 * sv; kf[i + 32] = x2 * cc + x1 * sv; }
#pragma unroll
            for (int i = 0; i < 8; ++i) { v4u o; o.x = cvtpk(kf[8 * i], kf[8 * i + 1]); o.y = cvtpk(kf[8 * i + 2], kf[8 * i + 3]); o.z = cvtpk(kf[8 * i + 4], kf[8 * i + 5]); o.w = cvtpk(kf[8 * i + 6], kf[8 * i + 7]);
                *(LAS v4u*)(krow + 16 * i) = o; }
            const bool lastw = (blk == SEQ / WIN - 1 && key >= WIN);
            if (lastw) { float* ok = F.out + O_PK + ((size_t)(b * WIN + key - WIN) * NKV + kvh) * HD;
#pragma unroll
                for (int i = 0; i < 16; ++i) *(f32x4*)(ok + 4 * i) = (f32x4){kf[4 * i], kf[4 * i + 1], kf[4 * i + 2], kf[4 * i + 3]}; }
            asm volatile("" ::: "memory");
#pragma unroll
            for (int i = 0; i < 8; ++i) vr[i] = *(const v4u*)(prow + C_V + kvh * 64 + 8 * i);
#pragma unroll
            for (int i = 0; i < 8; ++i) { const unsigned q4[4] = {vr[i].x, vr[i].y, vr[i].z, vr[i].w};
#pragma unroll
                for (int e = 0; e < 4; ++e) { vcol[(8 * i + 2 * e) * (VT_STRIDE / 2)] = (bf16)(q4[e] & 0xffffu); vcol[(8 * i + 2 * e + 1) * (VT_STRIDE / 2)] = (bf16)(q4[e] >> 16); } }
            if (lastw) { float* ov = F.out + O_PV + ((size_t)(b * WIN + key - WIN) * NKV + kvh) * HD;
#pragma unroll
                for (int i = 0; i < 8; ++i) { *(f32x4*)(ov + 8 * i) = (f32x4){bflo(vr[i].x), bfhi(vr[i].x), bflo(vr[i].y), bfhi(vr[i].y)}; *(f32x4*)(ov + 8 * i + 4) = (f32x4){bflo(vr[i].z), bfhi(vr[i].z), bflo(vr[i].w), bfhi(vr[i].w)}; }
            }
        } else {
#pragma unroll
            for (int i = 0; i < 8; ++i) *(LAS v4u*)(krow + 16 * i) = (v4u){0u, 0u, 0u, 0u};
#pragma unroll
            for (int d = 0; d < 64; ++d) vcol[d * (VT_STRIDE / 2)] = (bf16)0;
        }
    }
    __syncthreads();
    const int hh = lane >> 5, ql = lane & 31, kvh = w >> 2;
    const float sinkl2 = F.in[I_SINK][w] * LOG2E;
    const float QS = 0.125f * LOG2E;
    const float* qn = F.in[I_QN]; const float* aon = F.in[I_AON] + w * 64;
    for (int s = 0; s < 4; ++s) {
        const int qi = 32 * s + ql, t = blk * WIN + qi; const size_t row = (size_t)b * SEQ + t;
        bf16x8 qf[4];
        {
            const bf16* qp = F.PROJ + row * INW + C_Q + w * 64 + 8 * hh;
            float qv[4][8]; float ss = 0.f;
#pragma unroll
            for (int ds = 0; ds < 4; ++ds) { const v4u r4 = *(const v4u*)(qp + 16 * ds);
                qv[ds][0] = bflo(r4.x); qv[ds][1] = bfhi(r4.x); qv[ds][2] = bflo(r4.y); qv[ds][3] = bfhi(r4.y); qv[ds][4] = bflo(r4.z); qv[ds][5] = bfhi(r4.z); qv[ds][6] = bflo(r4.w); qv[ds][7] = bfhi(r4.w); }
#pragma unroll
            for (int ds = 0; ds < 4; ++ds)
#pragma unroll
                for (int j = 0; j < 8; ++j) ss += qv[ds][j] * qv[ds][j];
            ss += __shfl_xor(ss, 32);
            const float rs = __builtin_amdgcn_rsqf(ss * (1.0f / 64.0f) + EPS);
            const float* cs = F.ROPEC + (size_t)t * 32; const float* sn = F.ROPES + (size_t)t * 32;
#pragma unroll
            for (int ds = 0; ds < 2; ++ds)
#pragma unroll
                for (int j = 0; j < 8; ++j) { const int i = 16 * ds + 8 * hh + j; const float x1 = qv[ds][j] * rs * qn[i], x2 = qv[ds + 2][j] * rs * qn[i + 32], cc = cs[i], sv = sn[i];
                    qv[ds][j] = (x1 * cc - x2 * sv) * QS; qv[ds + 2][j] = (x2 * cc + x1 * sv) * QS; }
#pragma unroll
            for (int ds = 0; ds < 4; ++ds) { v4u o; o.x = cvtpk(qv[ds][0], qv[ds][1]); o.y = cvtpk(qv[ds][2], qv[ds][3]); o.z = cvtpk(qv[ds][4], qv[ds][5]); o.w = cvtpk(qv[ds][6], qv[ds][7]); qf[ds] = __builtin_bit_cast(bf16x8, o); }
        }
        f32x16 p[5];
#pragma unroll
        for (int kt = 0; kt < 5; ++kt) {
            const LAS unsigned char* kp = Ks + kvh * KS_KVH + (32 * (s + kt) + ql) * KS_STRIDE + 16 * hh;
            f32x16 acc = {0.f, 0.f, 0.f, 0.f, 0.f, 0.f, 0.f, 0.f, 0.f, 0.f, 0.f, 0.f, 0.f, 0.f, 0.f, 0.f};
#pragma unroll
            for (int ds = 0; ds < 4; ++ds) { const bf16x8 kfr = *(const LAS bf16x8*)(kp + 32 * ds); acc = __builtin_amdgcn_mfma_f32_32x32x16_bf16(kfr, qf[ds], acc, 0, 0, 0); }
            p[kt] = acc;
        }
        float mx = -INFINITY;
#pragma unroll
        for (int kt = 0; kt < 5; ++kt)
#pragma unroll
            for (int r = 0; r < 16; ++r) { const int kj = 32 * (s + kt) + (r & 3) + 8 * (r >> 2) + 4 * hh;
                const bool valid = (kj > qi) && (kj <= qi + WIN) && (blk > 0 || kj >= WIN);
                const float v = valid ? p[kt][r] : -INFINITY; p[kt][r] = v; mx = fmaxf(mx, v); }
        mx = fmaxf(mx, __shfl_xor(mx, 32)); mx = fmaxf(mx, sinkl2);
        float sum = 0.f;
#pragma unroll
        for (int kt = 0; kt < 5; ++kt)
#pragma unroll
            for (int r = 0; r < 16; ++r) { const float e = __builtin_amdgcn_exp2f(p[kt][r] - mx); p[kt][r] = e; sum += e; }
        sum += __shfl_xor(sum, 32);
        const float inv = __builtin_amdgcn_rcpf(sum + __builtin_amdgcn_exp2f(sinkl2 - mx));
        f32x16 o0 = {0.f, 0.f, 0.f, 0.f, 0.f, 0.f, 0.f, 0.f, 0.f, 0.f, 0.f, 0.f, 0.f, 0.f, 0.f, 0.f}, o1 = o0;
#pragma unroll
        for (int kt = 0; kt < 5; ++kt)
#pragma unroll
            for (int ss2 = 0; ss2 < 2; ++ss2) {
                v4u pw; pw.x = cvtpk(p[kt][8 * ss2 + 0], p[kt][8 * ss2 + 1]); pw.y = cvtpk(p[kt][8 * ss2 + 2], p[kt][8 * ss2 + 3]); pw.z = cvtpk(p[kt][8 * ss2 + 4], p[kt][8 * ss2 + 5]); pw.w = cvtpk(p[kt][8 * ss2 + 6], p[kt][8 * ss2 + 7]);
                const bf16x8 pf = __builtin_bit_cast(bf16x8, pw);
                const LAS unsigned char* vp = Vt + kvh * VT_KVH + ql * VT_STRIDE + (16 * (2 * (s + kt) + ss2) + 8 * hh) * 2;
                const bf16x8 v0 = *(const LAS bf16x8*)(vp), v1 = *(const LAS bf16x8*)(vp + 32 * VT_STRIDE);
                o0 = __builtin_amdgcn_mfma_f32_32x32x16_bf16(v0, pf, o0, 0, 0, 0);
                o1 = __builtin_amdgcn_mfma_f32_32x32x16_bf16(v1, pf, o1, 0, 0, 0);
            }
        float hsq = 0.f;
#pragma unroll
        for (int r = 0; r < 16; ++r) { o0[r] *= inv; o1[r] *= inv; hsq += o0[r] * o0[r] + o1[r] * o1[r]; }
        hsq += __shfl_xor(hsq, 32);
        if (hh == 0) hs[(s * 8 + w) * 32 + ql] = hsq;
        __syncthreads();
        float tot = 0.f;
#pragma unroll
        for (int w2 = 0; w2 < 8; ++w2) tot += hs[(s * 8 + w2) * 32 + ql];
        const float rsn = __builtin_amdgcn_rsqf(tot * (1.0f / 512.0f) + EPS);
        bf16* crow = F.CAT + row * DM + 512 + w * 64;
#pragma unroll
        for (int g = 0; g < 4; ++g) { const int d0 = 8 * g + 4 * hh;
            const f32x4 g0 = *(const f32x4*)(aon + d0), g1 = *(const f32x4*)(aon + 32 + d0);
            v2u a, c2; a.x = cvtpk(o0[4 * g] * rsn * g0[0], o0[4 * g + 1] * rsn * g0[1]); a.y = cvtpk(o0[4 * g + 2] * rsn * g0[2], o0[4 * g + 3] * rsn * g0[3]);
            c2.x = cvtpk(o1[4 * g] * rsn * g1[0], o1[4 * g + 1] * rsn * g1[1]); c2.y = cvtpk(o1[4 * g + 2] * rsn * g1[2], o1[4 * g + 3] * rsn * g1[3]);
            *(v2u*)(crow + d0) = a; *(v2u*)(crow + 32 + d0) = c2; }
    }
    __syncthreads();
}

constexpr int SK_ROW = 136, SK_KVH = 68;
constexpr int SM_KC = 0, SM_VC = 132 * SK_ROW * 4, SM_QS = SM_VC + 132 * 128 * 4, SM_HS = SM_QS + 8 * 64 * 4, SM_END = SM_HS + 64 * 4;
static_assert(SM_END <= SCR_BYTES, "sample LDS");
__device__ __forceinline__ void sample_item(Frame& F, int b) {
    int tid_ = F.tid; asm volatile("" : "+v"(tid_));
    const int tid = tid_, lane = tid & 63, w = F.wave;
    const size_t row0 = (size_t)MP + (size_t)b * DEC_T;
    {
        const int c = tid, blk = w, cj = c & 63;
        LAS float* xcs = (LAS float*)F.lds;
        LAS float* red = xcs + 4 * 512;
        const float cw0 = F.in[I_CW][c], cw1 = F.in[I_CW][512 + c], cw2 = F.in[I_CW][1024 + c], cw3 = F.in[I_CW][1536 + c], cb = F.in[I_CB][c];
        const float lam = F.in[I_LAM][c];
        const float c8 = -8.0f * (fmaxf(-lam, 0.f) + log1pf(expf(-fabsf(lam))));
        float xs[7];
#pragma unroll
        for (int j = 0; j < 3; ++j) xs[j] = F.in[I_SC][((size_t)b * 3 + j) * 512 + c];
#pragma unroll
        for (int t = 0; t < 4; ++t) xs[3 + t] = bf1(F.PROJ[(row0 + t) * INW + c]);
#pragma unroll
        for (int t = 0; t < 4; ++t) xcs[t * 512 + c] = cb + cw0 * xs[t] + cw1 * xs[t + 1] + cw2 * xs[t + 2] + cw3 * xs[t + 3];
        __syncthreads();
        float rp[4], ip[4];
#pragma unroll
        for (int t = 0; t < 4; ++t) { rp[t] = F.in[I_BA][c]; ip[t] = F.in[I_BX][c]; }
        for (int k = 0; k < 64; ++k) { const float wa = F.in[I_WA][(blk * 64 + k) * 64 + cj], wx = F.in[I_WX][(blk * 64 + k) * 64 + cj];
#pragma unroll
            for (int t = 0; t < 4; ++t) { const float xv = xcs[t * 512 + blk * 64 + k]; rp[t] += xv * wa; ip[t] += xv * wx; } }
        float h = F.in[I_SH][(size_t)b * 512 + c]; float ov[4];
#pragma unroll
        for (int t = 0; t < 4; ++t) {
            const float r = sigmoid_f(rp[t]), ig = sigmoid_f(ip[t]);
            const float la = c8 * r, a = __builtin_amdgcn_exp2f(la * LOG2E);
            const float mult = __builtin_amdgcn_sqrtf(one_minus_exp(2.0f * la));
            h = a * h + mult * ig * xcs[t * 512 + c];
            const float g = bf1(F.PROJ[(row0 + t) * INW + C_GATE + c]);
            ov[t] = h * gelu_tanh(g);
            const float s = wave_sum(ov[t] * ov[t]); if (lane == 0) red[t * 8 + w] = s;
        }
        F.out[O_SH + (size_t)b * 512 + c] = h;
#pragma unroll
        for (int j = 0; j < 3; ++j) F.out[O_SC + ((size_t)b * 3 + j) * 512 + c] = xs[4 + j];
        __syncthreads();
        const float lon = F.in[I_LON][c];
#pragma unroll
        for (int t = 0; t < 4; ++t) { float s = 0.f;
#pragma unroll
            for (int w2 = 0; w2 < 8; ++w2) s += red[t * 8 + w2];
            F.CAT[(row0 + t) * DM + c] = (bf16)f2bf(ov[t] * __builtin_amdgcn_rsqf(s * (1.0f / 512.0f) + EPS) * lon); }
        __syncthreads();
    }
    LAS float* Kc = (LAS float*)(F.lds + SM_KC); LAS float* Vc = (LAS float*)(F.lds + SM_VC); LAS float* qs = (LAS float*)(F.lds + SM_QS); LAS float* hs = (LAS float*)(F.lds + SM_HS);
    {
        const float* ck = F.in[I_CK] + (size_t)b * WIN * 128; const float* cv = F.in[I_CV] + (size_t)b * WIN * 128;
        float* ok = F.out + O_SK + (size_t)b * WIN * 128; float* ov = F.out + O_SV + (size_t)b * WIN * 128;
#pragma unroll
        for (int i = 0; i < 8; ++i) { const int idx = tid * 4 + 2048 * i, j = idx >> 7, rem = idx & 127;
            const f32x4 kv = *(const f32x4*)(ck + idx), vv = *(const f32x4*)(cv + idx);
            *(LAS f32x4*)(Kc + j * SK_ROW + (rem >> 6) * SK_KVH + (rem & 63)) = kv; *(LAS f32x4*)(Vc + j * 128 + rem) = vv;
            if (j >= DEC_T) { *(f32x4*)(ok + idx - DEC_T * 128) = kv; *(f32x4*)(ov + idx - DEC_T * 128) = vv; } }
        if (w < DEC_T) {
            const int t = w, kvh = lane >> 5, i = lane & 31;
            const bf16* pr = F.PROJ + (row0 + t) * INW;
            const float k1 = bf1(pr[C_K + kvh * 64 + i]), k2 = bf1(pr[C_K + kvh * 64 + 32 + i]);
            float ss = k1 * k1 + k2 * k2;
#pragma unroll
            for (int o = 1; o < 32; o <<= 1) ss += __shfl_xor(ss, o);
            const float rs = __builtin_amdgcn_rsqf(ss * (1.0f / 64.0f) + EPS);
            const float x1 = k1 * rs * F.in[I_KN][i], x2 = k2 * rs * F.in[I_KN][i + 32];
            const float cc = F.ROPEC[(size_t)(SEQ + t) * 32 + i], sv = F.ROPES[(size_t)(SEQ + t) * 32 + i];
            const float o1 = x1 * cc - x2 * sv, o2 = x2 * cc + x1 * sv;
            Kc[(WIN + t) * SK_ROW + kvh * SK_KVH + i] = o1; Kc[(WIN + t) * SK_ROW + kvh * SK_KVH + 32 + i] = o2;
            const float v1 = bf1(pr[C_V + kvh * 64 + i]), v2 = bf1(pr[C_V + kvh * 64 + 32 + i]);
            Vc[(WIN + t) * 128 + kvh * 64 + i] = v1; Vc[(WIN + t) * 128 + kvh * 64 + 32 + i] = v2;
            const size_t oo = ((size_t)(WIN - DEC_T + t) * NKV + kvh) * HD;
            ok[oo + i] = o1; ok[oo + 32 + i] = o2; ov[oo + i] = v1; ov[oo + 32 + i] = v2;
        }
    }
    __syncthreads();
    const int head = w, kvh = w >> 2;
    const float sinkl2 = F.in[I_SINK][head] * LOG2E;
    float osave[4];
#pragma unroll
    for (int t = 0; t < DEC_T; ++t) {
        {
            const float x = bf1(F.PROJ[(row0 + t) * INW + C_Q + head * 64 + lane]);
            const float ss = wave_sum(x * x);
            const float xn = x * __builtin_amdgcn_rsqf(ss * (1.0f / 64.0f) + EPS) * F.in[I_QN][lane];
            const float other = __shfl_xor(xn, 32);
            const int i = lane & 31; const float cc = F.ROPEC[(size_t)(SEQ + t) * 32 + i], sv = F.ROPES[(size_t)(SEQ + t) * 32 + i];
            const float qo = (lane < 32) ? (xn * cc - other * sv) : (xn * cc + other * sv);
            qs[w * 64 + lane] = qo * (0.125f * LOG2E);
        }
        LDS_WAIT(); asm volatile("" ::: "memory");
        const int j0 = t + 1 + lane, j1 = j0 + 64;
        float s0 = 0.f, s1 = 0.f;
        const LAS f32x4* q4 = (const LAS f32x4*)(qs + w * 64);
        const LAS f32x4* k0 = (const LAS f32x4*)(Kc + j0 * SK_ROW + kvh * SK_KVH); const LAS f32x4* k1 = (const LAS f32x4*)(Kc + j1 * SK_ROW + kvh * SK_KVH);
#pragma unroll
        for (int d4 = 0; d4 < 16; ++d4) { const f32x4 q = q4[d4], a = k0[d4], c = k1[d4];
            s0 += q[0] * a[0] + q[1] * a[1] + q[2] * a[2] + q[3] * a[3]; s1 += q[0] * c[0] + q[1] * c[1] + q[2] * c[2] + q[3] * c[3]; }
        float mx = wave_max(fmaxf(s0, s1)); mx = fmaxf(mx, sinkl2);
        const float p0 = __builtin_amdgcn_exp2f(s0 - mx), p1 = __builtin_amdgcn_exp2f(s1 - mx);
        const float l = wave_sum(p0 + p1) + __builtin_amdgcn_exp2f(sinkl2 - mx);
        float o = 0.f;
        for (int jj = 0; jj < 64; ++jj) {
            const float pa = __shfl(p0, jj), pb = __shfl(p1, jj);
            o += pa * Vc[(t + 1 + jj) * 128 + kvh * 64 + lane] + pb * Vc[(t + 65 + jj) * 128 + kvh * 64 + lane];
        }
        o *= __builtin_amdgcn_rcpf(l);
        osave[t] = o;
        const float hq = wave_sum(o * o); if (lane == 0) hs[t * 8 + w] = hq;
    }
    __syncthreads();
#pragma unroll
    for (int t = 0; t < DEC_T; ++t) { float s = 0.f;
#pragma unroll
        for (int w2 = 0; w2 < 8; ++w2) s += hs[t * 8 + w2];
        F.CAT[(row0 + t) * DM + 512 + head * 64 + lane] = (bf16)f2bf(osave[t] * __builtin_amdgcn_rsqf(s * (1.0f / 512.0f) + EPS) * F.in[I_AON][head * 64 + lane]); }
    __syncthreads();
}

#ifndef MK_N_LAUNCHES
#define MK_N_LAUNCHES 1
#endif
constexpr int N_PHASES = 9;
constexpr int N_LAUNCHES = MK_N_LAUNCHES;
struct Args { const float* in[29]; float* out; unsigned char* ws; int ph_lo, ph_hi, li, pad; };
__global__ void __launch_bounds__(NWAVES * 64, 2) hymba_fwd(Args args) {
    extern __shared__ __attribute__((aligned(16))) unsigned char lds[];
    Frame F;
    F.lds = (LAS unsigned char*)lds;
    F.MISC = (volatile LAS unsigned*)(F.lds + MISC_OFF);
    F.tid = threadIdx.x; F.lane = F.tid & 63; F.wave = __builtin_amdgcn_readfirstlane(F.tid >> 6);
    F.G = gridDim.x; { const int bx = blockIdx.x; F.vcu = (F.G % 8 == 0) ? (bx % 8) * (F.G / 8) + bx / 8 : bx; }
    unsigned char* ws = args.ws;
    F.ctl = (gu32*)(ws + WS_CTL);
#pragma unroll
    for (int i = 0; i < 29; ++i) F.in[i] = args.in[i];
    F.out = args.out;
    F.WGU1 = (bf16*)(ws + WS_WGU1); F.WD1 = (bf16*)(ws + WS_WD1); F.WINT = (bf16*)(ws + WS_WIN); F.WOUT = (bf16*)(ws + WS_WOUT); F.WGU2 = (bf16*)(ws + WS_WGU2); F.WD2 = (bf16*)(ws + WS_WD2);
    F.ROPEC = (float*)(ws + WS_ROPE); F.ROPES = F.ROPEC + ROPE_ROWS * 32; F.SSQ = (float*)(ws + WS_SSQ); F.LSUM = (float*)(ws + WS_LSUM);
    F.XB = (bf16*)(ws + WS_XB); F.CAT = (bf16*)(ws + WS_CAT); F.PROJ = (bf16*)(ws + WS_PROJ); F.HB = (bf16*)(ws + WS_H);
    for (int u = F.tid; u < (LDS_BYTES - LDSCTL_OFF) / 4; u += NWAVES * 64) ((LAS unsigned*)(F.lds + LDSCTL_OFF))[u] = 0u;
    __syncthreads();
    XcdBarrier bar; bar.bar = (unsigned*)(F.ctl + CW_BAR); bar.x = 0; bar.st = nullptr;
    if (N_LAUNCHES == 1) bar = xcd_barrier_post((unsigned*)(F.ctl + CW_BAR), F.MISC + 8);
#define GRID_BAR() do { if (N_LAUNCHES == 1) xcd_barrier(bar); } while (0)
    const int lo = args.ph_lo, hi = args.ph_hi;
#define IN(k) (lo <= (k) && (k) < hi)
#define BOTH(k) (IN(k) && IN((k) + 1))

#ifndef SKIP_P0
    if (IN(0)) { p0_prologue(F); if (BOTH(0)) GRID_BAR(); }
#endif
    if (IN(1)) {
        pg8::Gemm g{F.XB, F.WGU1, MT, 2 * DFF, DM}; pg8::StaticOrder S; S.init(MT, 2 * DFF, F.G, (int)blockIdx.x);
        pg8::EpiSwiglu E{F.HB, DFF, F.SSQ};
        pg8::gemm_phase<pg8::EpiSwiglu, pg8::StaticOrder, true, true>(F.lds + RING_OFF, g, S, E);
        if (BOTH(1)) GRID_BAR();
    }
    if (IN(2)) {
        pg8::Gemm g{F.HB, F.WD1, MT, DM, DFF}; pg8::StaticOrder S; S.init(MT, DM, F.G, (int)blockIdx.x);
        pg8::EpiResid<true> E{F.in[I_XP], F.in[I_XS], MP, F.out, F.XB, F.SSQ, 0.5f};
        pg8::gemm_phase<pg8::EpiResid<true>, pg8::StaticOrder, true, true>(F.lds + RING_OFF, g, S, E);
        if (BOTH(2)) GRID_BAR();
    }
    if (IN(3)) {
        pg8::Gemm g{F.XB, F.WINT, MT, INW, DM}; pg8::StaticOrder S; S.init(MT, INW, F.G, (int)blockIdx.x);
        pg8::EpiScaleBf16 E{F.PROJ, INW, F.SSQ};
        pg8::gemm_phase<pg8::EpiScaleBf16, pg8::StaticOrder, true, true>(F.lds + RING_OFF, g, S, E);
        if (BOTH(3)) GRID_BAR();
    }
    if (IN(4)) {
#ifndef SKIP_ATTN
        for (int it = blockIdx.x; it < BATCH * (SEQ / WIN); it += F.G) attn_prompt_item(F, it);
#endif
#ifndef SKIP_LRU1
        for (int it = blockIdx.x; it < BATCH * NCHUNK; it += F.G) lru_prompt_item<1>(F, it);
#endif
#ifndef SKIP_SAMPLE
        for (int it = blockIdx.x; it < DEC_B; it += F.G) sample_item(F, it);
#endif
        if (BOTH(4)) GRID_BAR();
    }
    if (IN(5)) {
#ifndef SKIP_LRU2
        for (int it = blockIdx.x; it < BATCH * NCHUNK; it += F.G) lru_prompt_item<2>(F, it);
#endif
        if (BOTH(5)) GRID_BAR();
    }
    if (IN(6)) {
        pg8::Gemm g{F.CAT, F.WOUT, MT, DM, DM}; pg8::StaticOrder S; S.init(MT, DM, F.G, (int)blockIdx.x);
        pg8::EpiResid<true> E{F.out, F.out, MT, F.out, F.XB, F.SSQ, 1.0f};
        pg8::gemm_phase<pg8::EpiResid<true>, pg8::StaticOrder, true, true>(F.lds + RING_OFF, g, S, E);
        if (BOTH(6)) GRID_BAR();
    }
    if (IN(7)) {
        pg8::Gemm g{F.XB, F.WGU2, MT, 2 * DFF, DM}; pg8::StaticOrder S; S.init(MT, 2 * DFF, F.G, (int)blockIdx.x);
        pg8::EpiSwiglu E{F.HB, DFF, F.SSQ};
        pg8::gemm_phase<pg8::EpiSwiglu, pg8::StaticOrder, true, true>(F.lds + RING_OFF, g, S, E);
        if (BOTH(7)) GRID_BAR();
    }
    if (IN(8)) {
        pg8::Gemm g{F.HB, F.WD2, MT, DM, DFF}; pg8::StaticOrder S; S.init(MT, DM, F.G, (int)blockIdx.x);
        pg8::EpiResid<false> E{F.out, F.out, MT, F.out, nullptr, nullptr, 0.5f};
        pg8::gemm_phase<pg8::EpiResid<false>, pg8::StaticOrder, true, true>(F.lds + RING_OFF, g, S, E);
    }
#undef IN
#undef BOTH
}

extern "C" void kernel_launch(void* const* d_in, const int* in_sizes, int n_in, void* d_out, int out_size, void* d_ws, size_t ws_size, hipStream_t stream) {
    static int grid = 0;
    if (grid == 0) {
        if (n_in != 29 || in_sizes[0] != MP * DM || (size_t)out_size != O_END || ws_size < WS_END) { fprintf(stderr, "kernel_launch: unexpected shapes (n_in %d in0 %d out %d ws %zu); nothing launched\n", n_in, n_in > 0 ? in_sizes[0] : -1, out_size, ws_size); grid = -1; return; }
        int dev = 0, cus = 0, per_cu = 0;
        if (hipGetDevice(&dev) != hipSuccess || hipDeviceGetAttribute(&cus, hipDeviceAttributeMultiprocessorCount, dev) != hipSuccess) { fprintf(stderr, "kernel_launch: device query failed\n"); grid = -1; return; }
        if (hipFuncSetAttribute((const void*)hymba_fwd, hipFuncAttributeMaxDynamicSharedMemorySize, LDS_BYTES) != hipSuccess) { fprintf(stderr, "kernel_launch: hipFuncSetAttribute failed\n"); grid = -1; return; }
        if (hipOccupancyMaxActiveBlocksPerMultiprocessor(&per_cu, (const void*)hymba_fwd, NWAVES * 64, LDS_BYTES) != hipSuccess || per_cu < 1) { fprintf(stderr, "kernel_launch: occupancy query reports %d workgroups per CU\n", per_cu); per_cu = 1; }
        (void)hipGetLastError();
        grid = cus;
    }
    if (grid < 0) return;
    if (hipMemsetAsync((char*)d_ws + WS_CTL, 0, CTL_ZERO_BYTES, stream) != hipSuccess) { fprintf(stderr, "kernel_launch: memset failed\n"); return; }
    Args a{};
    for (int i = 0; i < 29; ++i) a.in[i] = (const float*)d_in[i];
    a.out = (float*)d_out; a.ws = (unsigned char*)d_ws;
    if (N_LAUNCHES == 1) {
        a.ph_lo = 0; a.ph_hi = N_PHASES; a.li = 0;
        hipLaunchKernelGGL(hymba_fwd, dim3(grid), dim3(NWAVES * 64), LDS_BYTES, stream, a);
    } else {
        for (int li = 0; li < N_PHASES; ++li) { a.ph_lo = li; a.ph_hi = li + 1; a.li = li; hipLaunchKernelGGL(hymba_fwd, dim3(grid), dim3(NWAVES * 64), LDS_BYTES, stream, a); }
    }
    const hipError_t le = hipPeekAtLastError();
    if (le != hipSuccess) fprintf(stderr, "kernel_launch: launch failed: %s\n", hipGetErrorName(le));
}
```

```cpp
#include <hip/hip_runtime.h>
#include <cstdio>
#include <cstdint>
#include <cmath>
namespace pg8 {
#define PG8_LAS __attribute__((address_space(3)))
typedef unsigned short bf16_t;
typedef short bf16x8 __attribute__((ext_vector_type(8)));
typedef float f32x4 __attribute__((ext_vector_type(4)));
typedef unsigned u32x4 __attribute__((ext_vector_type(4)));
constexpr int BM = 256, BK = 64, HALF = 128, HTB = HALF * BK * 2  , STAGE_BYTES = 8 * HTB, NXCD = 8, WGM = 8;

__host__ __device__ __forceinline__ int lds_byte(int r, int c) { const int st = (r >> 4) * 2 + (c >> 5), rr = r & 15, cc = c & 31, ob = rr * 64 + cc * 2; return st * 1024 + (ob ^ (((ob >> 9) & 1) << 5)); }
__host__ __device__ __forceinline__ void stage_rc(int b, int& R, int& C) { const int st = b / 1024, sb = b % 1024, swz = sb ^ (((sb >> 9) & 1) << 5); R = (st >> 1) * 16 + swz / 64; C = (st & 1) * 32 + (swz % 64) / 2; }
__host__ __device__ __forceinline__ int perm32(int rho) { const int n = rho >> 4, i = rho & 15; return 8 * (i >> 2) + 4 * n + (i & 3); }

struct Unit { int pm, pn; };
struct Gemm { const bf16_t* A; const bf16_t* Bt; int M, N, K; };

struct StaticOrder {
    int nM, nN, nwg, G, c;
    __host__ __device__ void init(int M, int N, int G_, int c_) { nM = M / BM; nN = N / BM; nwg = nM * nN; G = G_; c = c_; }
    __host__ __device__ bool next(int i, Unit& u) const {
        const long L = (long)i * G + c; if (L >= nwg) return false;
        int wgid = (int)L; { const int q = nwg / NXCD, r = nwg % NXCD, xcd = wgid % NXCD, off = wgid / NXCD; wgid = (xcd < r ? xcd * (q + 1) : r * (q + 1) + (xcd - r) * q) + off; }
        const int nig = WGM * nN, gid = wgid / nig, fm = gid * WGM, gsz = (nM - fm) < WGM ? (nM - fm) : WGM;
        u.pm = fm + ((wgid % nig) % gsz); u.pn = (wgid % nig) / gsz; return true;
    }
    __device__ __forceinline__ void a_ready(const Unit&) const {}
    __device__ __forceinline__ void done(const Unit&) const {}
};

__device__ __forceinline__ unsigned cvt_pk_bf16(float lo, float hi) { unsigned r; asm volatile("v_cvt_pk_bf16_f32 %0, %1, %2" : "=v"(r) : "v"(lo), "v"(hi)); return r; }
typedef float f32x2 __attribute__((ext_vector_type(2)));
typedef unsigned u32x2 __attribute__((ext_vector_type(2)));
constexpr float RMS_EPS = 1e-6f;
__device__ __forceinline__ float row_rs(const float* ssq, int r) {
    const f32x4* p = (const f32x4*)(ssq + (size_t)r * 16);
    const f32x4 a = p[0], b = p[1], c = p[2], d = p[3];
    const float s = ((a[0] + a[1]) + (a[2] + a[3])) + ((b[0] + b[1]) + (b[2] + b[3])) + ((c[0] + c[1]) + (c[2] + c[3])) + ((d[0] + d[1]) + (d[2] + d[3]));
    return __builtin_amdgcn_rsqf(s * (1.0f / 1024.0f) + RMS_EPS);
}
__device__ __forceinline__ float silu_f(float g) { return g * __builtin_amdgcn_rcpf(1.0f + __builtin_amdgcn_exp2f(g * -1.4426950408889634f)); }

constexpr int RS_CACHE_OFF = STAGE_BYTES;
template <class Sched> __device__ __forceinline__ void rs_cache_fill(PG8_LAS unsigned char* lds, const Sched& S, const float* ssq) {
    PG8_LAS float* rsl = (PG8_LAS float*)(lds + RS_CACHE_OFF); Unit u; const int t = threadIdx.x & 255, hf = threadIdx.x >> 8;
    for (int i = hf; S.next(i, u); i += 2) rsl[i * 256 + t] = row_rs(ssq, u.pm * BM + t);
    __syncthreads();
}
struct EpiSwiglu {
    static constexpr bool PERM = true, AFTER_DRAIN = false;
    bf16_t* H; int ldh;
    __device__ __forceinline__ void operator()(const f32x4 (&acc)[2][2][4][2], const Unit& u, int wr, int wc, int fr, int fq, int ui, PG8_LAS unsigned char* lds) const {
        const int row0 = u.pm * BM + wr * 64 + fr, col0 = u.pn * HALF + wc * 32 + 8 * fq;
        const PG8_LAS float* rsl = (const PG8_LAS float*)(lds + RS_CACHE_OFF) + ui * 256 + wr * 64 + fr;
#pragma unroll
        for (int ai = 0; ai < 2; ++ai)
#pragma unroll
            for (int m = 0; m < 4; ++m) {
                const int r = row0 + ai * HALF + m * 16; const float rs = rsl[ai * HALF + m * 16];
                float hv[8];
#pragma unroll
                for (int n = 0; n < 2; ++n)
#pragma unroll
                    for (int e = 0; e < 4; ++e) hv[n * 4 + e] = silu_f(acc[ai][0][m][n][e] * rs) * (acc[ai][1][m][n][e] * rs);
                u32x4 w; w.x = cvt_pk_bf16(hv[0], hv[1]); w.y = cvt_pk_bf16(hv[2], hv[3]); w.z = cvt_pk_bf16(hv[4], hv[5]); w.w = cvt_pk_bf16(hv[6], hv[7]);
                *(u32x4*)(H + (size_t)r * ldh + col0) = w;
            }
    }
};
struct EpiScaleBf16 {
    static constexpr bool PERM = true, AFTER_DRAIN = false;
    bf16_t* O; int ldc;
    __device__ __forceinline__ void operator()(const f32x4 (&acc)[2][2][4][2], const Unit& u, int wr, int wc, int fr, int fq, int ui, PG8_LAS unsigned char* lds) const {
        const int row0 = u.pm * BM + wr * 64 + fr, col0 = u.pn * BM + wc * 32 + 8 * fq;
        const PG8_LAS float* rsl = (const PG8_LAS float*)(lds + RS_CACHE_OFF) + ui * 256 + wr * 64 + fr;
#pragma unroll
        for (int ai = 0; ai < 2; ++ai)
#pragma unroll
            for (int m = 0; m < 4; ++m) {
                const int r = row0 + ai * HALF + m * 16; const float rs = rsl[ai * HALF + m * 16];
#pragma unroll
                for (int bj = 0; bj < 2; ++bj) {
                    const f32x4 v0 = acc[ai][bj][m][0] * rs, v1 = acc[ai][bj][m][1] * rs;
                    u32x4 w; w.x = cvt_pk_bf16(v0[0], v0[1]); w.y = cvt_pk_bf16(v0[2], v0[3]); w.z = cvt_pk_bf16(v1[0], v1[1]); w.w = cvt_pk_bf16(v1[2], v1[3]);
                    *(u32x4*)(O + (size_t)r * ldc + col0 + bj * HALF) = w;
                }
            }
    }
};
__device__ __forceinline__ f32x4 bf4_to_f32(u32x2 w) { f32x4 r; r[0] = __builtin_bit_cast(float, w.x << 16); r[1] = __builtin_bit_cast(float, w.x & 0xffff0000u); r[2] = __builtin_bit_cast(float, w.y << 16); r[3] = __builtin_bit_cast(float, w.y & 0xffff0000u); return r; }
template <int MODE> struct EpiResid {
    static constexpr bool PERM = false, AFTER_DRAIN = false;
    const float* basef; float* out; bf16_t* xb; float* ssq; float scale;
    __device__ __forceinline__ void operator()(const f32x4 (&acc)[2][2][4][2], const Unit& u, int wr, int wc, int fr, int fq, int ui, PG8_LAS unsigned char* lds) const {
        const int row0 = u.pm * BM + wr * 64 + fr, col0 = u.pn * BM + wc * 32 + 4 * fq;
#pragma unroll
        for (int ai = 0; ai < 2; ++ai) {
            f32x4 pre[4][2][2];
#pragma unroll
            for (int m = 0; m < 4; ++m) { const size_t off = (size_t)(row0 + ai * HALF + m * 16) * 1024 + col0;
#pragma unroll
                for (int bj = 0; bj < 2; ++bj)
#pragma unroll
                    for (int n = 0; n < 2; ++n) {
                        if (MODE == 0) pre[m][bj][n] = *(const f32x4*)(basef + off + bj * HALF + n * 16);
                        else pre[m][bj][n] = bf4_to_f32(*(const u32x2*)(xb + off + bj * HALF + n * 16)); } }
#pragma unroll
            for (int m = 0; m < 4; ++m) { const int r = row0 + ai * HALF + m * 16; const size_t off = (size_t)r * 1024 + col0; float s = 0.f;
#pragma unroll
                for (int bj = 0; bj < 2; ++bj)
#pragma unroll
                    for (int n = 0; n < 2; ++n) {
                        const f32x4 o = pre[m][bj][n] + acc[ai][bj][m][n] * scale;
                        if (MODE == 2) *(f32x4*)(out + off + bj * HALF + n * 16) = o;
                        else { s += (o[0] * o[0] + o[1] * o[1]) + (o[2] * o[2] + o[3] * o[3]);
                            u32x2 w; w.x = cvt_pk_bf16(o[0], o[1]); w.y = cvt_pk_bf16(o[2], o[3]); *(u32x2*)(xb + off + bj * HALF + n * 16) = w; }
                    }
                if (MODE != 2) { s += __shfl_xor(s, 16); s += __shfl_xor(s, 32); if (fq == 0) ssq[(size_t)r * 16 + u.pn * 4 + wc] = s; }
            }
        }
    }
};
template <class Epi, class Sched, bool ALIGN_EPI = false, bool SP2 = false>
__device__ __forceinline__ void gemm_phase(PG8_LAS unsigned char* lds, const Gemm g, const Sched& S, const Epi& E) {
    const int tid = threadIdx.x, wid = __builtin_amdgcn_readfirstlane(tid >> 6), lane = tid & 63, wr = wid >> 2, wc = wid & 3, fr = lane & 15, fq = lane >> 4;
    const int K = g.K, nt = K / BK;
    unsigned voffA[2], voffB[2];
#pragma unroll
    for (int i = 0; i < 2; ++i) { int R, C; stage_rc(tid * 16 + i * 8192, R, C); const int Rb = Epi::PERM ? ((R & ~31) + perm32(R & 31)) : R;
        voffA[i] = (unsigned)(R * K + C) * 2u; voffB[i] = (unsigned)(Rb * K + C) * 2u; }
    const size_t kstep = (size_t)(BK * 2);
    const size_t hstep = (size_t)HALF * K * 2;
    const size_t tstep = 2 * hstep;
    const unsigned ldsw = (unsigned)wid * 1024u;
    const int aoff = lds_byte(wr * 64 + fr, fq * 8), boff = lds_byte(wc * 32 + fr, fq * 8);
#define PG8_SA(b, h) (((b) * 2 + (h)) * HTB)
#define PG8_SB(b, h) ((4 + (b) * 2 + (h)) * HTB)
#define PG8_STAGE(bufoff, gbase, voff) do { _Pragma("unroll") for (int _i = 0; _i < 2; ++_i) \
        __builtin_amdgcn_global_load_lds((const unsigned*)((const char*)(gbase) + (voff)[_i]), (PG8_LAS unsigned*)(lds + (bufoff) + ldsw + _i * 8192), 16, 0, 0); } while (0)
#define PG8_LDA(dst, b, h) do { _Pragma("unroll") for (int m = 0; m < 4; ++m) _Pragma("unroll") for (int k = 0; k < 2; ++k) dst[m][k] = *(const PG8_LAS bf16x8*)(lds + PG8_SA(b, h) + aoff + m * 2048 + k * 1024); } while (0)
#define PG8_LDB(dst, b, h) do { _Pragma("unroll") for (int n = 0; n < 2; ++n) _Pragma("unroll") for (int k = 0; k < 2; ++k) dst[n][k] = *(const PG8_LAS bf16x8*)(lds + PG8_SB(b, h) + boff + n * 2048 + k * 1024); } while (0)
#define PG8_MMA(ai, bj, At, Bt) do { __builtin_amdgcn_s_setprio(1); _Pragma("unroll") for (int m = 0; m < 4; ++m) _Pragma("unroll") for (int n = 0; n < 2; ++n) _Pragma("unroll") for (int k = 0; k < 2; ++k) \
        acc[ai][bj][m][n] = __builtin_amdgcn_mfma_f32_16x16x32_bf16(Bt[n][k], At[m][k], acc[ai][bj][m][n], 0, 0, 0); __builtin_amdgcn_s_setprio(0); } while (0)
#define PG8_WAIT_V(n) asm volatile("s_waitcnt vmcnt(" #n ")" ::: "memory")
#define PG8_WAIT_L(n) asm volatile("s_waitcnt lgkmcnt(" #n ")" ::: "memory")
#define PG8_BAR __builtin_amdgcn_s_barrier()
#define PG8_SCHED __builtin_amdgcn_sched_barrier(0)
    Unit cur, nxt; int ui = 0;
    if (!S.next(0, cur)) return;
    f32x4 acc[2][2][4][2];
#pragma unroll
    for (int a = 0; a < 2; ++a)
#pragma unroll
        for (int b = 0; b < 2; ++b)
#pragma unroll
            for (int m = 0; m < 4; ++m)
#pragma unroll
                for (int n = 0; n < 2; ++n) acc[a][b][m][n] = (f32x4){0.f, 0.f, 0.f, 0.f};
    bf16x8 At[4][2], B0[2][2], B1[2][2];
    const char* cA = (const char*)g.A + (size_t)cur.pm * tstep; const char* cB = (const char*)g.Bt + (size_t)cur.pn * tstep;
    S.a_ready(cur);
    if constexpr (SP2) {
        PG8_STAGE(PG8_SB(0, 0), cB, voffB); PG8_STAGE(PG8_SB(0, 1), cB + hstep, voffB); PG8_STAGE(PG8_SA(0, 0), cA, voffA); PG8_STAGE(PG8_SA(0, 1), cA + hstep, voffA);
        if (wr == 1) PG8_BAR;
        PG8_WAIT_V(2); PG8_BAR;
        PG8_STAGE(PG8_SB(1, 0), cB + kstep, voffB); PG8_STAGE(PG8_SA(1, 0), cA + kstep, voffA); PG8_STAGE(PG8_SB(1, 1), cB + hstep + kstep, voffB);
        PG8_WAIT_V(6); PG8_BAR;
    } else {
        PG8_STAGE(PG8_SB(0, 0), cB, voffB); PG8_STAGE(PG8_SA(0, 0), cA, voffA); PG8_STAGE(PG8_SB(0, 1), cB + hstep, voffB); PG8_STAGE(PG8_SA(0, 1), cA + hstep, voffA);
        if (wr == 1) PG8_BAR;
        PG8_WAIT_V(4); PG8_BAR;
        PG8_STAGE(PG8_SB(1, 0), cB + kstep, voffB); PG8_STAGE(PG8_SA(1, 0), cA + kstep, voffA); PG8_STAGE(PG8_SB(1, 1), cB + hstep + kstep, voffB);
        PG8_WAIT_V(6); PG8_BAR;
    }
    for (;;) {
        const bool has_next = S.next(ui + 1, nxt);
        const char* nA = has_next ? (const char*)g.A + (size_t)nxt.pm * tstep : cA; const char* nB = has_next ? (const char*)g.Bt + (size_t)nxt.pn * tstep : cB;
        for (int t = 0; t < nt; t += 2) {
            const bool last = (t == nt - 2);
            const char* a1 = cA + (size_t)(t + 1) * kstep;
            const char* a2 = last ? nA : cA + (size_t)(t + 2) * kstep; const char* b2 = last ? nB : cB + (size_t)(t + 2) * kstep;
            const char* a3 = a2 + kstep; const char* b3 = b2 + kstep;
            if (last && has_next) S.a_ready(nxt);
            if constexpr (SP2) {
            PG8_LDB(B0, 0, 0); PG8_LDB(B1, 0, 1); PG8_SCHED; PG8_LDA(At, 0, 0); PG8_STAGE(PG8_SA(1, 1), a1 + hstep, voffA);
            PG8_WAIT_V(8); PG8_WAIT_L(0); PG8_BAR; PG8_MMA(0, 0, At, B0); PG8_MMA(0, 1, At, B1); PG8_BAR; PG8_SCHED;
            PG8_LDA(At, 0, 1); PG8_STAGE(PG8_SB(0, 0), b2, voffB); PG8_STAGE(PG8_SB(0, 1), b2 + hstep, voffB); PG8_STAGE(PG8_SA(0, 0), a2, voffA);
            PG8_WAIT_V(8); PG8_WAIT_L(0); PG8_BAR; PG8_MMA(1, 0, At, B0); PG8_MMA(1, 1, At, B1); PG8_BAR; PG8_SCHED;
            PG8_LDB(B0, 1, 0); PG8_LDB(B1, 1, 1); PG8_SCHED; PG8_LDA(At, 1, 0); PG8_STAGE(PG8_SA(0, 1), a2 + hstep, voffA);
            PG8_WAIT_V(8); PG8_WAIT_L(0); PG8_BAR; PG8_MMA(0, 0, At, B0); PG8_MMA(0, 1, At, B1); PG8_BAR; PG8_SCHED;
            PG8_LDA(At, 1, 1); PG8_STAGE(PG8_SB(1, 0), b3, voffB); PG8_STAGE(PG8_SB(1, 1), b3 + hstep, voffB); PG8_STAGE(PG8_SA(1, 0), a3, voffA);
            PG8_WAIT_V(8); PG8_WAIT_L(0); PG8_BAR; PG8_MMA(1, 0, At, B0); PG8_MMA(1, 1, At, B1); PG8_BAR; PG8_SCHED;
            } else {
            PG8_LDB(B0, 0, 0); PG8_SCHED; PG8_LDA(At, 0, 0); PG8_STAGE(PG8_SA(1, 1), a1 + hstep, voffA);
            PG8_WAIT_L(8); PG8_BAR; PG8_WAIT_L(0); PG8_MMA(0, 0, At, B0); PG8_BAR; PG8_SCHED;
            PG8_LDB(B1, 0, 1); PG8_STAGE(PG8_SB(0, 0), b2, voffB);
            PG8_BAR; PG8_WAIT_L(0); PG8_MMA(0, 1, At, B1); PG8_BAR;
            PG8_LDA(At, 0, 1); PG8_STAGE(PG8_SA(0, 0), a2, voffA);
            PG8_BAR; PG8_WAIT_L(0); PG8_MMA(1, 0, At, B0); PG8_BAR; PG8_SCHED;
            PG8_STAGE(PG8_SB(0, 1), b2 + hstep, voffB);
            PG8_WAIT_V(6); PG8_BAR; PG8_MMA(1, 1, At, B1); PG8_BAR;
            PG8_LDB(B0, 1, 0); PG8_SCHED; PG8_LDA(At, 1, 0); PG8_STAGE(PG8_SA(0, 1), a2 + hstep, voffA);
            PG8_WAIT_L(8); PG8_BAR; PG8_WAIT_L(0); PG8_MMA(0, 0, At, B0); PG8_BAR; PG8_SCHED;
            PG8_LDB(B1, 1, 1); PG8_STAGE(PG8_SB(1, 0), b3, voffB);
            PG8_BAR; PG8_WAIT_L(0); PG8_MMA(0, 1, At, B1); PG8_BAR;
            PG8_LDA(At, 1, 1); PG8_STAGE(PG8_SA(1, 0), a3, voffA);
            PG8_BAR; PG8_WAIT_L(0); PG8_MMA(1, 0, At, B0); PG8_BAR; PG8_SCHED;
            PG8_STAGE(PG8_SB(1, 1), b3 + hstep, voffB);
            PG8_WAIT_V(6); PG8_BAR; PG8_MMA(1, 1, At, B1); PG8_BAR;
            }
        }
        if constexpr (ALIGN_EPI) { if (wr == 0) PG8_BAR; }
        if constexpr (!Epi::AFTER_DRAIN) { E(acc, cur, wr, wc, fr, fq, ui, lds); S.done(cur); }
        if (!has_next) break;
#pragma unroll
        for (int a = 0; a < 2; ++a)
#pragma unroll
            for (int b = 0; b < 2; ++b)
#pragma unroll
                for (int m = 0; m < 4; ++m)
#pragma unroll
                    for (int n = 0; n < 2; ++n) acc[a][b][m][n] = (f32x4){0.f, 0.f, 0.f, 0.f};
        cur = nxt; cA = nA; cB = nB; ++ui;
        if constexpr (ALIGN_EPI) { if (wr == 1) PG8_BAR; }
    }
    PG8_WAIT_V(0);
    if constexpr (!ALIGN_EPI) { if (wr == 0) PG8_BAR; }
    PG8_BAR;
    if constexpr (Epi::AFTER_DRAIN) { E.fused(acc, cur, wr, wc, fr, fq, lds, wid, lane); S.done(cur); }
#undef PG8_SA
#undef PG8_SB
#undef PG8_STAGE
#undef PG8_LDA
#undef PG8_LDB
#undef PG8_MMA
#undef PG8_WAIT_V
#undef PG8_WAIT_L
#undef PG8_BAR
#undef PG8_SCHED
}
}

constexpr int NWAVES = 8;
constexpr int DM = 1024, BATCH = 4, SEQ = 8192, MP = BATCH * SEQ, DEC_B = 128, DEC_T = 4, MS = DEC_B * DEC_T, MT = MP + MS;
constexpr int LRU_W = 512, NH = 8, NKV = 2, HD = 64, DFF = 2816, INW = 1792, WIN = 128, PAST = 16384;
constexpr int C_XL = 0, C_GATE = 512, C_Q = 1024, C_K = 1536, C_V = 1664;
constexpr int NCHUNK = 64, CHUNK = SEQ / NCHUNK;
constexpr float EPS = 1e-6f, LOG2E = 1.4426950408889634f;
constexpr size_t O_YP = 0, O_YS = 33554432, O_PH = 34078720, O_PC = 34080768, O_PK = 34086912, O_PV = 34152448, O_SH = 34217984, O_SC = 34283520, O_SK = 34480128, O_SV = 36577280, O_END = 38674432;
constexpr size_t MiB = 1u << 20;
constexpr size_t WS_CTL = 0, CTL_ZERO_BYTES = 1 * MiB;
constexpr size_t WS_WGU1 = 2 * MiB, WS_WD1 = 13 * MiB, WS_WIN = 19 * MiB, WS_WOUT = 23 * MiB, WS_WGU2 = 25 * MiB, WS_WD2 = 36 * MiB;
constexpr size_t WS_ROPE = 42 * MiB;
constexpr size_t WS_SSQ = 45 * MiB;
constexpr size_t WS_LSUM = 48 * MiB;
constexpr size_t WS_XB = 50 * MiB;
constexpr size_t WS_CAT = 115 * MiB;
constexpr size_t WS_PROJ = 180 * MiB;
constexpr size_t WS_H = 294 * MiB;
constexpr size_t WS_END = 473 * MiB;
constexpr int ROPE_ROWS = SEQ + DEC_T;
constexpr int CW_TMO = 0, CW_BAR = 4096;
constexpr int RING_OFF = 0, RING_BYTES = 131072;
constexpr int SCR_BYTES = 147456;
constexpr int LDSCTL_OFF = SCR_BYTES, MISC_OFF = LDSCTL_OFF + 64;
constexpr int LDS_BYTES = SCR_BYTES + 512;

#define GAS __attribute__((address_space(1)))
#define LAS __attribute__((address_space(3)))
typedef unsigned short bf16;
typedef unsigned v4u __attribute__((ext_vector_type(4)));
typedef unsigned v2u __attribute__((ext_vector_type(2)));
typedef float f32x4 __attribute__((ext_vector_type(4)));
typedef float f32x16 __attribute__((ext_vector_type(16)));
typedef short bf16x8 __attribute__((ext_vector_type(8)));
typedef GAS unsigned gu32;
#define RLX_AGENT __ATOMIC_RELAXED, __HIP_MEMORY_SCOPE_AGENT
#define LDS_WAIT() asm volatile("s_waitcnt lgkmcnt(0)" ::: "memory")
#define VM_WAIT() asm volatile("s_waitcnt vmcnt(0)" ::: "memory")
__device__ __forceinline__ unsigned f2bf(float f) { unsigned u = __builtin_bit_cast(unsigned, f); return (u + 0x7fffu + ((u >> 16) & 1u)) >> 16; }
__device__ __forceinline__ unsigned pk2(float lo, float hi) { return f2bf(lo) | (f2bf(hi) << 16); }
__device__ __forceinline__ float bflo(unsigned w) { return __builtin_bit_cast(float, w << 16); }
__device__ __forceinline__ float bfhi(unsigned w) { return __builtin_bit_cast(float, w & 0xffff0000u); }
__device__ __forceinline__ float bf1(bf16 v) { return __builtin_bit_cast(float, (unsigned)v << 16); }
typedef float f32x2_t __attribute__((ext_vector_type(2))); typedef __bf16 bf16x2_t __attribute__((ext_vector_type(2)));
__device__ __forceinline__ unsigned cvtpk(float lo, float hi) { f32x2_t v = {lo, hi}; bf16x2_t b = __builtin_convertvector(v, bf16x2_t); return __builtin_bit_cast(unsigned, b); }
__device__ __forceinline__ float wave_sum(float v) {
#pragma unroll
    for (int o = 1; o < 64; o <<= 1) v += __shfl_xor(v, o);
    return v;
}
__device__ __forceinline__ float wave_max(float v) {
#pragma unroll
    for (int o = 1; o < 64; o <<= 1) v = fmaxf(v, __shfl_xor(v, o));
    return v;
}
__device__ __forceinline__ float sigmoid_f(float x) { return __builtin_amdgcn_rcpf(1.0f + __builtin_amdgcn_exp2f(-x * LOG2E)); }
__device__ __forceinline__ float gelu_tanh(float x) {
    const float y = 0.7978845608028654f * (x + 0.044715f * x * x * x);
    const float e = __builtin_amdgcn_exp2f(2.0f * LOG2E * y);
    const float th = 1.0f - 2.0f * __builtin_amdgcn_rcpf(e + 1.0f);
    return 0.5f * x * (1.0f + th);
}
__device__ __forceinline__ float one_minus_exp(float t) {
    const float ser = -t * (1.0f + t * (0.5f + t * (0.16666667f + t * (0.041666668f + t * 0.0083333338f))));
    const float dir = 1.0f - __builtin_amdgcn_exp2f(t * LOG2E);
    return t > -0.25f ? ser : dir;
}
__device__ __forceinline__ float dot2bf(unsigned a, unsigned b, float c) { return __builtin_amdgcn_fdot2_f32_bf16(__builtin_bit_cast(bf16x2_t, a), __builtin_bit_cast(bf16x2_t, b), c, false); }
#define XB_TMO      128
#define XB_XCNT(j)  (256  + 64 * (j))
#define XB_XSUB(j)  (1280 + 64 * (j))
#define XB_XGEN(j)  (2304 + 64 * (j))
#define XB_TOP      3328
#define XB_TOPGEN   3392
#define XCD_BAR_WORDS 3456
#define XB_SPIN_CAP (1u << 18)

__device__ __forceinline__ unsigned xb_ld(unsigned* p)              { return __hip_atomic_load(p, __ATOMIC_RELAXED, __HIP_MEMORY_SCOPE_AGENT); }
__device__ __forceinline__ unsigned xb_add(unsigned* p, unsigned v) { return __hip_atomic_fetch_add(p, v, __ATOMIC_RELAXED, __HIP_MEMORY_SCOPE_AGENT); }
__device__ __forceinline__ unsigned xb_xcc_id() { return (unsigned)__builtin_amdgcn_s_getreg((3 << 11) | 20) & 0xFu; }
#define XB_SPIN(cond, bar) do { unsigned _sp = 0; while (cond) { __builtin_amdgcn_s_sleep(1); \
    if ((++_sp & 255u) == 0u) { if (xb_ld(&(bar)[XB_TMO])) break; if (_sp > XB_SPIN_CAP) { atomicAdd(&(bar)[XB_TMO], 1u); break; } } } } while (0)

struct XcdBarrier {
    unsigned* bar; unsigned x;
    volatile LAS unsigned* st;
};

__device__ __forceinline__ XcdBarrier xcd_barrier_post(unsigned* bar, volatile LAS unsigned* st) {
    XcdBarrier b; b.bar = bar; b.x = xb_xcc_id(); b.st = st;
    if (threadIdx.x == 0) (void)xb_add(&bar[XB_XCNT(b.x)], 1u);
    return b;
}
__device__ __forceinline__ void xcd_barrier_complete(unsigned* bar, unsigned x, unsigned& nloc, unsigned& nx) {
    const unsigned G = gridDim.x * gridDim.y * gridDim.z;
    unsigned sum, cnt, mine, sp = 0u;
    for (;;) {
        sum = 0u; cnt = 0u; mine = 0u;
#pragma unroll
        for (unsigned j = 0; j < 16; ++j) { const unsigned c = xb_ld(&bar[XB_XCNT(j)]); sum += c; cnt += (c > 0u) ? 1u : 0u; mine = (j == x) ? c : mine; }
        if (sum == G) break;
        __builtin_amdgcn_s_sleep(1);
        if ((++sp & 255u) == 0u) { if (xb_ld(&bar[XB_TMO])) break; if (sp > XB_SPIN_CAP) { atomicAdd(&bar[XB_TMO], 1u); break; } }
    }
    nloc = mine > 0u ? mine : 1u; nx = cnt > 0u ? cnt : 1u;
}

__device__ __forceinline__ void xcd_barrier(const XcdBarrier& b) {
    asm volatile("s_waitcnt vmcnt(0)" ::: "memory");
    __syncthreads();
    if (threadIdx.x == 0) {
        unsigned* bar = b.bar;
        __builtin_amdgcn_s_waitcnt(0);
        unsigned nloc = b.st[0], nx = b.st[1];
        if (nloc == 0u) { xcd_barrier_complete(bar, b.x, nloc, nx); b.st[0] = nloc; b.st[1] = nx; }
        const unsigned old = xb_add(&bar[XB_XSUB(b.x)], 1u);
        const unsigned gen = old / nloc;
        if (old + 1u == (gen + 1u) * nloc) {
            __builtin_amdgcn_fence(__ATOMIC_RELEASE, "agent");
            asm volatile("s_waitcnt vmcnt(0)" ::: "memory");
            const unsigned og = xb_add(&bar[XB_TOP], 1u);
            const unsigned tg = og / nx;
            if (og + 1u == (tg + 1u) * nx) xb_add(&bar[XB_TOPGEN], 1u);
            else XB_SPIN(xb_ld(&bar[XB_TOPGEN]) == tg, bar);
            __builtin_amdgcn_fence(__ATOMIC_ACQUIRE, "agent");
            xb_add(&bar[XB_XGEN(b.x)], 1u);
            asm volatile("s_waitcnt vmcnt(0)" ::: "memory");
        } else {
            XB_SPIN(xb_ld(&bar[XB_XGEN(b.x)]) == gen, bar);
            __builtin_amdgcn_fence(__ATOMIC_ACQUIRE, "agent");
            asm volatile("s_waitcnt vmcnt(0)" ::: "memory");
        }
    }
    __syncthreads();
}

struct Frame {
    LAS unsigned char* lds;
    volatile LAS unsigned* MISC;
    gu32* ctl;
    int tid, lane, wave;
    int vcu, G;
    const float* in[29];
    float* out;
    bf16 *WGU1, *WD1, *WINT, *WOUT, *WGU2, *WD2;
    float *ROPEC, *ROPES, *SSQ, *LSUM;
    bf16 *XB, *CAT, *PROJ, *HB;
};
enum { I_XP = 0, I_XS, I_SH, I_SC, I_CK, I_CV, I_F1N, I_F1G, I_F1U, I_F1D, I_MN, I_WIN, I_CW, I_CB, I_WA, I_BA, I_WX, I_BX, I_LAM, I_QN, I_KN, I_SINK, I_LON, I_AON, I_WOUT, I_F2N, I_F2G, I_F2U, I_F2D };

template <int MODE> __device__ __forceinline__ void p0_transpose_item(const float* W, const float* gain, int K, int N, bf16* WT, LAS float* scr, int item, int lane) {
    const int nblk = N / 32, kb = item / nblk, nb = item % nblk, k0 = 64 * kb, n0 = 32 * nb;
#pragma unroll 8
    for (int i = 0; i < 32; ++i) { const int kk = 2 * i + (lane >> 5); float v = W[(size_t)(k0 + kk) * N + n0 + (lane & 31)]; if (gain) v *= gain[k0 + kk]; scr[kk * 33 + (lane & 31)] = v; }
    LDS_WAIT(); asm volatile("" ::: "memory");
    const int c = lane & 7;
    const int rb = (MODE == 0) ? n0 : ((n0 >> 7) * 256 + (MODE - 1) * 128 + (n0 & 127));
#pragma unroll
    for (int j = 0; j < 4; ++j) { const int n = (lane >> 3) + 8 * j; const LAS float* s = scr + (8 * c) * 33 + n;
        v4u o; o.x = pk2(s[0 * 33], s[1 * 33]); o.y = pk2(s[2 * 33], s[3 * 33]); o.z = pk2(s[4 * 33], s[5 * 33]); o.w = pk2(s[6 * 33], s[7 * 33]);
        *(GAS v4u*)(WT + (size_t)(rb + n) * K + k0 + 8 * c) = o; }
    LDS_WAIT(); asm volatile("" ::: "memory");
}
__device__ __forceinline__ void p0_row(Frame& F, const float* xrow, bf16* orow, float* ssq16) {
    const GAS f32x4* xr = (const GAS f32x4*)xrow + F.lane;
    f32x4 v[4]; float s = 0.f;
#pragma unroll
    for (int j = 0; j < 4; ++j) { v[j] = xr[64 * j]; s += (v[j].x * v[j].x + v[j].y * v[j].y) + (v[j].z * v[j].z + v[j].w * v[j].w); }
    s = wave_sum(s);
    GAS unsigned long long* o8 = (GAS unsigned long long*)orow + F.lane;
#pragma unroll
    for (int j = 0; j < 4; ++j) o8[64 * j] = (unsigned long long)pk2(v[j].x, v[j].y) | ((unsigned long long)pk2(v[j].z, v[j].w) << 32);
    if (F.lane < 16) ssq16[F.lane] = (F.lane == 0) ? s : 0.f;
}
__device__ __forceinline__ void p0_prologue(Frame& F) {
    LAS float* scr = (LAS float*)(F.lds + RING_OFF + F.wave * 16384);
    const int gw = F.vcu * NWAVES + F.wave, NGW = F.G * NWAVES;
    constexpr int I_GU = (DM / 64) * (DFF / 32), I_D = (DFF / 64) * (DM / 32), I_IN = (DM / 64) * (INW / 32), I_OUT = (DM / 64) * (DM / 32);
    constexpr int NITEMS = 4 * I_GU + 2 * I_D + I_IN + I_OUT;
    for (int it = gw; it < NITEMS; it += NGW) {
        int r = it;
        if (r < I_GU) { p0_transpose_item<1>(F.in[I_F1G], F.in[I_F1N], DM, DFF, F.WGU1, scr, r, F.lane); continue; } r -= I_GU;
        if (r < I_GU) { p0_transpose_item<2>(F.in[I_F1U], F.in[I_F1N], DM, DFF, F.WGU1, scr, r, F.lane); continue; } r -= I_GU;
        if (r < I_GU) { p0_transpose_item<1>(F.in[I_F2G], F.in[I_F2N], DM, DFF, F.WGU2, scr, r, F.lane); continue; } r -= I_GU;
        if (r < I_GU) { p0_transpose_item<2>(F.in[I_F2U], F.in[I_F2N], DM, DFF, F.WGU2, scr, r, F.lane); continue; } r -= I_GU;
        if (r < I_D) { p0_transpose_item<0>(F.in[I_F1D], nullptr, DFF, DM, F.WD1, scr, r, F.lane); continue; } r -= I_D;
        if (r < I_D) { p0_transpose_item<0>(F.in[I_F2D], nullptr, DFF, DM, F.WD2, scr, r, F.lane); continue; } r -= I_D;
        if (r < I_IN) { p0_transpose_item<0>(F.in[I_WIN], F.in[I_MN], DM, INW, F.WINT, scr, r, F.lane); continue; } r -= I_IN;
        p0_transpose_item<0>(F.in[I_WOUT], nullptr, DM, DM, F.WOUT, scr, r, F.lane);
    }
    for (int m = gw; m < MT; m += NGW) {
        const float* xr = (m < MP) ? F.in[I_XP] + (size_t)m * DM : F.in[I_XS] + (size_t)(m - MP) * DM;
        p0_row(F, xr, F.XB + (size_t)m * DM, F.SSQ + (size_t)m * 16);
    }
    const int gt = F.vcu * (NWAVES * 64) + F.tid, NGT = F.G * NWAVES * 64;
    for (int e = gt; e < ROPE_ROWS * 32; e += NGT) {
        const int pi = e >> 5, i = e & 31; const int pos = pi < SEQ ? pi : PAST + (pi - SEQ);
        const float invf = (float)exp(-(double)i * (9.210340371976184 / 32.0));
        const float ang = (float)pos * invf; const double a = (double)ang;
        F.ROPEC[e] = (float)cos(a); F.ROPES[e] = (float)sin(a);
    }
}

template <int PASS> __device__ __forceinline__ void lru_prompt_item(Frame& F, int item) {
    int c_ = F.tid; asm volatile("" : "+v"(c_));
    const int b = item / NCHUNK, chunk = item % NCHUNK, t0 = chunk * CHUNK, c = c_, blk = F.wave, cj = c & 63;
    LAS bf16* xcs = (LAS bf16*)F.lds;
    LAS float* outs = (LAS float*)(F.lds + 32 * 512 * 2);
    LAS float* rsv = outs + 32 * 512;
    const float cw0 = F.in[I_CW][c], cw1 = F.in[I_CW][512 + c], cw2 = F.in[I_CW][1024 + c], cw3 = F.in[I_CW][1536 + c], cb = F.in[I_CB][c];
    const float ba = F.in[I_BA][c], bx = F.in[I_BX][c];
    const float lam = F.in[I_LAM][c];
    const float c8 = -8.0f * (fmaxf(-lam, 0.f) + log1pf(expf(-fabsf(lam))));
    const float lon = F.in[I_LON][c];
    unsigned wab[32], wxb[32];
#pragma unroll
    for (int k = 0; k < 32; ++k) { wab[k] = pk2(F.in[I_WA][(blk * 64 + 2 * k) * 64 + cj], F.in[I_WA][(blk * 64 + 2 * k + 1) * 64 + cj]); wxb[k] = pk2(F.in[I_WX][(blk * 64 + 2 * k) * 64 + cj], F.in[I_WX][(blk * 64 + 2 * k + 1) * 64 + cj]); if ((k & 3) == 3) asm volatile("" ::: "memory"); }
    const bf16* prow = F.PROJ + (size_t)(b * SEQ + t0) * INW;
    float xm3 = 0.f, xm2 = 0.f, xm1 = 0.f;
    if (chunk > 0) { xm3 = bf1(prow[-3 * INW + c]); xm2 = bf1(prow[-2 * INW + c]); xm1 = bf1(prow[-1 * INW + c]); }
    float h = 0.f, P = 1.f;
    if (PASS == 2) {
        const float* ls = F.LSUM + ((size_t)b * NCHUNK * 512 + c) * 2;
#pragma unroll 8
        for (int j = 0; j < chunk; ++j) { const f32x2_t pe = *(const f32x2_t*)(ls + (size_t)j * 1024); h = pe.x * h + pe.y; }
    }
    for (int sub = 0; sub < CHUNK / 32; ++sub) {
        const bf16* pr = prow + (size_t)(sub * 32) * INW;
#pragma unroll 8
        for (int tt = 0; tt < 32; ++tt) {
            const float x = bf1(pr[(size_t)tt * INW + c]);
            xcs[tt * 512 + c] = (bf16)f2bf(cb + cw0 * xm3 + cw1 * xm2 + cw2 * xm1 + cw3 * x);
            xm3 = xm2; xm2 = xm1; xm1 = x;
        }
        __syncthreads();
        for (int tt = 0; tt < 32; ++tt) {
            float rp = ba, ip = bx;
            const LAS v4u* xb4 = (const LAS v4u*)(xcs + tt * 512 + blk * 64);
#pragma unroll
            for (int k8 = 0; k8 < 8; ++k8) { const v4u xv = xb4[k8];
                rp = dot2bf(xv.x, wab[4 * k8], rp); rp = dot2bf(xv.y, wab[4 * k8 + 1], rp); rp = dot2bf(xv.z, wab[4 * k8 + 2], rp); rp = dot2bf(xv.w, wab[4 * k8 + 3], rp);
                ip = dot2bf(xv.x, wxb[4 * k8], ip); ip = dot2bf(xv.y, wxb[4 * k8 + 1], ip); ip = dot2bf(xv.z, wxb[4 * k8 + 2], ip); ip = dot2bf(xv.w, wxb[4 * k8 + 3], ip); }
            const float r = sigmoid_f(rp), ig = sigmoid_f(ip);
            const float la = c8 * r, a = __builtin_amdgcn_exp2f(la * LOG2E);
            const float mult = __builtin_amdgcn_sqrtf(one_minus_exp(2.0f * la));
            const float u = mult * ig * bf1(xcs[tt * 512 + c]);
            h = a * h + u;
            if (PASS == 1) P *= a;
            if (PASS == 2) { const float g = bf1(pr[(size_t)tt * INW + C_GATE + c]); outs[tt * 512 + c] = h * gelu_tanh(g); }
        }
        if (PASS == 2) {
            __syncthreads();
#pragma unroll
            for (int q = 0; q < 4; ++q) { const int tt = 4 * F.wave + q; const LAS f32x4* o4 = (const LAS f32x4*)(outs + tt * 512) + F.lane;
                const f32x4 a0 = o4[0], a1 = o4[64];
                float s = (a0[0] * a0[0] + a0[1] * a0[1]) + (a0[2] * a0[2] + a0[3] * a0[3]) + (a1[0] * a1[0] + a1[1] * a1[1]) + (a1[2] * a1[2] + a1[3] * a1[3]);
                s = wave_sum(s); if (F.lane == 0) rsv[tt] = __builtin_amdgcn_rsqf(s * (1.0f / 512.0f) + EPS); }
            __syncthreads();
            bf16* crow = F.CAT + (size_t)(b * SEQ + t0 + sub * 32) * DM + c;
#pragma unroll 8
            for (int tt = 0; tt < 32; ++tt) crow[(size_t)tt * DM] = (bf16)f2bf(outs[tt * 512 + c] * rsv[tt] * lon);
        }
        __syncthreads();
    }
    if (PASS == 1) { *(f32x2_t*)(F.LSUM + (((size_t)b * NCHUNK + chunk) * 512 + c) * 2) = (f32x2_t){P, h}; }
    if (PASS == 2 && chunk == NCHUNK - 1) {
        F.out[O_PH + b * 512 + c] = h;
        F.out[O_PC + (b * 3 + 0) * 512 + c] = xm3; F.out[O_PC + (b * 3 + 1) * 512 + c] = xm2; F.out[O_PC + (b * 3 + 2) * 512 + c] = xm1;
    }
}

constexpr int KS_STRIDE = 144, KS_KVH = 256 * KS_STRIDE;
constexpr int VT_STRIDE = 528, VT_KVH = 64 * VT_STRIDE;
constexpr int AT_KS = 0, AT_VT = 2 * KS_KVH, AT_HS = AT_VT + 2 * VT_KVH, AT_END = AT_HS + 4 * 8 * 32 * 4;
static_assert(AT_END <= SCR_BYTES, "attention LDS");
__device__ __forceinline__ int vt_pos(int key) { const int o = key & 15; return (key & ~15) + 8 * ((o >> 2) & 1) + (o & 3) + 4 * (o >> 3); }
__device__ __forceinline__ void attn_prompt_item(Frame& F, int item) {
    const int b = item / (SEQ / WIN), blk = item % (SEQ / WIN);
    int tid_ = F.tid; asm volatile("" : "+v"(tid_));
    const int tid = tid_, lane = tid & 63, w = F.wave;
    LAS unsigned char* Ks = F.lds + AT_KS; LAS unsigned char* Vt = F.lds + AT_VT; LAS float* hs = (LAS float*)(F.lds + AT_HS);
    {
        const int key = tid & 255, kvh = tid >> 8, tb = blk * WIN - WIN + key;
        LAS unsigned char* krow = Ks + kvh * KS_KVH + key * KS_STRIDE;
        LAS bf16* vcol = (LAS bf16*)(Vt + kvh * VT_KVH) + vt_pos(key);
        if (tb >= 0) {
            const bf16* prow = F.PROJ + (size_t)(b * SEQ + tb) * INW;
            v4u kr[8], vr[8];
#pragma unroll
            for (int i = 0; i < 8; ++i) kr[i] = *(const v4u*)(prow + C_K + kvh * 64 + 8 * i);
            float kf[64]; float ss = 0.f;
#pragma unroll
            for (int i = 0; i < 8; ++i) { kf[8 * i + 0] = bflo(kr[i].x); kf[8 * i + 1] = bfhi(kr[i].x); kf[8 * i + 2] = bflo(kr[i].y); kf[8 * i + 3] = bfhi(kr[i].y);
                kf[8 * i + 4] = bflo(kr[i].z); kf[8 * i + 5] = bfhi(kr[i].z); kf[8 * i + 6] = bflo(kr[i].w); kf[8 * i + 7] = bfhi(kr[i].w); }
#pragma unroll
            for (int d = 0; d < 64; ++d) ss += kf[d] * kf[d];
            const float rs = __builtin_amdgcn_rsqf(ss * (1.0f / 64.0f) + EPS);
            const float* cs = F.ROPEC + (size_t)tb * 32; const float* sn = F.ROPES + (size_t)tb * 32; const float* kn = F.in[I_KN];
#pragma unroll
            for (int i = 0; i < 32; ++i) { const float x1 = kf[i] * rs * kn[i], x2 = kf[i + 32] * rs * kn[i + 32], cc = cs[i], sv = sn[i]; kf[i] = x1 * cc - x2 * sv; kf[i + 32] = x2 * cc + x1 * sv; }
#pragma unroll
            for (int i = 0; i < 8; ++i) { v4u o; o.x = cvtpk(kf[8 * i], kf[8 * i + 1]); o.y = cvtpk(kf[8 * i + 2], kf[8 * i + 3]); o.z = cvtpk(kf[8 * i + 4], kf[8 * i + 5]); o.w = cvtpk(kf[8 * i + 6], kf[8 * i + 7]);
                *(LAS v4u*)(krow + 16 * i) = o; }
            const bool lastw = (blk == SEQ / WIN - 1 && key >= WIN);
            if (lastw) { float* ok = F.out + O_PK + ((size_t)(b * WIN + key - WIN) * NKV + kvh) * HD;
#pragma unroll
                for (int i = 0; i < 16; ++i) *(f32x4*)(ok + 4 * i) = (f32x4){kf[4 * i], kf[4 * i + 1], kf[4 * i + 2], kf[4 * i + 3]}; }
            asm volatile("" ::: "memory");
#pragma unroll
            for (int i = 0; i < 8; ++i) vr[i] = *(const v4u*)(prow + C_V + kvh * 64 + 8 * i);
#pragma unroll
            for (int i = 0; i < 8; ++i) { const unsigned q4[4] = {vr[i].x, vr[i].y, vr[i].z, vr[i].w};
#pragma unroll
                for (int e = 0; e < 4; ++e) { vcol[(8 * i + 2 * e) * (VT_STRIDE / 2)] = (bf16)(q4[e] & 0xffffu); vcol[(8 * i + 2 * e + 1) * (VT_STRIDE / 2)] = (bf16)(q4[e] >> 16); } }
            if (lastw) { float* ov = F.out + O_PV + ((size_t)(b * WIN + key - WIN) * NKV + kvh) * HD;
#pragma unroll
                for (int i = 0; i < 8; ++i) { *(f32x4*)(ov + 8 * i) = (f32x4){bflo(vr[i].x), bfhi(vr[i].x), bflo(vr[i].y), bfhi(vr[i].y)}; *(f32x4*)(ov + 8 * i + 4) = (f32x4){bflo(vr[i].z), bfhi(vr[i].z), bflo(vr[i].w), bfhi(vr[i].w)}; }
            }
        } else {
#pragma unroll
            for (int i = 0; i < 8; ++i) *(LAS v4u*)(krow + 16 * i) = (v4u){0u, 0u, 0u, 0u};
#pragma unroll
            for (int d = 0; d < 64; ++d) vcol[d * (VT_STRIDE / 2)] = (bf16)0;
        }
    }
    __syncthreads();
    const int hh = lane >> 5, ql = lane & 31, kvh = w >> 2;
    const float sinkl2 = F.in[I_SINK][w] * LOG2E;
    const float QS = 0.125f * LOG2E;
    const float* qn = F.in[I_QN]; const float* aon = F.in[I_AON] + w * 64;
    for (int s = 0; s < 4; ++s) {
        const int qi = 32 * s + ql, t = blk * WIN + qi; const size_t row = (size_t)b * SEQ + t;
        bf16x8 qf[4];
        {
            const bf16* qp = F.PROJ + row * INW + C_Q + w * 64 + 8 * hh;
            float qv[4][8]; float ss = 0.f;
#pragma unroll
            for (int ds = 0; ds < 4; ++ds) { const v4u r4 = *(const v4u*)(qp + 16 * ds);
                qv[ds][0] = bflo(r4.x); qv[ds][1] = bfhi(r4.x); qv[ds][2] = bflo(r4.y); qv[ds][3] = bfhi(r4.y); qv[ds][4] = bflo(r4.z); qv[ds][5] = bfhi(r4.z); qv[ds][6] = bflo(r4.w); qv[ds][7] = bfhi(r4.w); }
#pragma unroll
            for (int ds = 0; ds < 4; ++ds)
#pragma unroll
                for (int j = 0; j < 8; ++j) ss += qv[ds][j] * qv[ds][j];
            ss += __shfl_xor(ss, 32);
            const float rs = __builtin_amdgcn_rsqf(ss * (1.0f / 64.0f) + EPS);
            const float* cs = F.ROPEC + (size_t)t * 32; const float* sn = F.ROPES + (size_t)t * 32;
#pragma unroll
            for (int ds = 0; ds < 2; ++ds)
#pragma unroll
                for (int j = 0; j < 8; ++j) { const int i = 16 * ds + 8 * hh + j; const float x1 = qv[ds][j] * rs * qn[i], x2 = qv[ds + 2][j] * rs * qn[i + 32], cc = cs[i], sv = sn[i];
                    qv[ds][j] = (x1 * cc - x2 * sv) * QS; qv[ds + 2][j] = (x2 * cc + x1 * sv) * QS; }
#pragma unroll
            for (int ds = 0; ds < 4; ++ds) { v4u o; o.x = cvtpk(qv[ds][0], qv[ds][1]); o.y = cvtpk(qv[ds][2], qv[ds][3]); o.z = cvtpk(qv[ds][4], qv[ds][5]); o.w = cvtpk(qv[ds][6], qv[ds][7]); qf[ds] = __builtin_bit_cast(bf16x8, o); }
        }
        f32x16 p[5];
#pragma unroll
        for (int kt = 0; kt < 5; ++kt) {
            const LAS unsigned char* kp = Ks + kvh * KS_KVH + (32 * (s + kt) + ql) * KS_STRIDE + 16 * hh;
            f32x16 acc = {0.f, 0.f, 0.f, 0.f, 0.f, 0.f, 0.f, 0.f, 0.f, 0.f, 0.f, 0.f, 0.f, 0.f, 0.f, 0.f};
#pragma unroll
            for (int ds = 0; ds < 4; ++ds) { const bf16x8 kfr = *(const LAS bf16x8*)(kp + 32 * ds); acc = __builtin_amdgcn_mfma_f32_32x32x16_bf16(kfr, qf[ds], acc, 0, 0, 0); }
            p[kt] = acc;
        }
        float mx = -INFINITY;
#pragma unroll
        for (int kt = 0; kt < 5; ++kt)
#pragma unroll
            for (int r = 0; r < 16; ++r) { const int kj = 32 * (s + kt) + (r & 3) + 8 * (r >> 2) + 4 * hh;
                const bool valid = (kj > qi) && (kj <= qi + WIN) && (blk > 0 || kj >= WIN);
                const float v = valid ? p[kt][r] : -INFINITY; p[kt][r] = v; mx = fmaxf(mx, v); }
        mx = fmaxf(mx, __shfl_xor(mx, 32)); mx = fmaxf(mx, sinkl2);
        float sum = 0.f;
#pragma unroll
        for (int kt = 0; kt < 5; ++kt)
#pragma unroll
            for (int r = 0; r < 16; ++r) { const float e = __builtin_amdgcn_exp2f(p[kt][r] - mx); p[kt][r] = e; sum += e; }
        sum += __shfl_xor(sum, 32);
        const float inv = __builtin_amdgcn_rcpf(sum + __builtin_amdgcn_exp2f(sinkl2 - mx));
        f32x16 o0 = {0.f, 0.f, 0.f, 0.f, 0.f, 0.f, 0.f, 0.f, 0.f, 0.f, 0.f, 0.f, 0.f, 0.f, 0.f, 0.f}, o1 = o0;
#pragma unroll
        for (int kt = 0; kt < 5; ++kt)
#pragma unroll
            for (int ss2 = 0; ss2 < 2; ++ss2) {
                v4u pw; pw.x = cvtpk(p[kt][8 * ss2 + 0], p[kt][8 * ss2 + 1]); pw.y = cvtpk(p[kt][8 * ss2 + 2], p[kt][8 * ss2 + 3]); pw.z = cvtpk(p[kt][8 * ss2 + 4], p[kt][8 * ss2 + 5]); pw.w = cvtpk(p[kt][8 * ss2 + 6], p[kt][8 * ss2 + 7]);
                const bf16x8 pf = __builtin_bit_cast(bf16x8, pw);
                const LAS unsigned char* vp = Vt + kvh * VT_KVH + ql * VT_STRIDE + (16 * (2 * (s + kt) + ss2) + 8 * hh) * 2;
                const bf16x8 v0 = *(const LAS bf16x8*)(vp), v1 = *(const LAS bf16x8*)(vp + 32 * VT_STRIDE);
                o0 = __builtin_amdgcn_mfma_f32_32x32x16_bf16(v0, pf, o0, 0, 0, 0);
                o1 = __builtin_amdgcn_mfma_f32_32x32x16_bf16(v1, pf, o1, 0, 0, 0);
            }
        float hsq = 0.f;
#pragma unroll
        for (int r = 0; r < 16; ++r) { o0[r] *= inv; o1[r] *= inv; hsq += o0[r] * o0[r] + o1[r] * o1[r]; }
        hsq += __shfl_xor(hsq, 32);
        if (hh == 0) hs[(s * 8 + w) * 32 + ql] = hsq;
        __syncthreads();
        float tot = 0.f;
#pragma unroll
        for (int w2 = 0; w2 < 8; ++w2) tot += hs[(s * 8 + w2) * 32 + ql];
        const float rsn = __builtin_amdgcn_rsqf(tot * (1.0f / 512.0f) + EPS);
        bf16* crow = F.CAT + row * DM + 512 + w * 64;
#pragma unroll
        for (int g = 0; g < 4; ++g) { const int d0 = 8 * g + 4 * hh;
            const f32x4 g0 = *(const f32x4*)(aon + d0), g1 = *(const f32x4*)(aon + 32 + d0);
            v2u a, c2; a.x = cvtpk(o0[4 * g] * rsn * g0[0], o0[4 * g + 1] * rsn * g0[1]); a.y = cvtpk(o0[4 * g + 2] * rsn * g0[2], o0[4 * g + 3] * rsn * g0[3]);
            c2.x = cvtpk(o1[4 * g] * rsn * g1[0], o1[4 * g + 1] * rsn * g1[1]); c2.y = cvtpk(o1[4 * g + 2] * rsn * g1[2], o1[4 * g + 3] * rsn * g1[3]);
            *(v2u*)(crow + d0) = a; *(v2u*)(crow + 32 + d0) = c2; }
    }
    __syncthreads();
}

constexpr int SK_ROW = 136, SK_KVH = 68;
constexpr int SM_KC = 0, SM_VC = 132 * SK_ROW * 4, SM_QS = SM_VC + 132 * 128 * 4, SM_HS = SM_QS + 8 * 64 * 4, SM_END = SM_HS + 64 * 4;
static_assert(SM_END <= SCR_BYTES, "sample LDS");
__device__ __forceinline__ void sample_item(Frame& F, int b) {
    int tid_ = F.tid; asm volatile("" : "+v"(tid_));
    const int tid = tid_, lane = tid & 63, w = F.wave;
    const size_t row0 = (size_t)MP + (size_t)b * DEC_T;
    {
        const int c = tid, blk = w, cj = c & 63;
        LAS float* xcs = (LAS float*)F.lds;
        LAS float* red = xcs + 4 * 512;
        const float cw0 = F.in[I_CW][c], cw1 = F.in[I_CW][512 + c], cw2 = F.in[I_CW][1024 + c], cw3 = F.in[I_CW][1536 + c], cb = F.in[I_CB][c];
        const float lam = F.in[I_LAM][c];
        const float c8 = -8.0f * (fmaxf(-lam, 0.f) + log1pf(expf(-fabsf(lam))));
        float xs[7];
#pragma unroll
        for (int j = 0; j < 3; ++j) xs[j] = F.in[I_SC][((size_t)b * 3 + j) * 512 + c];
#pragma unroll
        for (int t = 0; t < 4; ++t) xs[3 + t] = bf1(F.PROJ[(row0 + t) * INW + c]);
#pragma unroll
        for (int t = 0; t < 4; ++t) xcs[t * 512 + c] = cb + cw0 * xs[t] + cw1 * xs[t + 1] + cw2 * xs[t + 2] + cw3 * xs[t + 3];
        __syncthreads();
        float rp[4], ip[4];
#pragma unroll
        for (int t = 0; t < 4; ++t) { rp[t] = F.in[I_BA][c]; ip[t] = F.in[I_BX][c]; }
        for (int k = 0; k < 64; ++k) { const float wa = F.in[I_WA][(blk * 64 + k) * 64 + cj], wx = F.in[I_WX][(blk * 64 + k) * 64 + cj];
#pragma unroll
            for (int t = 0; t < 4; ++t) { const float xv = xcs[t * 512 + blk * 64 + k]; rp[t] += xv * wa; ip[t] += xv * wx; } }
        float h = F.in[I_SH][(size_t)b * 512 + c]; float ov[4];
#pragma unroll
        for (int t = 0; t < 4; ++t) {
            const float r = sigmoid_f(rp[t]), ig = sigmoid_f(ip[t]);
            const float la = c8 * r, a = __builtin_amdgcn_exp2f(la * LOG2E);
            const float mult = __builtin_amdgcn_sqrtf(one_minus_exp(2.0f * la));
            h = a * h + mult * ig * xcs[t * 512 + c];
            const float g = bf1(F.PROJ[(row0 + t) * INW + C_GATE + c]);
            ov[t] = h * gelu_tanh(g);
            const float s = wave_sum(ov[t] * ov[t]); if (lane == 0) red[t * 8 + w] = s;
        }
        F.out[O_SH + (size_t)b * 512 + c] = h;
#pragma unroll
        for (int j = 0; j < 3; ++j) F.out[O_SC + ((size_t)b * 3 + j) * 512 + c] = xs[4 + j];
        __syncthreads();
        const float lon = F.in[I_LON][c];
#pragma unroll
        for (int t = 0; t < 4; ++t) { float s = 0.f;
#pragma unroll
            for (int w2 = 0; w2 < 8; ++w2) s += red[t * 8 + w2];
            F.CAT[(row0 + t) * DM + c] = (bf16)f2bf(ov[t] * __builtin_amdgcn_rsqf(s * (1.0f / 512.0f) + EPS) * lon); }
        __syncthreads();
    }
    LAS float* Kc = (LAS float*)(F.lds + SM_KC); LAS float* Vc = (LAS float*)(F.lds + SM_VC); LAS float* qs = (LAS float*)(F.lds + SM_QS); LAS float* hs = (LAS float*)(F.lds + SM_HS);
    {
        const float* ck = F.in[I_CK] + (size_t)b * WIN * 128; const float* cv = F.in[I_CV] + (size_t)b * WIN * 128;
        float* ok = F.out + O_SK + (size_t)b * WIN * 128; float* ov = F.out + O_SV + (size_t)b * WIN * 128;
#pragma unroll
        for (int i = 0; i < 8; ++i) { const int idx = tid * 4 + 2048 * i, j = idx >> 7, rem = idx & 127;
            const f32x4 kv = *(const f32x4*)(ck + idx), vv = *(const f32x4*)(cv + idx);
            *(LAS f32x4*)(Kc + j * SK_ROW + (rem >> 6) * SK_KVH + (rem & 63)) = kv; *(LAS f32x4*)(Vc + j * 128 + rem) = vv;
            if (j >= DEC_T) { *(f32x4*)(ok + idx - DEC_T * 128) = kv; *(f32x4*)(ov + idx - DEC_T * 128) = vv; } }
        if (w < DEC_T) {
            const int t = w, kvh = lane >> 5, i = lane & 31;
            const bf16* pr = F.PROJ + (row0 + t) * INW;
            const float k1 = bf1(pr[C_K + kvh * 64 + i]), k2 = bf1(pr[C_K + kvh * 64 + 32 + i]);
            float ss = k1 * k1 + k2 * k2;
#pragma unroll
            for (int o = 1; o < 32; o <<= 1) ss += __shfl_xor(ss, o);
            const float rs = __builtin_amdgcn_rsqf(ss * (1.0f / 64.0f) + EPS);
            const float x1 = k1 * rs * F.in[I_KN][i], x2 = k2 * rs * F.in[I_KN][i + 32];
            const float cc = F.ROPEC[(size_t)(SEQ + t) * 32 + i], sv = F.ROPES[(size_t)(SEQ + t) * 32 + i];
            const float o1 = x1 * cc - x2 * sv, o2 = x2 * cc + x1 * sv;
            Kc[(WIN + t) * SK_ROW + kvh * SK_KVH + i] = o1; Kc[(WIN + t) * SK_ROW + kvh * SK_KVH + 32 + i] = o2;
            const float v1 = bf1(pr[C_V + kvh * 64 + i]), v2 = bf1(pr[C_V + kvh * 64 + 32 + i]);
            Vc[(WIN + t) * 128 + kvh * 64 + i] = v1; Vc[(WIN + t) * 128 + kvh * 64 + 32 + i] = v2;
            const size_t oo = ((size_t)(WIN - DEC_T + t) * NKV + kvh) * HD;
            ok[oo + i] = o1; ok[oo + 32 + i] = o2; ov[oo + i] = v1; ov[oo + 32 + i] = v2;
        }
    }
    __syncthreads();
    const int head = w, kvh = w >> 2;
    const float sinkl2 = F.in[I_SINK][head] * LOG2E;
    float osave[4];
#pragma unroll
    for (int t = 0; t < DEC_T; ++t) {
        {
            const float x = bf1(F.PROJ[(row0 + t) * INW + C_Q + head * 64 + lane]);
            const float ss = wave_sum(x * x);
            const float xn = x * __builtin_amdgcn_rsqf(ss * (1.0f / 64.0f) + EPS) * F.in[I_QN][lane];
            const float other = __shfl_xor(xn, 32);
            const int i = lane & 31; const float cc = F.ROPEC[(size_t)(SEQ + t) * 32 + i], sv = F.ROPES[(size_t)(SEQ + t) * 32 + i];
            const float qo = (lane < 32) ? (xn * cc - other * sv) : (xn * cc + other * sv);
            qs[w * 64 + lane] = qo * (0.125f * LOG2E);
        }
        LDS_WAIT(); asm volatile("" ::: "memory");
        const int j0 = t + 1 + lane, j1 = j0 + 64;
        float s0 = 0.f, s1 = 0.f;
        const LAS f32x4* q4 = (const LAS f32x4*)(qs + w * 64);
        const LAS f32x4* k0 = (const LAS f32x4*)(Kc + j0 * SK_ROW + kvh * SK_KVH); const LAS f32x4* k1 = (const LAS f32x4*)(Kc + j1 * SK_ROW + kvh * SK_KVH);
#pragma unroll
        for (int d4 = 0; d4 < 16; ++d4) { const f32x4 q = q4[d4], a = k0[d4], c = k1[d4];
            s0 += q[0] * a[0] + q[1] * a[1] + q[2] * a[2] + q[3] * a[3]; s1 += q[0] * c[0] + q[1] * c[1] + q[2] * c[2] + q[3] * c[3]; }
        float mx = wave_max(fmaxf(s0, s1)); mx = fmaxf(mx, sinkl2);
        const float p0 = __builtin_amdgcn_exp2f(s0 - mx), p1 = __builtin_amdgcn_exp2f(s1 - mx);
        const float l = wave_sum(p0 + p1) + __builtin_amdgcn_exp2f(sinkl2 - mx);
        float o = 0.f;
        for (int jj = 0; jj < 64; ++jj) {
            const float pa = __shfl(p0, jj), pb = __shfl(p1, jj);
            o += pa * Vc[(t + 1 + jj) * 128 + kvh * 64 + lane] + pb * Vc[(t + 65 + jj) * 128 + kvh * 64 + lane];
        }
        o *= __builtin_amdgcn_rcpf(l);
        osave[t] = o;
        const float hq = wave_sum(o * o); if (lane == 0) hs[t * 8 + w] = hq;
    }
    __syncthreads();
#pragma unroll
    for (int t = 0; t < DEC_T; ++t) { float s = 0.f;
#pragma unroll
        for (int w2 = 0; w2 < 8; ++w2) s += hs[t * 8 + w2];
        F.CAT[(row0 + t) * DM + 512 + head * 64 + lane] = (bf16)f2bf(osave[t] * __builtin_amdgcn_rsqf(s * (1.0f / 512.0f) + EPS) * F.in[I_AON][head * 64 + lane]); }
    __syncthreads();
}

struct SEpiSwiglu {
    bf16* H; const float* ssq;
    __device__ __forceinline__ int brow0(int cb) const { const int hc0 = 32 * cb; return (hc0 >> 7) * 256 + (hc0 & 127); }
    __device__ __forceinline__ int brow1(int cb) const { return brow0(cb) + 128; }
    __device__ __forceinline__ void operator()(const f32x16& a0, const f32x16& a1, int r, int cb, int h) const {
        const float rs = pg8::row_rs(ssq, r);
#pragma unroll
        for (int g = 0; g < 4; ++g) { float hv[4];
#pragma unroll
            for (int e = 0; e < 4; ++e) hv[e] = pg8::silu_f(a0[4 * g + e] * rs) * (a1[4 * g + e] * rs);
            v2u w; w.x = cvtpk(hv[0], hv[1]); w.y = cvtpk(hv[2], hv[3]); *(v2u*)(H + (size_t)r * DFF + 32 * cb + 8 * g + 4 * h) = w; }
    }
};
struct SEpiScale {
    bf16* O; int ldc; const float* ssq;
    __device__ __forceinline__ int brow0(int cb) const { return 64 * cb; }
    __device__ __forceinline__ int brow1(int cb) const { return 64 * cb + 32; }
    __device__ __forceinline__ void operator()(const f32x16& a0, const f32x16& a1, int r, int cb, int h) const {
        const float rs = pg8::row_rs(ssq, r);
#pragma unroll
        for (int g = 0; g < 4; ++g) {
            v2u w; w.x = cvtpk(a0[4 * g] * rs, a0[4 * g + 1] * rs); w.y = cvtpk(a0[4 * g + 2] * rs, a0[4 * g + 3] * rs); *(v2u*)(O + (size_t)r * ldc + 64 * cb + 8 * g + 4 * h) = w;
            v2u x; x.x = cvtpk(a1[4 * g] * rs, a1[4 * g + 1] * rs); x.y = cvtpk(a1[4 * g + 2] * rs, a1[4 * g + 3] * rs); *(v2u*)(O + (size_t)r * ldc + 64 * cb + 32 + 8 * g + 4 * h) = x; }
    }
};
template <int MODE> struct SEpiResid {
    const float* basef; float* out; bf16* xb; float* ssq; float scale;
    __device__ __forceinline__ int brow0(int cb) const { return 64 * cb; }
    __device__ __forceinline__ int brow1(int cb) const { return 64 * cb + 32; }
    __device__ __forceinline__ void operator()(const f32x16& a0, const f32x16& a1, int r, int cb, int h) const {
        float s = 0.f;
#pragma unroll
        for (int a = 0; a < 2; ++a)
#pragma unroll
            for (int g = 0; g < 4; ++g) { const size_t off = (size_t)r * DM + 64 * cb + 32 * a + 8 * g + 4 * h;
                f32x4 b; if (MODE == 0) b = *(const f32x4*)(basef + off); else b = pg8::bf4_to_f32(*(const v2u*)(xb + off));
                const f32x4 v = a == 0 ? (f32x4){a0[4 * g], a0[4 * g + 1], a0[4 * g + 2], a0[4 * g + 3]} : (f32x4){a1[4 * g], a1[4 * g + 1], a1[4 * g + 2], a1[4 * g + 3]};
                const f32x4 o = b + v * scale;
                if (MODE == 2) *(f32x4*)(out + off) = o;
                else { s += (o[0] * o[0] + o[1] * o[1]) + (o[2] * o[2] + o[3] * o[3]); v2u w; w.x = cvtpk(o[0], o[1]); w.y = cvtpk(o[2], o[3]); *(v2u*)(xb + off) = w; } }
        if (MODE != 2) { s += __shfl_xor(s, 32); if (h == 0) ssq[(size_t)r * 16 + cb] = s; }
    }
};
template <int K, int KS, class Epi> __device__ __forceinline__ void small_gemm(Frame& F, const bf16* A, int lda, const bf16* Bt, int ncb, const Epi& E) {
    int lane_ = F.lane; asm volatile("" : "+v"(lane_));
    const int lane = lane_, w = F.wave, ql = lane & 31, h = lane >> 5;
    const int nitems = 16 * ncb * KS;
    LAS float* red = (LAS float*)F.lds;
    for (int base = blockIdx.x * NWAVES; base < nitems; base += F.G * NWAVES) {
        const int it = base + w; const bool valid = it < nitems;
        const int tile = it / KS, ks = it % KS, rb = tile & 15, cb = tile >> 4;
        f32x16 acc0 = {0.f, 0.f, 0.f, 0.f, 0.f, 0.f, 0.f, 0.f, 0.f, 0.f, 0.f, 0.f, 0.f, 0.f, 0.f, 0.f}, acc1 = acc0;
        const int r = MP + 32 * rb + ql;
        if (valid) {
            const bf16* ap = A + (size_t)r * lda + ks * (K / KS) + 8 * h;
            const bf16* b0 = Bt + (size_t)(E.brow0(cb) + ql) * K + ks * (K / KS) + 8 * h;
            const bf16* b1 = Bt + (size_t)(E.brow1(cb) + ql) * K + ks * (K / KS) + 8 * h;
#pragma unroll 8
            for (int k0 = 0; k0 < K / KS; k0 += 16) {
                const bf16x8 af = *(const bf16x8*)(ap + k0), bf0 = *(const bf16x8*)(b0 + k0), bf1v = *(const bf16x8*)(b1 + k0);
                acc0 = __builtin_amdgcn_mfma_f32_32x32x16_bf16(bf0, af, acc0, 0, 0, 0);
                acc1 = __builtin_amdgcn_mfma_f32_32x32x16_bf16(bf1v, af, acc1, 0, 0, 0);
            }
        }
        if (KS > 1) {
#pragma unroll
            for (int q = 0; q < 16; ++q) { red[((w * 2 + 0) * 16 + q) * 64 + lane] = acc0[q]; red[((w * 2 + 1) * 16 + q) * 64 + lane] = acc1[q]; }
            __syncthreads();
            if (valid && ks == 0) {
#pragma unroll
                for (int j = 1; j < KS; ++j)
#pragma unroll
                    for (int q = 0; q < 16; ++q) { acc0[q] += red[(((w + j) * 2 + 0) * 16 + q) * 64 + lane]; acc1[q] += red[(((w + j) * 2 + 1) * 16 + q) * 64 + lane]; }
            }
        }
        if (valid && ks == 0) E(acc0, acc1, r, cb, h);
        if (KS > 1) __syncthreads();
    }
}

#ifndef MK_N_LAUNCHES
#define MK_N_LAUNCHES 1
#endif
constexpr int N_PHASES = 9;
constexpr int N_LAUNCHES = MK_N_LAUNCHES;
struct Args { const float* in[29]; float* out; unsigned char* ws; int ph_lo, ph_hi, li, pad; };
__global__ void __launch_bounds__(NWAVES * 64, 2) hymba_fwd(Args args) {
    extern __shared__ __attribute__((aligned(16))) unsigned char lds[];
    Frame F;
    F.lds = (LAS unsigned char*)lds;
    F.MISC = (volatile LAS unsigned*)(F.lds + MISC_OFF);
    F.tid = threadIdx.x; F.lane = F.tid & 63; F.wave = __builtin_amdgcn_readfirstlane(F.tid >> 6);
    F.G = gridDim.x; { const int bx = blockIdx.x; F.vcu = (F.G % 8 == 0) ? (bx % 8) * (F.G / 8) + bx / 8 : bx; }
    unsigned char* ws = args.ws;
    F.ctl = (gu32*)(ws + WS_CTL);
#pragma unroll
    for (int i = 0; i < 29; ++i) F.in[i] = args.in[i];
    F.out = args.out;
    F.WGU1 = (bf16*)(ws + WS_WGU1); F.WD1 = (bf16*)(ws + WS_WD1); F.WINT = (bf16*)(ws + WS_WIN); F.WOUT = (bf16*)(ws + WS_WOUT); F.WGU2 = (bf16*)(ws + WS_WGU2); F.WD2 = (bf16*)(ws + WS_WD2);
    F.ROPEC = (float*)(ws + WS_ROPE); F.ROPES = F.ROPEC + ROPE_ROWS * 32; F.SSQ = (float*)(ws + WS_SSQ); F.LSUM = (float*)(ws + WS_LSUM);
    F.XB = (bf16*)(ws + WS_XB); F.CAT = (bf16*)(ws + WS_CAT); F.PROJ = (bf16*)(ws + WS_PROJ); F.HB = (bf16*)(ws + WS_H);
    for (int u = F.tid; u < (LDS_BYTES - LDSCTL_OFF) / 4; u += NWAVES * 64) ((LAS unsigned*)(F.lds + LDSCTL_OFF))[u] = 0u;
    __syncthreads();
    XcdBarrier bar; bar.bar = (unsigned*)(F.ctl + CW_BAR); bar.x = 0; bar.st = nullptr;
    if (N_LAUNCHES == 1) bar = xcd_barrier_post((unsigned*)(F.ctl + CW_BAR), F.MISC + 8);
#define GRID_BAR() do { if (N_LAUNCHES == 1) xcd_barrier(bar); } while (0)
    const int lo = args.ph_lo, hi = args.ph_hi;
#define IN(k) (lo <= (k) && (k) < hi)
#define BOTH(k) (IN(k) && IN((k) + 1))
#ifndef PROBE_REP
#define PROBE_REP 0
#endif
#define REP(k) for (int rep_ = 0; rep_ < (((PROBE_REP >> (k)) & 1) ? 2 : 1); ++rep_)

#ifndef SKIP_P0
    if (IN(0)) REP(0) { p0_prologue(F); if (BOTH(0)) GRID_BAR(); }
#endif
    if (IN(1)) REP(1) {
        pg8::Gemm g{F.XB, F.WGU1, MP, 2 * DFF, DM}; pg8::StaticOrder S; S.init(MP, 2 * DFF, F.G, (int)blockIdx.x);
        pg8::EpiSwiglu E{F.HB, DFF}; pg8::rs_cache_fill(F.lds + RING_OFF, S, F.SSQ);
        pg8::gemm_phase<pg8::EpiSwiglu, pg8::StaticOrder, true, true>(F.lds + RING_OFF, g, S, E);
        { SEpiSwiglu SE{F.HB, F.SSQ}; small_gemm<DM, 1, SEpiSwiglu>(F, F.XB, DM, F.WGU1, DFF / 32, SE); }
        if (BOTH(1)) GRID_BAR();
    }
    if (IN(2)) REP(2) {
        pg8::Gemm g{F.HB, F.WD1, MP, DM, DFF}; pg8::StaticOrder S; S.init(MP, DM, F.G, (int)blockIdx.x);
        pg8::EpiResid<0> E{F.in[I_XP], nullptr, F.XB, F.SSQ, 0.5f};
        pg8::gemm_phase<pg8::EpiResid<0>, pg8::StaticOrder, true, true>(F.lds + RING_OFF, g, S, E);
        { SEpiResid<0> SE{F.in[I_XS] - (size_t)MP * DM, nullptr, F.XB, F.SSQ, 0.5f}; small_gemm<DFF, 8, SEpiResid<0>>(F, F.HB, DFF, F.WD1, DM / 64, SE); }
        if (BOTH(2)) GRID_BAR();
    }
    if (IN(3)) REP(3) {
        pg8::Gemm g{F.XB, F.WINT, MP, INW, DM}; pg8::StaticOrder S; S.init(MP, INW, F.G, (int)blockIdx.x);
        pg8::EpiScaleBf16 E{F.PROJ, INW}; pg8::rs_cache_fill(F.lds + RING_OFF, S, F.SSQ);
        pg8::gemm_phase<pg8::EpiScaleBf16, pg8::StaticOrder, true, true>(F.lds + RING_OFF, g, S, E);
        { SEpiScale SE{F.PROJ, INW, F.SSQ}; small_gemm<DM, 4, SEpiScale>(F, F.XB, DM, F.WINT, INW / 64, SE); }
        if (BOTH(3)) GRID_BAR();
    }
    if (IN(4)) REP(4) {
#ifndef SKIP_ATTN
        for (int it = blockIdx.x; it < BATCH * (SEQ / WIN); it += F.G) attn_prompt_item(F, it);
#endif
#ifndef SKIP_LRU1
        for (int it = blockIdx.x; it < BATCH * NCHUNK; it += F.G) lru_prompt_item<1>(F, it);
#endif
#ifndef SKIP_SAMPLE
        for (int it = blockIdx.x; it < DEC_B; it += F.G) sample_item(F, it);
#endif
        if (BOTH(4)) GRID_BAR();
    }
    if (IN(5)) REP(5) {
#ifndef SKIP_LRU2
        for (int it = blockIdx.x; it < BATCH * NCHUNK; it += F.G) lru_prompt_item<2>(F, it);
#endif
        if (BOTH(5)) GRID_BAR();
    }
    if (IN(6)) {
        pg8::Gemm g{F.CAT, F.WOUT, MP, DM, DM}; pg8::StaticOrder S; S.init(MP, DM, F.G, (int)blockIdx.x);
        pg8::EpiResid<1> E{nullptr, nullptr, F.XB, F.SSQ, 1.0f};
        pg8::gemm_phase<pg8::EpiResid<1>, pg8::StaticOrder, true, true>(F.lds + RING_OFF, g, S, E);
        { SEpiResid<1> SE{nullptr, nullptr, F.XB, F.SSQ, 1.0f}; small_gemm<DM, 8, SEpiResid<1>>(F, F.CAT, DM, F.WOUT, DM / 64, SE); }
        if (BOTH(6)) GRID_BAR();
    }
    if (IN(7)) REP(7) {
        pg8::Gemm g{F.XB, F.WGU2, MP, 2 * DFF, DM}; pg8::StaticOrder S; S.init(MP, 2 * DFF, F.G, (int)blockIdx.x);
        pg8::EpiSwiglu E{F.HB, DFF}; pg8::rs_cache_fill(F.lds + RING_OFF, S, F.SSQ);
        pg8::gemm_phase<pg8::EpiSwiglu, pg8::StaticOrder, true, true>(F.lds + RING_OFF, g, S, E);
        { SEpiSwiglu SE{F.HB, F.SSQ}; small_gemm<DM, 1, SEpiSwiglu>(F, F.XB, DM, F.WGU2, DFF / 32, SE); }
        if (BOTH(7)) GRID_BAR();
    }
    if (IN(8)) {
        pg8::Gemm g{F.HB, F.WD2, MP, DM, DFF}; pg8::StaticOrder S; S.init(MP, DM, F.G, (int)blockIdx.x);
        pg8::EpiResid<2> E{nullptr, F.out, F.XB, nullptr, 0.5f};
        pg8::gemm_phase<pg8::EpiResid<2>, pg8::StaticOrder, true, true>(F.lds + RING_OFF, g, S, E);
        { SEpiResid<2> SE{nullptr, F.out, F.XB, nullptr, 0.5f}; small_gemm<DFF, 8, SEpiResid<2>>(F, F.HB, DFF, F.WD2, DM / 64, SE); }
    }
#undef IN
#undef BOTH
}

extern "C" void kernel_launch(void* const* d_in, const int* in_sizes, int n_in, void* d_out, int out_size, void* d_ws, size_t ws_size, hipStream_t stream) {
    static int grid = 0;
    if (grid == 0) {
        if (n_in != 29 || in_sizes[0] != MP * DM || (size_t)out_size != O_END || ws_size < WS_END) { fprintf(stderr, "kernel_launch: unexpected shapes (n_in %d in0 %d out %d ws %zu); nothing launched\n", n_in, n_in > 0 ? in_sizes[0] : -1, out_size, ws_size); grid = -1; return; }
        int dev = 0, cus = 0, per_cu = 0;
        if (hipGetDevice(&dev) != hipSuccess || hipDeviceGetAttribute(&cus, hipDeviceAttributeMultiprocessorCount, dev) != hipSuccess) { fprintf(stderr, "kernel_launch: device query failed\n"); grid = -1; return; }
        if (hipFuncSetAttribute((const void*)hymba_fwd, hipFuncAttributeMaxDynamicSharedMemorySize, LDS_BYTES) != hipSuccess) { fprintf(stderr, "kernel_launch: hipFuncSetAttribute failed\n"); grid = -1; return; }
        if (hipOccupancyMaxActiveBlocksPerMultiprocessor(&per_cu, (const void*)hymba_fwd, NWAVES * 64, LDS_BYTES) != hipSuccess || per_cu < 1) { fprintf(stderr, "kernel_launch: occupancy query reports %d workgroups per CU\n", per_cu); per_cu = 1; }
        (void)hipGetLastError();
        grid = cus;
    }
    if (grid < 0) return;
    if (hipMemsetAsync((char*)d_ws + WS_CTL, 0, CTL_ZERO_BYTES, stream) != hipSuccess) { fprintf(stderr, "kernel_launch: memset failed\n"); return; }
    Args a{};
    for (int i = 0; i < 29; ++i) a.in[i] = (const float*)d_in[i];
    a.out = (float*)d_out; a.ws = (unsigned char*)d_ws;
    if (N_LAUNCHES == 1) {
        a.ph_lo = 0; a.ph_hi = N_PHASES; a.li = 0;
        hipLaunchKernelGGL(hymba_fwd, dim3(grid), dim3(NWAVES * 64), LDS_BYTES, stream, a);
    } else {
        for (int li = 0; li < N_PHASES; ++li) { a.ph_lo = li; a.ph_hi = li + 1; a.li = li; hipLaunchKernelGGL(hymba_fwd, dim3(grid), dim3(NWAVES * 64), LDS_BYTES, stream, a); }
    }
    const hipError_t le = hipPeekAtLastError();
    if (le != hipSuccess) fprintf(stderr, "kernel_launch: launch failed: %s\n", hipGetErrorName(le));
}
```

```cpp
#include <hip/hip_runtime.h>
#include <cstdio>
#include <cstdint>
#include <cmath>
namespace pg8 {
#define PG8_LAS __attribute__((address_space(3)))
typedef unsigned short bf16_t;
typedef short bf16x8 __attribute__((ext_vector_type(8)));
typedef float f32x4 __attribute__((ext_vector_type(4)));
typedef unsigned u32x4 __attribute__((ext_vector_type(4)));
constexpr int BM = 256, BK = 64, HALF = 128, HTB = HALF * BK * 2  , STAGE_BYTES = 8 * HTB, NXCD = 8, WGM = 8;

__host__ __device__ __forceinline__ int lds_byte(int r, int c) { const int st = (r >> 4) * 2 + (c >> 5), rr = r & 15, cc = c & 31, ob = rr * 64 + cc * 2; return st * 1024 + (ob ^ (((ob >> 9) & 1) << 5)); }
__host__ __device__ __forceinline__ void stage_rc(int b, int& R, int& C) { const int st = b / 1024, sb = b % 1024, swz = sb ^ (((sb >> 9) & 1) << 5); R = (st >> 1) * 16 + swz / 64; C = (st & 1) * 32 + (swz % 64) / 2; }
__host__ __device__ __forceinline__ int perm32(int rho) { const int n = rho >> 4, i = rho & 15; return 8 * (i >> 2) + 4 * n + (i & 3); }

struct Unit { int pm, pn; };
struct Gemm { const bf16_t* A; const bf16_t* Bt; int M, N, K; };

struct StaticOrder {
    int nM, nN, nwg, G, c;
    __host__ __device__ void init(int M, int N, int G_, int c_) { nM = M / BM; nN = N / BM; nwg = nM * nN; G = G_; c = c_; }
    __host__ __device__ bool next(int i, Unit& u) const {
        const long L = (long)i * G + c; if (L >= nwg) return false;
        int wgid = (int)L; { const int q = nwg / NXCD, r = nwg % NXCD, xcd = wgid % NXCD, off = wgid / NXCD; wgid = (xcd < r ? xcd * (q + 1) : r * (q + 1) + (xcd - r) * q) + off; }
        const int nig = WGM * nN, gid = wgid / nig, fm = gid * WGM, gsz = (nM - fm) < WGM ? (nM - fm) : WGM;
        u.pm = fm + ((wgid % nig) % gsz); u.pn = (wgid % nig) / gsz; return true;
    }
    __device__ __forceinline__ void a_ready(const Unit&) const {}
    __device__ __forceinline__ void done(const Unit&) const {}
};

__device__ __forceinline__ unsigned cvt_pk_bf16(float lo, float hi) { unsigned r; asm volatile("v_cvt_pk_bf16_f32 %0, %1, %2" : "=v"(r) : "v"(lo), "v"(hi)); return r; }
#ifndef PROBE_WHICH
#define PROBE_WHICH 0
#endif
constexpr bool TM_ON = PROBE_WHICH != 0;
struct Tm { unsigned long long k, e; };
__device__ __forceinline__ int pg8_lane_id() { int l; asm volatile("v_mbcnt_lo_u32_b32 %0, -1, 0\n\tv_mbcnt_hi_u32_b32 %0, -1, %0" : "=v"(l)); return l; }
typedef float f32x2 __attribute__((ext_vector_type(2)));
typedef unsigned u32x2 __attribute__((ext_vector_type(2)));
constexpr float RMS_EPS = 1e-6f;
__device__ __forceinline__ float row_rs(const float* ssq, int r) {
    const f32x4* p = (const f32x4*)(ssq + (size_t)r * 16);
    const f32x4 a = p[0], b = p[1], c = p[2], d = p[3];
    const float s = ((a[0] + a[1]) + (a[2] + a[3])) + ((b[0] + b[1]) + (b[2] + b[3])) + ((c[0] + c[1]) + (c[2] + c[3])) + ((d[0] + d[1]) + (d[2] + d[3]));
    return __builtin_amdgcn_rsqf(s * (1.0f / 1024.0f) + RMS_EPS);
}
__device__ __forceinline__ float silu_f(float g) { return g * __builtin_amdgcn_rcpf(1.0f + __builtin_amdgcn_exp2f(g * -1.4426950408889634f)); }

constexpr int RS_CACHE_OFF = STAGE_BYTES;
template <class Sched> __device__ __forceinline__ void rs_cache_fill(PG8_LAS unsigned char* lds, const Sched& S, const float* ssq, int wid) {
    PG8_LAS float* rsl = (PG8_LAS float*)(lds + RS_CACHE_OFF); Unit u; const int tid_ = wid * 64 + pg8_lane_id(), t = tid_ & 255, hf = tid_ >> 8;
    for (int i = hf; S.next(i, u); i += 2) rsl[i * 256 + t] = row_rs(ssq, u.pm * BM + t);
    __syncthreads();
}
struct EpiSwiglu {
    static constexpr bool PERM = true, AFTER_DRAIN = false, MID = false;
    bf16_t* H; int ldh;
    __device__ __forceinline__ void operator()(const f32x4 (&acc)[2][2][4][2], const Unit& u, int wr, int wc, int fr, int fq, int ui, PG8_LAS unsigned char* lds) const {
        const int row0 = u.pm * BM + wr * 64 + fr, col0 = u.pn * HALF + wc * 32 + 8 * fq;
        const PG8_LAS float* rsl = (const PG8_LAS float*)(lds + RS_CACHE_OFF) + ui * 256 + wr * 64 + fr;
#pragma unroll
        for (int ai = 0; ai < 2; ++ai)
#pragma unroll
            for (int m = 0; m < 4; ++m) {
                const int r = row0 + ai * HALF + m * 16; const float rs = rsl[ai * HALF + m * 16];
                float hv[8];
#pragma unroll
                for (int n = 0; n < 2; ++n)
#pragma unroll
                    for (int e = 0; e < 4; ++e) hv[n * 4 + e] = silu_f(acc[ai][0][m][n][e] * rs) * (acc[ai][1][m][n][e] * rs);
                u32x4 w; w.x = cvt_pk_bf16(hv[0], hv[1]); w.y = cvt_pk_bf16(hv[2], hv[3]); w.z = cvt_pk_bf16(hv[4], hv[5]); w.w = cvt_pk_bf16(hv[6], hv[7]);
                *(u32x4*)(H + (size_t)r * ldh + col0) = w;
            }
    }
};
struct EpiScaleBf16 {
    static constexpr bool PERM = true, AFTER_DRAIN = false, MID = false;
    bf16_t* O; int ldc;
    __device__ __forceinline__ void operator()(const f32x4 (&acc)[2][2][4][2], const Unit& u, int wr, int wc, int fr, int fq, int ui, PG8_LAS unsigned char* lds) const {
        const int row0 = u.pm * BM + wr * 64 + fr, col0 = u.pn * BM + wc * 32 + 8 * fq;
        const PG8_LAS float* rsl = (const PG8_LAS float*)(lds + RS_CACHE_OFF) + ui * 256 + wr * 64 + fr;
#pragma unroll
        for (int ai = 0; ai < 2; ++ai)
#pragma unroll
            for (int m = 0; m < 4; ++m) {
                const int r = row0 + ai * HALF + m * 16; const float rs = rsl[ai * HALF + m * 16];
#pragma unroll
                for (int bj = 0; bj < 2; ++bj) {
                    const f32x4 v0 = acc[ai][bj][m][0] * rs, v1 = acc[ai][bj][m][1] * rs;
                    u32x4 w; w.x = cvt_pk_bf16(v0[0], v0[1]); w.y = cvt_pk_bf16(v0[2], v0[3]); w.z = cvt_pk_bf16(v1[0], v1[1]); w.w = cvt_pk_bf16(v1[2], v1[3]);
                    *(u32x4*)(O + (size_t)r * ldc + col0 + bj * HALF) = w;
                }
            }
    }
};
__device__ __forceinline__ f32x4 bf4_to_f32(u32x2 w) { f32x4 r; r[0] = __builtin_bit_cast(float, w.x << 16); r[1] = __builtin_bit_cast(float, w.x & 0xffff0000u); r[2] = __builtin_bit_cast(float, w.y << 16); r[3] = __builtin_bit_cast(float, w.y & 0xffff0000u); return r; }
template <int MODE> struct EpiResid {
    static constexpr bool PERM = true, AFTER_DRAIN = false, MID = false;
    const float* basef; float* out; bf16_t* xb; float* ssq; float scale;
    __device__ __forceinline__ void operator()(const f32x4 (&acc)[2][2][4][2], const Unit& u, int wr, int wc, int fr, int fq, int ui, PG8_LAS unsigned char* lds) const {
        const int row0 = u.pm * BM + wr * 64 + fr, col0 = u.pn * BM + wc * 32 + 8 * fq;
#pragma unroll
        for (int ai = 0; ai < 2; ++ai) {
            f32x4 pre[4][2][2];
#pragma unroll
            for (int m = 0; m < 4; ++m) { const size_t off = (size_t)(row0 + ai * HALF + m * 16) * 1024 + col0;
#pragma unroll
                for (int bj = 0; bj < 2; ++bj) {
                    if (MODE == 0) { pre[m][bj][0] = *(const f32x4*)(basef + off + bj * HALF); pre[m][bj][1] = *(const f32x4*)(basef + off + bj * HALF + 4); }
                    else { const u32x4 w = *(const u32x4*)(xb + off + bj * HALF); pre[m][bj][0] = bf4_to_f32((u32x2){w.x, w.y}); pre[m][bj][1] = bf4_to_f32((u32x2){w.z, w.w}); } } }
#pragma unroll
            for (int m = 0; m < 4; ++m) { const int r = row0 + ai * HALF + m * 16; const size_t off = (size_t)r * 1024 + col0; float s = 0.f;
#pragma unroll
                for (int bj = 0; bj < 2; ++bj) {
                    const f32x4 o0 = pre[m][bj][0] + acc[ai][bj][m][0] * scale, o1 = pre[m][bj][1] + acc[ai][bj][m][1] * scale;
                    if (MODE == 2) { *(f32x4*)(out + off + bj * HALF) = o0; *(f32x4*)(out + off + bj * HALF + 4) = o1; }
                    else { s += ((o0[0] * o0[0] + o0[1] * o0[1]) + (o0[2] * o0[2] + o0[3] * o0[3])) + ((o1[0] * o1[0] + o1[1] * o1[1]) + (o1[2] * o1[2] + o1[3] * o1[3]));
                        u32x4 w; w.x = cvt_pk_bf16(o0[0], o0[1]); w.y = cvt_pk_bf16(o0[2], o0[3]); w.z = cvt_pk_bf16(o1[0], o1[1]); w.w = cvt_pk_bf16(o1[2], o1[3]); *(u32x4*)(xb + off + bj * HALF) = w; }
                }
                if (MODE != 2) { s += __shfl_xor(s, 16); s += __shfl_xor(s, 32); if (fq == 0) ssq[(size_t)r * 16 + u.pn * 4 + wc] = s; }
            }
        }
    }
};
template <class Sched> __device__ __forceinline__ void mix_cache_fill(PG8_LAS unsigned char* lds, const Sched& S, const float* ssql, const float* ssqa, int wid) {
    PG8_LAS f32x2* c2 = (PG8_LAS f32x2*)(lds + RS_CACHE_OFF); Unit u; const int tid_ = wid * 64 + pg8_lane_id(), t = tid_ & 255, hf = tid_ >> 8;
    for (int i = hf; S.next(i, u); i += 2) { const size_t r = (size_t)u.pm * BM + t;
        const f32x4* pl = (const f32x4*)(ssql + r * 8); const f32x4* pa = (const f32x4*)(ssqa + r * 8); const f32x4 l0 = pl[0], l1 = pl[1], a0 = pa[0], a1 = pa[1];
        const float rl = __builtin_amdgcn_rsqf((((l0[0] + l0[1]) + (l0[2] + l0[3])) + ((l1[0] + l1[1]) + (l1[2] + l1[3]))) * (1.0f / 512.0f) + RMS_EPS);
        const float ra = __builtin_amdgcn_rsqf((((a0[0] + a0[1]) + (a0[2] + a0[3])) + ((a1[0] + a1[1]) + (a1[2] + a1[3]))) * (1.0f / 512.0f) + RMS_EPS);
        c2[i * 256 + t] = (f32x2){rl * __builtin_amdgcn_rcpf(ra), ra}; }
    __syncthreads();
}
struct EpiResidMix {
    static constexpr bool PERM = true, AFTER_DRAIN = false, MID = true;
    bf16_t* xb; float* ssq;
    __device__ __forceinline__ void mid(f32x4 (&acc)[2][2][4][2], int wr, int fr, int ui, PG8_LAS unsigned char* lds) const {
        const PG8_LAS f32x2* c2 = (const PG8_LAS f32x2*)(lds + RS_CACHE_OFF) + ui * 256 + wr * 64 + fr;
#pragma unroll
        for (int ai = 0; ai < 2; ++ai)
#pragma unroll
            for (int m = 0; m < 4; ++m) { const float q = c2[ai * HALF + m * 16].x;
#pragma unroll
                for (int bj = 0; bj < 2; ++bj)
#pragma unroll
                    for (int n = 0; n < 2; ++n) acc[ai][bj][m][n] *= q; }
    }
    __device__ __forceinline__ void operator()(const f32x4 (&acc)[2][2][4][2], const Unit& u, int wr, int wc, int fr, int fq, int ui, PG8_LAS unsigned char* lds) const {
        const int row0 = u.pm * BM + wr * 64 + fr, col0 = u.pn * BM + wc * 32 + 8 * fq;
        const PG8_LAS f32x2* c2 = (const PG8_LAS f32x2*)(lds + RS_CACHE_OFF) + ui * 256 + wr * 64 + fr;
#pragma unroll
        for (int ai = 0; ai < 2; ++ai) {
            u32x4 pre[4][2];
#pragma unroll
            for (int m = 0; m < 4; ++m) { const size_t off = (size_t)(row0 + ai * HALF + m * 16) * 1024 + col0;
#pragma unroll
                for (int bj = 0; bj < 2; ++bj) pre[m][bj] = *(const u32x4*)(xb + off + bj * HALF); }
#pragma unroll
            for (int m = 0; m < 4; ++m) { const int r = row0 + ai * HALF + m * 16; const size_t off = (size_t)r * 1024 + col0; float s = 0.f; const float ra = c2[ai * HALF + m * 16].y;
#pragma unroll
                for (int bj = 0; bj < 2; ++bj) {
                    const f32x4 o0 = bf4_to_f32((u32x2){pre[m][bj].x, pre[m][bj].y}) + acc[ai][bj][m][0] * ra, o1 = bf4_to_f32((u32x2){pre[m][bj].z, pre[m][bj].w}) + acc[ai][bj][m][1] * ra;
                    s += ((o0[0] * o0[0] + o0[1] * o0[1]) + (o0[2] * o0[2] + o0[3] * o0[3])) + ((o1[0] * o1[0] + o1[1] * o1[1]) + (o1[2] * o1[2] + o1[3] * o1[3]));
                    u32x4 w; w.x = cvt_pk_bf16(o0[0], o0[1]); w.y = cvt_pk_bf16(o0[2], o0[3]); w.z = cvt_pk_bf16(o1[0], o1[1]); w.w = cvt_pk_bf16(o1[2], o1[3]); *(u32x4*)(xb + off + bj * HALF) = w;
                }
                s += __shfl_xor(s, 16); s += __shfl_xor(s, 32); if (fq == 0) ssq[(size_t)r * 16 + u.pn * 4 + wc] = s;
            }
        }
    }
};
template <class Epi, class Sched, bool ALIGN_EPI = false, bool SP2 = false>
__device__ __forceinline__ void gemm_phase(PG8_LAS unsigned char* lds, const Gemm g, const Sched& S, const Epi& E, int wid_in, Tm& tm) {
    const int wid = wid_in, lane = pg8_lane_id(), tid = wid * 64 + lane, wr = wid >> 2, wc = wid & 3, fr = lane & 15, fq = lane >> 4;
    const int K = g.K, nt = K / BK;
    unsigned voffA[2], voffB[2];
#pragma unroll
    for (int i = 0; i < 2; ++i) { int R, C; stage_rc(tid * 16 + i * 8192, R, C); const int Rb = Epi::PERM ? ((R & ~31) + perm32(R & 31)) : R;
        voffA[i] = (unsigned)(R * K + C) * 2u; voffB[i] = (unsigned)(Rb * K + C) * 2u; }
    const size_t kstep = (size_t)(BK * 2);
    const size_t hstep = (size_t)HALF * K * 2;
    const size_t tstep = 2 * hstep;
    const unsigned ldsw = (unsigned)wid * 1024u;
    const int aoff = lds_byte(wr * 64 + fr, fq * 8), boff = lds_byte(wc * 32 + fr, fq * 8);
#define PG8_SA(b, h) (((b) * 2 + (h)) * HTB)
#define PG8_SB(b, h) ((4 + (b) * 2 + (h)) * HTB)
#define PG8_STAGE(bufoff, gbase, voff) do { _Pragma("unroll") for (int _i = 0; _i < 2; ++_i) \
        __builtin_amdgcn_global_load_lds((const unsigned*)((const char*)(gbase) + (voff)[_i]), (PG8_LAS unsigned*)(lds + (bufoff) + ldsw + _i * 8192), 16, 0, 0); } while (0)
#define PG8_LDA(dst, b, h) do { _Pragma("unroll") for (int m = 0; m < 4; ++m) _Pragma("unroll") for (int k = 0; k < 2; ++k) dst[m][k] = *(const PG8_LAS bf16x8*)(lds + PG8_SA(b, h) + aoff + m * 2048 + k * 1024); } while (0)
#define PG8_LDB(dst, b, h) do { _Pragma("unroll") for (int n = 0; n < 2; ++n) _Pragma("unroll") for (int k = 0; k < 2; ++k) dst[n][k] = *(const PG8_LAS bf16x8*)(lds + PG8_SB(b, h) + boff + n * 2048 + k * 1024); } while (0)
#define PG8_MMA(ai, bj, At, Bt) do { __builtin_amdgcn_s_setprio(1); _Pragma("unroll") for (int m = 0; m < 4; ++m) _Pragma("unroll") for (int n = 0; n < 2; ++n) _Pragma("unroll") for (int k = 0; k < 2; ++k) \
        acc[ai][bj][m][n] = __builtin_amdgcn_mfma_f32_16x16x32_bf16(Bt[n][k], At[m][k], acc[ai][bj][m][n], 0, 0, 0); __builtin_amdgcn_s_setprio(0); } while (0)
#define PG8_WAIT_V(n) asm volatile("s_waitcnt vmcnt(" #n ")" ::: "memory")
#define PG8_WAIT_L(n) asm volatile("s_waitcnt lgkmcnt(" #n ")" ::: "memory")
#define PG8_BAR __builtin_amdgcn_s_barrier()
#define PG8_SCHED __builtin_amdgcn_sched_barrier(0)
    Unit cur, nxt; int ui = 0;
    if (!S.next(0, cur)) return;
    f32x4 acc[2][2][4][2];
#pragma unroll
    for (int a = 0; a < 2; ++a)
#pragma unroll
        for (int b = 0; b < 2; ++b)
#pragma unroll
            for (int m = 0; m < 4; ++m)
#pragma unroll
                for (int n = 0; n < 2; ++n) acc[a][b][m][n] = (f32x4){0.f, 0.f, 0.f, 0.f};
    bf16x8 At[4][2], B0[2][2], B1[2][2];
    const char* cA = (const char*)g.A + (size_t)cur.pm * tstep; const char* cB = (const char*)g.Bt + (size_t)cur.pn * tstep;
    S.a_ready(cur);
    if constexpr (SP2) {
        PG8_STAGE(PG8_SB(0, 0), cB, voffB); PG8_STAGE(PG8_SB(0, 1), cB + hstep, voffB); PG8_STAGE(PG8_SA(0, 0), cA, voffA); PG8_STAGE(PG8_SA(0, 1), cA + hstep, voffA);
        if (wr == 1) PG8_BAR;
        PG8_WAIT_V(2); PG8_BAR;
        PG8_STAGE(PG8_SB(1, 0), cB + kstep, voffB); PG8_STAGE(PG8_SA(1, 0), cA + kstep, voffA); PG8_STAGE(PG8_SB(1, 1), cB + hstep + kstep, voffB);
        PG8_WAIT_V(6); PG8_BAR;
    } else {
        PG8_STAGE(PG8_SB(0, 0), cB, voffB); PG8_STAGE(PG8_SA(0, 0), cA, voffA); PG8_STAGE(PG8_SB(0, 1), cB + hstep, voffB); PG8_STAGE(PG8_SA(0, 1), cA + hstep, voffA);
        if (wr == 1) PG8_BAR;
        PG8_WAIT_V(4); PG8_BAR;
        PG8_STAGE(PG8_SB(1, 0), cB + kstep, voffB); PG8_STAGE(PG8_SA(1, 0), cA + kstep, voffA); PG8_STAGE(PG8_SB(1, 1), cB + hstep + kstep, voffB);
        PG8_WAIT_V(6); PG8_BAR;
    }
    for (;;) {
        const bool has_next = S.next(ui + 1, nxt);
        const unsigned long long tm_a = TM_ON ? __builtin_amdgcn_s_memrealtime() : 0ull;
        const char* nA = has_next ? (const char*)g.A + (size_t)nxt.pm * tstep : cA; const char* nB = has_next ? (const char*)g.Bt + (size_t)nxt.pn * tstep : cB;
        for (int t = 0; t < nt; t += 2) {
            if constexpr (Epi::MID) { if (t == nt / 2) E.mid(acc, wr, fr, ui, lds); }
            const bool last = (t == nt - 2);
            const char* a1 = cA + (size_t)(t + 1) * kstep;
            const char* a2 = last ? nA : cA + (size_t)(t + 2) * kstep; const char* b2 = last ? nB : cB + (size_t)(t + 2) * kstep;
            const char* a3 = a2 + kstep; const char* b3 = b2 + kstep;
            if (last && has_next) S.a_ready(nxt);
            if constexpr (SP2) {
            PG8_LDB(B0, 0, 0); PG8_LDB(B1, 0, 1); PG8_SCHED; PG8_LDA(At, 0, 0); PG8_STAGE(PG8_SA(1, 1), a1 + hstep, voffA);
            PG8_WAIT_V(8); PG8_WAIT_L(0); PG8_BAR; PG8_MMA(0, 0, At, B0); PG8_MMA(0, 1, At, B1); PG8_BAR; PG8_SCHED;
            PG8_LDA(At, 0, 1); PG8_STAGE(PG8_SB(0, 0), b2, voffB); PG8_STAGE(PG8_SB(0, 1), b2 + hstep, voffB); PG8_STAGE(PG8_SA(0, 0), a2, voffA);
            PG8_WAIT_V(8); PG8_WAIT_L(0); PG8_BAR; PG8_MMA(1, 0, At, B0); PG8_MMA(1, 1, At, B1); PG8_BAR; PG8_SCHED;
            PG8_LDB(B0, 1, 0); PG8_LDB(B1, 1, 1); PG8_SCHED; PG8_LDA(At, 1, 0); PG8_STAGE(PG8_SA(0, 1), a2 + hstep, voffA);
            PG8_WAIT_V(8); PG8_WAIT_L(0); PG8_BAR; PG8_MMA(0, 0, At, B0); PG8_MMA(0, 1, At, B1); PG8_BAR; PG8_SCHED;
            PG8_LDA(At, 1, 1); PG8_STAGE(PG8_SB(1, 0), b3, voffB); PG8_STAGE(PG8_SB(1, 1), b3 + hstep, voffB); PG8_STAGE(PG8_SA(1, 0), a3, voffA);
            PG8_WAIT_V(8); PG8_WAIT_L(0); PG8_BAR; PG8_MMA(1, 0, At, B0); PG8_MMA(1, 1, At, B1); PG8_BAR; PG8_SCHED;
            } else {
            PG8_LDB(B0, 0, 0); PG8_SCHED; PG8_LDA(At, 0, 0); PG8_STAGE(PG8_SA(1, 1), a1 + hstep, voffA);
            PG8_WAIT_L(8); PG8_BAR; PG8_WAIT_L(0); PG8_MMA(0, 0, At, B0); PG8_BAR; PG8_SCHED;
            PG8_LDB(B1, 0, 1); PG8_STAGE(PG8_SB(0, 0), b2, voffB);
            PG8_BAR; PG8_WAIT_L(0); PG8_MMA(0, 1, At, B1); PG8_BAR;
            PG8_LDA(At, 0, 1); PG8_STAGE(PG8_SA(0, 0), a2, voffA);
            PG8_BAR; PG8_WAIT_L(0); PG8_MMA(1, 0, At, B0); PG8_BAR; PG8_SCHED;
            PG8_STAGE(PG8_SB(0, 1), b2 + hstep, voffB);
            PG8_WAIT_V(6); PG8_BAR; PG8_MMA(1, 1, At, B1); PG8_BAR;
            PG8_LDB(B0, 1, 0); PG8_SCHED; PG8_LDA(At, 1, 0); PG8_STAGE(PG8_SA(0, 1), a2 + hstep, voffA);
            PG8_WAIT_L(8); PG8_BAR; PG8_WAIT_L(0); PG8_MMA(0, 0, At, B0); PG8_BAR; PG8_SCHED;
            PG8_LDB(B1, 1, 1); PG8_STAGE(PG8_SB(1, 0), b3, voffB);
            PG8_BAR; PG8_WAIT_L(0); PG8_MMA(0, 1, At, B1); PG8_BAR;
            PG8_LDA(At, 1, 1); PG8_STAGE(PG8_SA(1, 0), a3, voffA);
            PG8_BAR; PG8_WAIT_L(0); PG8_MMA(1, 0, At, B0); PG8_BAR; PG8_SCHED;
            PG8_STAGE(PG8_SB(1, 1), b3 + hstep, voffB);
            PG8_WAIT_V(6); PG8_BAR; PG8_MMA(1, 1, At, B1); PG8_BAR;
            }
        }
        const unsigned long long tm_b = TM_ON ? __builtin_amdgcn_s_memrealtime() : 0ull;
        if constexpr (ALIGN_EPI) { if (wr == 0) PG8_BAR; }
        if constexpr (!Epi::AFTER_DRAIN) { E(acc, cur, wr, wc, fr, fq, ui, lds); S.done(cur); }
        if (TM_ON) { const unsigned long long tm_c = __builtin_amdgcn_s_memrealtime(); tm.k += tm_b - tm_a; tm.e += tm_c - tm_b; }
        if (!has_next) break;
#pragma unroll
        for (int a = 0; a < 2; ++a)
#pragma unroll
            for (int b = 0; b < 2; ++b)
#pragma unroll
                for (int m = 0; m < 4; ++m)
#pragma unroll
                    for (int n = 0; n < 2; ++n) acc[a][b][m][n] = (f32x4){0.f, 0.f, 0.f, 0.f};
        cur = nxt; cA = nA; cB = nB; ++ui;
        if constexpr (ALIGN_EPI) { if (wr == 1) PG8_BAR; }
    }
    PG8_WAIT_V(0);
    if constexpr (!ALIGN_EPI) { if (wr == 0) PG8_BAR; }
    PG8_BAR;
    if constexpr (Epi::AFTER_DRAIN) { E.fused(acc, cur, wr, wc, fr, fq, lds, wid, lane); S.done(cur); }
#undef PG8_SA
#undef PG8_SB
#undef PG8_STAGE
#undef PG8_LDA
#undef PG8_LDB
#undef PG8_MMA
#undef PG8_WAIT_V
#undef PG8_WAIT_L
#undef PG8_BAR
#undef PG8_SCHED
}
}

constexpr int NWAVES = 8;
constexpr int DM = 1024, BATCH = 4, SEQ = 8192, MP = BATCH * SEQ, DEC_B = 128, DEC_T = 4, MS = DEC_B * DEC_T, MT = MP + MS;
constexpr int LRU_W = 512, NH = 8, NKV = 2, HD = 64, DFF = 2816, INW = 1792, WIN = 128, PAST = 16384;
constexpr int C_XL = 0, C_GATE = 512, C_Q = 1024, C_K = 1536, C_V = 1664;
constexpr int NCHUNK = 64, CHUNK = SEQ / NCHUNK;
constexpr float EPS = 1e-6f, LOG2E = 1.4426950408889634f;
constexpr size_t O_YP = 0, O_YS = 33554432, O_PH = 34078720, O_PC = 34080768, O_PK = 34086912, O_PV = 34152448, O_SH = 34217984, O_SC = 34283520, O_SK = 34480128, O_SV = 36577280, O_END = 38674432;
constexpr size_t MiB = 1u << 20;
constexpr size_t WS_CTL = 0, CTL_ZERO_BYTES = 1 * MiB;
constexpr size_t WS_WGU1 = 2 * MiB, WS_WD1 = 13 * MiB, WS_WIN = 19 * MiB, WS_WOUT = 23 * MiB, WS_WGU2 = 25 * MiB, WS_WD2 = 36 * MiB;
constexpr size_t WS_ROPE = 42 * MiB;
constexpr size_t WS_SSQ = 45 * MiB;
constexpr size_t WS_LSUM = 48 * MiB;
constexpr size_t WS_WFRAG = 49 * MiB;
constexpr size_t WS_XB = 50 * MiB;
constexpr size_t WS_CAT = 115 * MiB;
constexpr size_t WS_PROJ = 180 * MiB;
constexpr size_t WS_H = 294 * MiB;
constexpr size_t WS_SSQL = 474 * MiB, WS_SSQA = 475 * MiB;
constexpr size_t WS_END = 476 * MiB;
constexpr int ROPE_ROWS = SEQ + DEC_T;
constexpr int CW_TMO = 0, CW_BAR = 4096;
constexpr int RING_OFF = 0, RING_BYTES = 131072;
constexpr int SCR_BYTES = 147456;
constexpr int LDSCTL_OFF = SCR_BYTES, MISC_OFF = LDSCTL_OFF + 64;
constexpr int LDS_BYTES = SCR_BYTES + 512;

#define GAS __attribute__((address_space(1)))
#define LAS __attribute__((address_space(3)))
typedef unsigned short bf16;
typedef unsigned v4u __attribute__((ext_vector_type(4)));
typedef unsigned v2u __attribute__((ext_vector_type(2)));
typedef float f32x4 __attribute__((ext_vector_type(4)));
typedef float f32x16 __attribute__((ext_vector_type(16)));
typedef short bf16x8 __attribute__((ext_vector_type(8)));
typedef GAS unsigned gu32;
#define RLX_AGENT __ATOMIC_RELAXED, __HIP_MEMORY_SCOPE_AGENT
__device__ __forceinline__ int lane_id() { int l; asm volatile("v_mbcnt_lo_u32_b32 %0, -1, 0\n\tv_mbcnt_hi_u32_b32 %0, -1, %0" : "=v"(l)); return l; }
#define LDS_WAIT() asm volatile("s_waitcnt lgkmcnt(0)" ::: "memory")
#define VM_WAIT() asm volatile("s_waitcnt vmcnt(0)" ::: "memory")
__device__ __forceinline__ unsigned f2bf(float f) { unsigned u = __builtin_bit_cast(unsigned, f); return (u + 0x7fffu + ((u >> 16) & 1u)) >> 16; }
__device__ __forceinline__ unsigned pk2(float lo, float hi) { return f2bf(lo) | (f2bf(hi) << 16); }
__device__ __forceinline__ float bflo(unsigned w) { return __builtin_bit_cast(float, w << 16); }
__device__ __forceinline__ float bfhi(unsigned w) { return __builtin_bit_cast(float, w & 0xffff0000u); }
__device__ __forceinline__ float bf1(bf16 v) { return __builtin_bit_cast(float, (unsigned)v << 16); }
typedef float f32x2_t __attribute__((ext_vector_type(2))); typedef __bf16 bf16x2_t __attribute__((ext_vector_type(2)));
__device__ __forceinline__ unsigned cvtpk(float lo, float hi) { f32x2_t v = {lo, hi}; bf16x2_t b = __builtin_convertvector(v, bf16x2_t); return __builtin_bit_cast(unsigned, b); }
__device__ __forceinline__ float wave_sum(float v) {
#pragma unroll
    for (int o = 1; o < 64; o <<= 1) v += __shfl_xor(v, o);
    return v;
}
__device__ __forceinline__ float wave_max(float v) {
#pragma unroll
    for (int o = 1; o < 64; o <<= 1) v = fmaxf(v, __shfl_xor(v, o));
    return v;
}
__device__ __forceinline__ float sigmoid_f(float x) { return __builtin_amdgcn_rcpf(1.0f + __builtin_amdgcn_exp2f(-x * LOG2E)); }
__device__ __forceinline__ float gelu_tanh(float x) {
    const float y = 0.7978845608028654f * (x + 0.044715f * x * x * x);
    const float e = __builtin_amdgcn_exp2f(2.0f * LOG2E * y);
    const float th = 1.0f - 2.0f * __builtin_amdgcn_rcpf(e + 1.0f);
    return 0.5f * x * (1.0f + th);
}
__device__ __forceinline__ float one_minus_exp(float t) {
    const float ser = -t * (1.0f + t * (0.5f + t * (0.16666667f + t * (0.041666668f + t * 0.0083333338f))));
    const float dir = 1.0f - __builtin_amdgcn_exp2f(t * LOG2E);
    return t > -0.25f ? ser : dir;
}
__device__ __forceinline__ float dot2bf(unsigned a, unsigned b, float c) { return __builtin_amdgcn_fdot2_f32_bf16(__builtin_bit_cast(bf16x2_t, a), __builtin_bit_cast(bf16x2_t, b), c, false); }
#define XB_TMO      128
#define XB_XCNT(j)  (256  + 64 * (j))
#define XB_XSUB(j)  (1280 + 64 * (j))
#define XB_XGEN(j)  (2304 + 64 * (j))
#define XB_TOP      3328
#define XB_TOPGEN   3392
#define XCD_BAR_WORDS 3456
#define XB_SPIN_CAP (1u << 18)

__device__ __forceinline__ unsigned xb_ld(unsigned* p)              { return __hip_atomic_load(p, __ATOMIC_RELAXED, __HIP_MEMORY_SCOPE_AGENT); }
__device__ __forceinline__ unsigned xb_add(unsigned* p, unsigned v) { return __hip_atomic_fetch_add(p, v, __ATOMIC_RELAXED, __HIP_MEMORY_SCOPE_AGENT); }
__device__ __forceinline__ unsigned xb_xcc_id() { return (unsigned)__builtin_amdgcn_s_getreg((3 << 11) | 20) & 0xFu; }
#define XB_SPIN(cond, bar) do { unsigned _sp = 0; while (cond) { __builtin_amdgcn_s_sleep(1); \
    if ((++_sp & 255u) == 0u) { if (xb_ld(&(bar)[XB_TMO])) break; if (_sp > XB_SPIN_CAP) { atomicAdd(&(bar)[XB_TMO], 1u); break; } } } } while (0)

struct XcdBarrier {
    unsigned* bar; unsigned x;
    volatile LAS unsigned* st;
};

__device__ __forceinline__ XcdBarrier xcd_barrier_post(unsigned* bar, volatile LAS unsigned* st, bool leader) {
    XcdBarrier b; b.bar = bar; b.x = xb_xcc_id(); b.st = st;
    if (leader) (void)xb_add(&bar[XB_XCNT(b.x)], 1u);
    return b;
}
__device__ __forceinline__ void xcd_barrier_complete(unsigned* bar, unsigned x, unsigned& nloc, unsigned& nx) {
    const unsigned G = gridDim.x * gridDim.y * gridDim.z;
    unsigned sum, cnt, mine, sp = 0u;
    for (;;) {
        sum = 0u; cnt = 0u; mine = 0u;
#pragma unroll
        for (unsigned j = 0; j < 16; ++j) { const unsigned c = xb_ld(&bar[XB_XCNT(j)]); sum += c; cnt += (c > 0u) ? 1u : 0u; mine = (j == x) ? c : mine; }
        if (sum == G) break;
        __builtin_amdgcn_s_sleep(1);
        if ((++sp & 255u) == 0u) { if (xb_ld(&bar[XB_TMO])) break; if (sp > XB_SPIN_CAP) { atomicAdd(&bar[XB_TMO], 1u); break; } }
    }
    nloc = mine > 0u ? mine : 1u; nx = cnt > 0u ? cnt : 1u;
}

__device__ __forceinline__ void xcd_barrier(const XcdBarrier& b, bool leader) {
    asm volatile("s_waitcnt vmcnt(0)" ::: "memory");
    __syncthreads();
    if (leader) {
        unsigned* bar = b.bar;
        __builtin_amdgcn_s_waitcnt(0);
        unsigned nloc = b.st[0], nx = b.st[1];
        if (nloc == 0u) { xcd_barrier_complete(bar, b.x, nloc, nx); b.st[0] = nloc; b.st[1] = nx; }
        const unsigned old = xb_add(&bar[XB_XSUB(b.x)], 1u);
        const unsigned gen = old / nloc;
        if (old + 1u == (gen + 1u) * nloc) {
            __builtin_amdgcn_fence(__ATOMIC_RELEASE, "agent");
            asm volatile("s_waitcnt vmcnt(0)" ::: "memory");
            const unsigned og = xb_add(&bar[XB_TOP], 1u);
            const unsigned tg = og / nx;
            if (og + 1u == (tg + 1u) * nx) xb_add(&bar[XB_TOPGEN], 1u);
            else XB_SPIN(xb_ld(&bar[XB_TOPGEN]) == tg, bar);
            __builtin_amdgcn_fence(__ATOMIC_ACQUIRE, "agent");
            xb_add(&bar[XB_XGEN(b.x)], 1u);
            asm volatile("s_waitcnt vmcnt(0)" ::: "memory");
        } else {
            XB_SPIN(xb_ld(&bar[XB_XGEN(b.x)]) == gen, bar);
            __builtin_amdgcn_fence(__ATOMIC_ACQUIRE, "agent");
            asm volatile("s_waitcnt vmcnt(0)" ::: "memory");
        }
    }
    __syncthreads();
}

typedef const void __attribute__((address_space(4)))* kernarg_ptr;
struct Frame {
    LAS unsigned char* lds;
    volatile LAS unsigned* MISC;
    int wave;
    __device__ __forceinline__ int lane() const { return lane_id(); }
    __device__ __forceinline__ int tid() const { return wave * 64 + lane_id(); }
    int vcu, G;
    kernarg_ptr kp;
    float* out; unsigned char* ws;
    __device__ __forceinline__ const float* inp(int i) const { kernarg_ptr k = kp; asm volatile("" : "+s"(k)); return ((const float* const __attribute__((address_space(4)))*)k)[i]; }
    __device__ __forceinline__ gu32* ctl() const { return (gu32*)(ws + WS_CTL); }
    __device__ __forceinline__ bf16* WGU1() const { return (bf16*)(ws + WS_WGU1); }
    __device__ __forceinline__ bf16* WD1() const { return (bf16*)(ws + WS_WD1); }
    __device__ __forceinline__ bf16* WINT() const { return (bf16*)(ws + WS_WIN); }
    __device__ __forceinline__ bf16* WOUT() const { return (bf16*)(ws + WS_WOUT); }
    __device__ __forceinline__ bf16* WGU2() const { return (bf16*)(ws + WS_WGU2); }
    __device__ __forceinline__ bf16* WD2() const { return (bf16*)(ws + WS_WD2); }
    __device__ __forceinline__ float* ROPEC() const { return (float*)(ws + WS_ROPE); }
    __device__ __forceinline__ float* ROPES() const { return (float*)(ws + WS_ROPE) + ROPE_ROWS * 32; }
    __device__ __forceinline__ float* SSQ() const { return (float*)(ws + WS_SSQ); }
    __device__ __forceinline__ float* LSUM() const { return (float*)(ws + WS_LSUM); }
    __device__ __forceinline__ float* SSQL() const { return (float*)(ws + WS_SSQL); }
    __device__ __forceinline__ float* SSQA() const { return (float*)(ws + WS_SSQA); }
    __device__ __forceinline__ bf16* WFRAG() const { return (bf16*)(ws + WS_WFRAG); }
    __device__ __forceinline__ bf16* XB() const { return (bf16*)(ws + WS_XB); }
    __device__ __forceinline__ bf16* CAT() const { return (bf16*)(ws + WS_CAT); }
    __device__ __forceinline__ bf16* PROJ() const { return (bf16*)(ws + WS_PROJ); }
    __device__ __forceinline__ bf16* HB() const { return (bf16*)(ws + WS_H); }
};
enum { I_XP = 0, I_XS, I_SH, I_SC, I_CK, I_CV, I_F1N, I_F1G, I_F1U, I_F1D, I_MN, I_WIN, I_CW, I_CB, I_WA, I_BA, I_WX, I_BX, I_LAM, I_QN, I_KN, I_SINK, I_LON, I_AON, I_WOUT, I_F2N, I_F2G, I_F2U, I_F2D };

template <int MODE> __device__ __forceinline__ void p0_transpose_item(const float* W, const float* gain, int K, int N, bf16* WT, LAS float* scr, int item, int lane) {
    const int nblk = N / 32, kb = item / nblk, nb = item % nblk, k0 = 64 * kb, n0 = 32 * nb;
    float tv[32];
#pragma unroll
    for (int i = 0; i < 32; ++i) { const int kk = 2 * i + (lane >> 5); tv[i] = W[(size_t)(k0 + kk) * N + n0 + (lane & 31)]; }
#pragma unroll
    for (int i = 0; i < 32; ++i) { const int kk = 2 * i + (lane >> 5); float v = tv[i]; if (gain) v *= gain[k0 + kk]; scr[kk * 33 + (lane & 31)] = v; }
    LDS_WAIT(); asm volatile("" ::: "memory");
    const int c = lane & 7;
    const int rb = (MODE == 0) ? n0 : ((n0 >> 7) * 256 + (MODE - 1) * 128 + (n0 & 127));
#pragma unroll
    for (int j = 0; j < 4; ++j) { const int n = (lane >> 3) + 8 * j; const LAS float* s = scr + (8 * c) * 33 + n;
        v4u o; o.x = pk2(s[0 * 33], s[1 * 33]); o.y = pk2(s[2 * 33], s[3 * 33]); o.z = pk2(s[4 * 33], s[5 * 33]); o.w = pk2(s[6 * 33], s[7 * 33]);
        *(GAS v4u*)(WT + (size_t)(rb + n) * K + k0 + 8 * c) = o; }
    LDS_WAIT(); asm volatile("" ::: "memory");
}
template <int NR> __device__ __forceinline__ void p0_rows(Frame& F, int m, int step, int lane) {
    f32x4 v[NR][4]; bool ok[NR];
#pragma unroll
    for (int q = 0; q < NR; ++q) { const int r = m + q * step; ok[q] = r < MT; const int rr = ok[q] ? r : m;
        const GAS f32x4* xr = (const GAS f32x4*)((rr < MP) ? F.inp(I_XP) + (size_t)rr * DM : F.inp(I_XS) + (size_t)(rr - MP) * DM) + lane;
#pragma unroll
        for (int j = 0; j < 4; ++j) v[q][j] = xr[64 * j]; }
#pragma unroll
    for (int q = 0; q < NR; ++q) { const int r = m + q * step; float s = 0.f;
#pragma unroll
        for (int j = 0; j < 4; ++j) s += (v[q][j].x * v[q][j].x + v[q][j].y * v[q][j].y) + (v[q][j].z * v[q][j].z + v[q][j].w * v[q][j].w);
        s = wave_sum(s);
        if (ok[q]) { GAS unsigned long long* o8 = (GAS unsigned long long*)(F.XB() + (size_t)r * DM) + lane;
#pragma unroll
            for (int j = 0; j < 4; ++j) o8[64 * j] = (unsigned long long)pk2(v[q][j].x, v[q][j].y) | ((unsigned long long)pk2(v[q][j].z, v[q][j].w) << 32);
            if (lane < 16) F.SSQ()[(size_t)r * 16 + lane] = (lane == 0) ? s : 0.f; } }
}
__device__ __forceinline__ void p0_prologue(Frame& F) {
    LAS float* scr = (LAS float*)(F.lds + RING_OFF + F.wave * 16384);
    const int gw = F.vcu * NWAVES + F.wave, NGW = F.G * NWAVES;
    constexpr int I_GU = (DM / 64) * (DFF / 32), I_D = (DFF / 64) * (DM / 32), I_IN = (DM / 64) * (INW / 32), I_OUT = (DM / 64) * (DM / 32);
    constexpr int NITEMS = 4 * I_GU + 2 * I_D + I_IN + I_OUT;
    for (int it = gw; it < NITEMS; it += NGW) {
        int r = it;
        if (r < I_GU) { p0_transpose_item<1>(F.inp(I_F1G), F.inp(I_F1N), DM, DFF, F.WGU1(), scr, r, F.lane()); continue; } r -= I_GU;
        if (r < I_GU) { p0_transpose_item<2>(F.inp(I_F1U), F.inp(I_F1N), DM, DFF, F.WGU1(), scr, r, F.lane()); continue; } r -= I_GU;
        if (r < I_GU) { p0_transpose_item<1>(F.inp(I_F2G), F.inp(I_F2N), DM, DFF, F.WGU2(), scr, r, F.lane()); continue; } r -= I_GU;
        if (r < I_GU) { p0_transpose_item<2>(F.inp(I_F2U), F.inp(I_F2N), DM, DFF, F.WGU2(), scr, r, F.lane()); continue; } r -= I_GU;
        if (r < I_D) { p0_transpose_item<0>(F.inp(I_F1D), nullptr, DFF, DM, F.WD1(), scr, r, F.lane()); continue; } r -= I_D;
        if (r < I_D) { p0_transpose_item<0>(F.inp(I_F2D), nullptr, DFF, DM, F.WD2(), scr, r, F.lane()); continue; } r -= I_D;
        if (r < I_IN) { p0_transpose_item<0>(F.inp(I_WIN), F.inp(I_MN), DM, INW, F.WINT(), scr, r, F.lane()); continue; } r -= I_IN;
        { const int k0 = 64 * (r / (DM / 32));
          p0_transpose_item<0>(F.inp(I_WOUT), k0 < 512 ? F.inp(I_LON) : F.inp(I_AON) - 512, DM, DM, F.WOUT(), scr, r, F.lane()); }
    }
    { const int ln = F.lane(); for (int m = gw; m < MT; m += 4 * NGW) p0_rows<4>(F, m, NGW, ln); }
    for (int e = F.vcu * (NWAVES * 64) + F.tid(); e < 8 * 2 * 2 * 4 * 64; e += F.G * NWAVES * 64) {
        const int ln = e & 63, ks = (e >> 6) & 3, ct = (e >> 8) & 1, gate = (e >> 9) & 1, blk = e >> 10, ql = ln & 31, hh = ln >> 5;
        const float* pw = (gate ? F.inp(I_WX) : F.inp(I_WA)) + (size_t)(blk * 64 + 16 * ks + 8 * hh) * 64 + 32 * ct + ql;
        v4u o; o.x = pk2(pw[0], pw[64]); o.y = pk2(pw[128], pw[192]); o.z = pk2(pw[256], pw[320]); o.w = pk2(pw[384], pw[448]);
        *(v4u*)(F.WFRAG() + (size_t)e * 8) = o;
    }
    const int gt = F.vcu * (NWAVES * 64) + F.tid(), NGT = F.G * NWAVES * 64;
    for (int e = gt; e < ROPE_ROWS * 32; e += NGT) {
        const int pi = e >> 5, i = e & 31; const int pos = pi < SEQ ? pi : PAST + (pi - SEQ);
        const float invf = (float)exp(-(double)i * (9.210340371976184 / 32.0));
        const float ang = (float)pos * invf; const double a = (double)ang;
        F.ROPEC()[e] = (float)cos(a); F.ROPES()[e] = (float)sin(a);
    }
}

constexpr int LW_XRAW = 0, LW_XCS = 35 * 128, LW_GS = LW_XCS + 32 * 144, LW_OUT = LW_GS + 32 * 128, LW_BYTES = LW_OUT + 32 * 128;
static_assert(8 * LW_BYTES <= SCR_BYTES, "lru LDS");
#define LWAIT() asm volatile("s_waitcnt lgkmcnt(0)" ::: "memory")
template <int PASS> __device__ __forceinline__ void lru_prompt_item(Frame& F, int item) {
    int lane_ = F.lane(); asm volatile("" : "+v"(lane_));
    const int lane0 = lane_, w = F.wave;
    const int b = item / NCHUNK, chunk = item % NCHUNK, t0 = chunk * CHUNK;
    LAS unsigned char* wl = F.lds + w * LW_BYTES;
    float ba[2], bx[2], c8[2];
    { const int ql = lane0 & 31;
#pragma unroll
    for (int ct = 0; ct < 2; ++ct) { const int c = 64 * w + 32 * ct + ql; ba[ct] = F.inp(I_BA)[c]; bx[ct] = F.inp(I_BX)[c];
        const float lam = F.inp(I_LAM)[c]; c8[ct] = -8.0f * (fmaxf(-lam, 0.f) + log1pf(expf(-fabsf(lam)))); } }
    float hst[2] = {0.f, 0.f}, Pst[2] = {1.f, 1.f};
    if (PASS == 2) {
        const float* ls = F.LSUM() + ((size_t)b * NCHUNK * 512 + 64 * w + (lane0 & 31)) * 2; float h0 = 0.f, h1 = 0.f;
#pragma unroll 8
        for (int j = 0; j < chunk; ++j) { const f32x2_t p0 = *(const f32x2_t*)(ls + (size_t)j * 1024), p1 = *(const f32x2_t*)(ls + (size_t)j * 1024 + 64); h0 = p0.x * h0 + p0.y; h1 = p1.x * h1 + p1.y; }
        hst[0] = h0; hst[1] = h1;
    }
    for (int sub = 0; sub < CHUNK / 32; ++sub) {
        const int ts = t0 + sub * 32;
        int lq_ = lane0; asm volatile("" : "+v"(lq_));
        const int lane = lq_, ql = lane & 31, hh = lane >> 5;
        LAS unsigned char* xraw = wl + LW_XRAW; LAS unsigned char* xcs = wl + LW_XCS; LAS unsigned char* gs = wl + LW_GS; LAS unsigned char* outs = wl + LW_OUT;
        const bf16* wfr = F.WFRAG() + (size_t)w * (2 * 2 * 4 * 64 * 8) + lane * 8;
        {
            const bf16* pbase = F.PROJ() + (size_t)(b * SEQ) * INW + 64 * w;
            v4u xv[5], gv[4];
#pragma unroll
            for (int i = 0; i < 5; ++i) { const int idx = lane + 64 * i, row = idx >> 3, ch = idx & 7, t = ts - 3 + row; xv[i] = (v4u){0u, 0u, 0u, 0u};
                if (row < 35 && t >= 0) xv[i] = *(const v4u*)(pbase + (size_t)t * INW + C_XL + 8 * ch); }
            if (PASS == 2) {
#pragma unroll
                for (int i = 0; i < 4; ++i) { const int idx = lane + 64 * i, row = idx >> 3, ch = idx & 7; gv[i] = *(const v4u*)(pbase + (size_t)(ts + row) * INW + C_GATE + 8 * ch); }
            }
#pragma unroll
            for (int i = 0; i < 5; ++i) { const int idx = lane + 64 * i, row = idx >> 3, ch = idx & 7; if (row < 35) *(LAS v4u*)(xraw + row * 128 + 16 * ch) = xv[i]; }
            if (PASS == 2) {
#pragma unroll
                for (int i = 0; i < 4; ++i) { const int idx = lane + 64 * i, row = idx >> 3, ch = idx & 7; *(LAS v4u*)(gs + row * 128 + 16 * ch) = gv[i]; }
            }
        }
        LWAIT();
        {
            const int cch = 64 * w + lane;
            const LAS bf16* xr = (const LAS bf16*)xraw + lane; LAS bf16* xo = (LAS bf16*)xcs + lane;
            const float* cwp = F.inp(I_CW) + cch; const float cw0 = cwp[0], cw1 = cwp[512], cw2 = cwp[1024], cw3 = cwp[1536], cb = F.inp(I_CB)[cch];
            float xm3 = bf1(xr[0]), xm2 = bf1(xr[64]), xm1 = bf1(xr[128]);
#pragma unroll 8
            for (int tt = 0; tt < 32; ++tt) { const float x = bf1(xr[(tt + 3) * 64]);
                xo[tt * 72] = (bf16)f2bf(cb + cw0 * xm3 + cw1 * xm2 + cw2 * xm1 + cw3 * x); xm3 = xm2; xm2 = xm1; xm1 = x; }
            if (PASS == 2 && chunk == NCHUNK - 1 && sub == CHUNK / 32 - 1) {
                F.out[O_PC + (b * 3 + 0) * 512 + cch] = xm3; F.out[O_PC + (b * 3 + 1) * 512 + cch] = xm2; F.out[O_PC + (b * 3 + 2) * 512 + cch] = xm1; }
        }
        LWAIT();
        bf16x8 af[4];
#pragma unroll
        for (int ks = 0; ks < 4; ++ks) af[ks] = *(const LAS bf16x8*)(xcs + ql * 144 + (16 * ks + 8 * hh) * 2);
        float ssv[16];
#pragma unroll
        for (int r = 0; r < 16; ++r) ssv[r] = 0.f;
#pragma unroll
        for (int ct = 0; ct < 2; ++ct) {
            f32x16 ra = {0.f, 0.f, 0.f, 0.f, 0.f, 0.f, 0.f, 0.f, 0.f, 0.f, 0.f, 0.f, 0.f, 0.f, 0.f, 0.f}, rx = ra;
            {   bf16x8 wa4[4], wx4[4];
#pragma unroll
                for (int ks = 0; ks < 4; ++ks) { wa4[ks] = *(const bf16x8*)(wfr + (size_t)((0 * 2 + ct) * 4 + ks) * 512); wx4[ks] = *(const bf16x8*)(wfr + (size_t)((1 * 2 + ct) * 4 + ks) * 512); }
#pragma unroll
                for (int ks = 0; ks < 4; ++ks) { ra = __builtin_amdgcn_mfma_f32_32x32x16_bf16(af[ks], wa4[ks], ra, 0, 0, 0); rx = __builtin_amdgcn_mfma_f32_32x32x16_bf16(af[ks], wx4[ks], rx, 0, 0, 0); } }
            const int cl = 32 * ct + ql;
            float av[16], uv[16];
#pragma unroll
            for (int r = 0; r < 16; ++r) { const int tk = (r & 3) + 8 * (r >> 2) + 4 * hh;
                const float rg = sigmoid_f(ra[r] + ba[ct]), ig = sigmoid_f(rx[r] + bx[ct]);
                const float la = c8[ct] * rg; av[r] = __builtin_amdgcn_exp2f(la * LOG2E);
                const float mult = __builtin_amdgcn_sqrtf(one_minus_exp(2.0f * la));
                uv[r] = mult * ig * bf1(*((const LAS bf16*)(xcs + tk * 144) + cl)); }
            float Ag[4], Ug[4], Ap[4], Up[4], st[4];
#pragma unroll
            for (int g = 0; g < 4; ++g) { Ag[g] = (av[4 * g] * av[4 * g + 1]) * (av[4 * g + 2] * av[4 * g + 3]);
                Ug[g] = ((uv[4 * g] * av[4 * g + 1] + uv[4 * g + 1]) * av[4 * g + 2] + uv[4 * g + 2]) * av[4 * g + 3] + uv[4 * g + 3];
                Ap[g] = __shfl_xor(Ag[g], 32); Up[g] = __shfl_xor(Ug[g], 32); }
            float carry = hst[ct], pp = Pst[ct];
#pragma unroll
            for (int g = 0; g < 4; ++g) { const float Alo = hh ? Ap[g] : Ag[g], Ulo = hh ? Up[g] : Ug[g], Ahi = hh ? Ag[g] : Ap[g], Uhi = hh ? Ug[g] : Up[g];
                const float s_lo = carry; carry = Alo * carry + Ulo; const float s_hi = carry; carry = Ahi * carry + Uhi; st[g] = hh ? s_hi : s_lo; pp *= Alo * Ahi; }
            hst[ct] = carry; Pst[ct] = pp;
            if (PASS == 2) {
#pragma unroll
                for (int g = 0; g < 4; ++g) { float hc = st[g];
#pragma unroll
                    for (int e = 0; e < 4; ++e) { const int r = 4 * g + e, tk = e + 8 * g + 4 * hh; hc = av[r] * hc + uv[r];
                        const float o = hc * gelu_tanh(bf1(*((const LAS bf16*)(gs + tk * 128) + cl)));
                        ssv[r] += o * o; *((LAS bf16*)(outs + tk * 128) + cl) = (bf16)f2bf(o); } }
            }
        }
        if (PASS == 2) {
            float* sq = F.SSQL() + (size_t)(b * SEQ + ts) * 8 + w;
#pragma unroll
            for (int r = 0; r < 16; ++r) { float v = ssv[r];
                v += __shfl_xor(v, 1); v += __shfl_xor(v, 2); v += __shfl_xor(v, 4); v += __shfl_xor(v, 8); v += __shfl_xor(v, 16);
                if (ql == 0) sq[((r & 3) + 8 * (r >> 2) + 4 * hh) * 8] = v; }
            LWAIT();
            bf16* cbase = F.CAT() + (size_t)(b * SEQ + ts) * DM + 64 * w;
#pragma unroll
            for (int i = 0; i < 4; ++i) { const int idx = lane + 64 * i, row = idx >> 3, ch = idx & 7; *(v4u*)(cbase + (size_t)row * DM + 8 * ch) = *(const LAS v4u*)(outs + row * 128 + 16 * ch); }
            LWAIT();
        }
    }
    if ((lane0 & 32) == 0) {
#pragma unroll
        for (int ct = 0; ct < 2; ++ct) { const int c = 64 * w + 32 * ct + (lane0 & 31);
            if (PASS == 1) *(f32x2_t*)(F.LSUM() + (((size_t)b * NCHUNK + chunk) * 512 + c) * 2) = (f32x2_t){Pst[ct], hst[ct]};
            if (PASS == 2 && chunk == NCHUNK - 1) F.out[O_PH + b * 512 + c] = hst[ct]; }
    }
}

constexpr int KS_STRIDE = 144, KS_KVH = 256 * KS_STRIDE;
constexpr int VT_STRIDE = 528, VT_KVH = 64 * VT_STRIDE;
constexpr int AT_KS = 0, AT_VT = 2 * KS_KVH, AT_END = AT_VT + 2 * VT_KVH;
static_assert(AT_END <= SCR_BYTES, "attention LDS");
__device__ __forceinline__ int vt_pos(int key) { const int o = key & 15; return (key & ~15) + 8 * ((o >> 2) & 1) + (o & 3) + 4 * (o >> 3); }
__device__ __forceinline__ void attn_prompt_item(Frame& F, int item) {
    const int b = item / (SEQ / WIN), blk = item % (SEQ / WIN);
    int tid_ = F.tid(); asm volatile("" : "+v"(tid_));
    const int tid = tid_, lane = tid & 63, w = F.wave;
    LAS unsigned char* Ks = F.lds + AT_KS; LAS unsigned char* Vt = F.lds + AT_VT;
    {
        const int key = tid & 255, kvh = tid >> 8, tb = blk * WIN - WIN + key;
        LAS unsigned char* krow = Ks + kvh * KS_KVH + key * KS_STRIDE;
        LAS bf16* vcol = (LAS bf16*)(Vt + kvh * VT_KVH) + vt_pos(key);
        if (tb >= 0) {
            const bf16* prow = F.PROJ() + (size_t)(b * SEQ + tb) * INW;
            v4u kr[8], vr[8];
#pragma unroll
            for (int i = 0; i < 8; ++i) kr[i] = *(const v4u*)(prow + C_K + kvh * 64 + 8 * i);
            float kf[64]; float ss = 0.f;
#pragma unroll
            for (int i = 0; i < 8; ++i) { kf[8 * i + 0] = bflo(kr[i].x); kf[8 * i + 1] = bfhi(kr[i].x); kf[8 * i + 2] = bflo(kr[i].y); kf[8 * i + 3] = bfhi(kr[i].y);
                kf[8 * i + 4] = bflo(kr[i].z); kf[8 * i + 5] = bfhi(kr[i].z); kf[8 * i + 6] = bflo(kr[i].w); kf[8 * i + 7] = bfhi(kr[i].w); }
#pragma unroll
            for (int d = 0; d < 64; ++d) ss += kf[d] * kf[d];
            const float rs = __builtin_amdgcn_rsqf(ss * (1.0f / 64.0f) + EPS);
            const float* cs = F.ROPEC() + (size_t)tb * 32; const float* sn = F.ROPES() + (size_t)tb * 32; const float* kn = F.inp(I_KN);
#pragma unroll
            for (int i = 0; i < 32; ++i) { const float x1 = kf[i] * rs * kn[i], x2 = kf[i + 32] * rs * kn[i + 32], cc = cs[i], sv = sn[i]; kf[i] = x1 * cc - x2 * sv; kf[i + 32] = x2 * cc + x1 * sv; }
#pragma unroll
            for (int i = 0; i < 8; ++i) { v4u o; o.x = cvtpk(kf[8 * i], kf[8 * i + 1]); o.y = cvtpk(kf[8 * i + 2], kf[8 * i + 3]); o.z = cvtpk(kf[8 * i + 4], kf[8 * i + 5]); o.w = cvtpk(kf[8 * i + 6], kf[8 * i + 7]);
                *(LAS v4u*)(krow + 16 * i) = o; }
            const bool lastw = (blk == SEQ / WIN - 1 && key >= WIN);
            if (lastw) { float* ok = F.out + O_PK + ((size_t)(b * WIN + key - WIN) * NKV + kvh) * HD;
#pragma unroll
                for (int i = 0; i < 16; ++i) *(f32x4*)(ok + 4 * i) = (f32x4){kf[4 * i], kf[4 * i + 1], kf[4 * i + 2], kf[4 * i + 3]}; }
            asm volatile("" ::: "memory");
#pragma unroll
            for (int i = 0; i < 8; ++i) vr[i] = *(const v4u*)(prow + C_V + kvh * 64 + 8 * i);
#pragma unroll
            for (int i = 0; i < 8; ++i) { const unsigned q4[4] = {vr[i].x, vr[i].y, vr[i].z, vr[i].w};
#pragma unroll
                for (int e = 0; e < 4; ++e) { vcol[(8 * i + 2 * e) * (VT_STRIDE / 2)] = (bf16)(q4[e] & 0xffffu); vcol[(8 * i + 2 * e + 1) * (VT_STRIDE / 2)] = (bf16)(q4[e] >> 16); } }
            if (lastw) { float* ov = F.out + O_PV + ((size_t)(b * WIN + key - WIN) * NKV + kvh) * HD;
#pragma unroll
                for (int i = 0; i < 8; ++i) { *(f32x4*)(ov + 8 * i) = (f32x4){bflo(vr[i].x), bfhi(vr[i].x), bflo(vr[i].y), bfhi(vr[i].y)}; *(f32x4*)(ov + 8 * i + 4) = (f32x4){bflo(vr[i].z), bfhi(vr[i].z), bflo(vr[i].w), bfhi(vr[i].w)}; }
            }
        } else {
#pragma unroll
            for (int i = 0; i < 8; ++i) *(LAS v4u*)(krow + 16 * i) = (v4u){0u, 0u, 0u, 0u};
#pragma unroll
            for (int d = 0; d < 64; ++d) vcol[d * (VT_STRIDE / 2)] = (bf16)0;
        }
    }
    __syncthreads();
    const int hh = lane >> 5, ql = lane & 31, kvh = w >> 2;
    const float sinkl2 = F.inp(I_SINK)[w] * LOG2E;
    const float QS = 0.125f * LOG2E;
    const float* qn = F.inp(I_QN);
    for (int s = 0; s < 4; ++s) {
        const int qi = 32 * s + ql, t = blk * WIN + qi; const size_t row = (size_t)b * SEQ + t;
        bf16x8 qf[4];
        {
            const bf16* qp = F.PROJ() + row * INW + C_Q + w * 64 + 8 * hh;
            float qv[4][8]; float ss = 0.f;
#pragma unroll
            for (int ds = 0; ds < 4; ++ds) { const v4u r4 = *(const v4u*)(qp + 16 * ds);
                qv[ds][0] = bflo(r4.x); qv[ds][1] = bfhi(r4.x); qv[ds][2] = bflo(r4.y); qv[ds][3] = bfhi(r4.y); qv[ds][4] = bflo(r4.z); qv[ds][5] = bfhi(r4.z); qv[ds][6] = bflo(r4.w); qv[ds][7] = bfhi(r4.w); }
#pragma unroll
            for (int ds = 0; ds < 4; ++ds)
#pragma unroll
                for (int j = 0; j < 8; ++j) ss += qv[ds][j] * qv[ds][j];
            ss += __shfl_xor(ss, 32);
            const float rs = __builtin_amdgcn_rsqf(ss * (1.0f / 64.0f) + EPS);
            const float* cs = F.ROPEC() + (size_t)t * 32; const float* sn = F.ROPES() + (size_t)t * 32;
#pragma unroll
            for (int ds = 0; ds < 2; ++ds)
#pragma unroll
                for (int j = 0; j < 8; ++j) { const int i = 16 * ds + 8 * hh + j; const float x1 = qv[ds][j] * rs * qn[i], x2 = qv[ds + 2][j] * rs * qn[i + 32], cc = cs[i], sv = sn[i];
                    qv[ds][j] = (x1 * cc - x2 * sv) * QS; qv[ds + 2][j] = (x2 * cc + x1 * sv) * QS; }
#pragma unroll
            for (int ds = 0; ds < 4; ++ds) { v4u o; o.x = cvtpk(qv[ds][0], qv[ds][1]); o.y = cvtpk(qv[ds][2], qv[ds][3]); o.z = cvtpk(qv[ds][4], qv[ds][5]); o.w = cvtpk(qv[ds][6], qv[ds][7]); qf[ds] = __builtin_bit_cast(bf16x8, o); }
        }
        f32x16 p[5];
#pragma unroll
        for (int kt = 0; kt < 5; ++kt) {
            const LAS unsigned char* kp = Ks + kvh * KS_KVH + (32 * (s + kt) + ql) * KS_STRIDE + 16 * hh;
            f32x16 acc = {0.f, 0.f, 0.f, 0.f, 0.f, 0.f, 0.f, 0.f, 0.f, 0.f, 0.f, 0.f, 0.f, 0.f, 0.f, 0.f};
#pragma unroll
            for (int ds = 0; ds < 4; ++ds) { const bf16x8 kfr = *(const LAS bf16x8*)(kp + 32 * ds); acc = __builtin_amdgcn_mfma_f32_32x32x16_bf16(kfr, qf[ds], acc, 0, 0, 0); }
            p[kt] = acc;
        }
        float mx = -INFINITY;
#pragma unroll
        for (int kt = 0; kt < 5; ++kt)
#pragma unroll
            for (int r = 0; r < 16; ++r) { const int kj = 32 * (s + kt) + (r & 3) + 8 * (r >> 2) + 4 * hh;
                const bool valid = (kj > qi) && (kj <= qi + WIN) && (blk > 0 || kj >= WIN);
                const float v = valid ? p[kt][r] : -INFINITY; p[kt][r] = v; mx = fmaxf(mx, v); }
        mx = fmaxf(mx, __shfl_xor(mx, 32)); mx = fmaxf(mx, sinkl2);
        float sum = 0.f;
#pragma unroll
        for (int kt = 0; kt < 5; ++kt)
#pragma unroll
            for (int r = 0; r < 16; ++r) { const float e = __builtin_amdgcn_exp2f(p[kt][r] - mx); p[kt][r] = e; sum += e; }
        sum += __shfl_xor(sum, 32);
        const float inv = __builtin_amdgcn_rcpf(sum + __builtin_amdgcn_exp2f(sinkl2 - mx));
        f32x16 o0 = {0.f, 0.f, 0.f, 0.f, 0.f, 0.f, 0.f, 0.f, 0.f, 0.f, 0.f, 0.f, 0.f, 0.f, 0.f, 0.f}, o1 = o0;
#pragma unroll
        for (int kt = 0; kt < 5; ++kt)
#pragma unroll
            for (int ss2 = 0; ss2 < 2; ++ss2) {
                v4u pw; pw.x = cvtpk(p[kt][8 * ss2 + 0], p[kt][8 * ss2 + 1]); pw.y = cvtpk(p[kt][8 * ss2 + 2], p[kt][8 * ss2 + 3]); pw.z = cvtpk(p[kt][8 * ss2 + 4], p[kt][8 * ss2 + 5]); pw.w = cvtpk(p[kt][8 * ss2 + 6], p[kt][8 * ss2 + 7]);
                const bf16x8 pf = __builtin_bit_cast(bf16x8, pw);
                const LAS unsigned char* vp = Vt + kvh * VT_KVH + ql * VT_STRIDE + (16 * (2 * (s + kt) + ss2) + 8 * hh) * 2;
                const bf16x8 v0 = *(const LAS bf16x8*)(vp), v1 = *(const LAS bf16x8*)(vp + 32 * VT_STRIDE);
                o0 = __builtin_amdgcn_mfma_f32_32x32x16_bf16(v0, pf, o0, 0, 0, 0);
                o1 = __builtin_amdgcn_mfma_f32_32x32x16_bf16(v1, pf, o1, 0, 0, 0);
            }
        float hsq = 0.f;
#pragma unroll
        for (int r = 0; r < 16; ++r) { o0[r] *= inv; o1[r] *= inv; hsq += o0[r] * o0[r] + o1[r] * o1[r]; }
        hsq += __shfl_xor(hsq, 32);
        if (hh == 0) F.SSQA()[row * 8 + w] = hsq;
        bf16* crow = F.CAT() + row * DM + 512 + w * 64;
#pragma unroll
        for (int g = 0; g < 4; ++g) { const int d0 = 8 * g + 4 * hh;
            v2u a, c2; a.x = cvtpk(o0[4 * g], o0[4 * g + 1]); a.y = cvtpk(o0[4 * g + 2], o0[4 * g + 3]);
            c2.x = cvtpk(o1[4 * g], o1[4 * g + 1]); c2.y = cvtpk(o1[4 * g + 2], o1[4 * g + 3]);
            *(v2u*)(crow + d0) = a; *(v2u*)(crow + 32 + d0) = c2; }
    }
    __syncthreads();
}

constexpr int SK_ROW = 136, SK_KVH = 68;
constexpr int SM_KC = 0, SM_VC = 132 * SK_ROW * 4, SM_QS = SM_VC + 132 * 128 * 4, SM_HS = SM_QS + 8 * 64 * 4, SM_END = SM_HS + 64 * 4;
static_assert(SM_END <= SCR_BYTES, "sample LDS");
__device__ __forceinline__ void sample_lru_item(Frame& F, int b) {
    int tid_ = F.tid(); asm volatile("" : "+v"(tid_));
    const int tid = tid_, lane = tid & 63, w = F.wave;
    const size_t row0 = (size_t)MP + (size_t)b * DEC_T;
    {
        const int c = tid, blk = w, cj = c & 63;
        LAS float* xcs = (LAS float*)F.lds;
        LAS float* red = xcs + 4 * 512;
        const float cw0 = F.inp(I_CW)[c], cw1 = F.inp(I_CW)[512 + c], cw2 = F.inp(I_CW)[1024 + c], cw3 = F.inp(I_CW)[1536 + c], cb = F.inp(I_CB)[c];
        const float lam = F.inp(I_LAM)[c];
        const float c8 = -8.0f * (fmaxf(-lam, 0.f) + log1pf(expf(-fabsf(lam))));
        float xs[7];
#pragma unroll
        for (int j = 0; j < 3; ++j) xs[j] = F.inp(I_SC)[((size_t)b * 3 + j) * 512 + c];
#pragma unroll
        for (int t = 0; t < 4; ++t) xs[3 + t] = bf1(F.PROJ()[(row0 + t) * INW + c]);
#pragma unroll
        for (int t = 0; t < 4; ++t) xcs[t * 512 + c] = cb + cw0 * xs[t] + cw1 * xs[t + 1] + cw2 * xs[t + 2] + cw3 * xs[t + 3];
        __syncthreads();
        float rp[4], ip[4];
#pragma unroll
        for (int t = 0; t < 4; ++t) { rp[t] = F.inp(I_BA)[c]; ip[t] = F.inp(I_BX)[c]; }
        const float* wap = F.inp(I_WA) + (size_t)(blk * 64) * 64 + cj; const float* wxp = F.inp(I_WX) + (size_t)(blk * 64) * 64 + cj;
#pragma unroll 16
        for (int k = 0; k < 64; ++k) { const float wa = wap[k * 64], wx = wxp[k * 64];
#pragma unroll
            for (int t = 0; t < 4; ++t) { const float xv = xcs[t * 512 + blk * 64 + k]; rp[t] += xv * wa; ip[t] += xv * wx; } }
        float h = F.inp(I_SH)[(size_t)b * 512 + c]; float ov[4];
#pragma unroll
        for (int t = 0; t < 4; ++t) {
            const float r = sigmoid_f(rp[t]), ig = sigmoid_f(ip[t]);
            const float la = c8 * r, a = __builtin_amdgcn_exp2f(la * LOG2E);
            const float mult = __builtin_amdgcn_sqrtf(one_minus_exp(2.0f * la));
            h = a * h + mult * ig * xcs[t * 512 + c];
            const float g = bf1(F.PROJ()[(row0 + t) * INW + C_GATE + c]);
            ov[t] = h * gelu_tanh(g);
            const float s = wave_sum(ov[t] * ov[t]); if (lane == 0) red[t * 8 + w] = s;
        }
        F.out[O_SH + (size_t)b * 512 + c] = h;
#pragma unroll
        for (int j = 0; j < 3; ++j) F.out[O_SC + ((size_t)b * 3 + j) * 512 + c] = xs[4 + j];
        __syncthreads();
#pragma unroll
        for (int t = 0; t < 4; ++t) { float s = 0.f;
#pragma unroll
            for (int w2 = 0; w2 < 8; ++w2) s += red[t * 8 + w2];
            F.CAT()[(row0 + t) * DM + c] = (bf16)f2bf(ov[t] * __builtin_amdgcn_rsqf(s * (1.0f / 512.0f) + EPS)); }
        __syncthreads();
    }
}
__device__ __forceinline__ void sample_attn_item(Frame& F, int b) {
    int tid_ = F.tid(); asm volatile("" : "+v"(tid_));
    const int tid = tid_, lane = tid & 63, w = F.wave;
    const size_t row0 = (size_t)MP + (size_t)b * DEC_T;
    LAS float* Kc = (LAS float*)(F.lds + SM_KC); LAS float* Vc = (LAS float*)(F.lds + SM_VC); LAS float* qs = (LAS float*)(F.lds + SM_QS); LAS float* hs = (LAS float*)(F.lds + SM_HS);
    {
        const float* ck = F.inp(I_CK) + (size_t)b * WIN * 128; const float* cv = F.inp(I_CV) + (size_t)b * WIN * 128;
        float* ok = F.out + O_SK + (size_t)b * WIN * 128; float* ov = F.out + O_SV + (size_t)b * WIN * 128;
#pragma unroll
        for (int i = 0; i < 8; ++i) { const int idx = tid * 4 + 2048 * i, j = idx >> 7, rem = idx & 127;
            const f32x4 kv = *(const f32x4*)(ck + idx), vv = *(const f32x4*)(cv + idx);
            *(LAS f32x4*)(Kc + j * SK_ROW + (rem >> 6) * SK_KVH + (rem & 63)) = kv; *(LAS f32x4*)(Vc + j * 128 + rem) = vv;
            if (j >= DEC_T) { *(f32x4*)(ok + idx - DEC_T * 128) = kv; *(f32x4*)(ov + idx - DEC_T * 128) = vv; } }
        if (w < DEC_T) {
            const int t = w, kvh = lane >> 5, i = lane & 31;
            const bf16* pr = F.PROJ() + (row0 + t) * INW;
            const float k1 = bf1(pr[C_K + kvh * 64 + i]), k2 = bf1(pr[C_K + kvh * 64 + 32 + i]);
            float ss = k1 * k1 + k2 * k2;
#pragma unroll
            for (int o = 1; o < 32; o <<= 1) ss += __shfl_xor(ss, o);
            const float rs = __builtin_amdgcn_rsqf(ss * (1.0f / 64.0f) + EPS);
            const float x1 = k1 * rs * F.inp(I_KN)[i], x2 = k2 * rs * F.inp(I_KN)[i + 32];
            const float cc = F.ROPEC()[(size_t)(SEQ + t) * 32 + i], sv = F.ROPES()[(size_t)(SEQ + t) * 32 + i];
            const float o1 = x1 * cc - x2 * sv, o2 = x2 * cc + x1 * sv;
            Kc[(WIN + t) * SK_ROW + kvh * SK_KVH + i] = o1; Kc[(WIN + t) * SK_ROW + kvh * SK_KVH + 32 + i] = o2;
            const float v1 = bf1(pr[C_V + kvh * 64 + i]), v2 = bf1(pr[C_V + kvh * 64 + 32 + i]);
            Vc[(WIN + t) * 128 + kvh * 64 + i] = v1; Vc[(WIN + t) * 128 + kvh * 64 + 32 + i] = v2;
            const size_t oo = ((size_t)(WIN - DEC_T + t) * NKV + kvh) * HD;
            ok[oo + i] = o1; ok[oo + 32 + i] = o2; ov[oo + i] = v1; ov[oo + 32 + i] = v2;
        }
    }
    __syncthreads();
    const int head = w, kvh = w >> 2;
    const float sinkl2 = F.inp(I_SINK)[head] * LOG2E;
    float osave[4];
#pragma unroll
    for (int t = 0; t < DEC_T; ++t) {
        {
            const float x = bf1(F.PROJ()[(row0 + t) * INW + C_Q + head * 64 + lane]);
            const float ss = wave_sum(x * x);
            const float xn = x * __builtin_amdgcn_rsqf(ss * (1.0f / 64.0f) + EPS) * F.inp(I_QN)[lane];
            const float other = __shfl_xor(xn, 32);
            const int i = lane & 31; const float cc = F.ROPEC()[(size_t)(SEQ + t) * 32 + i], sv = F.ROPES()[(size_t)(SEQ + t) * 32 + i];
            const float qo = (lane < 32) ? (xn * cc - other * sv) : (xn * cc + other * sv);
            qs[w * 64 + lane] = qo * (0.125f * LOG2E);
        }
        LDS_WAIT(); asm volatile("" ::: "memory");
        const int j0 = t + 1 + lane, j1 = j0 + 64;
        float s0 = 0.f, s1 = 0.f;
        const LAS f32x4* q4 = (const LAS f32x4*)(qs + w * 64);
        const LAS f32x4* k0 = (const LAS f32x4*)(Kc + j0 * SK_ROW + kvh * SK_KVH); const LAS f32x4* k1 = (const LAS f32x4*)(Kc + j1 * SK_ROW + kvh * SK_KVH);
#pragma unroll
        for (int d4 = 0; d4 < 16; ++d4) { const f32x4 q = q4[d4], a = k0[d4], c = k1[d4];
            s0 += q[0] * a[0] + q[1] * a[1] + q[2] * a[2] + q[3] * a[3]; s1 += q[0] * c[0] + q[1] * c[1] + q[2] * c[2] + q[3] * c[3]; }
        float mx = wave_max(fmaxf(s0, s1)); mx = fmaxf(mx, sinkl2);
        const float p0 = __builtin_amdgcn_exp2f(s0 - mx), p1 = __builtin_amdgcn_exp2f(s1 - mx);
        const float l = wave_sum(p0 + p1) + __builtin_amdgcn_exp2f(sinkl2 - mx);
        float o = 0.f;
        for (int jj = 0; jj < 64; ++jj) {
            const float pa = __shfl(p0, jj), pb = __shfl(p1, jj);
            o += pa * Vc[(t + 1 + jj) * 128 + kvh * 64 + lane] + pb * Vc[(t + 65 + jj) * 128 + kvh * 64 + lane];
        }
        o *= __builtin_amdgcn_rcpf(l);
        osave[t] = o;
        const float hq = wave_sum(o * o); if (lane == 0) hs[t * 8 + w] = hq;
    }
    __syncthreads();
#pragma unroll
    for (int t = 0; t < DEC_T; ++t) { float s = 0.f;
#pragma unroll
        for (int w2 = 0; w2 < 8; ++w2) s += hs[t * 8 + w2];
        F.CAT()[(row0 + t) * DM + 512 + head * 64 + lane] = (bf16)f2bf(osave[t] * __builtin_amdgcn_rsqf(s * (1.0f / 512.0f) + EPS)); }
    __syncthreads();
}

struct SEpiSwiglu {
    bf16* H; const float* ssq;
    __device__ __forceinline__ int brow0(int cb) const { const int hc0 = 32 * cb; return (hc0 >> 7) * 256 + (hc0 & 127); }
    __device__ __forceinline__ int brow1(int cb) const { return brow0(cb) + 128; }
    __device__ __forceinline__ void operator()(const f32x16& a0, const f32x16& a1, int r, int cb, int h) const {
        const float rs = pg8::row_rs(ssq, r);
#pragma unroll
        for (int g = 0; g < 4; ++g) { float hv[4];
#pragma unroll
            for (int e = 0; e < 4; ++e) hv[e] = pg8::silu_f(a0[4 * g + e] * rs) * (a1[4 * g + e] * rs);
            v2u w; w.x = cvtpk(hv[0], hv[1]); w.y = cvtpk(hv[2], hv[3]); *(v2u*)(H + (size_t)r * DFF + 32 * cb + 8 * g + 4 * h) = w; }
    }
};
struct SEpiScale {
    bf16* O; int ldc; const float* ssq;
    __device__ __forceinline__ int brow0(int cb) const { return 64 * cb; }
    __device__ __forceinline__ int brow1(int cb) const { return 64 * cb + 32; }
    __device__ __forceinline__ void operator()(const f32x16& a0, const f32x16& a1, int r, int cb, int h) const {
        const float rs = pg8::row_rs(ssq, r);
#pragma unroll
        for (int g = 0; g < 4; ++g) {
            v2u w; w.x = cvtpk(a0[4 * g] * rs, a0[4 * g + 1] * rs); w.y = cvtpk(a0[4 * g + 2] * rs, a0[4 * g + 3] * rs); *(v2u*)(O + (size_t)r * ldc + 64 * cb + 8 * g + 4 * h) = w;
            v2u x; x.x = cvtpk(a1[4 * g] * rs, a1[4 * g + 1] * rs); x.y = cvtpk(a1[4 * g + 2] * rs, a1[4 * g + 3] * rs); *(v2u*)(O + (size_t)r * ldc + 64 * cb + 32 + 8 * g + 4 * h) = x; }
    }
};
template <int MODE> struct SEpiResid {
    const float* basef; float* out; bf16* xb; float* ssq; float scale;
    __device__ __forceinline__ int brow0(int cb) const { return 64 * cb; }
    __device__ __forceinline__ int brow1(int cb) const { return 64 * cb + 32; }
    __device__ __forceinline__ void operator()(const f32x16& a0, const f32x16& a1, int r, int cb, int h) const {
        float s = 0.f;
#pragma unroll
        for (int a = 0; a < 2; ++a)
#pragma unroll
            for (int g = 0; g < 4; ++g) { const size_t off = (size_t)r * DM + 64 * cb + 32 * a + 8 * g + 4 * h;
                f32x4 b; if (MODE == 0) b = *(const f32x4*)(basef + off); else b = pg8::bf4_to_f32(*(const v2u*)(xb + off));
                const f32x4 v = a == 0 ? (f32x4){a0[4 * g], a0[4 * g + 1], a0[4 * g + 2], a0[4 * g + 3]} : (f32x4){a1[4 * g], a1[4 * g + 1], a1[4 * g + 2], a1[4 * g + 3]};
                const f32x4 o = b + v * scale;
                if (MODE == 2) *(f32x4*)(out + off) = o;
                else { s += (o[0] * o[0] + o[1] * o[1]) + (o[2] * o[2] + o[3] * o[3]); v2u w; w.x = cvtpk(o[0], o[1]); w.y = cvtpk(o[2], o[3]); *(v2u*)(xb + off) = w; } }
        if (MODE != 2) { s += __shfl_xor(s, 32); if (h == 0) ssq[(size_t)r * 16 + cb] = s; }
    }
};
template <int K, int KS, class Epi> __device__ __forceinline__ void small_gemm(Frame& F, const bf16* A, int lda, const bf16* Bt, int ncb, const Epi& E) {
    int lane_ = F.lane(); asm volatile("" : "+v"(lane_));
    const int lane = lane_, w = F.wave, ql = lane & 31, h = lane >> 5;
    const int nitems = 16 * ncb * KS;
    LAS float* red = (LAS float*)F.lds;
    for (int base = blockIdx.x * NWAVES; base < nitems; base += F.G * NWAVES) {
        const int it = base + w; const bool valid = it < nitems;
        const int tile = it / KS, ks = it % KS, rb = tile & 15, cb = tile >> 4;
        f32x16 acc0 = {0.f, 0.f, 0.f, 0.f, 0.f, 0.f, 0.f, 0.f, 0.f, 0.f, 0.f, 0.f, 0.f, 0.f, 0.f, 0.f}, acc1 = acc0;
        const int r = MP + 32 * rb + ql;
        if (valid) {
            const bf16* ap = A + (size_t)r * lda + ks * (K / KS) + 8 * h;
            const bf16* b0 = Bt + (size_t)(E.brow0(cb) + ql) * K + ks * (K / KS) + 8 * h;
            const bf16* b1 = Bt + (size_t)(E.brow1(cb) + ql) * K + ks * (K / KS) + 8 * h;
#pragma unroll 8
            for (int k0 = 0; k0 < K / KS; k0 += 16) {
                const bf16x8 af = *(const bf16x8*)(ap + k0), bf0 = *(const bf16x8*)(b0 + k0), bf1v = *(const bf16x8*)(b1 + k0);
                acc0 = __builtin_amdgcn_mfma_f32_32x32x16_bf16(bf0, af, acc0, 0, 0, 0);
                acc1 = __builtin_amdgcn_mfma_f32_32x32x16_bf16(bf1v, af, acc1, 0, 0, 0);
            }
        }
        if (KS > 1) {
#pragma unroll
            for (int q = 0; q < 16; ++q) { red[((w * 2 + 0) * 16 + q) * 64 + lane] = acc0[q]; red[((w * 2 + 1) * 16 + q) * 64 + lane] = acc1[q]; }
            __syncthreads();
            if (valid && ks == 0) {
#pragma unroll
                for (int j = 1; j < KS; ++j)
#pragma unroll
                    for (int q = 0; q < 16; ++q) { acc0[q] += red[(((w + j) * 2 + 0) * 16 + q) * 64 + lane]; acc1[q] += red[(((w + j) * 2 + 1) * 16 + q) * 64 + lane]; }
            }
        }
        if (valid && ks == 0) E(acc0, acc1, r, cb, h);
        if (KS > 1) __syncthreads();
    }
}

#ifndef MK_N_LAUNCHES
#define MK_N_LAUNCHES 1
#endif
constexpr int N_PHASES = 9;
constexpr int N_LAUNCHES = MK_N_LAUNCHES;
struct Args { const float* in[29]; float* out; unsigned char* ws; int ph_lo, ph_hi, li, pad; };
__global__ void __launch_bounds__(NWAVES * 64, 2) hymba_fwd(Args args) {
    extern __shared__ __attribute__((aligned(16))) unsigned char lds[];
    Frame F;
    F.lds = (LAS unsigned char*)lds;
    F.MISC = (volatile LAS unsigned*)(F.lds + MISC_OFF);
    F.wave = __builtin_amdgcn_readfirstlane((int)threadIdx.x >> 6);
    F.G = gridDim.x; { const int bx = blockIdx.x; F.vcu = (F.G % 8 == 0) ? (bx % 8) * (F.G / 8) + bx / 8 : bx; }
    F.kp = (kernarg_ptr)__builtin_amdgcn_kernarg_segment_ptr(); F.out = args.out; F.ws = args.ws;
    for (int u = F.tid(); u < (LDS_BYTES - LDSCTL_OFF) / 4; u += NWAVES * 64) ((LAS unsigned*)(F.lds + LDSCTL_OFF))[u] = 0u;
    __syncthreads();
    XcdBarrier bar; bar.bar = (unsigned*)(F.ctl() + CW_BAR); bar.x = 0; bar.st = nullptr;
    if (N_LAUNCHES == 1) bar = xcd_barrier_post((unsigned*)(F.ctl() + CW_BAR), F.MISC + 8, F.tid() == 0);
#define GRID_BAR() do { if (N_LAUNCHES == 1) xcd_barrier(bar, F.tid() == 0); } while (0)
    const int lo = args.ph_lo, hi = args.ph_hi;
#define IN(k) (lo <= (k) && (k) < hi)
#ifndef PROBE_PHASE
#define PROBE_PHASE -1
#endif
    unsigned long long tsA = 0, tsB = 0; pg8::Tm tm{0, 0};
#define STAMP(k) do { if (PROBE_PHASE >= 0 && PROBE_WHICH == 0) { if ((k) == PROBE_PHASE) tsA = __builtin_amdgcn_s_memrealtime(); if ((k) == PROBE_PHASE + 1) tsB = __builtin_amdgcn_s_memrealtime(); } } while (0)
#define BOTH(k) (IN(k) && IN((k) + 1))
#ifndef PROBE_REP
#define PROBE_REP 0
#endif
#define REP(k) for (int rep_ = 0; rep_ < (((PROBE_REP >> (k)) & 1) ? 2 : 1); ++rep_)

#ifndef SKIP_P0
    STAMP(0);
    if (IN(0)) REP(0) { p0_prologue(F); if (BOTH(0)) GRID_BAR(); }
#endif
    STAMP(1);
    if (IN(1)) REP(1) {
        pg8::Gemm g{F.XB(), F.WGU1(), MP, 2 * DFF, DM}; pg8::StaticOrder S; S.init(MP, 2 * DFF, F.G, (int)blockIdx.x);
        pg8::EpiSwiglu E{F.HB(), DFF}; pg8::rs_cache_fill(F.lds + RING_OFF, S, F.SSQ(), F.wave);
        pg8::gemm_phase<pg8::EpiSwiglu, pg8::StaticOrder, true, true>(F.lds + RING_OFF, g, S, E, F.wave, tm);
        if (PROBE_WHICH != 0 && PROBE_PHASE == 1) { tsA = 0; tsB = (PROBE_WHICH == 1) ? tm.k : tm.e; } tm.k = 0; tm.e = 0;
        { SEpiSwiglu SE{F.HB(), F.SSQ()}; small_gemm<DM, 1, SEpiSwiglu>(F, F.XB(), DM, F.WGU1(), DFF / 32, SE); }
        if (BOTH(1)) GRID_BAR();
    }
    STAMP(2);
    if (IN(2)) REP(2) {
        pg8::Gemm g{F.HB(), F.WD1(), MP, DM, DFF}; pg8::StaticOrder S; S.init(MP, DM, F.G, (int)blockIdx.x);
        pg8::EpiResid<1> E{nullptr, nullptr, F.XB(), F.SSQ(), 0.5f};
        pg8::gemm_phase<pg8::EpiResid<1>, pg8::StaticOrder, true, true>(F.lds + RING_OFF, g, S, E, F.wave, tm);
        if (PROBE_WHICH != 0 && PROBE_PHASE == 2) { tsA = 0; tsB = (PROBE_WHICH == 1) ? tm.k : tm.e; } tm.k = 0; tm.e = 0;
        { SEpiResid<1> SE{nullptr, nullptr, F.XB(), F.SSQ(), 0.5f}; small_gemm<DFF, 8, SEpiResid<1>>(F, F.HB(), DFF, F.WD1(), DM / 64, SE); }
        if (BOTH(2)) GRID_BAR();
    }
    STAMP(3);
    if (IN(3)) REP(3) {
        pg8::Gemm g{F.XB(), F.WINT(), MP, INW, DM}; pg8::StaticOrder S; S.init(MP, INW, F.G, (int)blockIdx.x);
        pg8::EpiScaleBf16 E{F.PROJ(), INW}; pg8::rs_cache_fill(F.lds + RING_OFF, S, F.SSQ(), F.wave);
        pg8::gemm_phase<pg8::EpiScaleBf16, pg8::StaticOrder, true, true>(F.lds + RING_OFF, g, S, E, F.wave, tm);
        if (PROBE_WHICH != 0 && PROBE_PHASE == 3) { tsA = 0; tsB = (PROBE_WHICH == 1) ? tm.k : tm.e; } tm.k = 0; tm.e = 0;
        { SEpiScale SE{F.PROJ(), INW, F.SSQ()}; small_gemm<DM, 4, SEpiScale>(F, F.XB(), DM, F.WINT(), INW / 64, SE); }
        if (BOTH(3)) GRID_BAR();
    }
    STAMP(4);
    if (IN(4)) REP(4) {
#ifndef SKIP_ATTN
        REP(8) for (int it = blockIdx.x; it < BATCH * (SEQ / WIN); it += F.G) attn_prompt_item(F, it);
#endif
#ifndef SKIP_LRU1
        REP(9) for (int it = blockIdx.x; it < BATCH * NCHUNK; it += F.G) lru_prompt_item<1>(F, it);
#endif
#ifndef SKIP_SAMPLE
        __syncthreads();
        REP(10) for (int it = blockIdx.x; it < 2 * DEC_B; it += F.G) { if (it < DEC_B) sample_lru_item(F, it); else sample_attn_item(F, it - DEC_B); }
#endif
        if (BOTH(4)) GRID_BAR();
    }
    STAMP(5);
    if (IN(5)) REP(5) {
#ifndef SKIP_LRU2
        for (int it = blockIdx.x; it < BATCH * NCHUNK; it += F.G) lru_prompt_item<2>(F, it);
#endif
        if (BOTH(5)) GRID_BAR();
    }
    STAMP(6);
    if (IN(6)) {
        pg8::Gemm g{F.CAT(), F.WOUT(), MP, DM, DM}; pg8::StaticOrder S; S.init(MP, DM, F.G, (int)blockIdx.x);
        pg8::EpiResidMix E{F.XB(), F.SSQ()}; pg8::mix_cache_fill(F.lds + RING_OFF, S, F.SSQL(), F.SSQA(), F.wave);
        pg8::gemm_phase<pg8::EpiResidMix, pg8::StaticOrder, true, true>(F.lds + RING_OFF, g, S, E, F.wave, tm);
        if (PROBE_WHICH != 0 && PROBE_PHASE == 6) { tsA = 0; tsB = (PROBE_WHICH == 1) ? tm.k : tm.e; } tm.k = 0; tm.e = 0;
        { SEpiResid<1> SE{nullptr, nullptr, F.XB(), F.SSQ(), 1.0f}; small_gemm<DM, 8, SEpiResid<1>>(F, F.CAT(), DM, F.WOUT(), DM / 64, SE); }
        if (BOTH(6)) GRID_BAR();
    }
    STAMP(7);
    if (IN(7)) REP(7) {
        pg8::Gemm g{F.XB(), F.WGU2(), MP, 2 * DFF, DM}; pg8::StaticOrder S; S.init(MP, 2 * DFF, F.G, (int)blockIdx.x);
        pg8::EpiSwiglu E{F.HB(), DFF}; pg8::rs_cache_fill(F.lds + RING_OFF, S, F.SSQ(), F.wave);
        pg8::gemm_phase<pg8::EpiSwiglu, pg8::StaticOrder, true, true>(F.lds + RING_OFF, g, S, E, F.wave, tm);
        if (PROBE_WHICH != 0 && PROBE_PHASE == 7) { tsA = 0; tsB = (PROBE_WHICH == 1) ? tm.k : tm.e; } tm.k = 0; tm.e = 0;
        { SEpiSwiglu SE{F.HB(), F.SSQ()}; small_gemm<DM, 1, SEpiSwiglu>(F, F.XB(), DM, F.WGU2(), DFF / 32, SE); }
        if (BOTH(7)) GRID_BAR();
    }
    STAMP(8);
    if (IN(8)) {
        pg8::Gemm g{F.HB(), F.WD2(), MP, DM, DFF}; pg8::StaticOrder S; S.init(MP, DM, F.G, (int)blockIdx.x);
        pg8::EpiResid<2> E{nullptr, F.out, F.XB(), nullptr, 0.5f};
        pg8::gemm_phase<pg8::EpiResid<2>, pg8::StaticOrder, true, true>(F.lds + RING_OFF, g, S, E, F.wave, tm);
        if (PROBE_WHICH != 0 && PROBE_PHASE == 8) { tsA = 0; tsB = (PROBE_WHICH == 1) ? tm.k : tm.e; } tm.k = 0; tm.e = 0;
        { SEpiResid<2> SE{nullptr, F.out, F.XB(), nullptr, 0.5f}; small_gemm<DFF, 8, SEpiResid<2>>(F, F.HB(), DFF, F.WD2(), DM / 64, SE); }
    }
    STAMP(9);
    if (PROBE_PHASE >= 0 && blockIdx.x == 0) { asm volatile("s_waitcnt vmcnt(0)" ::: "memory"); const unsigned long long te = __builtin_amdgcn_s_memrealtime(), d = 4 * (tsB - tsA); while (__builtin_amdgcn_s_memrealtime() - te < d) __builtin_amdgcn_s_sleep(8); }
#undef IN
#undef BOTH
}

extern "C" void kernel_launch(void* const* d_in, const int* in_sizes, int n_in, void* d_out, int out_size, void* d_ws, size_t ws_size, hipStream_t stream) {
    static int grid = 0;
    if (grid == 0) {
        if (n_in != 29 || in_sizes[0] != MP * DM || (size_t)out_size != O_END || ws_size < WS_END) { fprintf(stderr, "kernel_launch: unexpected shapes (n_in %d in0 %d out %d ws %zu); nothing launched\n", n_in, n_in > 0 ? in_sizes[0] : -1, out_size, ws_size); grid = -1; return; }
        int dev = 0, cus = 0, per_cu = 0;
        if (hipGetDevice(&dev) != hipSuccess || hipDeviceGetAttribute(&cus, hipDeviceAttributeMultiprocessorCount, dev) != hipSuccess) { fprintf(stderr, "kernel_launch: device query failed\n"); grid = -1; return; }
        if (hipFuncSetAttribute((const void*)hymba_fwd, hipFuncAttributeMaxDynamicSharedMemorySize, LDS_BYTES) != hipSuccess) { fprintf(stderr, "kernel_launch: hipFuncSetAttribute failed\n"); grid = -1; return; }
        if (hipOccupancyMaxActiveBlocksPerMultiprocessor(&per_cu, (const void*)hymba_fwd, NWAVES * 64, LDS_BYTES) != hipSuccess || per_cu < 1) { fprintf(stderr, "kernel_launch: occupancy query reports %d workgroups per CU\n", per_cu); per_cu = 1; }
        (void)hipGetLastError();
        grid = cus;
    }
    if (grid < 0) return;
    if (hipMemsetAsync((char*)d_ws + WS_CTL, 0, CTL_ZERO_BYTES, stream) != hipSuccess) { fprintf(stderr, "kernel_launch: memset failed\n"); return; }
    Args a{};
    for (int i = 0; i < 29; ++i) a.in[i] = (const float*)d_in[i];
    a.out = (float*)d_out; a.ws = (unsigned char*)d_ws;
    if (N_LAUNCHES == 1) {
        a.ph_lo = 0; a.ph_hi = N_PHASES; a.li = 0;
        hipLaunchKernelGGL(hymba_fwd, dim3(grid), dim3(NWAVES * 64), LDS_BYTES, stream, a);
    } else {
        for (int li = 0; li < N_PHASES; ++li) { a.ph_lo = li; a.ph_hi = li + 1; a.li = li; hipLaunchKernelGGL(hymba_fwd, dim3(grid), dim3(NWAVES * 64), LDS_BYTES, stream, a); }
    }
    const hipError_t le = hipPeekAtLastError();
    if (le != hipSuccess) fprintf(stderr, "kernel_launch: launch failed: %s\n", hipGetErrorName(le));
}
```

```cpp
#include <hip/hip_runtime.h>
#include <cstdio>
#include <cstdint>
#include <cmath>
namespace pg8 {
#define PG8_LAS __attribute__((address_space(3)))
typedef unsigned short bf16_t;
typedef short bf16x8 __attribute__((ext_vector_type(8)));
typedef float f32x4 __attribute__((ext_vector_type(4)));
typedef unsigned u32x4 __attribute__((ext_vector_type(4)));
constexpr int BM = 256, BK = 64, HALF = 128, HTB = HALF * BK * 2  , STAGE_BYTES = 8 * HTB, NXCD = 8, WGM = 8;

__host__ __device__ __forceinline__ int lds_byte(int r, int c) { const int st = (r >> 4) * 2 + (c >> 5), rr = r & 15, cc = c & 31, ob = rr * 64 + cc * 2; return st * 1024 + (ob ^ (((ob >> 9) & 1) << 5)); }
__host__ __device__ __forceinline__ void stage_rc(int b, int& R, int& C) { const int st = b / 1024, sb = b % 1024, swz = sb ^ (((sb >> 9) & 1) << 5); R = (st >> 1) * 16 + swz / 64; C = (st & 1) * 32 + (swz % 64) / 2; }
__host__ __device__ __forceinline__ int perm32(int rho) { const int n = rho >> 4, i = rho & 15; return 8 * (i >> 2) + 4 * n + (i & 3); }

struct Unit { int pm, pn; };
struct Gemm { const bf16_t* A; const bf16_t* Bt; int M, N, K; };

struct StaticOrder {
    int nM, nN, nwg, G, c;
    __host__ __device__ void init(int M, int N, int G_, int c_) { nM = M / BM; nN = N / BM; nwg = nM * nN; G = G_; c = c_; }
    __host__ __device__ bool next(int i, Unit& u) const {
        const long L = (long)i * G + c; if (L >= nwg) return false;
        int wgid = (int)L; { const int q = nwg / NXCD, r = nwg % NXCD, xcd = wgid % NXCD, off = wgid / NXCD; wgid = (xcd < r ? xcd * (q + 1) : r * (q + 1) + (xcd - r) * q) + off; }
        const int nig = WGM * nN, gid = wgid / nig, fm = gid * WGM, gsz = (nM - fm) < WGM ? (nM - fm) : WGM;
        u.pm = fm + ((wgid % nig) % gsz); u.pn = (wgid % nig) / gsz; return true;
    }
    __device__ __forceinline__ void a_ready(const Unit&) const {}
    __device__ __forceinline__ void done(const Unit&) const {}
};

__device__ __forceinline__ unsigned cvt_pk_bf16(float lo, float hi) { unsigned r; asm volatile("v_cvt_pk_bf16_f32 %0, %1, %2" : "=v"(r) : "v"(lo), "v"(hi)); return r; }
#ifndef PROBE_WHICH
#define PROBE_WHICH 0
#endif
constexpr bool TM_ON = PROBE_WHICH != 0;
struct Tm { unsigned long long k, e; };
__device__ __forceinline__ int pg8_lane_id() { int l; asm volatile("v_mbcnt_lo_u32_b32 %0, -1, 0\n\tv_mbcnt_hi_u32_b32 %0, -1, %0" : "=v"(l)); return l; }
typedef float f32x2 __attribute__((ext_vector_type(2)));
typedef unsigned u32x2 __attribute__((ext_vector_type(2)));
constexpr float RMS_EPS = 1e-6f;
__device__ __forceinline__ float row_rs(const float* ssq, int r) {
    const f32x4* p = (const f32x4*)(ssq + (size_t)r * 16);
    const f32x4 a = p[0], b = p[1], c = p[2], d = p[3];
    const float s = ((a[0] + a[1]) + (a[2] + a[3])) + ((b[0] + b[1]) + (b[2] + b[3])) + ((c[0] + c[1]) + (c[2] + c[3])) + ((d[0] + d[1]) + (d[2] + d[3]));
    return __builtin_amdgcn_rsqf(s * (1.0f / 1024.0f) + RMS_EPS);
}
__device__ __forceinline__ float silu_f(float g) { return g * __builtin_amdgcn_rcpf(1.0f + __builtin_amdgcn_exp2f(g * -1.4426950408889634f)); }

constexpr int RS_CACHE_OFF = STAGE_BYTES;
template <class Sched> __device__ __forceinline__ void rs_cache_fill(PG8_LAS unsigned char* lds, const Sched& S, const float* ssq, int wid) {
    PG8_LAS float* rsl = (PG8_LAS float*)(lds + RS_CACHE_OFF); Unit u; const int tid_ = wid * 64 + pg8_lane_id(), t = tid_ & 255, hf = tid_ >> 8;
    for (int i = hf; S.next(i, u); i += 2) rsl[i * 256 + t] = row_rs(ssq, u.pm * BM + t);
    __syncthreads();
}
struct EpiSwiglu {
    static constexpr bool PERM = true, AFTER_DRAIN = false, MID = false;
    bf16_t* H; int ldh;
    __device__ __forceinline__ void operator()(const f32x4 (&acc)[2][2][4][2], const Unit& u, int wr, int wc, int fr, int fq, int ui, PG8_LAS unsigned char* lds) const {
        const int row0 = u.pm * BM + wr * 64 + fr, col0 = u.pn * HALF + wc * 32 + 8 * fq;
        const PG8_LAS float* rsl = (const PG8_LAS float*)(lds + RS_CACHE_OFF) + ui * 256 + wr * 64 + fr;
#pragma unroll
        for (int ai = 0; ai < 2; ++ai)
#pragma unroll
            for (int m = 0; m < 4; ++m) {
                const int r = row0 + ai * HALF + m * 16; const float rs = rsl[ai * HALF + m * 16];
                float hv[8];
#pragma unroll
                for (int n = 0; n < 2; ++n)
#pragma unroll
                    for (int e = 0; e < 4; ++e) hv[n * 4 + e] = silu_f(acc[ai][0][m][n][e] * rs) * (acc[ai][1][m][n][e] * rs);
                u32x4 w; w.x = cvt_pk_bf16(hv[0], hv[1]); w.y = cvt_pk_bf16(hv[2], hv[3]); w.z = cvt_pk_bf16(hv[4], hv[5]); w.w = cvt_pk_bf16(hv[6], hv[7]);
                *(u32x4*)(H + (size_t)r * ldh + col0) = w;
            }
    }
};
struct EpiScaleBf16 {
    static constexpr bool PERM = true, AFTER_DRAIN = false, MID = false;
    bf16_t* O; int ldc;
    __device__ __forceinline__ void operator()(const f32x4 (&acc)[2][2][4][2], const Unit& u, int wr, int wc, int fr, int fq, int ui, PG8_LAS unsigned char* lds) const {
        const int row0 = u.pm * BM + wr * 64 + fr, col0 = u.pn * BM + wc * 32 + 8 * fq;
        const PG8_LAS float* rsl = (const PG8_LAS float*)(lds + RS_CACHE_OFF) + ui * 256 + wr * 64 + fr;
#pragma unroll
        for (int ai = 0; ai < 2; ++ai)
#pragma unroll
            for (int m = 0; m < 4; ++m) {
                const int r = row0 + ai * HALF + m * 16; const float rs = rsl[ai * HALF + m * 16];
#pragma unroll
                for (int bj = 0; bj < 2; ++bj) {
                    const f32x4 v0 = acc[ai][bj][m][0] * rs, v1 = acc[ai][bj][m][1] * rs;
                    u32x4 w; w.x = cvt_pk_bf16(v0[0], v0[1]); w.y = cvt_pk_bf16(v0[2], v0[3]); w.z = cvt_pk_bf16(v1[0], v1[1]); w.w = cvt_pk_bf16(v1[2], v1[3]);
                    *(u32x4*)(O + (size_t)r * ldc + col0 + bj * HALF) = w;
                }
            }
    }
};
__device__ __forceinline__ f32x4 bf4_to_f32(u32x2 w) { f32x4 r; r[0] = __builtin_bit_cast(float, w.x << 16); r[1] = __builtin_bit_cast(float, w.x & 0xffff0000u); r[2] = __builtin_bit_cast(float, w.y << 16); r[3] = __builtin_bit_cast(float, w.y & 0xffff0000u); return r; }
template <int MODE> struct EpiResid {
    static constexpr bool PERM = true, AFTER_DRAIN = false, MID = false;
    const float* basef; float* out; bf16_t* xb; float* ssq; float scale;
    __device__ __forceinline__ void operator()(const f32x4 (&acc)[2][2][4][2], const Unit& u, int wr, int wc, int fr, int fq, int ui, PG8_LAS unsigned char* lds) const {
        const int row0 = u.pm * BM + wr * 64 + fr, col0 = u.pn * BM + wc * 32 + 8 * fq;
#pragma unroll
        for (int ai = 0; ai < 2; ++ai) {
            f32x4 pre[4][2][2];
#pragma unroll
            for (int m = 0; m < 4; ++m) { const size_t off = (size_t)(row0 + ai * HALF + m * 16) * 1024 + col0;
#pragma unroll
                for (int bj = 0; bj < 2; ++bj) {
                    if (MODE == 0) { pre[m][bj][0] = *(const f32x4*)(basef + off + bj * HALF); pre[m][bj][1] = *(const f32x4*)(basef + off + bj * HALF + 4); }
                    else { const u32x4 w = *(const u32x4*)(xb + off + bj * HALF); pre[m][bj][0] = bf4_to_f32((u32x2){w.x, w.y}); pre[m][bj][1] = bf4_to_f32((u32x2){w.z, w.w}); } } }
#pragma unroll
            for (int m = 0; m < 4; ++m) { const int r = row0 + ai * HALF + m * 16; const size_t off = (size_t)r * 1024 + col0; float s = 0.f;
#pragma unroll
                for (int bj = 0; bj < 2; ++bj) {
                    const f32x4 o0 = pre[m][bj][0] + acc[ai][bj][m][0] * scale, o1 = pre[m][bj][1] + acc[ai][bj][m][1] * scale;
                    if (MODE == 2) { *(f32x4*)(out + off + bj * HALF) = o0; *(f32x4*)(out + off + bj * HALF + 4) = o1; }
                    else { s += ((o0[0] * o0[0] + o0[1] * o0[1]) + (o0[2] * o0[2] + o0[3] * o0[3])) + ((o1[0] * o1[0] + o1[1] * o1[1]) + (o1[2] * o1[2] + o1[3] * o1[3]));
                        u32x4 w; w.x = cvt_pk_bf16(o0[0], o0[1]); w.y = cvt_pk_bf16(o0[2], o0[3]); w.z = cvt_pk_bf16(o1[0], o1[1]); w.w = cvt_pk_bf16(o1[2], o1[3]); *(u32x4*)(xb + off + bj * HALF) = w; }
                }
                if (MODE != 2) { s += __shfl_xor(s, 16); s += __shfl_xor(s, 32); if (fq == 0) ssq[(size_t)r * 16 + u.pn * 4 + wc] = s; }
            }
        }
    }
};
template <class Sched> __device__ __forceinline__ void mix_cache_fill(PG8_LAS unsigned char* lds, const Sched& S, const float* ssql, const float* ssqa, int wid) {
    PG8_LAS f32x2* c2 = (PG8_LAS f32x2*)(lds + RS_CACHE_OFF); Unit u; const int tid_ = wid * 64 + pg8_lane_id(), t = tid_ & 255, hf = tid_ >> 8;
    for (int i = hf; S.next(i, u); i += 2) { const size_t r = (size_t)u.pm * BM + t;
        const f32x4* pl = (const f32x4*)(ssql + r * 8); const f32x4* pa = (const f32x4*)(ssqa + r * 8); const f32x4 l0 = pl[0], l1 = pl[1], a0 = pa[0], a1 = pa[1];
        const float rl = __builtin_amdgcn_rsqf((((l0[0] + l0[1]) + (l0[2] + l0[3])) + ((l1[0] + l1[1]) + (l1[2] + l1[3]))) * (1.0f / 512.0f) + RMS_EPS);
        const float ra = __builtin_amdgcn_rsqf((((a0[0] + a0[1]) + (a0[2] + a0[3])) + ((a1[0] + a1[1]) + (a1[2] + a1[3]))) * (1.0f / 512.0f) + RMS_EPS);
        c2[i * 256 + t] = (f32x2){rl * __builtin_amdgcn_rcpf(ra), ra}; }
    __syncthreads();
}
struct EpiResidMix {
    static constexpr bool PERM = true, AFTER_DRAIN = false, MID = true;
    bf16_t* xb; float* ssq;
    __device__ __forceinline__ void mid(f32x4 (&acc)[2][2][4][2], int wr, int fr, int ui, PG8_LAS unsigned char* lds) const {
        const PG8_LAS f32x2* c2 = (const PG8_LAS f32x2*)(lds + RS_CACHE_OFF) + ui * 256 + wr * 64 + fr;
#pragma unroll
        for (int ai = 0; ai < 2; ++ai)
#pragma unroll
            for (int m = 0; m < 4; ++m) { const float q = c2[ai * HALF + m * 16].x;
#pragma unroll
                for (int bj = 0; bj < 2; ++bj)
#pragma unroll
                    for (int n = 0; n < 2; ++n) acc[ai][bj][m][n] *= q; }
    }
    __device__ __forceinline__ void operator()(const f32x4 (&acc)[2][2][4][2], const Unit& u, int wr, int wc, int fr, int fq, int ui, PG8_LAS unsigned char* lds) const {
        const int row0 = u.pm * BM + wr * 64 + fr, col0 = u.pn * BM + wc * 32 + 8 * fq;
        const PG8_LAS f32x2* c2 = (const PG8_LAS f32x2*)(lds + RS_CACHE_OFF) + ui * 256 + wr * 64 + fr;
#pragma unroll
        for (int ai = 0; ai < 2; ++ai) {
            u32x4 pre[4][2];
#pragma unroll
            for (int m = 0; m < 4; ++m) { const size_t off = (size_t)(row0 + ai * HALF + m * 16) * 1024 + col0;
#pragma unroll
                for (int bj = 0; bj < 2; ++bj) pre[m][bj] = *(const u32x4*)(xb + off + bj * HALF); }
#pragma unroll
            for (int m = 0; m < 4; ++m) { const int r = row0 + ai * HALF + m * 16; const size_t off = (size_t)r * 1024 + col0; float s = 0.f; const float ra = c2[ai * HALF + m * 16].y;
#pragma unroll
                for (int bj = 0; bj < 2; ++bj) {
                    const f32x4 o0 = bf4_to_f32((u32x2){pre[m][bj].x, pre[m][bj].y}) + acc[ai][bj][m][0] * ra, o1 = bf4_to_f32((u32x2){pre[m][bj].z, pre[m][bj].w}) + acc[ai][bj][m][1] * ra;
                    s += ((o0[0] * o0[0] + o0[1] * o0[1]) + (o0[2] * o0[2] + o0[3] * o0[3])) + ((o1[0] * o1[0] + o1[1] * o1[1]) + (o1[2] * o1[2] + o1[3] * o1[3]));
                    u32x4 w; w.x = cvt_pk_bf16(o0[0], o0[1]); w.y = cvt_pk_bf16(o0[2], o0[3]); w.z = cvt_pk_bf16(o1[0], o1[1]); w.w = cvt_pk_bf16(o1[2], o1[3]); *(u32x4*)(xb + off + bj * HALF) = w;
                }
                s += __shfl_xor(s, 16); s += __shfl_xor(s, 32); if (fq == 0) ssq[(size_t)r * 16 + u.pn * 4 + wc] = s;
            }
        }
    }
};
template <class Epi, class Sched, bool ALIGN_EPI = false, bool SP2 = false>
__device__ __forceinline__ void gemm_phase(PG8_LAS unsigned char* lds, const Gemm g, const Sched& S, const Epi& E, int wid_in, Tm& tm) {
    const int wid = wid_in, lane = pg8_lane_id(), tid = wid * 64 + lane, wr = wid >> 2, wc = wid & 3, fr = lane & 15, fq = lane >> 4;
    const int K = g.K, nt = K / BK;
    unsigned voffA[2], voffB[2];
#pragma unroll
    for (int i = 0; i < 2; ++i) { int R, C; stage_rc(tid * 16 + i * 8192, R, C); const int Rb = Epi::PERM ? ((R & ~31) + perm32(R & 31)) : R;
        voffA[i] = (unsigned)(R * K + C) * 2u; voffB[i] = (unsigned)(Rb * K + C) * 2u; }
    const size_t kstep = (size_t)(BK * 2);
    const size_t hstep = (size_t)HALF * K * 2;
    const size_t tstep = 2 * hstep;
    const unsigned ldsw = (unsigned)wid * 1024u;
    const int aoff = lds_byte(wr * 64 + fr, fq * 8), boff = lds_byte(wc * 32 + fr, fq * 8);
#define PG8_SA(b, h) (((b) * 2 + (h)) * HTB)
#define PG8_SB(b, h) ((4 + (b) * 2 + (h)) * HTB)
#define PG8_STAGE(bufoff, gbase, voff) do { _Pragma("unroll") for (int _i = 0; _i < 2; ++_i) \
        __builtin_amdgcn_global_load_lds((const unsigned*)((const char*)(gbase) + (voff)[_i]), (PG8_LAS unsigned*)(lds + (bufoff) + ldsw + _i * 8192), 16, 0, 0); } while (0)
#define PG8_LDA(dst, b, h) do { _Pragma("unroll") for (int m = 0; m < 4; ++m) _Pragma("unroll") for (int k = 0; k < 2; ++k) dst[m][k] = *(const PG8_LAS bf16x8*)(lds + PG8_SA(b, h) + aoff + m * 2048 + k * 1024); } while (0)
#define PG8_LDB(dst, b, h) do { _Pragma("unroll") for (int n = 0; n < 2; ++n) _Pragma("unroll") for (int k = 0; k < 2; ++k) dst[n][k] = *(const PG8_LAS bf16x8*)(lds + PG8_SB(b, h) + boff + n * 2048 + k * 1024); } while (0)
#define PG8_MMA(ai, bj, At, Bt) do { __builtin_amdgcn_s_setprio(1); _Pragma("unroll") for (int m = 0; m < 4; ++m) _Pragma("unroll") for (int n = 0; n < 2; ++n) _Pragma("unroll") for (int k = 0; k < 2; ++k) \
        acc[ai][bj][m][n] = __builtin_amdgcn_mfma_f32_16x16x32_bf16(Bt[n][k], At[m][k], acc[ai][bj][m][n], 0, 0, 0); __builtin_amdgcn_s_setprio(0); } while (0)
#define PG8_WAIT_V(n) asm volatile("s_waitcnt vmcnt(" #n ")" ::: "memory")
#define PG8_WAIT_L(n) asm volatile("s_waitcnt lgkmcnt(" #n ")" ::: "memory")
#define PG8_BAR __builtin_amdgcn_s_barrier()
#define PG8_SCHED __builtin_amdgcn_sched_barrier(0)
    Unit cur, nxt; int ui = 0;
    if (!S.next(0, cur)) return;
    f32x4 acc[2][2][4][2];
#pragma unroll
    for (int a = 0; a < 2; ++a)
#pragma unroll
        for (int b = 0; b < 2; ++b)
#pragma unroll
            for (int m = 0; m < 4; ++m)
#pragma unroll
                for (int n = 0; n < 2; ++n) acc[a][b][m][n] = (f32x4){0.f, 0.f, 0.f, 0.f};
    bf16x8 At[4][2], B0[2][2], B1[2][2];
    const char* cA = (const char*)g.A + (size_t)cur.pm * tstep; const char* cB = (const char*)g.Bt + (size_t)cur.pn * tstep;
    S.a_ready(cur);
    if constexpr (SP2) {
        PG8_STAGE(PG8_SB(0, 0), cB, voffB); PG8_STAGE(PG8_SB(0, 1), cB + hstep, voffB); PG8_STAGE(PG8_SA(0, 0), cA, voffA); PG8_STAGE(PG8_SA(0, 1), cA + hstep, voffA);
        if (wr == 1) PG8_BAR;
        PG8_WAIT_V(2); PG8_BAR;
        PG8_STAGE(PG8_SB(1, 0), cB + kstep, voffB); PG8_STAGE(PG8_SA(1, 0), cA + kstep, voffA); PG8_STAGE(PG8_SB(1, 1), cB + hstep + kstep, voffB);
        PG8_WAIT_V(6); PG8_BAR;
    } else {
        PG8_STAGE(PG8_SB(0, 0), cB, voffB); PG8_STAGE(PG8_SA(0, 0), cA, voffA); PG8_STAGE(PG8_SB(0, 1), cB + hstep, voffB); PG8_STAGE(PG8_SA(0, 1), cA + hstep, voffA);
        if (wr == 1) PG8_BAR;
        PG8_WAIT_V(4); PG8_BAR;
        PG8_STAGE(PG8_SB(1, 0), cB + kstep, voffB); PG8_STAGE(PG8_SA(1, 0), cA + kstep, voffA); PG8_STAGE(PG8_SB(1, 1), cB + hstep + kstep, voffB);
        PG8_WAIT_V(6); PG8_BAR;
    }
    for (;;) {
        const bool has_next = S.next(ui + 1, nxt);
        const unsigned long long tm_a = TM_ON ? __builtin_amdgcn_s_memrealtime() : 0ull;
        const char* nA = has_next ? (const char*)g.A + (size_t)nxt.pm * tstep : cA; const char* nB = has_next ? (const char*)g.Bt + (size_t)nxt.pn * tstep : cB;
        for (int t = 0; t < nt; t += 2) {
            if constexpr (Epi::MID) { if (t == nt / 2) E.mid(acc, wr, fr, ui, lds); }
            const bool last = (t == nt - 2);
            const char* a1 = cA + (size_t)(t + 1) * kstep;
            const char* a2 = last ? nA : cA + (size_t)(t + 2) * kstep; const char* b2 = last ? nB : cB + (size_t)(t + 2) * kstep;
            const char* a3 = a2 + kstep; const char* b3 = b2 + kstep;
            if (last && has_next) S.a_ready(nxt);
            if constexpr (SP2) {
            PG8_LDB(B0, 0, 0); PG8_LDB(B1, 0, 1); PG8_SCHED; PG8_LDA(At, 0, 0); PG8_STAGE(PG8_SA(1, 1), a1 + hstep, voffA);
            PG8_WAIT_V(8); PG8_WAIT_L(0); PG8_BAR; PG8_MMA(0, 0, At, B0); PG8_MMA(0, 1, At, B1); PG8_BAR; PG8_SCHED;
            PG8_LDA(At, 0, 1); PG8_STAGE(PG8_SB(0, 0), b2, voffB); PG8_STAGE(PG8_SB(0, 1), b2 + hstep, voffB); PG8_STAGE(PG8_SA(0, 0), a2, voffA);
            PG8_WAIT_V(8); PG8_WAIT_L(0); PG8_BAR; PG8_MMA(1, 0, At, B0); PG8_MMA(1, 1, At, B1); PG8_BAR; PG8_SCHED;
            PG8_LDB(B0, 1, 0); PG8_LDB(B1, 1, 1); PG8_SCHED; PG8_LDA(At, 1, 0); PG8_STAGE(PG8_SA(0, 1), a2 + hstep, voffA);
            PG8_WAIT_V(8); PG8_WAIT_L(0); PG8_BAR; PG8_MMA(0, 0, At, B0); PG8_MMA(0, 1, At, B1); PG8_BAR; PG8_SCHED;
            PG8_LDA(At, 1, 1); PG8_STAGE(PG8_SB(1, 0), b3, voffB); PG8_STAGE(PG8_SB(1, 1), b3 + hstep, voffB); PG8_STAGE(PG8_SA(1, 0), a3, voffA);
            PG8_WAIT_V(8); PG8_WAIT_L(0); PG8_BAR; PG8_MMA(1, 0, At, B0); PG8_MMA(1, 1, At, B1); PG8_BAR; PG8_SCHED;
            } else {
            PG8_LDB(B0, 0, 0); PG8_SCHED; PG8_LDA(At, 0, 0); PG8_STAGE(PG8_SA(1, 1), a1 + hstep, voffA);
            PG8_WAIT_L(8); PG8_BAR; PG8_WAIT_L(0); PG8_MMA(0, 0, At, B0); PG8_BAR; PG8_SCHED;
            PG8_LDB(B1, 0, 1); PG8_STAGE(PG8_SB(0, 0), b2, voffB);
            PG8_BAR; PG8_WAIT_L(0); PG8_MMA(0, 1, At, B1); PG8_BAR;
            PG8_LDA(At, 0, 1); PG8_STAGE(PG8_SA(0, 0), a2, voffA);
            PG8_BAR; PG8_WAIT_L(0); PG8_MMA(1, 0, At, B0); PG8_BAR; PG8_SCHED;
            PG8_STAGE(PG8_SB(0, 1), b2 + hstep, voffB);
            PG8_WAIT_V(6); PG8_BAR; PG8_MMA(1, 1, At, B1); PG8_BAR;
            PG8_LDB(B0, 1, 0); PG8_SCHED; PG8_LDA(At, 1, 0); PG8_STAGE(PG8_SA(0, 1), a2 + hstep, voffA);
            PG8_WAIT_L(8); PG8_BAR; PG8_WAIT_L(0); PG8_MMA(0, 0, At, B0); PG8_BAR; PG8_SCHED;
            PG8_LDB(B1, 1, 1); PG8_STAGE(PG8_SB(1, 0), b3, voffB);
            PG8_BAR; PG8_WAIT_L(0); PG8_MMA(0, 1, At, B1); PG8_BAR;
            PG8_LDA(At, 1, 1); PG8_STAGE(PG8_SA(1, 0), a3, voffA);
            PG8_BAR; PG8_WAIT_L(0); PG8_MMA(1, 0, At, B0); PG8_BAR; PG8_SCHED;
            PG8_STAGE(PG8_SB(1, 1), b3 + hstep, voffB);
            PG8_WAIT_V(6); PG8_BAR; PG8_MMA(1, 1, At, B1); PG8_BAR;
            }
        }
        const unsigned long long tm_b = TM_ON ? __builtin_amdgcn_s_memrealtime() : 0ull;
        if constexpr (ALIGN_EPI) { if (wr == 0) PG8_BAR; }
        if constexpr (!Epi::AFTER_DRAIN) { E(acc, cur, wr, wc, fr, fq, ui, lds); S.done(cur); }
        if (TM_ON) { const unsigned long long tm_c = __builtin_amdgcn_s_memrealtime(); tm.k += tm_b - tm_a; tm.e += tm_c - tm_b; }
        if (!has_next) break;
#pragma unroll
        for (int a = 0; a < 2; ++a)
#pragma unroll
            for (int b = 0; b < 2; ++b)
#pragma unroll
                for (int m = 0; m < 4; ++m)
#pragma unroll
                    for (int n = 0; n < 2; ++n) acc[a][b][m][n] = (f32x4){0.f, 0.f, 0.f, 0.f};
        cur = nxt; cA = nA; cB = nB; ++ui;
        if constexpr (ALIGN_EPI) { if (wr == 1) PG8_BAR; }
    }
    PG8_WAIT_V(0);
    if constexpr (!ALIGN_EPI) { if (wr == 0) PG8_BAR; }
    PG8_BAR;
    if constexpr (Epi::AFTER_DRAIN) { E.fused(acc, cur, wr, wc, fr, fq, lds, wid, lane); S.done(cur); }
#undef PG8_SA
#undef PG8_SB
#undef PG8_STAGE
#undef PG8_LDA
#undef PG8_LDB
#undef PG8_MMA
#undef PG8_WAIT_V
#undef PG8_WAIT_L
#undef PG8_BAR
#undef PG8_SCHED
}
}

constexpr int NWAVES = 8;
constexpr int DM = 1024, BATCH = 4, SEQ = 8192, MP = BATCH * SEQ, DEC_B = 128, DEC_T = 4, MS = DEC_B * DEC_T, MT = MP + MS;
constexpr int LRU_W = 512, NH = 8, NKV = 2, HD = 64, DFF = 2816, INW = 1792, WIN = 128, PAST = 16384;
constexpr int C_XL = 0, C_GATE = 512, C_Q = 1024, C_K = 1536, C_V = 1664;
constexpr int NCHUNK = 64, CHUNK = SEQ / NCHUNK;
constexpr float EPS = 1e-6f, LOG2E = 1.4426950408889634f;
constexpr size_t O_YP = 0, O_YS = 33554432, O_PH = 34078720, O_PC = 34080768, O_PK = 34086912, O_PV = 34152448, O_SH = 34217984, O_SC = 34283520, O_SK = 34480128, O_SV = 36577280, O_END = 38674432;
constexpr size_t MiB = 1u << 20;
constexpr size_t WS_CTL = 0, CTL_ZERO_BYTES = 1 * MiB;
constexpr size_t WS_WGU1 = 2 * MiB, WS_WD1 = 13 * MiB, WS_WIN = 19 * MiB, WS_WOUT = 23 * MiB, WS_WGU2 = 25 * MiB, WS_WD2 = 36 * MiB;
constexpr size_t WS_ROPE = 42 * MiB;
constexpr size_t WS_SSQ = 45 * MiB;
constexpr size_t WS_LSUM = 48 * MiB;
constexpr size_t WS_WFRAG = 49 * MiB;
constexpr size_t WS_XB = 50 * MiB;
constexpr size_t WS_CAT = 115 * MiB;
constexpr size_t WS_PROJ = 180 * MiB;
constexpr size_t WS_H = 294 * MiB;
constexpr size_t WS_SSQL = 474 * MiB, WS_SSQA = 475 * MiB;
constexpr size_t WS_END = 476 * MiB;
constexpr int ROPE_ROWS = SEQ + DEC_T;
constexpr int CW_TMO = 0, CW_BAR = 4096;
constexpr int RING_OFF = 0, RING_BYTES = 131072;
constexpr int SCR_BYTES = 147456;
constexpr int LDSCTL_OFF = SCR_BYTES, MISC_OFF = LDSCTL_OFF + 64;
constexpr int LDS_BYTES = SCR_BYTES + 512;

#define GAS __attribute__((address_space(1)))
#define LAS __attribute__((address_space(3)))
typedef unsigned short bf16;
typedef unsigned v4u __attribute__((ext_vector_type(4)));
typedef unsigned v2u __attribute__((ext_vector_type(2)));
typedef float f32x4 __attribute__((ext_vector_type(4)));
typedef float f32x16 __attribute__((ext_vector_type(16)));
typedef short bf16x8 __attribute__((ext_vector_type(8)));
typedef GAS unsigned gu32;
#define RLX_AGENT __ATOMIC_RELAXED, __HIP_MEMORY_SCOPE_AGENT
__device__ __forceinline__ int lane_id() { int l; asm volatile("v_mbcnt_lo_u32_b32 %0, -1, 0\n\tv_mbcnt_hi_u32_b32 %0, -1, %0" : "=v"(l)); return l; }
#define LDS_WAIT() asm volatile("s_waitcnt lgkmcnt(0)" ::: "memory")
#define VM_WAIT() asm volatile("s_waitcnt vmcnt(0)" ::: "memory")
__device__ __forceinline__ unsigned f2bf(float f) { unsigned u = __builtin_bit_cast(unsigned, f); return (u + 0x7fffu + ((u >> 16) & 1u)) >> 16; }
__device__ __forceinline__ unsigned pk2(float lo, float hi) { return f2bf(lo) | (f2bf(hi) << 16); }
__device__ __forceinline__ float bflo(unsigned w) { return __builtin_bit_cast(float, w << 16); }
__device__ __forceinline__ float bfhi(unsigned w) { return __builtin_bit_cast(float, w & 0xffff0000u); }
__device__ __forceinline__ float bf1(bf16 v) { return __builtin_bit_cast(float, (unsigned)v << 16); }
typedef float f32x2_t __attribute__((ext_vector_type(2))); typedef __bf16 bf16x2_t __attribute__((ext_vector_type(2)));
__device__ __forceinline__ unsigned cvtpk(float lo, float hi) { f32x2_t v = {lo, hi}; bf16x2_t b = __builtin_convertvector(v, bf16x2_t); return __builtin_bit_cast(unsigned, b); }
__device__ __forceinline__ float wave_sum(float v) {
#pragma unroll
    for (int o = 1; o < 64; o <<= 1) v += __shfl_xor(v, o);
    return v;
}
__device__ __forceinline__ float wave_max(float v) {
#pragma unroll
    for (int o = 1; o < 64; o <<= 1) v = fmaxf(v, __shfl_xor(v, o));
    return v;
}
__device__ __forceinline__ float sigmoid_f(float x) { return __builtin_amdgcn_rcpf(1.0f + __builtin_amdgcn_exp2f(-x * LOG2E)); }
__device__ __forceinline__ float gelu_tanh(float x) {
    const float y = 0.7978845608028654f * (x + 0.044715f * x * x * x);
    const float e = __builtin_amdgcn_exp2f(2.0f * LOG2E * y);
    const float th = 1.0f - 2.0f * __builtin_amdgcn_rcpf(e + 1.0f);
    return 0.5f * x * (1.0f + th);
}
__device__ __forceinline__ float one_minus_exp(float t) {
    const float ser = -t * (1.0f + t * (0.5f + t * (0.16666667f + t * (0.041666668f + t * 0.0083333338f))));
    const float dir = 1.0f - __builtin_amdgcn_exp2f(t * LOG2E);
    return t > -0.25f ? ser : dir;
}
__device__ __forceinline__ float dot2bf(unsigned a, unsigned b, float c) { return __builtin_amdgcn_fdot2_f32_bf16(__builtin_bit_cast(bf16x2_t, a), __builtin_bit_cast(bf16x2_t, b), c, false); }
#define XB_TMO      128
#define XB_XCNT(j)  (256  + 64 * (j))
#define XB_XSUB(j)  (1280 + 64 * (j))
#define XB_XGEN(j)  (2304 + 64 * (j))
#define XB_TOP      3328
#define XB_TOPGEN   3392
#define XCD_BAR_WORDS 3456
#define XB_SPIN_CAP (1u << 18)

__device__ __forceinline__ unsigned xb_ld(unsigned* p)              { return __hip_atomic_load(p, __ATOMIC_RELAXED, __HIP_MEMORY_SCOPE_AGENT); }
__device__ __forceinline__ unsigned xb_add(unsigned* p, unsigned v) { return __hip_atomic_fetch_add(p, v, __ATOMIC_RELAXED, __HIP_MEMORY_SCOPE_AGENT); }
__device__ __forceinline__ unsigned xb_xcc_id() { return (unsigned)__builtin_amdgcn_s_getreg((3 << 11) | 20) & 0xFu; }
#define XB_SPIN(cond, bar) do { unsigned _sp = 0; while (cond) { __builtin_amdgcn_s_sleep(1); \
    if ((++_sp & 255u) == 0u) { if (xb_ld(&(bar)[XB_TMO])) break; if (_sp > XB_SPIN_CAP) { atomicAdd(&(bar)[XB_TMO], 1u); break; } } } } while (0)

struct XcdBarrier {
    unsigned* bar; unsigned x;
    volatile LAS unsigned* st;
};

__device__ __forceinline__ XcdBarrier xcd_barrier_post(unsigned* bar, volatile LAS unsigned* st, bool leader) {
    XcdBarrier b; b.bar = bar; b.x = xb_xcc_id(); b.st = st;
    if (leader) (void)xb_add(&bar[XB_XCNT(b.x)], 1u);
    return b;
}
__device__ __forceinline__ void xcd_barrier_complete(unsigned* bar, unsigned x, unsigned& nloc, unsigned& nx) {
    const unsigned G = gridDim.x * gridDim.y * gridDim.z;
    unsigned sum, cnt, mine, sp = 0u;
    for (;;) {
        sum = 0u; cnt = 0u; mine = 0u;
#pragma unroll
        for (unsigned j = 0; j < 16; ++j) { const unsigned c = xb_ld(&bar[XB_XCNT(j)]); sum += c; cnt += (c > 0u) ? 1u : 0u; mine = (j == x) ? c : mine; }
        if (sum == G) break;
        __builtin_amdgcn_s_sleep(1);
        if ((++sp & 255u) == 0u) { if (xb_ld(&bar[XB_TMO])) break; if (sp > XB_SPIN_CAP) { atomicAdd(&bar[XB_TMO], 1u); break; } }
    }
    nloc = mine > 0u ? mine : 1u; nx = cnt > 0u ? cnt : 1u;
}

__device__ __forceinline__ void xcd_barrier(const XcdBarrier& b, bool leader) {
    asm volatile("s_waitcnt vmcnt(0)" ::: "memory");
    __syncthreads();
    if (leader) {
        unsigned* bar = b.bar;
        __builtin_amdgcn_s_waitcnt(0);
        unsigned nloc = b.st[0], nx = b.st[1];
        if (nloc == 0u) { xcd_barrier_complete(bar, b.x, nloc, nx); b.st[0] = nloc; b.st[1] = nx; }
        const unsigned old = xb_add(&bar[XB_XSUB(b.x)], 1u);
        const unsigned gen = old / nloc;
        if (old + 1u == (gen + 1u) * nloc) {
            __builtin_amdgcn_fence(__ATOMIC_RELEASE, "agent");
            asm volatile("s_waitcnt vmcnt(0)" ::: "memory");
            const unsigned og = xb_add(&bar[XB_TOP], 1u);
            const unsigned tg = og / nx;
            if (og + 1u == (tg + 1u) * nx) xb_add(&bar[XB_TOPGEN], 1u);
            else XB_SPIN(xb_ld(&bar[XB_TOPGEN]) == tg, bar);
            __builtin_amdgcn_fence(__ATOMIC_ACQUIRE, "agent");
            xb_add(&bar[XB_XGEN(b.x)], 1u);
            asm volatile("s_waitcnt vmcnt(0)" ::: "memory");
        } else {
            XB_SPIN(xb_ld(&bar[XB_XGEN(b.x)]) == gen, bar);
            __builtin_amdgcn_fence(__ATOMIC_ACQUIRE, "agent");
            asm volatile("s_waitcnt vmcnt(0)" ::: "memory");
        }
    }
    __syncthreads();
}

typedef const void __attribute__((address_space(4)))* kernarg_ptr;
struct Frame {
    LAS unsigned char* lds;
    volatile LAS unsigned* MISC;
    int wave;
    __device__ __forceinline__ int lane() const { return lane_id(); }
    __device__ __forceinline__ int tid() const { return wave * 64 + lane_id(); }
    int vcu, G;
    kernarg_ptr kp;
    float* out; unsigned char* ws;
    __device__ __forceinline__ const float* inp(int i) const { kernarg_ptr k = kp; asm volatile("" : "+s"(k)); return ((const float* const __attribute__((address_space(4)))*)k)[i]; }
    __device__ __forceinline__ gu32* ctl() const { return (gu32*)(ws + WS_CTL); }
    __device__ __forceinline__ bf16* WGU1() const { return (bf16*)(ws + WS_WGU1); }
    __device__ __forceinline__ bf16* WD1() const { return (bf16*)(ws + WS_WD1); }
    __device__ __forceinline__ bf16* WINT() const { return (bf16*)(ws + WS_WIN); }
    __device__ __forceinline__ bf16* WOUT() const { return (bf16*)(ws + WS_WOUT); }
    __device__ __forceinline__ bf16* WGU2() const { return (bf16*)(ws + WS_WGU2); }
    __device__ __forceinline__ bf16* WD2() const { return (bf16*)(ws + WS_WD2); }
    __device__ __forceinline__ float* ROPEC() const { return (float*)(ws + WS_ROPE); }
    __device__ __forceinline__ float* ROPES() const { return (float*)(ws + WS_ROPE) + ROPE_ROWS * 32; }
    __device__ __forceinline__ float* SSQ() const { return (float*)(ws + WS_SSQ); }
    __device__ __forceinline__ float* LSUM() const { return (float*)(ws + WS_LSUM); }
    __device__ __forceinline__ float* SSQL() const { return (float*)(ws + WS_SSQL); }
    __device__ __forceinline__ float* SSQA() const { return (float*)(ws + WS_SSQA); }
    __device__ __forceinline__ bf16* WFRAG() const { return (bf16*)(ws + WS_WFRAG); }
    __device__ __forceinline__ bf16* XB() const { return (bf16*)(ws + WS_XB); }
    __device__ __forceinline__ bf16* CAT() const { return (bf16*)(ws + WS_CAT); }
    __device__ __forceinline__ bf16* PROJ() const { return (bf16*)(ws + WS_PROJ); }
    __device__ __forceinline__ bf16* HB() const { return (bf16*)(ws + WS_H); }
};
enum { I_XP = 0, I_XS, I_SH, I_SC, I_CK, I_CV, I_F1N, I_F1G, I_F1U, I_F1D, I_MN, I_WIN, I_CW, I_CB, I_WA, I_BA, I_WX, I_BX, I_LAM, I_QN, I_KN, I_SINK, I_LON, I_AON, I_WOUT, I_F2N, I_F2G, I_F2U, I_F2D };

template <int MODE> __device__ __forceinline__ void p0_transpose_item(const float* W, const float* gain, int K, int N, bf16* WT, LAS float* scr, int item, int lane) {
    const int nblk = N / 32, kb = item / nblk, nb = item % nblk, k0 = 64 * kb, n0 = 32 * nb;
    float tv[32];
#pragma unroll
    for (int i = 0; i < 32; ++i) { const int kk = 2 * i + (lane >> 5); tv[i] = W[(size_t)(k0 + kk) * N + n0 + (lane & 31)]; }
#pragma unroll
    for (int i = 0; i < 32; ++i) { const int kk = 2 * i + (lane >> 5); float v = tv[i]; if (gain) v *= gain[k0 + kk]; scr[kk * 33 + (lane & 31)] = v; }
    LDS_WAIT(); asm volatile("" ::: "memory");
    const int c = lane & 7;
    const int rb = (MODE == 0) ? n0 : ((n0 >> 7) * 256 + (MODE - 1) * 128 + (n0 & 127));
#pragma unroll
    for (int j = 0; j < 4; ++j) { const int n = (lane >> 3) + 8 * j; const LAS float* s = scr + (8 * c) * 33 + n;
        v4u o; o.x = pk2(s[0 * 33], s[1 * 33]); o.y = pk2(s[2 * 33], s[3 * 33]); o.z = pk2(s[4 * 33], s[5 * 33]); o.w = pk2(s[6 * 33], s[7 * 33]);
        *(GAS v4u*)(WT + (size_t)(rb + n) * K + k0 + 8 * c) = o; }
    LDS_WAIT(); asm volatile("" ::: "memory");
}
template <int NR> __device__ __forceinline__ void p0_rows(Frame& F, int m, int step, int lane) {
    f32x4 v[NR][4]; bool ok[NR];
#pragma unroll
    for (int q = 0; q < NR; ++q) { const int r = m + q * step; ok[q] = r < MT; const int rr = ok[q] ? r : m;
        const GAS f32x4* xr = (const GAS f32x4*)((rr < MP) ? F.inp(I_XP) + (size_t)rr * DM : F.inp(I_XS) + (size_t)(rr - MP) * DM) + lane;
#pragma unroll
        for (int j = 0; j < 4; ++j) v[q][j] = xr[64 * j]; }
#pragma unroll
    for (int q = 0; q < NR; ++q) { const int r = m + q * step; float s = 0.f;
#pragma unroll
        for (int j = 0; j < 4; ++j) s += (v[q][j].x * v[q][j].x + v[q][j].y * v[q][j].y) + (v[q][j].z * v[q][j].z + v[q][j].w * v[q][j].w);
        s = wave_sum(s);
        if (ok[q]) { GAS unsigned long long* o8 = (GAS unsigned long long*)(F.XB() + (size_t)r * DM) + lane;
#pragma unroll
            for (int j = 0; j < 4; ++j) o8[64 * j] = (unsigned long long)pk2(v[q][j].x, v[q][j].y) | ((unsigned long long)pk2(v[q][j].z, v[q][j].w) << 32);
            if (lane < 16) F.SSQ()[(size_t)r * 16 + lane] = (lane == 0) ? s : 0.f; } }
}
__device__ __forceinline__ void p0_prologue(Frame& F) {
    LAS float* scr = (LAS float*)(F.lds + RING_OFF + F.wave * 16384);
    const int gw = F.vcu * NWAVES + F.wave, NGW = F.G * NWAVES;
    constexpr int I_GU = (DM / 64) * (DFF / 32), I_D = (DFF / 64) * (DM / 32), I_IN = (DM / 64) * (INW / 32), I_OUT = (DM / 64) * (DM / 32);
    constexpr int NITEMS = 4 * I_GU + 2 * I_D + I_IN + I_OUT;
    for (int it = gw; it < NITEMS; it += NGW) {
        int r = it;
        if (r < I_GU) { p0_transpose_item<1>(F.inp(I_F1G), F.inp(I_F1N), DM, DFF, F.WGU1(), scr, r, F.lane()); continue; } r -= I_GU;
        if (r < I_GU) { p0_transpose_item<2>(F.inp(I_F1U), F.inp(I_F1N), DM, DFF, F.WGU1(), scr, r, F.lane()); continue; } r -= I_GU;
        if (r < I_GU) { p0_transpose_item<1>(F.inp(I_F2G), F.inp(I_F2N), DM, DFF, F.WGU2(), scr, r, F.lane()); continue; } r -= I_GU;
        if (r < I_GU) { p0_transpose_item<2>(F.inp(I_F2U), F.inp(I_F2N), DM, DFF, F.WGU2(), scr, r, F.lane()); continue; } r -= I_GU;
        if (r < I_D) { p0_transpose_item<0>(F.inp(I_F1D), nullptr, DFF, DM, F.WD1(), scr, r, F.lane()); continue; } r -= I_D;
        if (r < I_D) { p0_transpose_item<0>(F.inp(I_F2D), nullptr, DFF, DM, F.WD2(), scr, r, F.lane()); continue; } r -= I_D;
        if (r < I_IN) { p0_transpose_item<0>(F.inp(I_WIN), F.inp(I_MN), DM, INW, F.WINT(), scr, r, F.lane()); continue; } r -= I_IN;
        { const int k0 = 64 * (r / (DM / 32));
          p0_transpose_item<0>(F.inp(I_WOUT), k0 < 512 ? F.inp(I_LON) : F.inp(I_AON) - 512, DM, DM, F.WOUT(), scr, r, F.lane()); }
    }
    { const int ln = F.lane(); for (int m = gw; m < MT; m += 4 * NGW) p0_rows<4>(F, m, NGW, ln); }
    for (int e = F.vcu * (NWAVES * 64) + F.tid(); e < 8 * 2 * 2 * 4 * 64; e += F.G * NWAVES * 64) {
        const int ln = e & 63, ks = (e >> 6) & 3, ct = (e >> 8) & 1, gate = (e >> 9) & 1, blk = e >> 10, ql = ln & 31, hh = ln >> 5;
        const float* pw = (gate ? F.inp(I_WX) : F.inp(I_WA)) + (size_t)(blk * 64 + 16 * ks + 8 * hh) * 64 + 32 * ct + ql;
        v4u o; o.x = pk2(pw[0], pw[64]); o.y = pk2(pw[128], pw[192]); o.z = pk2(pw[256], pw[320]); o.w = pk2(pw[384], pw[448]);
        *(v4u*)(F.WFRAG() + (size_t)e * 8) = o;
    }
    const int gt = F.vcu * (NWAVES * 64) + F.tid(), NGT = F.G * NWAVES * 64;
    for (int e = gt; e < ROPE_ROWS * 32; e += NGT) {
        const int pi = e >> 5, i = e & 31; const int pos = pi < SEQ ? pi : PAST + (pi - SEQ);
        const float invf = (float)exp(-(double)i * (9.210340371976184 / 32.0));
        const float ang = (float)pos * invf; const double a = (double)ang;
        F.ROPEC()[e] = (float)cos(a); F.ROPES()[e] = (float)sin(a);
    }
}

constexpr int LW_XRAW = 0, LW_XCS = 35 * 128, LW_GS = LW_XCS + 32 * 144, LW_OUT = LW_GS + 32 * 128, LW_BYTES = LW_OUT + 32 * 128;
static_assert(8 * LW_BYTES <= SCR_BYTES, "lru LDS");
#define LWAIT() asm volatile("s_waitcnt lgkmcnt(0)" ::: "memory")
template <int PASS> __device__ __forceinline__ void lru_prompt_item(Frame& F, int item) {
    int lane_ = F.lane(); asm volatile("" : "+v"(lane_));
    const int lane0 = lane_, w = F.wave;
    const int b = item / NCHUNK, chunk = item % NCHUNK, t0 = chunk * CHUNK;
    LAS unsigned char* wl = F.lds + w * LW_BYTES;
    float ba[2], bx[2], c8[2];
    { const int ql = lane0 & 31;
#pragma unroll
    for (int ct = 0; ct < 2; ++ct) { const int c = 64 * w + 32 * ct + ql; ba[ct] = F.inp(I_BA)[c]; bx[ct] = F.inp(I_BX)[c];
        const float lam = F.inp(I_LAM)[c]; c8[ct] = -8.0f * (fmaxf(-lam, 0.f) + log1pf(expf(-fabsf(lam)))); } }
    float hst[2] = {0.f, 0.f}, Pst[2] = {1.f, 1.f};
    if (PASS == 2) {
        const float* ls = F.LSUM() + ((size_t)b * NCHUNK * 512 + 64 * w + (lane0 & 31)) * 2; float h0 = 0.f, h1 = 0.f;
#pragma unroll 8
        for (int j = 0; j < chunk; ++j) { const f32x2_t p0 = *(const f32x2_t*)(ls + (size_t)j * 1024), p1 = *(const f32x2_t*)(ls + (size_t)j * 1024 + 64); h0 = p0.x * h0 + p0.y; h1 = p1.x * h1 + p1.y; }
        hst[0] = h0; hst[1] = h1;
    }
    for (int sub = 0; sub < CHUNK / 32; ++sub) {
        const int ts = t0 + sub * 32;
        int lq_ = lane0; asm volatile("" : "+v"(lq_));
        const int lane = lq_, ql = lane & 31, hh = lane >> 5;
        LAS unsigned char* xraw = wl + LW_XRAW; LAS unsigned char* xcs = wl + LW_XCS; LAS unsigned char* gs = wl + LW_GS; LAS unsigned char* outs = wl + LW_OUT;
        const bf16* wfr = F.WFRAG() + (size_t)w * (2 * 2 * 4 * 64 * 8) + lane * 8;
        {
            const bf16* pbase = F.PROJ() + (size_t)(b * SEQ) * INW + 64 * w;
            v4u xv[5], gv[4];
#pragma unroll
            for (int i = 0; i < 5; ++i) { const int idx = lane + 64 * i, row = idx >> 3, ch = idx & 7, t = ts - 3 + row; xv[i] = (v4u){0u, 0u, 0u, 0u};
                if (row < 35 && t >= 0) xv[i] = *(const v4u*)(pbase + (size_t)t * INW + C_XL + 8 * ch); }
            if (PASS == 2) {
#pragma unroll
                for (int i = 0; i < 4; ++i) { const int idx = lane + 64 * i, row = idx >> 3, ch = idx & 7; gv[i] = *(const v4u*)(pbase + (size_t)(ts + row) * INW + C_GATE + 8 * ch); }
            }
#pragma unroll
            for (int i = 0; i < 5; ++i) { const int idx = lane + 64 * i, row = idx >> 3, ch = idx & 7; if (row < 35) *(LAS v4u*)(xraw + row * 128 + 16 * ch) = xv[i]; }
            if (PASS == 2) {
#pragma unroll
                for (int i = 0; i < 4; ++i) { const int idx = lane + 64 * i, row = idx >> 3, ch = idx & 7; *(LAS v4u*)(gs + row * 128 + 16 * ch) = gv[i]; }
            }
        }
        LWAIT();
        {
            const int cch = 64 * w + lane;
            const LAS bf16* xr = (const LAS bf16*)xraw + lane; LAS bf16* xo = (LAS bf16*)xcs + lane;
            const float* cwp = F.inp(I_CW) + cch; const float cw0 = cwp[0], cw1 = cwp[512], cw2 = cwp[1024], cw3 = cwp[1536], cb = F.inp(I_CB)[cch];
            float xm3 = bf1(xr[0]), xm2 = bf1(xr[64]), xm1 = bf1(xr[128]);
#pragma unroll 8
            for (int tt = 0; tt < 32; ++tt) { const float x = bf1(xr[(tt + 3) * 64]);
                xo[tt * 72] = (bf16)f2bf(cb + cw0 * xm3 + cw1 * xm2 + cw2 * xm1 + cw3 * x); xm3 = xm2; xm2 = xm1; xm1 = x; }
            if (PASS == 2 && chunk == NCHUNK - 1 && sub == CHUNK / 32 - 1) {
                F.out[O_PC + (b * 3 + 0) * 512 + cch] = xm3; F.out[O_PC + (b * 3 + 1) * 512 + cch] = xm2; F.out[O_PC + (b * 3 + 2) * 512 + cch] = xm1; }
        }
        LWAIT();
        bf16x8 af[4];
#pragma unroll
        for (int ks = 0; ks < 4; ++ks) af[ks] = *(const LAS bf16x8*)(xcs + ql * 144 + (16 * ks + 8 * hh) * 2);
        float ssv[16];
#pragma unroll
        for (int r = 0; r < 16; ++r) ssv[r] = 0.f;
#pragma unroll
        for (int ct = 0; ct < 2; ++ct) {
            f32x16 ra = {0.f, 0.f, 0.f, 0.f, 0.f, 0.f, 0.f, 0.f, 0.f, 0.f, 0.f, 0.f, 0.f, 0.f, 0.f, 0.f}, rx = ra;
            {   bf16x8 wa4[4], wx4[4];
#pragma unroll
                for (int ks = 0; ks < 4; ++ks) { wa4[ks] = *(const bf16x8*)(wfr + (size_t)((0 * 2 + ct) * 4 + ks) * 512); wx4[ks] = *(const bf16x8*)(wfr + (size_t)((1 * 2 + ct) * 4 + ks) * 512); }
#pragma unroll
                for (int ks = 0; ks < 4; ++ks) { ra = __builtin_amdgcn_mfma_f32_32x32x16_bf16(af[ks], wa4[ks], ra, 0, 0, 0); rx = __builtin_amdgcn_mfma_f32_32x32x16_bf16(af[ks], wx4[ks], rx, 0, 0, 0); } }
            const int cl = 32 * ct + ql;
            float av[16], uv[16];
#pragma unroll
            for (int r = 0; r < 16; ++r) { const int tk = (r & 3) + 8 * (r >> 2) + 4 * hh;
                const float rg = sigmoid_f(ra[r] + ba[ct]), ig = sigmoid_f(rx[r] + bx[ct]);
                const float la = c8[ct] * rg; av[r] = __builtin_amdgcn_exp2f(la * LOG2E);
                const float mult = __builtin_amdgcn_sqrtf(one_minus_exp(2.0f * la));
                uv[r] = mult * ig * bf1(*((const LAS bf16*)(xcs + tk * 144) + cl)); }
            float Ag[4], Ug[4], Ap[4], Up[4], st[4];
#pragma unroll
            for (int g = 0; g < 4; ++g) { Ag[g] = (av[4 * g] * av[4 * g + 1]) * (av[4 * g + 2] * av[4 * g + 3]);
                Ug[g] = ((uv[4 * g] * av[4 * g + 1] + uv[4 * g + 1]) * av[4 * g + 2] + uv[4 * g + 2]) * av[4 * g + 3] + uv[4 * g + 3];
                Ap[g] = __shfl_xor(Ag[g], 32); Up[g] = __shfl_xor(Ug[g], 32); }
            float carry = hst[ct], pp = Pst[ct];
#pragma unroll
            for (int g = 0; g < 4; ++g) { const float Alo = hh ? Ap[g] : Ag[g], Ulo = hh ? Up[g] : Ug[g], Ahi = hh ? Ag[g] : Ap[g], Uhi = hh ? Ug[g] : Up[g];
                const float s_lo = carry; carry = Alo * carry + Ulo; const float s_hi = carry; carry = Ahi * carry + Uhi; st[g] = hh ? s_hi : s_lo; pp *= Alo * Ahi; }
            hst[ct] = carry; Pst[ct] = pp;
            if (PASS == 2) {
#pragma unroll
                for (int g = 0; g < 4; ++g) { float hc = st[g];
#pragma unroll
                    for (int e = 0; e < 4; ++e) { const int r = 4 * g + e, tk = e + 8 * g + 4 * hh; hc = av[r] * hc + uv[r];
                        const float o = hc * gelu_tanh(bf1(*((const LAS bf16*)(gs + tk * 128) + cl)));
                        ssv[r] += o * o; *((LAS bf16*)(outs + tk * 128) + cl) = (bf16)f2bf(o); } }
            }
        }
        if (PASS == 2) {
            float* sq = F.SSQL() + (size_t)(b * SEQ + ts) * 8 + w;
#pragma unroll
            for (int r = 0; r < 16; ++r) { float v = ssv[r];
                v += __shfl_xor(v, 1); v += __shfl_xor(v, 2); v += __shfl_xor(v, 4); v += __shfl_xor(v, 8); v += __shfl_xor(v, 16);
                if (ql == 0) sq[((r & 3) + 8 * (r >> 2) + 4 * hh) * 8] = v; }
            LWAIT();
            bf16* cbase = F.CAT() + (size_t)(b * SEQ + ts) * DM + 64 * w;
#pragma unroll
            for (int i = 0; i < 4; ++i) { const int idx = lane + 64 * i, row = idx >> 3, ch = idx & 7; *(v4u*)(cbase + (size_t)row * DM + 8 * ch) = *(const LAS v4u*)(outs + row * 128 + 16 * ch); }
            LWAIT();
        }
    }
    if ((lane0 & 32) == 0) {
#pragma unroll
        for (int ct = 0; ct < 2; ++ct) { const int c = 64 * w + 32 * ct + (lane0 & 31);
            if (PASS == 1) *(f32x2_t*)(F.LSUM() + (((size_t)b * NCHUNK + chunk) * 512 + c) * 2) = (f32x2_t){Pst[ct], hst[ct]};
            if (PASS == 2 && chunk == NCHUNK - 1) F.out[O_PH + b * 512 + c] = hst[ct]; }
    }
}

constexpr int KS_STRIDE = 144, KS_KVH = 256 * KS_STRIDE;
constexpr int VT_STRIDE = 528, VT_KVH = 64 * VT_STRIDE;
constexpr int AT_KS = 0, AT_VT = 2 * KS_KVH, AT_END = AT_VT + 2 * VT_KVH;
static_assert(AT_END <= SCR_BYTES, "attention LDS");
__device__ __forceinline__ int vt_pos(int key) { const int o = key & 15; return (key & ~15) + 8 * ((o >> 2) & 1) + (o & 3) + 4 * (o >> 3); }
__device__ __forceinline__ void attn_prompt_item(Frame& F, int item) {
    const int b = item / (SEQ / WIN), blk = item % (SEQ / WIN);
    int tid_ = F.tid(); asm volatile("" : "+v"(tid_));
    const int tid = tid_, lane = tid & 63, w = F.wave;
    LAS unsigned char* Ks = F.lds + AT_KS; LAS unsigned char* Vt = F.lds + AT_VT;
    {
        const int key = tid & 255, kvh = tid >> 8, tb = blk * WIN - WIN + key;
        LAS unsigned char* krow = Ks + kvh * KS_KVH + key * KS_STRIDE;
        LAS bf16* vcol = (LAS bf16*)(Vt + kvh * VT_KVH) + vt_pos(key);
        if (tb >= 0) {
            const bf16* prow = F.PROJ() + (size_t)(b * SEQ + tb) * INW;
            v4u kr[8], vr[8];
#pragma unroll
            for (int i = 0; i < 8; ++i) kr[i] = *(const v4u*)(prow + C_K + kvh * 64 + 8 * i);
            float kf[64]; float ss = 0.f;
#pragma unroll
            for (int i = 0; i < 8; ++i) { kf[8 * i + 0] = bflo(kr[i].x); kf[8 * i + 1] = bfhi(kr[i].x); kf[8 * i + 2] = bflo(kr[i].y); kf[8 * i + 3] = bfhi(kr[i].y);
                kf[8 * i + 4] = bflo(kr[i].z); kf[8 * i + 5] = bfhi(kr[i].z); kf[8 * i + 6] = bflo(kr[i].w); kf[8 * i + 7] = bfhi(kr[i].w); }
#pragma unroll
            for (int d = 0; d < 64; ++d) ss += kf[d] * kf[d];
            const float rs = __builtin_amdgcn_rsqf(ss * (1.0f / 64.0f) + EPS);
            const float* cs = F.ROPEC() + (size_t)tb * 32; const float* sn = F.ROPES() + (size_t)tb * 32; const float* kn = F.inp(I_KN);
#pragma unroll
            for (int i = 0; i < 32; ++i) { const float x1 = kf[i] * rs * kn[i], x2 = kf[i + 32] * rs * kn[i + 32], cc = cs[i], sv = sn[i]; kf[i] = x1 * cc - x2 * sv; kf[i + 32] = x2 * cc + x1 * sv; }
#pragma unroll
            for (int i = 0; i < 8; ++i) { v4u o; o.x = cvtpk(kf[8 * i], kf[8 * i + 1]); o.y = cvtpk(kf[8 * i + 2], kf[8 * i + 3]); o.z = cvtpk(kf[8 * i + 4], kf[8 * i + 5]); o.w = cvtpk(kf[8 * i + 6], kf[8 * i + 7]);
                *(LAS v4u*)(krow + 16 * i) = o; }
            const bool lastw = (blk == SEQ / WIN - 1 && key >= WIN);
            if (lastw) { float* ok = F.out + O_PK + ((size_t)(b * WIN + key - WIN) * NKV + kvh) * HD;
#pragma unroll
                for (int i = 0; i < 16; ++i) *(f32x4*)(ok + 4 * i) = (f32x4){kf[4 * i], kf[4 * i + 1], kf[4 * i + 2], kf[4 * i + 3]}; }
            asm volatile("" ::: "memory");
#pragma unroll
            for (int i = 0; i < 8; ++i) vr[i] = *(const v4u*)(prow + C_V + kvh * 64 + 8 * i);
#pragma unroll
            for (int i = 0; i < 8; ++i) { const unsigned q4[4] = {vr[i].x, vr[i].y, vr[i].z, vr[i].w};
#pragma unroll
                for (int e = 0; e < 4; ++e) { vcol[(8 * i + 2 * e) * (VT_STRIDE / 2)] = (bf16)(q4[e] & 0xffffu); vcol[(8 * i + 2 * e + 1) * (VT_STRIDE / 2)] = (bf16)(q4[e] >> 16); } }
            if (lastw) { float* ov = F.out + O_PV + ((size_t)(b * WIN + key - WIN) * NKV + kvh) * HD;
#pragma unroll
                for (int i = 0; i < 8; ++i) { *(f32x4*)(ov + 8 * i) = (f32x4){bflo(vr[i].x), bfhi(vr[i].x), bflo(vr[i].y), bfhi(vr[i].y)}; *(f32x4*)(ov + 8 * i + 4) = (f32x4){bflo(vr[i].z), bfhi(vr[i].z), bflo(vr[i].w), bfhi(vr[i].w)}; }
            }
        } else {
#pragma unroll
            for (int i = 0; i < 8; ++i) *(LAS v4u*)(krow + 16 * i) = (v4u){0u, 0u, 0u, 0u};
#pragma unroll
            for (int d = 0; d < 64; ++d) vcol[d * (VT_STRIDE / 2)] = (bf16)0;
        }
    }
    __syncthreads();
    const int hh = lane >> 5, ql = lane & 31, kvh = w >> 2;
    const float sinkl2 = F.inp(I_SINK)[w] * LOG2E;
    const float QS = 0.125f * LOG2E;
    const float* qn = F.inp(I_QN);
    for (int s = 0; s < 4; ++s) {
        const int qi = 32 * s + ql, t = blk * WIN + qi; const size_t row = (size_t)b * SEQ + t;
        bf16x8 qf[4];
        {
            const bf16* qp = F.PROJ() + row * INW + C_Q + w * 64 + 8 * hh;
            float qv[4][8]; float ss = 0.f;
#pragma unroll
            for (int ds = 0; ds < 4; ++ds) { const v4u r4 = *(const v4u*)(qp + 16 * ds);
                qv[ds][0] = bflo(r4.x); qv[ds][1] = bfhi(r4.x); qv[ds][2] = bflo(r4.y); qv[ds][3] = bfhi(r4.y); qv[ds][4] = bflo(r4.z); qv[ds][5] = bfhi(r4.z); qv[ds][6] = bflo(r4.w); qv[ds][7] = bfhi(r4.w); }
#pragma unroll
            for (int ds = 0; ds < 4; ++ds)
#pragma unroll
                for (int j = 0; j < 8; ++j) ss += qv[ds][j] * qv[ds][j];
            ss += __shfl_xor(ss, 32);
            const float rs = __builtin_amdgcn_rsqf(ss * (1.0f / 64.0f) + EPS);
            const float* cs = F.ROPEC() + (size_t)t * 32; const float* sn = F.ROPES() + (size_t)t * 32;
#pragma unroll
            for (int ds = 0; ds < 2; ++ds)
#pragma unroll
                for (int j = 0; j < 8; ++j) { const int i = 16 * ds + 8 * hh + j; const float x1 = qv[ds][j] * rs * qn[i], x2 = qv[ds + 2][j] * rs * qn[i + 32], cc = cs[i], sv = sn[i];
                    qv[ds][j] = (x1 * cc - x2 * sv) * QS; qv[ds + 2][j] = (x2 * cc + x1 * sv) * QS; }
#pragma unroll
            for (int ds = 0; ds < 4; ++ds) { v4u o; o.x = cvtpk(qv[ds][0], qv[ds][1]); o.y = cvtpk(qv[ds][2], qv[ds][3]); o.z = cvtpk(qv[ds][4], qv[ds][5]); o.w = cvtpk(qv[ds][6], qv[ds][7]); qf[ds] = __builtin_bit_cast(bf16x8, o); }
        }
        f32x16 p[5];
#pragma unroll
        for (int kt = 0; kt < 5; ++kt) {
            const LAS unsigned char* kp = Ks + kvh * KS_KVH + (32 * (s + kt) + ql) * KS_STRIDE + 16 * hh;
            f32x16 acc = {0.f, 0.f, 0.f, 0.f, 0.f, 0.f, 0.f, 0.f, 0.f, 0.f, 0.f, 0.f, 0.f, 0.f, 0.f, 0.f};
#pragma unroll
            for (int ds = 0; ds < 4; ++ds) { const bf16x8 kfr = *(const LAS bf16x8*)(kp + 32 * ds); acc = __builtin_amdgcn_mfma_f32_32x32x16_bf16(kfr, qf[ds], acc, 0, 0, 0); }
            p[kt] = acc;
        }
        float mx = -INFINITY;
#pragma unroll
        for (int kt = 0; kt < 5; ++kt)
#pragma unroll
            for (int r = 0; r < 16; ++r) { const int kj = 32 * (s + kt) + (r & 3) + 8 * (r >> 2) + 4 * hh;
                const bool valid = (kj > qi) && (kj <= qi + WIN) && (blk > 0 || kj >= WIN);
                const float v = valid ? p[kt][r] : -INFINITY; p[kt][r] = v; mx = fmaxf(mx, v); }
        mx = fmaxf(mx, __shfl_xor(mx, 32)); mx = fmaxf(mx, sinkl2);
        float sum = 0.f;
#pragma unroll
        for (int kt = 0; kt < 5; ++kt)
#pragma unroll
            for (int r = 0; r < 16; ++r) { const float e = __builtin_amdgcn_exp2f(p[kt][r] - mx); p[kt][r] = e; sum += e; }
        sum += __shfl_xor(sum, 32);
        const float inv = __builtin_amdgcn_rcpf(sum + __builtin_amdgcn_exp2f(sinkl2 - mx));
        f32x16 o0 = {0.f, 0.f, 0.f, 0.f, 0.f, 0.f, 0.f, 0.f, 0.f, 0.f, 0.f, 0.f, 0.f, 0.f, 0.f, 0.f}, o1 = o0;
#pragma unroll
        for (int kt = 0; kt < 5; ++kt)
#pragma unroll
            for (int ss2 = 0; ss2 < 2; ++ss2) {
                v4u pw; pw.x = cvtpk(p[kt][8 * ss2 + 0], p[kt][8 * ss2 + 1]); pw.y = cvtpk(p[kt][8 * ss2 + 2], p[kt][8 * ss2 + 3]); pw.z = cvtpk(p[kt][8 * ss2 + 4], p[kt][8 * ss2 + 5]); pw.w = cvtpk(p[kt][8 * ss2 + 6], p[kt][8 * ss2 + 7]);
                const bf16x8 pf = __builtin_bit_cast(bf16x8, pw);
                const LAS unsigned char* vp = Vt + kvh * VT_KVH + ql * VT_STRIDE + (16 * (2 * (s + kt) + ss2) + 8 * hh) * 2;
                const bf16x8 v0 = *(const LAS bf16x8*)(vp), v1 = *(const LAS bf16x8*)(vp + 32 * VT_STRIDE);
                o0 = __builtin_amdgcn_mfma_f32_32x32x16_bf16(v0, pf, o0, 0, 0, 0);
                o1 = __builtin_amdgcn_mfma_f32_32x32x16_bf16(v1, pf, o1, 0, 0, 0);
            }
        float hsq = 0.f;
#pragma unroll
        for (int r = 0; r < 16; ++r) { o0[r] *= inv; o1[r] *= inv; hsq += o0[r] * o0[r] + o1[r] * o1[r]; }
        hsq += __shfl_xor(hsq, 32);
        if (hh == 0) F.SSQA()[row * 8 + w] = hsq;
        bf16* crow = F.CAT() + row * DM + 512 + w * 64;
#pragma unroll
        for (int g = 0; g < 4; ++g) { const int d0 = 8 * g + 4 * hh;
            v2u a, c2; a.x = cvtpk(o0[4 * g], o0[4 * g + 1]); a.y = cvtpk(o0[4 * g + 2], o0[4 * g + 3]);
            c2.x = cvtpk(o1[4 * g], o1[4 * g + 1]); c2.y = cvtpk(o1[4 * g + 2], o1[4 * g + 3]);
            *(v2u*)(crow + d0) = a; *(v2u*)(crow + 32 + d0) = c2; }
    }
    __syncthreads();
}

constexpr int SK_ROW = 136, SK_KVH = 68;
constexpr int SM_KC = 0, SM_VC = 132 * SK_ROW * 4, SM_QS = SM_VC + 132 * 128 * 4, SM_HS = SM_QS + 8 * 64 * 4, SM_END = SM_HS + 64 * 4;
static_assert(SM_END <= SCR_BYTES, "sample LDS");
__device__ __forceinline__ void sample_lru_item(Frame& F, int b) {
    int tid_ = F.tid(); asm volatile("" : "+v"(tid_));
    const int tid = tid_, lane = tid & 63, w = F.wave;
    const size_t row0 = (size_t)MP + (size_t)b * DEC_T;
    {
        const int c = tid, blk = w, cj = c & 63;
        LAS float* xcs = (LAS float*)F.lds;
        LAS float* red = xcs + 4 * 512;
        const float cw0 = F.inp(I_CW)[c], cw1 = F.inp(I_CW)[512 + c], cw2 = F.inp(I_CW)[1024 + c], cw3 = F.inp(I_CW)[1536 + c], cb = F.inp(I_CB)[c];
        const float lam = F.inp(I_LAM)[c];
        const float c8 = -8.0f * (fmaxf(-lam, 0.f) + log1pf(expf(-fabsf(lam))));
        float xs[7];
#pragma unroll
        for (int j = 0; j < 3; ++j) xs[j] = F.inp(I_SC)[((size_t)b * 3 + j) * 512 + c];
#pragma unroll
        for (int t = 0; t < 4; ++t) xs[3 + t] = bf1(F.PROJ()[(row0 + t) * INW + c]);
#pragma unroll
        for (int t = 0; t < 4; ++t) xcs[t * 512 + c] = cb + cw0 * xs[t] + cw1 * xs[t + 1] + cw2 * xs[t + 2] + cw3 * xs[t + 3];
        __syncthreads();
        float rp[4], ip[4];
#pragma unroll
        for (int t = 0; t < 4; ++t) { rp[t] = F.inp(I_BA)[c]; ip[t] = F.inp(I_BX)[c]; }
        const float* wap = F.inp(I_WA) + (size_t)(blk * 64) * 64 + cj; const float* wxp = F.inp(I_WX) + (size_t)(blk * 64) * 64 + cj;
#pragma unroll 16
        for (int k = 0; k < 64; ++k) { const float wa = wap[k * 64], wx = wxp[k * 64];
#pragma unroll
            for (int t = 0; t < 4; ++t) { const float xv = xcs[t * 512 + blk * 64 + k]; rp[t] += xv * wa; ip[t] += xv * wx; } }
        float h = F.inp(I_SH)[(size_t)b * 512 + c]; float ov[4];
#pragma unroll
        for (int t = 0; t < 4; ++t) {
            const float r = sigmoid_f(rp[t]), ig = sigmoid_f(ip[t]);
            const float la = c8 * r, a = __builtin_amdgcn_exp2f(la * LOG2E);
            const float mult = __builtin_amdgcn_sqrtf(one_minus_exp(2.0f * la));
            h = a * h + mult * ig * xcs[t * 512 + c];
            const float g = bf1(F.PROJ()[(row0 + t) * INW + C_GATE + c]);
            ov[t] = h * gelu_tanh(g);
            const float s = wave_sum(ov[t] * ov[t]); if (lane == 0) red[t * 8 + w] = s;
        }
        F.out[O_SH + (size_t)b * 512 + c] = h;
#pragma unroll
        for (int j = 0; j < 3; ++j) F.out[O_SC + ((size_t)b * 3 + j) * 512 + c] = xs[4 + j];
        __syncthreads();
#pragma unroll
        for (int t = 0; t < 4; ++t) { float s = 0.f;
#pragma unroll
            for (int w2 = 0; w2 < 8; ++w2) s += red[t * 8 + w2];
            F.CAT()[(row0 + t) * DM + c] = (bf16)f2bf(ov[t] * __builtin_amdgcn_rsqf(s * (1.0f / 512.0f) + EPS)); }
        __syncthreads();
    }
}
__device__ __forceinline__ void sample_attn_item(Frame& F, int b) {
    int tid_ = F.tid(); asm volatile("" : "+v"(tid_));
    const int tid = tid_, lane = tid & 63, w = F.wave;
    const size_t row0 = (size_t)MP + (size_t)b * DEC_T;
    LAS float* Kc = (LAS float*)(F.lds + SM_KC); LAS float* Vc = (LAS float*)(F.lds + SM_VC); LAS float* qs = (LAS float*)(F.lds + SM_QS); LAS float* hs = (LAS float*)(F.lds + SM_HS);
    {
        const float* ck = F.inp(I_CK) + (size_t)b * WIN * 128; const float* cv = F.inp(I_CV) + (size_t)b * WIN * 128;
        float* ok = F.out + O_SK + (size_t)b * WIN * 128; float* ov = F.out + O_SV + (size_t)b * WIN * 128;
#pragma unroll
        for (int i = 0; i < 8; ++i) { const int idx = tid * 4 + 2048 * i, j = idx >> 7, rem = idx & 127;
            const f32x4 kv = *(const f32x4*)(ck + idx), vv = *(const f32x4*)(cv + idx);
            *(LAS f32x4*)(Kc + j * SK_ROW + (rem >> 6) * SK_KVH + (rem & 63)) = kv; *(LAS f32x4*)(Vc + j * 128 + rem) = vv;
            if (j >= DEC_T) { *(f32x4*)(ok + idx - DEC_T * 128) = kv; *(f32x4*)(ov + idx - DEC_T * 128) = vv; } }
        if (w < DEC_T) {
            const int t = w, kvh = lane >> 5, i = lane & 31;
            const bf16* pr = F.PROJ() + (row0 + t) * INW;
            const float k1 = bf1(pr[C_K + kvh * 64 + i]), k2 = bf1(pr[C_K + kvh * 64 + 32 + i]);
            float ss = k1 * k1 + k2 * k2;
#pragma unroll
            for (int o = 1; o < 32; o <<= 1) ss += __shfl_xor(ss, o);
            const float rs = __builtin_amdgcn_rsqf(ss * (1.0f / 64.0f) + EPS);
            const float x1 = k1 * rs * F.inp(I_KN)[i], x2 = k2 * rs * F.inp(I_KN)[i + 32];
            const float cc = F.ROPEC()[(size_t)(SEQ + t) * 32 + i], sv = F.ROPES()[(size_t)(SEQ + t) * 32 + i];
            const float o1 = x1 * cc - x2 * sv, o2 = x2 * cc + x1 * sv;
            Kc[(WIN + t) * SK_ROW + kvh * SK_KVH + i] = o1; Kc[(WIN + t) * SK_ROW + kvh * SK_KVH + 32 + i] = o2;
            const float v1 = bf1(pr[C_V + kvh * 64 + i]), v2 = bf1(pr[C_V + kvh * 64 + 32 + i]);
            Vc[(WIN + t) * 128 + kvh * 64 + i] = v1; Vc[(WIN + t) * 128 + kvh * 64 + 32 + i] = v2;
            const size_t oo = ((size_t)(WIN - DEC_T + t) * NKV + kvh) * HD;
            ok[oo + i] = o1; ok[oo + 32 + i] = o2; ov[oo + i] = v1; ov[oo + 32 + i] = v2;
        }
    }
    __syncthreads();
    const int head = w, kvh = w >> 2;
    const float sinkl2 = F.inp(I_SINK)[head] * LOG2E;
    float osave[4];
#pragma unroll
    for (int t = 0; t < DEC_T; ++t) {
        {
            const float x = bf1(F.PROJ()[(row0 + t) * INW + C_Q + head * 64 + lane]);
            const float ss = wave_sum(x * x);
            const float xn = x * __builtin_amdgcn_rsqf(ss * (1.0f / 64.0f) + EPS) * F.inp(I_QN)[lane];
            const float other = __shfl_xor(xn, 32);
            const int i = lane & 31; const float cc = F.ROPEC()[(size_t)(SEQ + t) * 32 + i], sv = F.ROPES()[(size_t)(SEQ + t) * 32 + i];
            const float qo = (lane < 32) ? (xn * cc - other * sv) : (xn * cc + other * sv);
            qs[w * 64 + lane] = qo * (0.125f * LOG2E);
        }
        LDS_WAIT(); asm volatile("" ::: "memory");
        const int j0 = t + 1 + lane, j1 = j0 + 64;
        float s0 = 0.f, s1 = 0.f;
        const LAS f32x4* q4 = (const LAS f32x4*)(qs + w * 64);
        const LAS f32x4* k0 = (const LAS f32x4*)(Kc + j0 * SK_ROW + kvh * SK_KVH); const LAS f32x4* k1 = (const LAS f32x4*)(Kc + j1 * SK_ROW + kvh * SK_KVH);
#pragma unroll
        for (int d4 = 0; d4 < 16; ++d4) { const f32x4 q = q4[d4], a = k0[d4], c = k1[d4];
            s0 += q[0] * a[0] + q[1] * a[1] + q[2] * a[2] + q[3] * a[3]; s1 += q[0] * c[0] + q[1] * c[1] + q[2] * c[2] + q[3] * c[3]; }
        float mx = wave_max(fmaxf(s0, s1)); mx = fmaxf(mx, sinkl2);
        const float p0 = __builtin_amdgcn_exp2f(s0 - mx), p1 = __builtin_amdgcn_exp2f(s1 - mx);
        const float l = wave_sum(p0 + p1) + __builtin_amdgcn_exp2f(sinkl2 - mx);
        float o = 0.f;
        for (int jj = 0; jj < 64; ++jj) {
            const float pa = __shfl(p0, jj), pb = __shfl(p1, jj);
            o += pa * Vc[(t + 1 + jj) * 128 + kvh * 64 + lane] + pb * Vc[(t + 65 + jj) * 128 + kvh * 64 + lane];
        }
        o *= __builtin_amdgcn_rcpf(l);
        osave[t] = o;
        const float hq = wave_sum(o * o); if (lane == 0) hs[t * 8 + w] = hq;
    }
    __syncthreads();
#pragma unroll
    for (int t = 0; t < DEC_T; ++t) { float s = 0.f;
#pragma unroll
        for (int w2 = 0; w2 < 8; ++w2) s += hs[t * 8 + w2];
        F.CAT()[(row0 + t) * DM + 512 + head * 64 + lane] = (bf16)f2bf(osave[t] * __builtin_amdgcn_rsqf(s * (1.0f / 512.0f) + EPS)); }
    __syncthreads();
}

struct SEpiSwiglu {
    bf16* H; const float* ssq;
    __device__ __forceinline__ int brow0(int cb) const { const int hc0 = 32 * cb; return (hc0 >> 7) * 256 + (hc0 & 127); }
    __device__ __forceinline__ int brow1(int cb) const { return brow0(cb) + 128; }
    __device__ __forceinline__ void operator()(const f32x16& a0, const f32x16& a1, int r, int cb, int h) const {
        const float rs = pg8::row_rs(ssq, r);
#pragma unroll
        for (int g = 0; g < 4; ++g) { float hv[4];
#pragma unroll
            for (int e = 0; e < 4; ++e) hv[e] = pg8::silu_f(a0[4 * g + e] * rs) * (a1[4 * g + e] * rs);
            v2u w; w.x = cvtpk(hv[0], hv[1]); w.y = cvtpk(hv[2], hv[3]); *(v2u*)(H + (size_t)r * DFF + 32 * cb + 8 * g + 4 * h) = w; }
    }
};
struct SEpiScale {
    bf16* O; int ldc; const float* ssq;
    __device__ __forceinline__ int brow0(int cb) const { return 64 * cb; }
    __device__ __forceinline__ int brow1(int cb) const { return 64 * cb + 32; }
    __device__ __forceinline__ void operator()(const f32x16& a0, const f32x16& a1, int r, int cb, int h) const {
        const float rs = pg8::row_rs(ssq, r);
#pragma unroll
        for (int g = 0; g < 4; ++g) {
            v2u w; w.x = cvtpk(a0[4 * g] * rs, a0[4 * g + 1] * rs); w.y = cvtpk(a0[4 * g + 2] * rs, a0[4 * g + 3] * rs); *(v2u*)(O + (size_t)r * ldc + 64 * cb + 8 * g + 4 * h) = w;
            v2u x; x.x = cvtpk(a1[4 * g] * rs, a1[4 * g + 1] * rs); x.y = cvtpk(a1[4 * g + 2] * rs, a1[4 * g + 3] * rs); *(v2u*)(O + (size_t)r * ldc + 64 * cb + 32 + 8 * g + 4 * h) = x; }
    }
};
template <int MODE> struct SEpiResid {
    const float* basef; float* out; bf16* xb; float* ssq; float scale;
    __device__ __forceinline__ int brow0(int cb) const { return 64 * cb; }
    __device__ __forceinline__ int brow1(int cb) const { return 64 * cb + 32; }
    __device__ __forceinline__ void operator()(const f32x16& a0, const f32x16& a1, int r, int cb, int h) const {
        float s = 0.f;
#pragma unroll
        for (int a = 0; a < 2; ++a)
#pragma unroll
            for (int g = 0; g < 4; ++g) { const size_t off = (size_t)r * DM + 64 * cb + 32 * a + 8 * g + 4 * h;
                f32x4 b; if (MODE == 0) b = *(const f32x4*)(basef + off); else b = pg8::bf4_to_f32(*(const v2u*)(xb + off));
                const f32x4 v = a == 0 ? (f32x4){a0[4 * g], a0[4 * g + 1], a0[4 * g + 2], a0[4 * g + 3]} : (f32x4){a1[4 * g], a1[4 * g + 1], a1[4 * g + 2], a1[4 * g + 3]};
                const f32x4 o = b + v * scale;
                if (MODE == 2) *(f32x4*)(out + off) = o;
                else { s += (o[0] * o[0] + o[1] * o[1]) + (o[2] * o[2] + o[3] * o[3]); v2u w; w.x = cvtpk(o[0], o[1]); w.y = cvtpk(o[2], o[3]); *(v2u*)(xb + off) = w; } }
        if (MODE != 2) { s += __shfl_xor(s, 32); if (h == 0) ssq[(size_t)r * 16 + cb] = s; }
    }
};
constexpr int SG_ROWB = 144, SG_TILE = 32 * SG_ROWB, SG_WAVE = 3 * SG_TILE;
static_assert(8 * SG_WAVE <= SCR_BYTES, "small gemm LDS");
template <int K, int KS, class Epi> __device__ __forceinline__ void small_gemm(Frame& F, const bf16* A, int lda, const bf16* Bt, int ncb, const Epi& E) {
    int lane_ = F.lane(); asm volatile("" : "+v"(lane_));
    const int lane = lane_, w = F.wave, ql = lane & 31, h = lane >> 5, lr = lane >> 3, ch = lane & 7;
    const int nitems = 16 * ncb * KS;
    constexpr int NBT = K / 64, NB_LO = NBT / KS, NB_REM = NBT % KS;
    LAS unsigned char* tl = F.lds + w * SG_WAVE;
    LAS float* red = (LAS float*)F.lds;
    for (int base = blockIdx.x * NWAVES; base < nitems; base += F.G * NWAVES) {
        const int it = base + w; const bool valid = it < nitems;
        const int tile = it / KS, ks = it % KS, rb = tile & 15, cb = tile >> 4;
        f32x16 acc0 = {0.f, 0.f, 0.f, 0.f, 0.f, 0.f, 0.f, 0.f, 0.f, 0.f, 0.f, 0.f, 0.f, 0.f, 0.f, 0.f}, acc1 = acc0;
        const int r = MP + 32 * rb + ql;
        if (valid) {
            const int nb = NB_LO + (ks < NB_REM ? 1 : 0), kb0 = 64 * (ks * NB_LO + (ks < NB_REM ? ks : NB_REM));
            const bf16* ga = A + (size_t)(MP + 32 * rb + lr) * lda + kb0 + 8 * ch;
            const bf16* g0 = Bt + (size_t)(E.brow0(cb) + lr) * K + kb0 + 8 * ch;
            const bf16* g1 = Bt + (size_t)(E.brow1(cb) + lr) * K + kb0 + 8 * ch;
            v4u ra[4], r0[4], r1[4];
#pragma unroll
            for (int i = 0; i < 4; ++i) { ra[i] = *(const v4u*)(ga + (size_t)(8 * i) * lda); r0[i] = *(const v4u*)(g0 + (size_t)(8 * i) * K); r1[i] = *(const v4u*)(g1 + (size_t)(8 * i) * K); }
            for (int b = 0; b < nb; ++b) {
#pragma unroll
                for (int i = 0; i < 4; ++i) { const int off = (lr + 8 * i) * SG_ROWB + 16 * ch;
                    *(LAS v4u*)(tl + off) = ra[i]; *(LAS v4u*)(tl + SG_TILE + off) = r0[i]; *(LAS v4u*)(tl + 2 * SG_TILE + off) = r1[i]; }
                if (b + 1 < nb) {
#pragma unroll
                    for (int i = 0; i < 4; ++i) { ra[i] = *(const v4u*)(ga + (size_t)(8 * i) * lda + 64 * (b + 1)); r0[i] = *(const v4u*)(g0 + (size_t)(8 * i) * K + 64 * (b + 1)); r1[i] = *(const v4u*)(g1 + (size_t)(8 * i) * K + 64 * (b + 1)); }
                }
#pragma unroll
                for (int sI = 0; sI < 4; ++sI) { const int fo = ql * SG_ROWB + 32 * sI + 16 * h;
                    const bf16x8 af = *(const LAS bf16x8*)(tl + fo), bf0 = *(const LAS bf16x8*)(tl + SG_TILE + fo), bf1v = *(const LAS bf16x8*)(tl + 2 * SG_TILE + fo);
                    acc0 = __builtin_amdgcn_mfma_f32_32x32x16_bf16(bf0, af, acc0, 0, 0, 0);
                    acc1 = __builtin_amdgcn_mfma_f32_32x32x16_bf16(bf1v, af, acc1, 0, 0, 0); }
            }
        }
        if (KS > 1) {
            __syncthreads();
#pragma unroll
            for (int q = 0; q < 16; ++q) { red[((w * 2 + 0) * 16 + q) * 64 + lane] = acc0[q]; red[((w * 2 + 1) * 16 + q) * 64 + lane] = acc1[q]; }
            __syncthreads();
            if (valid && ks == 0) {
#pragma unroll
                for (int j = 1; j < KS; ++j)
#pragma unroll
                    for (int q = 0; q < 16; ++q) { acc0[q] += red[(((w + j) * 2 + 0) * 16 + q) * 64 + lane]; acc1[q] += red[(((w + j) * 2 + 1) * 16 + q) * 64 + lane]; }
            }
        }
        if (valid && ks == 0) E(acc0, acc1, r, cb, h);
        if (KS > 1) __syncthreads();
    }
}

#ifndef MK_N_LAUNCHES
#define MK_N_LAUNCHES 1
#endif
constexpr int N_PHASES = 9;
constexpr int N_LAUNCHES = MK_N_LAUNCHES;
struct Args { const float* in[29]; float* out; unsigned char* ws; int ph_lo, ph_hi, li, pad; };
__global__ void __launch_bounds__(NWAVES * 64, 2) hymba_fwd(Args args) {
    extern __shared__ __attribute__((aligned(16))) unsigned char lds[];
    Frame F;
    F.lds = (LAS unsigned char*)lds;
    F.MISC = (volatile LAS unsigned*)(F.lds + MISC_OFF);
    F.wave = __builtin_amdgcn_readfirstlane((int)threadIdx.x >> 6);
    F.G = gridDim.x; { const int bx = blockIdx.x; F.vcu = (F.G % 8 == 0) ? (bx % 8) * (F.G / 8) + bx / 8 : bx; }
    F.kp = (kernarg_ptr)__builtin_amdgcn_kernarg_segment_ptr(); F.out = args.out; F.ws = args.ws;
    for (int u = F.tid(); u < (LDS_BYTES - LDSCTL_OFF) / 4; u += NWAVES * 64) ((LAS unsigned*)(F.lds + LDSCTL_OFF))[u] = 0u;
    __syncthreads();
    XcdBarrier bar; bar.bar = (unsigned*)(F.ctl() + CW_BAR); bar.x = 0; bar.st = nullptr;
    if (N_LAUNCHES == 1) bar = xcd_barrier_post((unsigned*)(F.ctl() + CW_BAR), F.MISC + 8, F.tid() == 0);
#define GRID_BAR() do { if (N_LAUNCHES == 1) xcd_barrier(bar, F.tid() == 0); } while (0)
    const int lo = args.ph_lo, hi = args.ph_hi;
#define IN(k) (lo <= (k) && (k) < hi)
#ifndef PROBE_PHASE
#define PROBE_PHASE -1
#endif
    unsigned long long tsA = 0, tsB = 0; pg8::Tm tm{0, 0};
#define STAMP(k) do { if (PROBE_PHASE >= 0 && PROBE_WHICH == 0) { if ((k) == PROBE_PHASE) tsA = __builtin_amdgcn_s_memrealtime(); if ((k) == PROBE_PHASE + 1) tsB = __builtin_amdgcn_s_memrealtime(); } } while (0)
#define BOTH(k) (IN(k) && IN((k) + 1))
#ifndef PROBE_REP
#define PROBE_REP 0
#endif
#define REP(k) for (int rep_ = 0; rep_ < (((PROBE_REP >> (k)) & 1) ? 2 : 1); ++rep_)

#ifndef SKIP_P0
#undef CURPH
#define CURPH 0
    STAMP(0);
    if (IN(0)) REP(0) { p0_prologue(F); if (BOTH(0)) GRID_BAR(); }
#endif
#undef CURPH
#define CURPH 1
    STAMP(1);
    if (IN(1)) REP(1) {
        pg8::Gemm g{F.XB(), F.WGU1(), MP, 2 * DFF, DM}; pg8::StaticOrder S; S.init(MP, 2 * DFF, F.G, (int)blockIdx.x);
        pg8::EpiSwiglu E{F.HB(), DFF}; pg8::rs_cache_fill(F.lds + RING_OFF, S, F.SSQ(), F.wave);
        pg8::gemm_phase<pg8::EpiSwiglu, pg8::StaticOrder, true, true>(F.lds + RING_OFF, g, S, E, F.wave, tm);
        if (PROBE_WHICH != 0 && PROBE_PHASE == 1) { tsA = 0; tsB = (PROBE_WHICH == 1) ? tm.k : tm.e; } tm.k = 0; tm.e = 0;
        { const unsigned long long ts0_ = (PROBE_WHICH == 3) ? __builtin_amdgcn_s_memrealtime() : 0ull;
        { SEpiSwiglu SE{F.HB(), F.SSQ()}; small_gemm<DM, 1, SEpiSwiglu>(F, F.XB(), DM, F.WGU1(), DFF / 32, SE); }
          if (PROBE_WHICH == 3 && PROBE_PHASE == CURPH) { asm volatile("s_waitcnt vmcnt(0)" ::: "memory"); tsA = ts0_; tsB = __builtin_amdgcn_s_memrealtime(); } }
        if (BOTH(1)) GRID_BAR();
    }
#undef CURPH
#define CURPH 2
    STAMP(2);
    if (IN(2)) REP(2) {
        pg8::Gemm g{F.HB(), F.WD1(), MP, DM, DFF}; pg8::StaticOrder S; S.init(MP, DM, F.G, (int)blockIdx.x);
        pg8::EpiResid<1> E{nullptr, nullptr, F.XB(), F.SSQ(), 0.5f};
        pg8::gemm_phase<pg8::EpiResid<1>, pg8::StaticOrder, true, true>(F.lds + RING_OFF, g, S, E, F.wave, tm);
        if (PROBE_WHICH != 0 && PROBE_PHASE == 2) { tsA = 0; tsB = (PROBE_WHICH == 1) ? tm.k : tm.e; } tm.k = 0; tm.e = 0;
        { const unsigned long long ts0_ = (PROBE_WHICH == 3) ? __builtin_amdgcn_s_memrealtime() : 0ull;
        { SEpiResid<1> SE{nullptr, nullptr, F.XB(), F.SSQ(), 0.5f}; small_gemm<DFF, 8, SEpiResid<1>>(F, F.HB(), DFF, F.WD1(), DM / 64, SE); }
          if (PROBE_WHICH == 3 && PROBE_PHASE == CURPH) { asm volatile("s_waitcnt vmcnt(0)" ::: "memory"); tsA = ts0_; tsB = __builtin_amdgcn_s_memrealtime(); } }
        if (BOTH(2)) GRID_BAR();
    }
#undef CURPH
#define CURPH 3
    STAMP(3);
    if (IN(3)) REP(3) {
        pg8::Gemm g{F.XB(), F.WINT(), MP, INW, DM}; pg8::StaticOrder S; S.init(MP, INW, F.G, (int)blockIdx.x);
        pg8::EpiScaleBf16 E{F.PROJ(), INW}; pg8::rs_cache_fill(F.lds + RING_OFF, S, F.SSQ(), F.wave);
        pg8::gemm_phase<pg8::EpiScaleBf16, pg8::StaticOrder, true, true>(F.lds + RING_OFF, g, S, E, F.wave, tm);
        if (PROBE_WHICH != 0 && PROBE_PHASE == 3) { tsA = 0; tsB = (PROBE_WHICH == 1) ? tm.k : tm.e; } tm.k = 0; tm.e = 0;
        { const unsigned long long ts0_ = (PROBE_WHICH == 3) ? __builtin_amdgcn_s_memrealtime() : 0ull;
        { SEpiScale SE{F.PROJ(), INW, F.SSQ()}; small_gemm<DM, 4, SEpiScale>(F, F.XB(), DM, F.WINT(), INW / 64, SE); }
          if (PROBE_WHICH == 3 && PROBE_PHASE == CURPH) { asm volatile("s_waitcnt vmcnt(0)" ::: "memory"); tsA = ts0_; tsB = __builtin_amdgcn_s_memrealtime(); } }
        if (BOTH(3)) GRID_BAR();
    }
#undef CURPH
#define CURPH 4
    STAMP(4);
    if (IN(4)) REP(4) {
#ifndef SKIP_ATTN
        REP(8) for (int it = blockIdx.x; it < BATCH * (SEQ / WIN); it += F.G) attn_prompt_item(F, it);
#endif
#ifndef SKIP_LRU1
        REP(9) for (int it = blockIdx.x; it < BATCH * NCHUNK; it += F.G) lru_prompt_item<1>(F, it);
#endif
#ifndef SKIP_SAMPLE
        __syncthreads();
        REP(10) for (int it = blockIdx.x; it < 2 * DEC_B; it += F.G) { if (it < DEC_B) sample_lru_item(F, it); else sample_attn_item(F, it - DEC_B); }
#endif
        if (BOTH(4)) GRID_BAR();
    }
#undef CURPH
#define CURPH 5
    STAMP(5);
    if (IN(5)) REP(5) {
#ifndef SKIP_LRU2
        for (int it = blockIdx.x; it < BATCH * NCHUNK; it += F.G) lru_prompt_item<2>(F, it);
#endif
        if (BOTH(5)) GRID_BAR();
    }
#undef CURPH
#define CURPH 6
    STAMP(6);
    if (IN(6)) {
        pg8::Gemm g{F.CAT(), F.WOUT(), MP, DM, DM}; pg8::StaticOrder S; S.init(MP, DM, F.G, (int)blockIdx.x);
        pg8::EpiResidMix E{F.XB(), F.SSQ()}; pg8::mix_cache_fill(F.lds + RING_OFF, S, F.SSQL(), F.SSQA(), F.wave);
        pg8::gemm_phase<pg8::EpiResidMix, pg8::StaticOrder, true, true>(F.lds + RING_OFF, g, S, E, F.wave, tm);
        if (PROBE_WHICH != 0 && PROBE_PHASE == 6) { tsA = 0; tsB = (PROBE_WHICH == 1) ? tm.k : tm.e; } tm.k = 0; tm.e = 0;
        { const unsigned long long ts0_ = (PROBE_WHICH == 3) ? __builtin_amdgcn_s_memrealtime() : 0ull;
        { SEpiResid<1> SE{nullptr, nullptr, F.XB(), F.SSQ(), 1.0f}; small_gemm<DM, 8, SEpiResid<1>>(F, F.CAT(), DM, F.WOUT(), DM / 64, SE); }
          if (PROBE_WHICH == 3 && PROBE_PHASE == CURPH) { asm volatile("s_waitcnt vmcnt(0)" ::: "memory"); tsA = ts0_; tsB = __builtin_amdgcn_s_memrealtime(); } }
        if (BOTH(6)) GRID_BAR();
    }
#undef CURPH
#define CURPH 7
    STAMP(7);
    if (IN(7)) REP(7) {
        pg8::Gemm g{F.XB(), F.WGU2(), MP, 2 * DFF, DM}; pg8::StaticOrder S; S.init(MP, 2 * DFF, F.G, (int)blockIdx.x);
        pg8::EpiSwiglu E{F.HB(), DFF}; pg8::rs_cache_fill(F.lds + RING_OFF, S, F.SSQ(), F.wave);
        pg8::gemm_phase<pg8::EpiSwiglu, pg8::StaticOrder, true, true>(F.lds + RING_OFF, g, S, E, F.wave, tm);
        if (PROBE_WHICH != 0 && PROBE_PHASE == 7) { tsA = 0; tsB = (PROBE_WHICH == 1) ? tm.k : tm.e; } tm.k = 0; tm.e = 0;
        { const unsigned long long ts0_ = (PROBE_WHICH == 3) ? __builtin_amdgcn_s_memrealtime() : 0ull;
        { SEpiSwiglu SE{F.HB(), F.SSQ()}; small_gemm<DM, 1, SEpiSwiglu>(F, F.XB(), DM, F.WGU2(), DFF / 32, SE); }
          if (PROBE_WHICH == 3 && PROBE_PHASE == CURPH) { asm volatile("s_waitcnt vmcnt(0)" ::: "memory"); tsA = ts0_; tsB = __builtin_amdgcn_s_memrealtime(); } }
        if (BOTH(7)) GRID_BAR();
    }
#undef CURPH
#define CURPH 8
    STAMP(8);
    if (IN(8)) {
        pg8::Gemm g{F.HB(), F.WD2(), MP, DM, DFF}; pg8::StaticOrder S; S.init(MP, DM, F.G, (int)blockIdx.x);
        pg8::EpiResid<2> E{nullptr, F.out, F.XB(), nullptr, 0.5f};
        pg8::gemm_phase<pg8::EpiResid<2>, pg8::StaticOrder, true, true>(F.lds + RING_OFF, g, S, E, F.wave, tm);
        if (PROBE_WHICH != 0 && PROBE_PHASE == 8) { tsA = 0; tsB = (PROBE_WHICH == 1) ? tm.k : tm.e; } tm.k = 0; tm.e = 0;
        { const unsigned long long ts0_ = (PROBE_WHICH == 3) ? __builtin_amdgcn_s_memrealtime() : 0ull;
        { SEpiResid<2> SE{nullptr, F.out, F.XB(), nullptr, 0.5f}; small_gemm<DFF, 8, SEpiResid<2>>(F, F.HB(), DFF, F.WD2(), DM / 64, SE); }
          if (PROBE_WHICH == 3 && PROBE_PHASE == CURPH) { asm volatile("s_waitcnt vmcnt(0)" ::: "memory"); tsA = ts0_; tsB = __builtin_amdgcn_s_memrealtime(); } }
    }
    STAMP(9);
    if (PROBE_PHASE >= 0 && blockIdx.x == 0) { asm volatile("s_waitcnt vmcnt(0)" ::: "memory"); const unsigned long long te = __builtin_amdgcn_s_memrealtime(), d = 4 * (tsB - tsA); while (__builtin_amdgcn_s_memrealtime() - te < d) __builtin_amdgcn_s_sleep(8); }
#undef IN
#undef BOTH
}

extern "C" void kernel_launch(void* const* d_in, const int* in_sizes, int n_in, void* d_out, int out_size, void* d_ws, size_t ws_size, hipStream_t stream) {
    static int grid = 0;
    if (grid == 0) {
        if (n_in != 29 || in_sizes[0] != MP * DM || (size_t)out_size != O_END || ws_size < WS_END) { fprintf(stderr, "kernel_launch: unexpected shapes (n_in %d in0 %d out %d ws %zu); nothing launched\n", n_in, n_in > 0 ? in_sizes[0] : -1, out_size, ws_size); grid = -1; return; }
        int dev = 0, cus = 0, per_cu = 0;
        if (hipGetDevice(&dev) != hipSuccess || hipDeviceGetAttribute(&cus, hipDeviceAttributeMultiprocessorCount, dev) != hipSuccess) { fprintf(stderr, "kernel_launch: device query failed\n"); grid = -1; return; }
        if (hipFuncSetAttribute((const void*)hymba_fwd, hipFuncAttributeMaxDynamicSharedMemorySize, LDS_BYTES) != hipSuccess) { fprintf(stderr, "kernel_launch: hipFuncSetAttribute failed\n"); grid = -1; return; }
        if (hipOccupancyMaxActiveBlocksPerMultiprocessor(&per_cu, (const void*)hymba_fwd, NWAVES * 64, LDS_BYTES) != hipSuccess || per_cu < 1) { fprintf(stderr, "kernel_launch: occupancy query reports %d workgroups per CU\n", per_cu); per_cu = 1; }
        (void)hipGetLastError();
        grid = cus;
    }
    if (grid < 0) return;
    if (hipMemsetAsync((char*)d_ws + WS_CTL, 0, CTL_ZERO_BYTES, stream) != hipSuccess) { fprintf(stderr, "kernel_launch: memset failed\n"); return; }
    Args a{};
    for (int i = 0; i < 29; ++i) a.in[i] = (const float*)d_in[i];
    a.out = (float*)d_out; a.ws = (unsigned char*)d_ws;
    if (N_LAUNCHES == 1) {
        a.ph_lo = 0; a.ph_hi = N_PHASES; a.li = 0;
        hipLaunchKernelGGL(hymba_fwd, dim3(grid), dim3(NWAVES * 64), LDS_BYTES, stream, a);
    } else {
        for (int li = 0; li < N_PHASES; ++li) { a.ph_lo = li; a.ph_hi = li + 1; a.li = li; hipLaunchKernelGGL(hymba_fwd, dim3(grid), dim3(NWAVES * 64), LDS_BYTES, stream, a); }
    }
    const hipError_t le = hipPeekAtLastError();
    if (le != hipSuccess) fprintf(stderr, "kernel_launch: launch failed: %s\n", hipGetErrorName(le));
}
```

```cpp
#include <hip/hip_runtime.h>
#include <cstdio>
#include <cstdint>
#include <cmath>
namespace pg8 {
#define PG8_LAS __attribute__((address_space(3)))
typedef unsigned short bf16_t;
typedef short bf16x8 __attribute__((ext_vector_type(8)));
typedef float f32x4 __attribute__((ext_vector_type(4)));
typedef unsigned u32x4 __attribute__((ext_vector_type(4)));
constexpr int BM = 256, BK = 64, HALF = 128, HTB = HALF * BK * 2  , STAGE_BYTES = 8 * HTB, NXCD = 8, WGM = 8;

__host__ __device__ __forceinline__ int lds_byte(int r, int c) { const int st = (r >> 4) * 2 + (c >> 5), rr = r & 15, cc = c & 31, ob = rr * 64 + cc * 2; return st * 1024 + (ob ^ (((ob >> 9) & 1) << 5)); }
__host__ __device__ __forceinline__ void stage_rc(int b, int& R, int& C) { const int st = b / 1024, sb = b % 1024, swz = sb ^ (((sb >> 9) & 1) << 5); R = (st >> 1) * 16 + swz / 64; C = (st & 1) * 32 + (swz % 64) / 2; }
__host__ __device__ __forceinline__ int perm32(int rho) { const int n = rho >> 4, i = rho & 15; return 8 * (i >> 2) + 4 * n + (i & 3); }

struct Unit { int pm, pn; };
struct Gemm { const bf16_t* A; const bf16_t* Bt; int M, N, K; };

struct StaticOrder {
    int nM, nN, nwg, G, c;
    __host__ __device__ void init(int M, int N, int G_, int c_) { nM = M / BM; nN = N / BM; nwg = nM * nN; G = G_; c = c_; }
    __host__ __device__ bool next(int i, Unit& u) const {
        const long L = (long)i * G + c; if (L >= nwg) return false;
        int wgid = (int)L; { const int q = nwg / NXCD, r = nwg % NXCD, xcd = wgid % NXCD, off = wgid / NXCD; wgid = (xcd < r ? xcd * (q + 1) : r * (q + 1) + (xcd - r) * q) + off; }
        const int nig = WGM * nN, gid = wgid / nig, fm = gid * WGM, gsz = (nM - fm) < WGM ? (nM - fm) : WGM;
        u.pm = fm + ((wgid % nig) % gsz); u.pn = (wgid % nig) / gsz; return true;
    }
    __device__ __forceinline__ void a_ready(const Unit&) const {}
    __device__ __forceinline__ void done(const Unit&) const {}
};

__device__ __forceinline__ unsigned cvt_pk_bf16(float lo, float hi) { unsigned r; asm volatile("v_cvt_pk_bf16_f32 %0, %1, %2" : "=v"(r) : "v"(lo), "v"(hi)); return r; }
#ifndef PROBE_WHICH
#define PROBE_WHICH 0
#endif
constexpr bool TM_ON = PROBE_WHICH != 0;
struct Tm { unsigned long long k, e; };
__device__ __forceinline__ int pg8_lane_id() { int l; asm volatile("v_mbcnt_lo_u32_b32 %0, -1, 0\n\tv_mbcnt_hi_u32_b32 %0, -1, %0" : "=v"(l)); return l; }
typedef float f32x2 __attribute__((ext_vector_type(2)));
typedef unsigned u32x2 __attribute__((ext_vector_type(2)));
constexpr float RMS_EPS = 1e-6f;
__device__ __forceinline__ float row_rs(const float* ssq, int r) {
    const f32x4* p = (const f32x4*)(ssq + (size_t)r * 16);
    const f32x4 a = p[0], b = p[1], c = p[2], d = p[3];
    const float s = ((a[0] + a[1]) + (a[2] + a[3])) + ((b[0] + b[1]) + (b[2] + b[3])) + ((c[0] + c[1]) + (c[2] + c[3])) + ((d[0] + d[1]) + (d[2] + d[3]));
    return __builtin_amdgcn_rsqf(s * (1.0f / 1024.0f) + RMS_EPS);
}
__device__ __forceinline__ float silu_f(float g) { return g * __builtin_amdgcn_rcpf(1.0f + __builtin_amdgcn_exp2f(g * -1.4426950408889634f)); }

constexpr int RS_CACHE_OFF = STAGE_BYTES;
template <class Sched> __device__ __forceinline__ void rs_cache_fill(PG8_LAS unsigned char* lds, const Sched& S, const float* ssq, int wid) {
    PG8_LAS float* rsl = (PG8_LAS float*)(lds + RS_CACHE_OFF); Unit u; const int tid_ = wid * 64 + pg8_lane_id(), t = tid_ & 255, hf = tid_ >> 8;
    for (int i = hf; S.next(i, u); i += 2) rsl[i * 256 + t] = row_rs(ssq, u.pm * BM + t);
    __syncthreads();
}
struct EpiSwiglu {
    static constexpr bool PERM = true, AFTER_DRAIN = false, MID = false;
    bf16_t* H; int ldh;
    __device__ __forceinline__ void operator()(const f32x4 (&acc)[2][2][4][2], const Unit& u, int wr, int wc, int fr, int fq, int ui, PG8_LAS unsigned char* lds) const {
        const int row0 = u.pm * BM + wr * 64 + fr, col0 = u.pn * HALF + wc * 32 + 8 * fq;
        const PG8_LAS float* rsl = (const PG8_LAS float*)(lds + RS_CACHE_OFF) + ui * 256 + wr * 64 + fr;
#pragma unroll
        for (int ai = 0; ai < 2; ++ai)
#pragma unroll
            for (int m = 0; m < 4; ++m) {
                const int r = row0 + ai * HALF + m * 16; const float rs = rsl[ai * HALF + m * 16];
                float hv[8];
#pragma unroll
                for (int n = 0; n < 2; ++n)
#pragma unroll
                    for (int e = 0; e < 4; ++e) hv[n * 4 + e] = silu_f(acc[ai][0][m][n][e] * rs) * (acc[ai][1][m][n][e] * rs);
                u32x4 w; w.x = cvt_pk_bf16(hv[0], hv[1]); w.y = cvt_pk_bf16(hv[2], hv[3]); w.z = cvt_pk_bf16(hv[4], hv[5]); w.w = cvt_pk_bf16(hv[6], hv[7]);
                *(u32x4*)(H + (size_t)r * ldh + col0) = w;
            }
    }
};
struct EpiScaleBf16 {
    static constexpr bool PERM = true, AFTER_DRAIN = false, MID = false;
    bf16_t* O; int ldc;
    __device__ __forceinline__ void operator()(const f32x4 (&acc)[2][2][4][2], const Unit& u, int wr, int wc, int fr, int fq, int ui, PG8_LAS unsigned char* lds) const {
        const int row0 = u.pm * BM + wr * 64 + fr, col0 = u.pn * BM + wc * 32 + 8 * fq;
        const PG8_LAS float* rsl = (const PG8_LAS float*)(lds + RS_CACHE_OFF) + ui * 256 + wr * 64 + fr;
#pragma unroll
        for (int ai = 0; ai < 2; ++ai)
#pragma unroll
            for (int m = 0; m < 4; ++m) {
                const int r = row0 + ai * HALF + m * 16; const float rs = rsl[ai * HALF + m * 16];
#pragma unroll
                for (int bj = 0; bj < 2; ++bj) {
                    const f32x4 v0 = acc[ai][bj][m][0] * rs, v1 = acc[ai][bj][m][1] * rs;
                    u32x4 w; w.x = cvt_pk_bf16(v0[0], v0[1]); w.y = cvt_pk_bf16(v0[2], v0[3]); w.z = cvt_pk_bf16(v1[0], v1[1]); w.w = cvt_pk_bf16(v1[2], v1[3]);
                    *(u32x4*)(O + (size_t)r * ldc + col0 + bj * HALF) = w;
                }
            }
    }
};
__device__ __forceinline__ f32x4 bf4_to_f32(u32x2 w) { f32x4 r; r[0] = __builtin_bit_cast(float, w.x << 16); r[1] = __builtin_bit_cast(float, w.x & 0xffff0000u); r[2] = __builtin_bit_cast(float, w.y << 16); r[3] = __builtin_bit_cast(float, w.y & 0xffff0000u); return r; }
template <int MODE> struct EpiResid {
    static constexpr bool PERM = true, AFTER_DRAIN = false, MID = false;
    const float* basef; float* out; bf16_t* xb; float* ssq; float scale;
    __device__ __forceinline__ void operator()(const f32x4 (&acc)[2][2][4][2], const Unit& u, int wr, int wc, int fr, int fq, int ui, PG8_LAS unsigned char* lds) const {
        const int row0 = u.pm * BM + wr * 64 + fr, col0 = u.pn * BM + wc * 32 + 8 * fq;
#pragma unroll
        for (int ai = 0; ai < 2; ++ai) {
            f32x4 pre[4][2][2];
#pragma unroll
            for (int m = 0; m < 4; ++m) { const size_t off = (size_t)(row0 + ai * HALF + m * 16) * 1024 + col0;
#pragma unroll
                for (int bj = 0; bj < 2; ++bj) {
                    if (MODE == 0) { pre[m][bj][0] = *(const f32x4*)(basef + off + bj * HALF); pre[m][bj][1] = *(const f32x4*)(basef + off + bj * HALF + 4); }
                    else { const u32x4 w = *(const u32x4*)(xb + off + bj * HALF); pre[m][bj][0] = bf4_to_f32((u32x2){w.x, w.y}); pre[m][bj][1] = bf4_to_f32((u32x2){w.z, w.w}); } } }
#pragma unroll
            for (int m = 0; m < 4; ++m) { const int r = row0 + ai * HALF + m * 16; const size_t off = (size_t)r * 1024 + col0; float s = 0.f;
#pragma unroll
                for (int bj = 0; bj < 2; ++bj) {
                    const f32x4 o0 = pre[m][bj][0] + acc[ai][bj][m][0] * scale, o1 = pre[m][bj][1] + acc[ai][bj][m][1] * scale;
                    if (MODE == 2) { *(f32x4*)(out + off + bj * HALF) = o0; *(f32x4*)(out + off + bj * HALF + 4) = o1; }
                    else { s += ((o0[0] * o0[0] + o0[1] * o0[1]) + (o0[2] * o0[2] + o0[3] * o0[3])) + ((o1[0] * o1[0] + o1[1] * o1[1]) + (o1[2] * o1[2] + o1[3] * o1[3]));
                        u32x4 w; w.x = cvt_pk_bf16(o0[0], o0[1]); w.y = cvt_pk_bf16(o0[2], o0[3]); w.z = cvt_pk_bf16(o1[0], o1[1]); w.w = cvt_pk_bf16(o1[2], o1[3]); *(u32x4*)(xb + off + bj * HALF) = w; }
                }
                if (MODE != 2) { s += __shfl_xor(s, 16); s += __shfl_xor(s, 32); if (fq == 0) ssq[(size_t)r * 16 + u.pn * 4 + wc] = s; }
            }
        }
    }
};
template <class Sched> __device__ __forceinline__ void mix_cache_fill(PG8_LAS unsigned char* lds, const Sched& S, const float* ssql, const float* ssqa, int wid) {
    PG8_LAS f32x2* c2 = (PG8_LAS f32x2*)(lds + RS_CACHE_OFF); Unit u; const int tid_ = wid * 64 + pg8_lane_id(), t = tid_ & 255, hf = tid_ >> 8;
    for (int i = hf; S.next(i, u); i += 2) { const size_t r = (size_t)u.pm * BM + t;
        const f32x4* pl = (const f32x4*)(ssql + r * 8); const f32x4* pa = (const f32x4*)(ssqa + r * 8); const f32x4 l0 = pl[0], l1 = pl[1], a0 = pa[0], a1 = pa[1];
        const float rl = __builtin_amdgcn_rsqf((((l0[0] + l0[1]) + (l0[2] + l0[3])) + ((l1[0] + l1[1]) + (l1[2] + l1[3]))) * (1.0f / 512.0f) + RMS_EPS);
        const float ra = __builtin_amdgcn_rsqf((((a0[0] + a0[1]) + (a0[2] + a0[3])) + ((a1[0] + a1[1]) + (a1[2] + a1[3]))) * (1.0f / 512.0f) + RMS_EPS);
        c2[i * 256 + t] = (f32x2){rl * __builtin_amdgcn_rcpf(ra), ra}; }
    __syncthreads();
}
struct EpiResidMix {
    static constexpr bool PERM = true, AFTER_DRAIN = false, MID = true;
    bf16_t* xb; float* ssq;
    __device__ __forceinline__ void mid(f32x4 (&acc)[2][2][4][2], int wr, int fr, int ui, PG8_LAS unsigned char* lds) const {
        const PG8_LAS f32x2* c2 = (const PG8_LAS f32x2*)(lds + RS_CACHE_OFF) + ui * 256 + wr * 64 + fr;
#pragma unroll
        for (int ai = 0; ai < 2; ++ai)
#pragma unroll
            for (int m = 0; m < 4; ++m) { const float q = c2[ai * HALF + m * 16].x;
#pragma unroll
                for (int bj = 0; bj < 2; ++bj)
#pragma unroll
                    for (int n = 0; n < 2; ++n) acc[ai][bj][m][n] *= q; }
    }
    __device__ __forceinline__ void operator()(const f32x4 (&acc)[2][2][4][2], const Unit& u, int wr, int wc, int fr, int fq, int ui, PG8_LAS unsigned char* lds) const {
        const int row0 = u.pm * BM + wr * 64 + fr, col0 = u.pn * BM + wc * 32 + 8 * fq;
        const PG8_LAS f32x2* c2 = (const PG8_LAS f32x2*)(lds + RS_CACHE_OFF) + ui * 256 + wr * 64 + fr;
#pragma unroll
        for (int ai = 0; ai < 2; ++ai) {
            u32x4 pre[4][2];
#pragma unroll
            for (int m = 0; m < 4; ++m) { const size_t off = (size_t)(row0 + ai * HALF + m * 16) * 1024 + col0;
#pragma unroll
                for (int bj = 0; bj < 2; ++bj) pre[m][bj] = *(const u32x4*)(xb + off + bj * HALF); }
#pragma unroll
            for (int m = 0; m < 4; ++m) { const int r = row0 + ai * HALF + m * 16; const size_t off = (size_t)r * 1024 + col0; float s = 0.f; const float ra = c2[ai * HALF + m * 16].y;
#pragma unroll
                for (int bj = 0; bj < 2; ++bj) {
                    const f32x4 o0 = bf4_to_f32((u32x2){pre[m][bj].x, pre[m][bj].y}) + acc[ai][bj][m][0] * ra, o1 = bf4_to_f32((u32x2){pre[m][bj].z, pre[m][bj].w}) + acc[ai][bj][m][1] * ra;
                    s += ((o0[0] * o0[0] + o0[1] * o0[1]) + (o0[2] * o0[2] + o0[3] * o0[3])) + ((o1[0] * o1[0] + o1[1] * o1[1]) + (o1[2] * o1[2] + o1[3] * o1[3]));
                    u32x4 w; w.x = cvt_pk_bf16(o0[0], o0[1]); w.y = cvt_pk_bf16(o0[2], o0[3]); w.z = cvt_pk_bf16(o1[0], o1[1]); w.w = cvt_pk_bf16(o1[2], o1[3]); *(u32x4*)(xb + off + bj * HALF) = w;
                }
                s += __shfl_xor(s, 16); s += __shfl_xor(s, 32); if (fq == 0) ssq[(size_t)r * 16 + u.pn * 4 + wc] = s;
            }
        }
    }
};
template <class Epi, class Sched, bool ALIGN_EPI = false, bool SP2 = false>
__device__ __forceinline__ void gemm_phase(PG8_LAS unsigned char* lds, const Gemm g, const Sched& S, const Epi& E, int wid_in, Tm& tm) {
    const int wid = wid_in, lane = pg8_lane_id(), tid = wid * 64 + lane, wr = wid >> 2, wc = wid & 3, fr = lane & 15, fq = lane >> 4;
    const int K = g.K, nt = K / BK;
    unsigned voffA[2], voffB[2];
#pragma unroll
    for (int i = 0; i < 2; ++i) { int R, C; stage_rc(tid * 16 + i * 8192, R, C); const int Rb = Epi::PERM ? ((R & ~31) + perm32(R & 31)) : R;
        voffA[i] = (unsigned)(R * K + C) * 2u; voffB[i] = (unsigned)(Rb * K + C) * 2u; }
    const size_t kstep = (size_t)(BK * 2);
    const size_t hstep = (size_t)HALF * K * 2;
    const size_t tstep = 2 * hstep;
    const unsigned ldsw = (unsigned)wid * 1024u;
    const int aoff = lds_byte(wr * 64 + fr, fq * 8), boff = lds_byte(wc * 32 + fr, fq * 8);
#define PG8_SA(b, h) (((b) * 2 + (h)) * HTB)
#define PG8_SB(b, h) ((4 + (b) * 2 + (h)) * HTB)
#define PG8_STAGE(bufoff, gbase, voff) do { _Pragma("unroll") for (int _i = 0; _i < 2; ++_i) \
        __builtin_amdgcn_global_load_lds((const unsigned*)((const char*)(gbase) + (voff)[_i]), (PG8_LAS unsigned*)(lds + (bufoff) + ldsw + _i * 8192), 16, 0, 0); } while (0)
#define PG8_LDA(dst, b, h) do { _Pragma("unroll") for (int m = 0; m < 4; ++m) _Pragma("unroll") for (int k = 0; k < 2; ++k) dst[m][k] = *(const PG8_LAS bf16x8*)(lds + PG8_SA(b, h) + aoff + m * 2048 + k * 1024); } while (0)
#define PG8_LDB(dst, b, h) do { _Pragma("unroll") for (int n = 0; n < 2; ++n) _Pragma("unroll") for (int k = 0; k < 2; ++k) dst[n][k] = *(const PG8_LAS bf16x8*)(lds + PG8_SB(b, h) + boff + n * 2048 + k * 1024); } while (0)
#define PG8_MMA(ai, bj, At, Bt) do { __builtin_amdgcn_s_setprio(1); _Pragma("unroll") for (int m = 0; m < 4; ++m) _Pragma("unroll") for (int n = 0; n < 2; ++n) _Pragma("unroll") for (int k = 0; k < 2; ++k) \
        acc[ai][bj][m][n] = __builtin_amdgcn_mfma_f32_16x16x32_bf16(Bt[n][k], At[m][k], acc[ai][bj][m][n], 0, 0, 0); __builtin_amdgcn_s_setprio(0); } while (0)
#define PG8_WAIT_V(n) asm volatile("s_waitcnt vmcnt(" #n ")" ::: "memory")
#define PG8_WAIT_L(n) asm volatile("s_waitcnt lgkmcnt(" #n ")" ::: "memory")
#define PG8_BAR __builtin_amdgcn_s_barrier()
#define PG8_SCHED __builtin_amdgcn_sched_barrier(0)
    Unit cur, nxt; int ui = 0;
    if (!S.next(0, cur)) return;
    f32x4 acc[2][2][4][2];
#pragma unroll
    for (int a = 0; a < 2; ++a)
#pragma unroll
        for (int b = 0; b < 2; ++b)
#pragma unroll
            for (int m = 0; m < 4; ++m)
#pragma unroll
                for (int n = 0; n < 2; ++n) acc[a][b][m][n] = (f32x4){0.f, 0.f, 0.f, 0.f};
    bf16x8 At[4][2], B0[2][2], B1[2][2];
    const char* cA = (const char*)g.A + (size_t)cur.pm * tstep; const char* cB = (const char*)g.Bt + (size_t)cur.pn * tstep;
    S.a_ready(cur);
    if constexpr (SP2) {
        PG8_STAGE(PG8_SB(0, 0), cB, voffB); PG8_STAGE(PG8_SB(0, 1), cB + hstep, voffB); PG8_STAGE(PG8_SA(0, 0), cA, voffA); PG8_STAGE(PG8_SA(0, 1), cA + hstep, voffA);
        if (wr == 1) PG8_BAR;
        PG8_WAIT_V(2); PG8_BAR;
        PG8_STAGE(PG8_SB(1, 0), cB + kstep, voffB); PG8_STAGE(PG8_SA(1, 0), cA + kstep, voffA); PG8_STAGE(PG8_SB(1, 1), cB + hstep + kstep, voffB);
        PG8_WAIT_V(6); PG8_BAR;
    } else {
        PG8_STAGE(PG8_SB(0, 0), cB, voffB); PG8_STAGE(PG8_SA(0, 0), cA, voffA); PG8_STAGE(PG8_SB(0, 1), cB + hstep, voffB); PG8_STAGE(PG8_SA(0, 1), cA + hstep, voffA);
        if (wr == 1) PG8_BAR;
        PG8_WAIT_V(4); PG8_BAR;
        PG8_STAGE(PG8_SB(1, 0), cB + kstep, voffB); PG8_STAGE(PG8_SA(1, 0), cA + kstep, voffA); PG8_STAGE(PG8_SB(1, 1), cB + hstep + kstep, voffB);
        PG8_WAIT_V(6); PG8_BAR;
    }
    for (;;) {
        const bool has_next = S.next(ui + 1, nxt);
        const unsigned long long tm_a = TM_ON ? __builtin_amdgcn_s_memrealtime() : 0ull;
        const char* nA = has_next ? (const char*)g.A + (size_t)nxt.pm * tstep : cA; const char* nB = has_next ? (const char*)g.Bt + (size_t)nxt.pn * tstep : cB;
        for (int t = 0; t < nt; t += 2) {
            if constexpr (Epi::MID) { if (t == nt / 2) E.mid(acc, wr, fr, ui, lds); }
            const bool last = (t == nt - 2);
            const char* a1 = cA + (size_t)(t + 1) * kstep;
            const char* a2 = last ? nA : cA + (size_t)(t + 2) * kstep; const char* b2 = last ? nB : cB + (size_t)(t + 2) * kstep;
            const char* a3 = a2 + kstep; const char* b3 = b2 + kstep;
            if (last && has_next) S.a_ready(nxt);
            if constexpr (SP2) {
            PG8_LDB(B0, 0, 0); PG8_LDB(B1, 0, 1); PG8_SCHED; PG8_LDA(At, 0, 0); PG8_STAGE(PG8_SA(1, 1), a1 + hstep, voffA);
            PG8_WAIT_V(8); PG8_WAIT_L(0); PG8_BAR; PG8_MMA(0, 0, At, B0); PG8_MMA(0, 1, At, B1); PG8_BAR; PG8_SCHED;
            PG8_LDA(At, 0, 1); PG8_STAGE(PG8_SB(0, 0), b2, voffB); PG8_STAGE(PG8_SB(0, 1), b2 + hstep, voffB); PG8_STAGE(PG8_SA(0, 0), a2, voffA);
            PG8_WAIT_V(8); PG8_WAIT_L(0); PG8_BAR; PG8_MMA(1, 0, At, B0); PG8_MMA(1, 1, At, B1); PG8_BAR; PG8_SCHED;
            PG8_LDB(B0, 1, 0); PG8_LDB(B1, 1, 1); PG8_SCHED; PG8_LDA(At, 1, 0); PG8_STAGE(PG8_SA(0, 1), a2 + hstep, voffA);
            PG8_WAIT_V(8); PG8_WAIT_L(0); PG8_BAR; PG8_MMA(0, 0, At, B0); PG8_MMA(0, 1, At, B1); PG8_BAR; PG8_SCHED;
            PG8_LDA(At, 1, 1); PG8_STAGE(PG8_SB(1, 0), b3, voffB); PG8_STAGE(PG8_SB(1, 1), b3 + hstep, voffB); PG8_STAGE(PG8_SA(1, 0), a3, voffA);
            PG8_WAIT_V(8); PG8_WAIT_L(0); PG8_BAR; PG8_MMA(1, 0, At, B0); PG8_MMA(1, 1, At, B1); PG8_BAR; PG8_SCHED;
            } else {
            PG8_LDB(B0, 0, 0); PG8_SCHED; PG8_LDA(At, 0, 0); PG8_STAGE(PG8_SA(1, 1), a1 + hstep, voffA);
            PG8_WAIT_L(8); PG8_BAR; PG8_WAIT_L(0); PG8_MMA(0, 0, At, B0); PG8_BAR; PG8_SCHED;
            PG8_LDB(B1, 0, 1); PG8_STAGE(PG8_SB(0, 0), b2, voffB);
            PG8_BAR; PG8_WAIT_L(0); PG8_MMA(0, 1, At, B1); PG8_BAR;
            PG8_LDA(At, 0, 1); PG8_STAGE(PG8_SA(0, 0), a2, voffA);
            PG8_BAR; PG8_WAIT_L(0); PG8_MMA(1, 0, At, B0); PG8_BAR; PG8_SCHED;
            PG8_STAGE(PG8_SB(0, 1), b2 + hstep, voffB);
            PG8_WAIT_V(6); PG8_BAR; PG8_MMA(1, 1, At, B1); PG8_BAR;
            PG8_LDB(B0, 1, 0); PG8_SCHED; PG8_LDA(At, 1, 0); PG8_STAGE(PG8_SA(0, 1), a2 + hstep, voffA);
            PG8_WAIT_L(8); PG8_BAR; PG8_WAIT_L(0); PG8_MMA(0, 0, At, B0); PG8_BAR; PG8_SCHED;
            PG8_LDB(B1, 1, 1); PG8_STAGE(PG8_SB(1, 0), b3, voffB);
            PG8_BAR; PG8_WAIT_L(0); PG8_MMA(0, 1, At, B1); PG8_BAR;
            PG8_LDA(At, 1, 1); PG8_STAGE(PG8_SA(1, 0), a3, voffA);
            PG8_BAR; PG8_WAIT_L(0); PG8_MMA(1, 0, At, B0); PG8_BAR; PG8_SCHED;
            PG8_STAGE(PG8_SB(1, 1), b3 + hstep, voffB);
            PG8_WAIT_V(6); PG8_BAR; PG8_MMA(1, 1, At, B1); PG8_BAR;
            }
        }
        const unsigned long long tm_b = TM_ON ? __builtin_amdgcn_s_memrealtime() : 0ull;
        if constexpr (ALIGN_EPI) { if (wr == 0) PG8_BAR; }
        if constexpr (!Epi::AFTER_DRAIN) { E(acc, cur, wr, wc, fr, fq, ui, lds); S.done(cur); }
        if (TM_ON) { const unsigned long long tm_c = __builtin_amdgcn_s_memrealtime(); tm.k += tm_b - tm_a; tm.e += tm_c - tm_b; }
        if (!has_next) break;
#pragma unroll
        for (int a = 0; a < 2; ++a)
#pragma unroll
            for (int b = 0; b < 2; ++b)
#pragma unroll
                for (int m = 0; m < 4; ++m)
#pragma unroll
                    for (int n = 0; n < 2; ++n) acc[a][b][m][n] = (f32x4){0.f, 0.f, 0.f, 0.f};
        cur = nxt; cA = nA; cB = nB; ++ui;
        if constexpr (ALIGN_EPI) { if (wr == 1) PG8_BAR; }
    }
    PG8_WAIT_V(0);
    if constexpr (!ALIGN_EPI) { if (wr == 0) PG8_BAR; }
    PG8_BAR;
    if constexpr (Epi::AFTER_DRAIN) { E.fused(acc, cur, wr, wc, fr, fq, lds, wid, lane); S.done(cur); }
#undef PG8_SA
#undef PG8_SB
#undef PG8_STAGE
#undef PG8_LDA
#undef PG8_LDB
#undef PG8_MMA
#undef PG8_WAIT_V
#undef PG8_WAIT_L
#undef PG8_BAR
#undef PG8_SCHED
}
}

constexpr int NWAVES = 8;
constexpr int DM = 1024, BATCH = 4, SEQ = 8192, MP = BATCH * SEQ, DEC_B = 128, DEC_T = 4, MS = DEC_B * DEC_T, MT = MP + MS;
constexpr int LRU_W = 512, NH = 8, NKV = 2, HD = 64, DFF = 2816, INW = 1792, WIN = 128, PAST = 16384;
constexpr int C_XL = 0, C_GATE = 512, C_Q = 1024, C_K = 1536, C_V = 1664;
constexpr int NCHUNK = 64, CHUNK = SEQ / NCHUNK;
constexpr float EPS = 1e-6f, LOG2E = 1.4426950408889634f;
constexpr size_t O_YP = 0, O_YS = 33554432, O_PH = 34078720, O_PC = 34080768, O_PK = 34086912, O_PV = 34152448, O_SH = 34217984, O_SC = 34283520, O_SK = 34480128, O_SV = 36577280, O_END = 38674432;
constexpr size_t MiB = 1u << 20;
constexpr size_t WS_CTL = 0, CTL_ZERO_BYTES = 64 * 1024;
constexpr size_t WS_WGU1 = 2 * MiB, WS_WD1 = 13 * MiB, WS_WIN = 19 * MiB, WS_WOUT = 23 * MiB, WS_WGU2 = 25 * MiB, WS_WD2 = 36 * MiB;
constexpr size_t WS_ROPE = 42 * MiB;
constexpr size_t WS_SSQ = 45 * MiB;
constexpr size_t WS_LSUM = 48 * MiB;
constexpr size_t WS_WFRAG = 49 * MiB;
constexpr size_t WS_XB = 50 * MiB;
constexpr size_t WS_CAT = 115 * MiB;
constexpr size_t WS_PROJ = 180 * MiB;
constexpr size_t WS_H = 294 * MiB;
constexpr size_t WS_SSQL = 474 * MiB, WS_SSQA = 475 * MiB;
constexpr size_t WS_SOA = 476 * MiB, WS_SSQS = 477 * MiB;
constexpr size_t WS_END = 478 * MiB;
constexpr int ROPE_ROWS = SEQ + DEC_T;
constexpr int CW_TMO = 0, CW_BAR = 4096;
constexpr int RING_OFF = 0, RING_BYTES = 131072;
constexpr int SCR_BYTES = 147456;
constexpr int LDSCTL_OFF = SCR_BYTES, MISC_OFF = LDSCTL_OFF + 64;
constexpr int LDS_BYTES = SCR_BYTES + 512;

#define GAS __attribute__((address_space(1)))
#define LAS __attribute__((address_space(3)))
typedef unsigned short bf16;
typedef unsigned v4u __attribute__((ext_vector_type(4)));
typedef unsigned v2u __attribute__((ext_vector_type(2)));
typedef float f32x4 __attribute__((ext_vector_type(4)));
typedef float f32x16 __attribute__((ext_vector_type(16)));
typedef short bf16x8 __attribute__((ext_vector_type(8)));
typedef GAS unsigned gu32;
#define RLX_AGENT __ATOMIC_RELAXED, __HIP_MEMORY_SCOPE_AGENT
__device__ __forceinline__ int lane_id() { int l; asm volatile("v_mbcnt_lo_u32_b32 %0, -1, 0\n\tv_mbcnt_hi_u32_b32 %0, -1, %0" : "=v"(l)); return l; }
#define LDS_WAIT() asm volatile("s_waitcnt lgkmcnt(0)" ::: "memory")
#define VM_WAIT() asm volatile("s_waitcnt vmcnt(0)" ::: "memory")
__device__ __forceinline__ unsigned f2bf(float f) { unsigned u = __builtin_bit_cast(unsigned, f); return (u + 0x7fffu + ((u >> 16) & 1u)) >> 16; }
__device__ __forceinline__ unsigned pk2(float lo, float hi) { return f2bf(lo) | (f2bf(hi) << 16); }
__device__ __forceinline__ float bflo(unsigned w) { return __builtin_bit_cast(float, w << 16); }
__device__ __forceinline__ float bfhi(unsigned w) { return __builtin_bit_cast(float, w & 0xffff0000u); }
__device__ __forceinline__ float bf1(bf16 v) { return __builtin_bit_cast(float, (unsigned)v << 16); }
typedef float f32x2_t __attribute__((ext_vector_type(2))); typedef __bf16 bf16x2_t __attribute__((ext_vector_type(2)));
__device__ __forceinline__ unsigned cvtpk(float lo, float hi) { f32x2_t v = {lo, hi}; bf16x2_t b = __builtin_convertvector(v, bf16x2_t); return __builtin_bit_cast(unsigned, b); }
__device__ __forceinline__ float wave_sum(float v) {
#pragma unroll
    for (int o = 1; o < 64; o <<= 1) v += __shfl_xor(v, o);
    return v;
}
__device__ __forceinline__ float wave_max(float v) {
#pragma unroll
    for (int o = 1; o < 64; o <<= 1) v = fmaxf(v, __shfl_xor(v, o));
    return v;
}
__device__ __forceinline__ float sigmoid_f(float x) { return __builtin_amdgcn_rcpf(1.0f + __builtin_amdgcn_exp2f(-x * LOG2E)); }
__device__ __forceinline__ float gelu_tanh(float x) {
    const float y = 0.7978845608028654f * (x + 0.044715f * x * x * x);
    const float e = __builtin_amdgcn_exp2f(2.0f * LOG2E * y);
    const float th = 1.0f - 2.0f * __builtin_amdgcn_rcpf(e + 1.0f);
    return 0.5f * x * (1.0f + th);
}
__device__ __forceinline__ float one_minus_exp(float t) {
    const float ser = -t * (1.0f + t * (0.5f + t * (0.16666667f + t * (0.041666668f + t * 0.0083333338f))));
    const float dir = 1.0f - __builtin_amdgcn_exp2f(t * LOG2E);
    return t > -0.25f ? ser : dir;
}
__device__ __forceinline__ float dot2bf(unsigned a, unsigned b, float c) { return __builtin_amdgcn_fdot2_f32_bf16(__builtin_bit_cast(bf16x2_t, a), __builtin_bit_cast(bf16x2_t, b), c, false); }
#define XB_TMO      128
#define XB_XCNT(j)  (256  + 64 * (j))
#define XB_XSUB(j)  (1280 + 64 * (j))
#define XB_XGEN(j)  (2304 + 64 * (j))
#define XB_TOP      3328
#define XB_TOPGEN   3392
#define XCD_BAR_WORDS 3456
#define XB_SPIN_CAP (1u << 18)

__device__ __forceinline__ unsigned xb_ld(unsigned* p)              { return __hip_atomic_load(p, __ATOMIC_RELAXED, __HIP_MEMORY_SCOPE_AGENT); }
__device__ __forceinline__ unsigned xb_add(unsigned* p, unsigned v) { return __hip_atomic_fetch_add(p, v, __ATOMIC_RELAXED, __HIP_MEMORY_SCOPE_AGENT); }
__device__ __forceinline__ unsigned xb_xcc_id() { return (unsigned)__builtin_amdgcn_s_getreg((3 << 11) | 20) & 0xFu; }
#define XB_SPIN(cond, bar) do { unsigned _sp = 0; while (cond) { __builtin_amdgcn_s_sleep(1); \
    if ((++_sp & 255u) == 0u) { if (xb_ld(&(bar)[XB_TMO])) break; if (_sp > XB_SPIN_CAP) { atomicAdd(&(bar)[XB_TMO], 1u); break; } } } } while (0)

struct XcdBarrier {
    unsigned* bar; unsigned x;
    volatile LAS unsigned* st;
};

__device__ __forceinline__ XcdBarrier xcd_barrier_post(unsigned* bar, volatile LAS unsigned* st, bool leader) {
    XcdBarrier b; b.bar = bar; b.x = xb_xcc_id(); b.st = st;
    if (leader) (void)xb_add(&bar[XB_XCNT(b.x)], 1u);
    return b;
}
__device__ __forceinline__ void xcd_barrier_complete(unsigned* bar, unsigned x, unsigned& nloc, unsigned& nx) {
    const unsigned G = gridDim.x * gridDim.y * gridDim.z;
    unsigned sum, cnt, mine, sp = 0u;
    for (;;) {
        sum = 0u; cnt = 0u; mine = 0u;
#pragma unroll
        for (unsigned j = 0; j < 16; ++j) { const unsigned c = xb_ld(&bar[XB_XCNT(j)]); sum += c; cnt += (c > 0u) ? 1u : 0u; mine = (j == x) ? c : mine; }
        if (sum == G) break;
        __builtin_amdgcn_s_sleep(1);
        if ((++sp & 255u) == 0u) { if (xb_ld(&bar[XB_TMO])) break; if (sp > XB_SPIN_CAP) { atomicAdd(&bar[XB_TMO], 1u); break; } }
    }
    nloc = mine > 0u ? mine : 1u; nx = cnt > 0u ? cnt : 1u;
}

__device__ __forceinline__ void xcd_barrier(const XcdBarrier& b, bool leader) {
    asm volatile("s_waitcnt vmcnt(0)" ::: "memory");
    __syncthreads();
    if (leader) {
        unsigned* bar = b.bar;
        __builtin_amdgcn_s_waitcnt(0);
        unsigned nloc = b.st[0], nx = b.st[1];
        if (nloc == 0u) { xcd_barrier_complete(bar, b.x, nloc, nx); b.st[0] = nloc; b.st[1] = nx; }
        const unsigned old = xb_add(&bar[XB_XSUB(b.x)], 1u);
        const unsigned gen = old / nloc;
        if (old + 1u == (gen + 1u) * nloc) {
            __builtin_amdgcn_fence(__ATOMIC_RELEASE, "agent");
            asm volatile("s_waitcnt vmcnt(0)" ::: "memory");
            const unsigned og = xb_add(&bar[XB_TOP], 1u);
            const unsigned tg = og / nx;
            if (og + 1u == (tg + 1u) * nx) xb_add(&bar[XB_TOPGEN], 1u);
            else XB_SPIN(xb_ld(&bar[XB_TOPGEN]) == tg, bar);
            __builtin_amdgcn_fence(__ATOMIC_ACQUIRE, "agent");
            xb_add(&bar[XB_XGEN(b.x)], 1u);
            asm volatile("s_waitcnt vmcnt(0)" ::: "memory");
        } else {
            XB_SPIN(xb_ld(&bar[XB_XGEN(b.x)]) == gen, bar);
            __builtin_amdgcn_fence(__ATOMIC_ACQUIRE, "agent");
            asm volatile("s_waitcnt vmcnt(0)" ::: "memory");
        }
    }
    __syncthreads();
}

typedef const void __attribute__((address_space(4)))* kernarg_ptr;
struct Frame {
    LAS unsigned char* lds;
    volatile LAS unsigned* MISC;
    int wave;
    __device__ __forceinline__ int lane() const { return lane_id(); }
    __device__ __forceinline__ int tid() const { return wave * 64 + lane_id(); }
    int vcu, G;
    kernarg_ptr kp;
    float* out; unsigned char* ws;
    __device__ __forceinline__ const float* inp(int i) const { kernarg_ptr k = kp; asm volatile("" : "+s"(k)); return ((const float* const __attribute__((address_space(4)))*)k)[i]; }
    __device__ __forceinline__ gu32* ctl() const { return (gu32*)(ws + WS_CTL); }
    __device__ __forceinline__ bf16* WGU1() const { return (bf16*)(ws + WS_WGU1); }
    __device__ __forceinline__ bf16* WD1() const { return (bf16*)(ws + WS_WD1); }
    __device__ __forceinline__ bf16* WINT() const { return (bf16*)(ws + WS_WIN); }
    __device__ __forceinline__ bf16* WOUT() const { return (bf16*)(ws + WS_WOUT); }
    __device__ __forceinline__ bf16* WGU2() const { return (bf16*)(ws + WS_WGU2); }
    __device__ __forceinline__ bf16* WD2() const { return (bf16*)(ws + WS_WD2); }
    __device__ __forceinline__ float* ROPEC() const { return (float*)(ws + WS_ROPE); }
    __device__ __forceinline__ float* ROPES() const { return (float*)(ws + WS_ROPE) + ROPE_ROWS * 32; }
    __device__ __forceinline__ float* SSQ() const { return (float*)(ws + WS_SSQ); }
    __device__ __forceinline__ float* LSUM() const { return (float*)(ws + WS_LSUM); }
    __device__ __forceinline__ float* SSQL() const { return (float*)(ws + WS_SSQL); }
    __device__ __forceinline__ float* SSQA() const { return (float*)(ws + WS_SSQA); }
    __device__ __forceinline__ float* SOA() const { return (float*)(ws + WS_SOA); }
    __device__ __forceinline__ float* SSQS() const { return (float*)(ws + WS_SSQS); }
    __device__ __forceinline__ bf16* WFRAG() const { return (bf16*)(ws + WS_WFRAG); }
    __device__ __forceinline__ bf16* XB() const { return (bf16*)(ws + WS_XB); }
    __device__ __forceinline__ bf16* CAT() const { return (bf16*)(ws + WS_CAT); }
    __device__ __forceinline__ bf16* PROJ() const { return (bf16*)(ws + WS_PROJ); }
    __device__ __forceinline__ bf16* HB() const { return (bf16*)(ws + WS_H); }
};
enum { I_XP = 0, I_XS, I_SH, I_SC, I_CK, I_CV, I_F1N, I_F1G, I_F1U, I_F1D, I_MN, I_WIN, I_CW, I_CB, I_WA, I_BA, I_WX, I_BX, I_LAM, I_QN, I_KN, I_SINK, I_LON, I_AON, I_WOUT, I_F2N, I_F2G, I_F2U, I_F2D };

template <int MODE> __device__ __forceinline__ void p0_transpose_item(const float* W, const float* gain, int K, int N, bf16* WT, LAS float* scr, int item, int lane) {
    const int nblk = N / 32, kb = item / nblk, nb = item % nblk, k0 = 64 * kb, n0 = 32 * nb;
    f32x4 tv[8];
#pragma unroll
    for (int i = 0; i < 8; ++i) { const int kk = 8 * i + (lane >> 3); tv[i] = __builtin_nontemporal_load((const f32x4*)(W + (size_t)(k0 + kk) * N + n0 + 4 * (lane & 7))); }
#pragma unroll
    for (int i = 0; i < 8; ++i) { const int kk = 8 * i + (lane >> 3); f32x4 v = tv[i]; if (gain) v *= gain[k0 + kk];
        LAS float* d = scr + kk * 33 + 4 * (lane & 7); d[0] = v[0]; d[1] = v[1]; d[2] = v[2]; d[3] = v[3]; }
    LDS_WAIT(); asm volatile("" ::: "memory");
    const int c = lane & 7;
    const int rb = (MODE == 0) ? n0 : ((n0 >> 7) * 256 + (MODE - 1) * 128 + (n0 & 127));
#pragma unroll
    for (int j = 0; j < 4; ++j) { const int n = (lane >> 3) + 8 * j; const LAS float* s = scr + (8 * c) * 33 + n;
        v4u o; o.x = pk2(s[0 * 33], s[1 * 33]); o.y = pk2(s[2 * 33], s[3 * 33]); o.z = pk2(s[4 * 33], s[5 * 33]); o.w = pk2(s[6 * 33], s[7 * 33]);
        *(GAS v4u*)(WT + (size_t)(rb + n) * K + k0 + 8 * c) = o; }
    LDS_WAIT(); asm volatile("" ::: "memory");
}
template <int NR> __device__ __forceinline__ void p0_rows(Frame& F, int m, int step, int lane) {
    f32x4 v[NR][4]; bool ok[NR];
#pragma unroll
    for (int q = 0; q < NR; ++q) { const int r = m + q * step; ok[q] = r < MT; const int rr = ok[q] ? r : m;
        const GAS f32x4* xr = (const GAS f32x4*)((rr < MP) ? F.inp(I_XP) + (size_t)rr * DM : F.inp(I_XS) + (size_t)(rr - MP) * DM) + lane;
#pragma unroll
        for (int j = 0; j < 4; ++j) v[q][j] = __builtin_nontemporal_load(xr + 64 * j); }
#pragma unroll
    for (int q = 0; q < NR; ++q) { const int r = m + q * step; float s = 0.f;
#pragma unroll
        for (int j = 0; j < 4; ++j) s += (v[q][j].x * v[q][j].x + v[q][j].y * v[q][j].y) + (v[q][j].z * v[q][j].z + v[q][j].w * v[q][j].w);
        s = wave_sum(s);
        if (ok[q]) { GAS unsigned long long* o8 = (GAS unsigned long long*)(F.XB() + (size_t)r * DM) + lane;
#pragma unroll
            for (int j = 0; j < 4; ++j) o8[64 * j] = (unsigned long long)pk2(v[q][j].x, v[q][j].y) | ((unsigned long long)pk2(v[q][j].z, v[q][j].w) << 32);
            if (lane < 16) F.SSQ()[(size_t)r * 16 + lane] = (lane == 0) ? s : 0.f; } }
}
__device__ __forceinline__ void p0_prologue(Frame& F) {
    LAS float* scr = (LAS float*)(F.lds + RING_OFF + F.wave * 16384);
    const int gw = F.vcu * NWAVES + F.wave, NGW = F.G * NWAVES;
    constexpr int I_GU = (DM / 64) * (DFF / 32), I_D = (DFF / 64) * (DM / 32), I_IN = (DM / 64) * (INW / 32), I_OUT = (DM / 64) * (DM / 32);
    constexpr int NITEMS = 4 * I_GU + 2 * I_D + I_IN + I_OUT;
    for (int it = gw; it < NITEMS; it += NGW) {
        int r = it;
        if (r < I_GU) { p0_transpose_item<1>(F.inp(I_F1G), F.inp(I_F1N), DM, DFF, F.WGU1(), scr, r, F.lane()); continue; } r -= I_GU;
        if (r < I_GU) { p0_transpose_item<2>(F.inp(I_F1U), F.inp(I_F1N), DM, DFF, F.WGU1(), scr, r, F.lane()); continue; } r -= I_GU;
        if (r < I_GU) { p0_transpose_item<1>(F.inp(I_F2G), F.inp(I_F2N), DM, DFF, F.WGU2(), scr, r, F.lane()); continue; } r -= I_GU;
        if (r < I_GU) { p0_transpose_item<2>(F.inp(I_F2U), F.inp(I_F2N), DM, DFF, F.WGU2(), scr, r, F.lane()); continue; } r -= I_GU;
        if (r < I_D) { p0_transpose_item<0>(F.inp(I_F1D), nullptr, DFF, DM, F.WD1(), scr, r, F.lane()); continue; } r -= I_D;
        if (r < I_D) { p0_transpose_item<0>(F.inp(I_F2D), nullptr, DFF, DM, F.WD2(), scr, r, F.lane()); continue; } r -= I_D;
        if (r < I_IN) { p0_transpose_item<0>(F.inp(I_WIN), F.inp(I_MN), DM, INW, F.WINT(), scr, r, F.lane()); continue; } r -= I_IN;
        { const int k0 = 64 * (r / (DM / 32));
          p0_transpose_item<0>(F.inp(I_WOUT), k0 < 512 ? F.inp(I_LON) : F.inp(I_AON) - 512, DM, DM, F.WOUT(), scr, r, F.lane()); }
    }
    { const int ln = F.lane(); for (int m = gw; m < MP; m += 4 * NGW) p0_rows<4>(F, m, NGW, ln);
      for (int m = MP + gw; m < MT; m += NGW) p0_rows<1>(F, m, NGW, ln); }
    for (int e = F.vcu * (NWAVES * 64) + F.tid(); e < 8 * 2 * 2 * 4 * 64; e += F.G * NWAVES * 64) {
        const int ln = e & 63, ks = (e >> 6) & 3, ct = (e >> 8) & 1, gate = (e >> 9) & 1, blk = e >> 10, ql = ln & 31, hh = ln >> 5;
        const float* pw = (gate ? F.inp(I_WX) : F.inp(I_WA)) + (size_t)(blk * 64 + 16 * ks + 8 * hh) * 64 + 32 * ct + ql;
        v4u o; o.x = pk2(pw[0], pw[64]); o.y = pk2(pw[128], pw[192]); o.z = pk2(pw[256], pw[320]); o.w = pk2(pw[384], pw[448]);
        *(v4u*)(F.WFRAG() + (size_t)e * 8) = o;
    }
    const int gt = F.vcu * (NWAVES * 64) + F.tid(), NGT = F.G * NWAVES * 64;
    for (int e = gt; e < ROPE_ROWS * 32; e += NGT) {
        const int pi = e >> 5, i = e & 31; const int pos = pi < SEQ ? pi : PAST + (pi - SEQ);
        const float invf = (float)exp(-(double)i * (9.210340371976184 / 32.0));
        const float ang = (float)pos * invf; const double a = (double)ang;
        F.ROPEC()[e] = (float)cos(a); F.ROPES()[e] = (float)sin(a);
    }
}

constexpr int LW_XRAW = 0, LW_XCS = 35 * 128, LW_GS = LW_XCS + 32 * 144, LW_OUT = LW_GS + 32 * 128, LW_BYTES = LW_OUT + 32 * 128;
static_assert(8 * LW_BYTES <= SCR_BYTES, "lru LDS");
#define LWAIT() asm volatile("s_waitcnt lgkmcnt(0)" ::: "memory")
template <int PASS> __device__ __forceinline__ void lru_prompt_item(Frame& F, int item) {
    int lane_ = F.lane(); asm volatile("" : "+v"(lane_));
    const int lane0 = lane_, w = F.wave;
    const int b = item / NCHUNK, chunk = item % NCHUNK, t0 = chunk * CHUNK;
    LAS unsigned char* wl = F.lds + w * LW_BYTES;
    float ba[2], bx[2], c8[2];
    { const int ql = lane0 & 31;
#pragma unroll
    for (int ct = 0; ct < 2; ++ct) { const int c = 64 * w + 32 * ct + ql; ba[ct] = F.inp(I_BA)[c]; bx[ct] = F.inp(I_BX)[c];
        const float lam = F.inp(I_LAM)[c]; c8[ct] = -8.0f * LOG2E * (fmaxf(-lam, 0.f) + log1pf(expf(-fabsf(lam)))); } }
    float hst[2] = {0.f, 0.f}, Pst[2] = {1.f, 1.f};
    if (PASS == 2) {
        const float* ls = F.LSUM() + ((size_t)b * NCHUNK * 512 + 64 * w + (lane0 & 31)) * 2; float h0 = 0.f, h1 = 0.f;
#pragma unroll 8
        for (int j = 0; j < chunk; ++j) { const f32x2_t p0 = *(const f32x2_t*)(ls + (size_t)j * 1024), p1 = *(const f32x2_t*)(ls + (size_t)j * 1024 + 64); h0 = p0.x * h0 + p0.y; h1 = p1.x * h1 + p1.y; }
        hst[0] = h0; hst[1] = h1;
    }
    for (int sub = 0; sub < CHUNK / 32; ++sub) {
        const int ts = t0 + sub * 32;
        int lq_ = lane0; asm volatile("" : "+v"(lq_));
        const int lane = lq_, ql = lane & 31, hh = lane >> 5;
        LAS unsigned char* xraw = wl + LW_XRAW; LAS unsigned char* xcs = wl + LW_XCS; LAS unsigned char* gs = wl + LW_GS; LAS unsigned char* outs = wl + LW_OUT;
        const bf16* wfr = F.WFRAG() + (size_t)w * (2 * 2 * 4 * 64 * 8) + lane * 8;
        {
            const bf16* pbase = F.PROJ() + (size_t)(b * SEQ) * INW + 64 * w;
            v4u xv[5], gv[4];
#pragma unroll
            for (int i = 0; i < 5; ++i) { const int idx = lane + 64 * i, row = idx >> 3, ch = idx & 7, t = ts - 3 + row; xv[i] = (v4u){0u, 0u, 0u, 0u};
                if (row < 35 && t >= 0) xv[i] = *(const v4u*)(pbase + (size_t)t * INW + C_XL + 8 * ch); }
            if (PASS == 2) {
#pragma unroll
                for (int i = 0; i < 4; ++i) { const int idx = lane + 64 * i, row = idx >> 3, ch = idx & 7; gv[i] = *(const v4u*)(pbase + (size_t)(ts + row) * INW + C_GATE + 8 * ch); }
            }
#pragma unroll
            for (int i = 0; i < 5; ++i) { const int idx = lane + 64 * i, row = idx >> 3, ch = idx & 7; if (row < 35) *(LAS v4u*)(xraw + row * 128 + 16 * ch) = xv[i]; }
            if (PASS == 2) {
#pragma unroll
                for (int i = 0; i < 4; ++i) { const int idx = lane + 64 * i, row = idx >> 3, ch = idx & 7; *(LAS v4u*)(gs + row * 128 + 16 * ch) = gv[i]; }
            }
        }
        LWAIT();
        {
            const int cch = 64 * w + lane;
            const LAS bf16* xr = (const LAS bf16*)xraw + lane; LAS bf16* xo = (LAS bf16*)xcs + lane;
            const float* cwp = F.inp(I_CW) + cch; const float cw0 = cwp[0], cw1 = cwp[512], cw2 = cwp[1024], cw3 = cwp[1536], cb = F.inp(I_CB)[cch];
            float xm3 = bf1(xr[0]), xm2 = bf1(xr[64]), xm1 = bf1(xr[128]);
#pragma unroll 8
            for (int tt = 0; tt < 32; ++tt) { const float x = bf1(xr[(tt + 3) * 64]);
                xo[tt * 72] = (bf16)f2bf(cb + cw0 * xm3 + cw1 * xm2 + cw2 * xm1 + cw3 * x); xm3 = xm2; xm2 = xm1; xm1 = x; }
            if (PASS == 2 && chunk == NCHUNK - 1 && sub == CHUNK / 32 - 1) {
                F.out[O_PC + (b * 3 + 0) * 512 + cch] = xm3; F.out[O_PC + (b * 3 + 1) * 512 + cch] = xm2; F.out[O_PC + (b * 3 + 2) * 512 + cch] = xm1; }
        }
        LWAIT();
        bf16x8 af[4];
#pragma unroll
        for (int ks = 0; ks < 4; ++ks) af[ks] = *(const LAS bf16x8*)(xcs + ql * 144 + (16 * ks + 8 * hh) * 2);
        float ssv[16];
#pragma unroll
        for (int r = 0; r < 16; ++r) ssv[r] = 0.f;
#pragma unroll
        for (int ct = 0; ct < 2; ++ct) {
            f32x16 ra = {0.f, 0.f, 0.f, 0.f, 0.f, 0.f, 0.f, 0.f, 0.f, 0.f, 0.f, 0.f, 0.f, 0.f, 0.f, 0.f}, rx = ra;
            {   bf16x8 wa4[4], wx4[4];
#pragma unroll
                for (int ks = 0; ks < 4; ++ks) { wa4[ks] = *(const bf16x8*)(wfr + (size_t)((0 * 2 + ct) * 4 + ks) * 512); wx4[ks] = *(const bf16x8*)(wfr + (size_t)((1 * 2 + ct) * 4 + ks) * 512); }
#pragma unroll
                for (int ks = 0; ks < 4; ++ks) { ra = __builtin_amdgcn_mfma_f32_32x32x16_bf16(af[ks], wa4[ks], ra, 0, 0, 0); rx = __builtin_amdgcn_mfma_f32_32x32x16_bf16(af[ks], wx4[ks], rx, 0, 0, 0); } }
            const int cl = 32 * ct + ql;
            float av[16], uv[16];
#pragma unroll
            for (int r = 0; r < 16; ++r) { const int tk = (r & 3) + 8 * (r >> 2) + 4 * hh;
                const float rg = sigmoid_f(ra[r] + ba[ct]), ig = sigmoid_f(rx[r] + bx[ct]);
                av[r] = __builtin_amdgcn_exp2f(c8[ct] * rg);
                const float mult = __builtin_amdgcn_sqrtf(fmaxf(1.0f - av[r] * av[r], 0.f));
                uv[r] = mult * ig * bf1(*((const LAS bf16*)(xcs + tk * 144) + cl)); }
            float Ag[4], Ug[4], Ap[4], Up[4], st[4];
#pragma unroll
            for (int g = 0; g < 4; ++g) { Ag[g] = (av[4 * g] * av[4 * g + 1]) * (av[4 * g + 2] * av[4 * g + 3]);
                Ug[g] = ((uv[4 * g] * av[4 * g + 1] + uv[4 * g + 1]) * av[4 * g + 2] + uv[4 * g + 2]) * av[4 * g + 3] + uv[4 * g + 3];
                Ap[g] = __shfl_xor(Ag[g], 32); Up[g] = __shfl_xor(Ug[g], 32); }
            float carry = hst[ct], pp = Pst[ct];
#pragma unroll
            for (int g = 0; g < 4; ++g) { const float Alo = hh ? Ap[g] : Ag[g], Ulo = hh ? Up[g] : Ug[g], Ahi = hh ? Ag[g] : Ap[g], Uhi = hh ? Ug[g] : Up[g];
                const float s_lo = carry; carry = Alo * carry + Ulo; const float s_hi = carry; carry = Ahi * carry + Uhi; st[g] = hh ? s_hi : s_lo; pp *= Alo * Ahi; }
            hst[ct] = carry; Pst[ct] = pp;
            if (PASS == 2) {
#pragma unroll
                for (int g = 0; g < 4; ++g) { float hc = st[g];
#pragma unroll
                    for (int e = 0; e < 4; ++e) { const int r = 4 * g + e, tk = e + 8 * g + 4 * hh; hc = av[r] * hc + uv[r];
                        const float o = hc * gelu_tanh(bf1(*((const LAS bf16*)(gs + tk * 128) + cl)));
                        ssv[r] += o * o; *((LAS bf16*)(outs + tk * 128) + cl) = (bf16)f2bf(o); } }
            }
        }
        if (PASS == 2) {
            float* sq = F.SSQL() + (size_t)(b * SEQ + ts) * 8 + w;
#pragma unroll
            for (int r = 0; r < 16; ++r) { float v = ssv[r];
                v += __shfl_xor(v, 1); v += __shfl_xor(v, 2); v += __shfl_xor(v, 4); v += __shfl_xor(v, 8); v += __shfl_xor(v, 16);
                if (ql == 0) sq[((r & 3) + 8 * (r >> 2) + 4 * hh) * 8] = v; }
            LWAIT();
            bf16* cbase = F.CAT() + (size_t)(b * SEQ + ts) * DM + 64 * w;
#pragma unroll
            for (int i = 0; i < 4; ++i) { const int idx = lane + 64 * i, row = idx >> 3, ch = idx & 7; *(v4u*)(cbase + (size_t)row * DM + 8 * ch) = *(const LAS v4u*)(outs + row * 128 + 16 * ch); }
            LWAIT();
        }
    }
    if ((lane0 & 32) == 0) {
#pragma unroll
        for (int ct = 0; ct < 2; ++ct) { const int c = 64 * w + 32 * ct + (lane0 & 31);
            if (PASS == 1) *(f32x2_t*)(F.LSUM() + (((size_t)b * NCHUNK + chunk) * 512 + c) * 2) = (f32x2_t){Pst[ct], hst[ct]};
            if (PASS == 2 && chunk == NCHUNK - 1) F.out[O_PH + b * 512 + c] = hst[ct]; }
    }
}

constexpr int KS_STRIDE = 144, KS_KVH = 256 * KS_STRIDE;
constexpr int VT_STRIDE = 528, VT_KVH = 64 * VT_STRIDE;
constexpr int AT_KS = 0, AT_VT = 2 * KS_KVH, AT_END = AT_VT + 2 * VT_KVH;
static_assert(AT_END <= SCR_BYTES, "attention LDS");
__device__ __forceinline__ int vt_pos(int key) { const int o = key & 15; return (key & ~15) + 8 * ((o >> 2) & 1) + (o & 3) + 4 * (o >> 3); }
__device__ __forceinline__ void attn_prompt_item(Frame& F, int item) {
    const int b = item / (SEQ / WIN), blk = item % (SEQ / WIN);
    int tid_ = F.tid(); asm volatile("" : "+v"(tid_));
    const int tid = tid_, lane = tid & 63, w = F.wave;
    LAS unsigned char* Ks = F.lds + AT_KS; LAS unsigned char* Vt = F.lds + AT_VT;
    {
        const bool lastb = (blk == SEQ / WIN - 1);
        const float* kn = F.inp(I_KN);
        v4u kr[8];
#pragma unroll
        for (int i = 0; i < 8; ++i) { const int idx = tid + 512 * i, key = idx >> 4, cc = idx & 15, tb = blk * WIN - WIN + key;
            kr[i] = (v4u){0u, 0u, 0u, 0u}; if (tb >= 0) kr[i] = *(const v4u*)(F.PROJ() + (size_t)(b * SEQ + tb) * INW + C_K + 8 * cc); }
#pragma unroll
        for (int i = 0; i < 8; ++i) { const int idx = tid + 512 * i, key = idx >> 4, cc = idx & 15, kvh = cc >> 3, c = cc & 7, tb = blk * WIN - WIN + key, tbc = tb < 0 ? 0 : tb;
            float x[8] = {bflo(kr[i].x), bfhi(kr[i].x), bflo(kr[i].y), bfhi(kr[i].y), bflo(kr[i].z), bfhi(kr[i].z), bflo(kr[i].w), bfhi(kr[i].w)};
            float ss = 0.f;
#pragma unroll
            for (int j = 0; j < 8; ++j) ss += x[j] * x[j];
            ss += __shfl_xor(ss, 1); ss += __shfl_xor(ss, 2); ss += __shfl_xor(ss, 4);
            const float rs = __builtin_amdgcn_rsqf(ss * (1.0f / 64.0f) + EPS);
            const f32x4 g0 = *(const f32x4*)(kn + 8 * c), g1 = *(const f32x4*)(kn + 8 * c + 4);
            const f32x4 c0 = *(const f32x4*)(F.ROPEC() + (size_t)tbc * 32 + 8 * (c & 3)), c1 = *(const f32x4*)(F.ROPEC() + (size_t)tbc * 32 + 8 * (c & 3) + 4);
            const f32x4 s0 = *(const f32x4*)(F.ROPES() + (size_t)tbc * 32 + 8 * (c & 3)), s1 = *(const f32x4*)(F.ROPES() + (size_t)tbc * 32 + 8 * (c & 3) + 4);
            float o[8];
#pragma unroll
            for (int j = 0; j < 8; ++j) { const float xn = x[j] * rs * (j < 4 ? g0[j] : g1[j - 4]); const float other = __shfl_xor(xn, 4);
                const float cc2 = j < 4 ? c0[j] : c1[j - 4], sv = j < 4 ? s0[j] : s1[j - 4];
                o[j] = (c < 4) ? (xn * cc2 - other * sv) : (xn * cc2 + other * sv); }
            v4u w4; w4.x = cvtpk(o[0], o[1]); w4.y = cvtpk(o[2], o[3]); w4.z = cvtpk(o[4], o[5]); w4.w = cvtpk(o[6], o[7]);
            *(LAS v4u*)(Ks + kvh * KS_KVH + key * KS_STRIDE + 16 * c) = w4;
            if (lastb && key >= WIN) { float* ok = F.out + O_PK + ((size_t)(b * WIN + key - WIN) * NKV + kvh) * HD + 8 * c;
                *(f32x4*)(ok) = (f32x4){o[0], o[1], o[2], o[3]}; *(f32x4*)(ok + 4) = (f32x4){o[4], o[5], o[6], o[7]}; }
        }
        asm volatile("" ::: "memory");
        v4u vr[8];
#pragma unroll
        for (int i = 0; i < 8; ++i) { const int idx = tid + 512 * i, key = idx >> 4, cc = idx & 15, tb = blk * WIN - WIN + key;
            vr[i] = (v4u){0u, 0u, 0u, 0u}; if (tb >= 0) vr[i] = *(const v4u*)(F.PROJ() + (size_t)(b * SEQ + tb) * INW + C_V + 8 * cc); }
#pragma unroll
        for (int i = 0; i < 8; ++i) { const int idx = tid + 512 * i, key = idx >> 4, cc = idx & 15, kvh = cc >> 3, c = cc & 7;
            LAS bf16* vcol = (LAS bf16*)(Vt + kvh * VT_KVH) + (8 * c) * (VT_STRIDE / 2) + vt_pos(key);
            const unsigned q4[4] = {vr[i].x, vr[i].y, vr[i].z, vr[i].w};
#pragma unroll
            for (int e = 0; e < 4; ++e) { vcol[(2 * e) * (VT_STRIDE / 2)] = (bf16)(q4[e] & 0xffffu); vcol[(2 * e + 1) * (VT_STRIDE / 2)] = (bf16)(q4[e] >> 16); }
            if (lastb && key >= WIN) { float* ov = F.out + O_PV + ((size_t)(b * WIN + key - WIN) * NKV + kvh) * HD + 8 * c;
                *(f32x4*)(ov) = (f32x4){bflo(vr[i].x), bfhi(vr[i].x), bflo(vr[i].y), bfhi(vr[i].y)}; *(f32x4*)(ov + 4) = (f32x4){bflo(vr[i].z), bfhi(vr[i].z), bflo(vr[i].w), bfhi(vr[i].w)}; }
        }
    }
    __syncthreads();
    const int hh = lane >> 5, ql = lane & 31, kvh = w >> 2;
    const float sinkl2 = F.inp(I_SINK)[w] * LOG2E;
    const float QS = 0.125f * LOG2E;
    const float* qn = F.inp(I_QN);
    for (int s = 0; s < 4; ++s) {
        const int qi = 32 * s + ql, t = blk * WIN + qi; const size_t row = (size_t)b * SEQ + t;
        bf16x8 qf[4];
        {
            const bf16* qp = F.PROJ() + row * INW + C_Q + w * 64 + 8 * hh;
            float qv[4][8]; float ss = 0.f;
#pragma unroll
            for (int ds = 0; ds < 4; ++ds) { const v4u r4 = *(const v4u*)(qp + 16 * ds);
                qv[ds][0] = bflo(r4.x); qv[ds][1] = bfhi(r4.x); qv[ds][2] = bflo(r4.y); qv[ds][3] = bfhi(r4.y); qv[ds][4] = bflo(r4.z); qv[ds][5] = bfhi(r4.z); qv[ds][6] = bflo(r4.w); qv[ds][7] = bfhi(r4.w); }
#pragma unroll
            for (int ds = 0; ds < 4; ++ds)
#pragma unroll
                for (int j = 0; j < 8; ++j) ss += qv[ds][j] * qv[ds][j];
            ss += __shfl_xor(ss, 32);
            const float rs = __builtin_amdgcn_rsqf(ss * (1.0f / 64.0f) + EPS);
            const float* cs = F.ROPEC() + (size_t)t * 32; const float* sn = F.ROPES() + (size_t)t * 32;
#pragma unroll
            for (int ds = 0; ds < 2; ++ds)
#pragma unroll
                for (int j = 0; j < 8; ++j) { const int i = 16 * ds + 8 * hh + j; const float x1 = qv[ds][j] * rs * qn[i], x2 = qv[ds + 2][j] * rs * qn[i + 32], cc = cs[i], sv = sn[i];
                    qv[ds][j] = (x1 * cc - x2 * sv) * QS; qv[ds + 2][j] = (x2 * cc + x1 * sv) * QS; }
#pragma unroll
            for (int ds = 0; ds < 4; ++ds) { v4u o; o.x = cvtpk(qv[ds][0], qv[ds][1]); o.y = cvtpk(qv[ds][2], qv[ds][3]); o.z = cvtpk(qv[ds][4], qv[ds][5]); o.w = cvtpk(qv[ds][6], qv[ds][7]); qf[ds] = __builtin_bit_cast(bf16x8, o); }
        }
        f32x16 p[5];
#pragma unroll
        for (int kt = 0; kt < 5; ++kt) {
            const LAS unsigned char* kp = Ks + kvh * KS_KVH + (32 * (s + kt) + ql) * KS_STRIDE + 16 * hh;
            f32x16 acc = {0.f, 0.f, 0.f, 0.f, 0.f, 0.f, 0.f, 0.f, 0.f, 0.f, 0.f, 0.f, 0.f, 0.f, 0.f, 0.f};
#pragma unroll
            for (int ds = 0; ds < 4; ++ds) { const bf16x8 kfr = *(const LAS bf16x8*)(kp + 32 * ds); acc = __builtin_amdgcn_mfma_f32_32x32x16_bf16(kfr, qf[ds], acc, 0, 0, 0); }
            p[kt] = acc;
        }
        float mx = -INFINITY;
#pragma unroll
        for (int kt = 0; kt < 5; ++kt) {
            if (kt == 0 || kt == 4 || blk == 0) {
#pragma unroll
                for (int r = 0; r < 16; ++r) { const int kj = 32 * (s + kt) + (r & 3) + 8 * (r >> 2) + 4 * hh;
                    const bool valid = (kj > qi) && (kj <= qi + WIN) && (blk > 0 || kj >= WIN);
                    const float v = valid ? p[kt][r] : -INFINITY; p[kt][r] = v; mx = fmaxf(mx, v); }
            } else {
#pragma unroll
                for (int r = 0; r < 16; ++r) mx = fmaxf(mx, p[kt][r]);
            }
        }
        mx = fmaxf(mx, __shfl_xor(mx, 32)); mx = fmaxf(mx, sinkl2);
        float sum = 0.f;
#pragma unroll
        for (int kt = 0; kt < 5; ++kt)
#pragma unroll
            for (int r = 0; r < 16; ++r) { const float e = __builtin_amdgcn_exp2f(p[kt][r] - mx); p[kt][r] = e; sum += e; }
        sum += __shfl_xor(sum, 32);
        const float inv = __builtin_amdgcn_rcpf(sum + __builtin_amdgcn_exp2f(sinkl2 - mx));
        f32x16 o0 = {0.f, 0.f, 0.f, 0.f, 0.f, 0.f, 0.f, 0.f, 0.f, 0.f, 0.f, 0.f, 0.f, 0.f, 0.f, 0.f}, o1 = o0;
#pragma unroll
        for (int kt = 0; kt < 5; ++kt)
#pragma unroll
            for (int ss2 = 0; ss2 < 2; ++ss2) {
                v4u pw; pw.x = cvtpk(p[kt][8 * ss2 + 0], p[kt][8 * ss2 + 1]); pw.y = cvtpk(p[kt][8 * ss2 + 2], p[kt][8 * ss2 + 3]); pw.z = cvtpk(p[kt][8 * ss2 + 4], p[kt][8 * ss2 + 5]); pw.w = cvtpk(p[kt][8 * ss2 + 6], p[kt][8 * ss2 + 7]);
                const bf16x8 pf = __builtin_bit_cast(bf16x8, pw);
                const LAS unsigned char* vp = Vt + kvh * VT_KVH + ql * VT_STRIDE + (16 * (2 * (s + kt) + ss2) + 8 * hh) * 2;
                const bf16x8 v0 = *(const LAS bf16x8*)(vp), v1 = *(const LAS bf16x8*)(vp + 32 * VT_STRIDE);
                o0 = __builtin_amdgcn_mfma_f32_32x32x16_bf16(v0, pf, o0, 0, 0, 0);
                o1 = __builtin_amdgcn_mfma_f32_32x32x16_bf16(v1, pf, o1, 0, 0, 0);
            }
        float hsq = 0.f;
#pragma unroll
        for (int r = 0; r < 16; ++r) { o0[r] *= inv; o1[r] *= inv; hsq += o0[r] * o0[r] + o1[r] * o1[r]; }
        hsq += __shfl_xor(hsq, 32);
        if (hh == 0) F.SSQA()[row * 8 + w] = hsq;
        bf16* crow = F.CAT() + row * DM + 512 + w * 64;
#pragma unroll
        for (int g = 0; g < 4; ++g) { const int d0 = 8 * g + 4 * hh;
            v2u a, c2; a.x = cvtpk(o0[4 * g], o0[4 * g + 1]); a.y = cvtpk(o0[4 * g + 2], o0[4 * g + 3]);
            c2.x = cvtpk(o1[4 * g], o1[4 * g + 1]); c2.y = cvtpk(o1[4 * g + 2], o1[4 * g + 3]);
            *(v2u*)(crow + d0) = a; *(v2u*)(crow + 32 + d0) = c2; }
    }
    __syncthreads();
}

__device__ __forceinline__ void sample_lru_item(Frame& F, int b) {
    int tid_ = F.tid(); asm volatile("" : "+v"(tid_));
    const int tid = tid_, lane = tid & 63, w = F.wave;
    const size_t row0 = (size_t)MP + (size_t)b * DEC_T;
    {
        const int c = tid, blk = w, cj = c & 63;
        LAS float* xcs = (LAS float*)F.lds;
        LAS float* red = xcs + 4 * 512;
        const float cw0 = F.inp(I_CW)[c], cw1 = F.inp(I_CW)[512 + c], cw2 = F.inp(I_CW)[1024 + c], cw3 = F.inp(I_CW)[1536 + c], cb = F.inp(I_CB)[c];
        const float lam = F.inp(I_LAM)[c];
        const float c8 = -8.0f * (fmaxf(-lam, 0.f) + log1pf(expf(-fabsf(lam))));
        float xs[7];
#pragma unroll
        for (int j = 0; j < 3; ++j) xs[j] = F.inp(I_SC)[((size_t)b * 3 + j) * 512 + c];
#pragma unroll
        for (int t = 0; t < 4; ++t) xs[3 + t] = bf1(F.PROJ()[(row0 + t) * INW + c]);
#pragma unroll
        for (int t = 0; t < 4; ++t) xcs[t * 512 + c] = cb + cw0 * xs[t] + cw1 * xs[t + 1] + cw2 * xs[t + 2] + cw3 * xs[t + 3];
        __syncthreads();
        float rp[4], ip[4];
#pragma unroll
        for (int t = 0; t < 4; ++t) { rp[t] = F.inp(I_BA)[c]; ip[t] = F.inp(I_BX)[c]; }
        const float* wap = F.inp(I_WA) + (size_t)(blk * 64) * 64 + cj; const float* wxp = F.inp(I_WX) + (size_t)(blk * 64) * 64 + cj;
#pragma unroll 16
        for (int k = 0; k < 64; ++k) { const float wa = wap[k * 64], wx = wxp[k * 64];
#pragma unroll
            for (int t = 0; t < 4; ++t) { const float xv = xcs[t * 512 + blk * 64 + k]; rp[t] += xv * wa; ip[t] += xv * wx; } }
        float h = F.inp(I_SH)[(size_t)b * 512 + c]; float ov[4];
#pragma unroll
        for (int t = 0; t < 4; ++t) {
            const float r = sigmoid_f(rp[t]), ig = sigmoid_f(ip[t]);
            const float la = c8 * r, a = __builtin_amdgcn_exp2f(la * LOG2E);
            const float mult = __builtin_amdgcn_sqrtf(one_minus_exp(2.0f * la));
            h = a * h + mult * ig * xcs[t * 512 + c];
            const float g = bf1(F.PROJ()[(row0 + t) * INW + C_GATE + c]);
            ov[t] = h * gelu_tanh(g);
            const float s = wave_sum(ov[t] * ov[t]); if (lane == 0) red[t * 8 + w] = s;
        }
        F.out[O_SH + (size_t)b * 512 + c] = h;
#pragma unroll
        for (int j = 0; j < 3; ++j) F.out[O_SC + ((size_t)b * 3 + j) * 512 + c] = xs[4 + j];
        __syncthreads();
#pragma unroll
        for (int t = 0; t < 4; ++t) { float s = 0.f;
#pragma unroll
            for (int w2 = 0; w2 < 8; ++w2) s += red[t * 8 + w2];
            F.CAT()[(row0 + t) * DM + c] = (bf16)f2bf(ov[t] * __builtin_amdgcn_rsqf(s * (1.0f / 512.0f) + EPS)); }
        __syncthreads();
    }
}
constexpr int SA_KROW = 68, SA_KC = 0, SA_VC = 132 * SA_KROW * 4, SA_QS = SA_VC + 132 * 64 * 4, SA_END = SA_QS + 8 * 64 * 4;
__device__ __forceinline__ void sample_attn_item(Frame& F, int b, int kvh) {
    int tid_ = F.tid(); asm volatile("" : "+v"(tid_));
    const int tid = tid_, lane = tid & 63, w = F.wave;
    const size_t row0 = (size_t)MP + (size_t)b * DEC_T;
    LAS float* Kc = (LAS float*)(F.lds + SA_KC); LAS float* Vc = (LAS float*)(F.lds + SA_VC); LAS float* qs = (LAS float*)(F.lds + SA_QS);
    {
        const float* ck = F.inp(I_CK) + (size_t)b * WIN * 128 + kvh * 64; const float* cv = F.inp(I_CV) + (size_t)b * WIN * 128 + kvh * 64;
        float* ok = F.out + O_SK + (size_t)b * WIN * 128 + kvh * 64; float* ov = F.out + O_SV + (size_t)b * WIN * 128 + kvh * 64;
#pragma unroll
        for (int i = 0; i < 4; ++i) { const int idx = tid + 512 * i, j = idx >> 4, d4 = (idx & 15) * 4;
            const f32x4 kv = *(const f32x4*)(ck + (size_t)j * 128 + d4), vv = *(const f32x4*)(cv + (size_t)j * 128 + d4);
            *(LAS f32x4*)(Kc + j * SA_KROW + d4) = kv; *(LAS f32x4*)(Vc + j * 64 + d4) = vv;
            if (j >= DEC_T) { *(f32x4*)(ok + (size_t)(j - DEC_T) * 128 + d4) = kv; *(f32x4*)(ov + (size_t)(j - DEC_T) * 128 + d4) = vv; } }
        if (w < DEC_T) {
            const int t = w, i = lane & 31;
            const bf16* pr = F.PROJ() + (row0 + t) * INW;
            const float k1 = bf1(pr[C_K + kvh * 64 + i]), k2 = bf1(pr[C_K + kvh * 64 + 32 + i]);
            float ss = k1 * k1 + k2 * k2;
#pragma unroll
            for (int o = 1; o < 32; o <<= 1) ss += __shfl_xor(ss, o);
            const float rs = __builtin_amdgcn_rsqf(ss * (1.0f / 64.0f) + EPS);
            const float x1 = k1 * rs * F.inp(I_KN)[i], x2 = k2 * rs * F.inp(I_KN)[i + 32];
            const float cc = F.ROPEC()[(size_t)(SEQ + t) * 32 + i], sv = F.ROPES()[(size_t)(SEQ + t) * 32 + i];
            const float o1 = x1 * cc - x2 * sv, o2 = x2 * cc + x1 * sv;
            const float v1 = bf1(pr[C_V + kvh * 64 + i]), v2 = bf1(pr[C_V + kvh * 64 + 32 + i]);
            if (lane < 32) {
                Kc[(WIN + t) * SA_KROW + i] = o1; Kc[(WIN + t) * SA_KROW + 32 + i] = o2; Vc[(WIN + t) * 64 + i] = v1; Vc[(WIN + t) * 64 + 32 + i] = v2;
                const size_t oo = (size_t)(WIN - DEC_T + t) * 128;
                ok[oo + i] = o1; ok[oo + 32 + i] = o2; ov[oo + i] = v1; ov[oo + 32 + i] = v2; }
        }
    }
    __syncthreads();
    const int head = kvh * 4 + (w & 3);
    const float sinkl2 = F.inp(I_SINK)[head] * LOG2E;
#pragma unroll
    for (int tt = 0; tt < 2; ++tt) {
        const int t = 2 * (w >> 2) + tt;
        {
            const float x = bf1(F.PROJ()[(row0 + t) * INW + C_Q + head * 64 + lane]);
            const float ss = wave_sum(x * x);
            const float xn = x * __builtin_amdgcn_rsqf(ss * (1.0f / 64.0f) + EPS) * F.inp(I_QN)[lane];
            const float other = __shfl_xor(xn, 32);
            const int i = lane & 31; const float cc = F.ROPEC()[(size_t)(SEQ + t) * 32 + i], sv = F.ROPES()[(size_t)(SEQ + t) * 32 + i];
            const float qo = (lane < 32) ? (xn * cc - other * sv) : (xn * cc + other * sv);
            qs[w * 64 + lane] = qo * (0.125f * LOG2E);
        }
        LDS_WAIT(); asm volatile("" ::: "memory");
        const int j0 = t + 1 + lane, j1 = j0 + 64;
        float s0 = 0.f, s1 = 0.f;
        const LAS f32x4* q4 = (const LAS f32x4*)(qs + w * 64);
        const LAS f32x4* k0 = (const LAS f32x4*)(Kc + j0 * SA_KROW); const LAS f32x4* k1 = (const LAS f32x4*)(Kc + j1 * SA_KROW);
#pragma unroll
        for (int d4 = 0; d4 < 16; ++d4) { const f32x4 q = q4[d4], a = k0[d4], c = k1[d4];
            s0 += q[0] * a[0] + q[1] * a[1] + q[2] * a[2] + q[3] * a[3]; s1 += q[0] * c[0] + q[1] * c[1] + q[2] * c[2] + q[3] * c[3]; }
        float mx = wave_max(fmaxf(s0, s1)); mx = fmaxf(mx, sinkl2);
        const float p0 = __builtin_amdgcn_exp2f(s0 - mx), p1 = __builtin_amdgcn_exp2f(s1 - mx);
        const float l = wave_sum(p0 + p1) + __builtin_amdgcn_exp2f(sinkl2 - mx);
        float o = 0.f;
#pragma unroll 8
        for (int jj = 0; jj < 64; ++jj) { const float pa = __shfl(p0, jj), pb = __shfl(p1, jj); o += pa * Vc[(t + 1 + jj) * 64 + lane] + pb * Vc[(t + 65 + jj) * 64 + lane]; }
        o *= __builtin_amdgcn_rcpf(l);
        F.SOA()[((size_t)b * DEC_T + t) * 512 + head * 64 + lane] = o;
        const float hq = wave_sum(o * o); if (lane == 0) F.SSQS()[((size_t)b * DEC_T + t) * 8 + head] = hq;
    }
    __syncthreads();
}
__device__ __forceinline__ void sample_attn_norm(Frame& F) {
    const int lane = F.lane(), gw = blockIdx.x * NWAVES + F.wave;
    for (int r = gw; r < MS; r += F.G * NWAVES) {
        const f32x4* sp = (const f32x4*)(F.SSQS() + (size_t)r * 8); const f32x4 s0 = sp[0], s1 = sp[1];
        const float rs = __builtin_amdgcn_rsqf((((s0[0] + s0[1]) + (s0[2] + s0[3])) + ((s1[0] + s1[1]) + (s1[2] + s1[3]))) * (1.0f / 512.0f) + EPS);
        const f32x4* op = (const f32x4*)(F.SOA() + (size_t)r * 512 + lane * 8); const f32x4 a = op[0], c = op[1];
        v4u o; o.x = cvtpk(a[0] * rs, a[1] * rs); o.y = cvtpk(a[2] * rs, a[3] * rs); o.z = cvtpk(c[0] * rs, c[1] * rs); o.w = cvtpk(c[2] * rs, c[3] * rs);
        *(v4u*)(F.CAT() + ((size_t)MP + r) * DM + 512 + lane * 8) = o;
    }
}

struct SEpiSwiglu {
    bf16* H; const float* ssq;
    __device__ __forceinline__ int brow0(int cb) const { const int hc0 = 32 * cb; return (hc0 >> 7) * 256 + (hc0 & 127); }
    __device__ __forceinline__ int brow1(int cb) const { return brow0(cb) + 128; }
    __device__ __forceinline__ void operator()(const f32x16& a0, const f32x16& a1, int r, int cb, int h) const {
        const float rs = pg8::row_rs(ssq, r);
#pragma unroll
        for (int g = 0; g < 4; ++g) { float hv[4];
#pragma unroll
            for (int e = 0; e < 4; ++e) hv[e] = pg8::silu_f(a0[4 * g + e] * rs) * (a1[4 * g + e] * rs);
            v2u w; w.x = cvtpk(hv[0], hv[1]); w.y = cvtpk(hv[2], hv[3]); *(v2u*)(H + (size_t)r * DFF + 32 * cb + 8 * g + 4 * h) = w; }
    }
};
struct SEpiScale {
    bf16* O; int ldc; const float* ssq;
    __device__ __forceinline__ int brow0(int cb) const { return 64 * cb; }
    __device__ __forceinline__ int brow1(int cb) const { return 64 * cb + 32; }
    __device__ __forceinline__ void operator()(const f32x16& a0, const f32x16& a1, int r, int cb, int h) const {
        const float rs = pg8::row_rs(ssq, r);
#pragma unroll
        for (int g = 0; g < 4; ++g) {
            v2u w; w.x = cvtpk(a0[4 * g] * rs, a0[4 * g + 1] * rs); w.y = cvtpk(a0[4 * g + 2] * rs, a0[4 * g + 3] * rs); *(v2u*)(O + (size_t)r * ldc + 64 * cb + 8 * g + 4 * h) = w;
            v2u x; x.x = cvtpk(a1[4 * g] * rs, a1[4 * g + 1] * rs); x.y = cvtpk(a1[4 * g + 2] * rs, a1[4 * g + 3] * rs); *(v2u*)(O + (size_t)r * ldc + 64 * cb + 32 + 8 * g + 4 * h) = x; }
    }
};
template <int MODE> struct SEpiResid {
    const float* basef; float* out; bf16* xb; float* ssq; float scale;
    __device__ __forceinline__ int brow0(int cb) const { return 64 * cb; }
    __device__ __forceinline__ int brow1(int cb) const { return 64 * cb + 32; }
    __device__ __forceinline__ void operator()(const f32x16& a0, const f32x16& a1, int r, int cb, int h) const {
        float s = 0.f;
#pragma unroll
        for (int a = 0; a < 2; ++a)
#pragma unroll
            for (int g = 0; g < 4; ++g) { const size_t off = (size_t)r * DM + 64 * cb + 32 * a + 8 * g + 4 * h;
                f32x4 b; if (MODE == 0) b = *(const f32x4*)(basef + off); else b = pg8::bf4_to_f32(*(const v2u*)(xb + off));
                const f32x4 v = a == 0 ? (f32x4){a0[4 * g], a0[4 * g + 1], a0[4 * g + 2], a0[4 * g + 3]} : (f32x4){a1[4 * g], a1[4 * g + 1], a1[4 * g + 2], a1[4 * g + 3]};
                const f32x4 o = b + v * scale;
                if (MODE == 2) *(f32x4*)(out + off) = o;
                else { s += (o[0] * o[0] + o[1] * o[1]) + (o[2] * o[2] + o[3] * o[3]); v2u w; w.x = cvtpk(o[0], o[1]); w.y = cvtpk(o[2], o[3]); *(v2u*)(xb + off) = w; } }
        if (MODE != 2) { s += __shfl_xor(s, 32); if (h == 0) ssq[(size_t)r * 16 + cb] = s; }
    }
};
constexpr int SG_ROWB = 144, SG_TILE = 32 * SG_ROWB, SG_WAVE = 3 * SG_TILE;
static_assert(8 * SG_WAVE <= SCR_BYTES, "small gemm LDS");
template <int K, int KS, class Epi> __device__ __forceinline__ void small_gemm(Frame& F, const bf16* A, int lda, const bf16* Bt, int ncb, const Epi& E) {
    int lane_ = F.lane(); asm volatile("" : "+v"(lane_));
    const int lane = lane_, w = F.wave, ql = lane & 31, h = lane >> 5, lr = lane >> 3, ch = lane & 7;
    const int nitems = 16 * ncb * KS;
    constexpr int NBT = K / 64, NB_LO = NBT / KS, NB_REM = NBT % KS;
    LAS unsigned char* tl = F.lds + w * SG_WAVE;
    LAS float* red = (LAS float*)F.lds;
    for (int base = blockIdx.x * NWAVES; base < nitems; base += F.G * NWAVES) {
        const int it = base + w; const bool valid = it < nitems;
        const int tile = it / KS, ks = it % KS, rb = tile & 15, cb = tile >> 4;
        f32x16 acc0 = {0.f, 0.f, 0.f, 0.f, 0.f, 0.f, 0.f, 0.f, 0.f, 0.f, 0.f, 0.f, 0.f, 0.f, 0.f, 0.f}, acc1 = acc0;
        const int r = MP + 32 * rb + ql;
        if (valid) {
            const int nb = NB_LO + (ks < NB_REM ? 1 : 0), kb0 = 64 * (ks * NB_LO + (ks < NB_REM ? ks : NB_REM));
            const bf16* ga = A + (size_t)(MP + 32 * rb + lr) * lda + kb0 + 8 * ch;
            const bf16* g0 = Bt + (size_t)(E.brow0(cb) + lr) * K + kb0 + 8 * ch;
            const bf16* g1 = Bt + (size_t)(E.brow1(cb) + lr) * K + kb0 + 8 * ch;
            v4u ra[4], r0[4], r1[4], sa[4], s0[4], s1[4];
#define SG_LD1(dst, ptr) asm volatile("global_load_dwordx4 %0, %1, off" : "=v"(dst) : "v"(ptr) : "memory")
#define SG_FETCH(RA, R0, R1, bb) do { _Pragma("unroll") for (int i = 0; i < 4; ++i) { SG_LD1(RA[i], ga + (size_t)(8 * i) * lda + 64 * (bb)); SG_LD1(R0[i], g0 + (size_t)(8 * i) * K + 64 * (bb)); SG_LD1(R1[i], g1 + (size_t)(8 * i) * K + 64 * (bb)); } } while (0)
#define SG_WAIT(N, RA, R0, R1) asm volatile("s_waitcnt vmcnt(" #N ")" : "+v"(RA[0]), "+v"(RA[1]), "+v"(RA[2]), "+v"(RA[3]), "+v"(R0[0]), "+v"(R0[1]), "+v"(R0[2]), "+v"(R0[3]), "+v"(R1[0]), "+v"(R1[1]), "+v"(R1[2]), "+v"(R1[3]) :: "memory")
#define SG_PARK(RA, R0, R1) do { _Pragma("unroll") for (int i = 0; i < 4; ++i) { const int off = (lr + 8 * i) * SG_ROWB + 16 * ch; *(LAS v4u*)(tl + off) = RA[i]; *(LAS v4u*)(tl + SG_TILE + off) = R0[i]; *(LAS v4u*)(tl + 2 * SG_TILE + off) = R1[i]; } } while (0)
#define SG_MMA() do { _Pragma("unroll") for (int sI = 0; sI < 4; ++sI) { const int fo = ql * SG_ROWB + 32 * sI + 16 * h; \
                    const bf16x8 af = *(const LAS bf16x8*)(tl + fo), bf0 = *(const LAS bf16x8*)(tl + SG_TILE + fo), bf1v = *(const LAS bf16x8*)(tl + 2 * SG_TILE + fo); \
                    acc0 = __builtin_amdgcn_mfma_f32_32x32x16_bf16(bf0, af, acc0, 0, 0, 0); acc1 = __builtin_amdgcn_mfma_f32_32x32x16_bf16(bf1v, af, acc1, 0, 0, 0); } } while (0)
            asm volatile("s_waitcnt vmcnt(0)" ::: "memory");
            SG_FETCH(ra, r0, r1, 0);
            if (nb > 1) SG_FETCH(sa, s0, s1, 1);
            int b = 0;
            for (; b + 3 < nb; b += 2) {
                SG_WAIT(12, ra, r0, r1); SG_PARK(ra, r0, r1); SG_FETCH(ra, r0, r1, b + 2); SG_MMA();
                SG_WAIT(12, sa, s0, s1); SG_PARK(sa, s0, s1); SG_FETCH(sa, s0, s1, b + 3); SG_MMA();
            }
            SG_WAIT(0, ra, r0, r1); if (b + 1 < nb) SG_WAIT(0, sa, s0, s1);
            SG_PARK(ra, r0, r1); if (b + 2 < nb) SG_FETCH(ra, r0, r1, b + 2); SG_MMA();
            if (b + 1 < nb) { SG_PARK(sa, s0, s1); SG_MMA(); }
            if (b + 2 < nb) { SG_WAIT(0, ra, r0, r1); SG_PARK(ra, r0, r1); SG_MMA(); }
#undef SG_LD1
#undef SG_FETCH
#undef SG_WAIT
#undef SG_PARK
#undef SG_MMA
        }
        if (KS > 1) {
            __syncthreads();
#pragma unroll
            for (int q = 0; q < 16; ++q) { red[((w * 2 + 0) * 16 + q) * 64 + lane] = acc0[q]; red[((w * 2 + 1) * 16 + q) * 64 + lane] = acc1[q]; }
            __syncthreads();
            if (valid && ks == 0) {
#pragma unroll
                for (int j = 1; j < KS; ++j)
#pragma unroll
                    for (int q = 0; q < 16; ++q) { acc0[q] += red[(((w + j) * 2 + 0) * 16 + q) * 64 + lane]; acc1[q] += red[(((w + j) * 2 + 1) * 16 + q) * 64 + lane]; }
            }
        }
        if (valid && ks == 0) E(acc0, acc1, r, cb, h);
        if (KS > 1) __syncthreads();
    }
}

#ifndef MK_N_LAUNCHES
#define MK_N_LAUNCHES 1
#endif
constexpr int N_PHASES = 9;
constexpr int N_LAUNCHES = MK_N_LAUNCHES;
struct Args { const float* in[29]; float* out; unsigned char* ws; int ph_lo, ph_hi, li, pad; };
__global__ void __launch_bounds__(NWAVES * 64, 2) hymba_fwd(Args args) {
    extern __shared__ __attribute__((aligned(16))) unsigned char lds[];
    Frame F;
    F.lds = (LAS unsigned char*)lds;
    F.MISC = (volatile LAS unsigned*)(F.lds + MISC_OFF);
    F.wave = __builtin_amdgcn_readfirstlane((int)threadIdx.x >> 6);
    F.G = gridDim.x; { const int bx = blockIdx.x; F.vcu = (F.G % 8 == 0) ? (bx % 8) * (F.G / 8) + bx / 8 : bx; }
    F.kp = (kernarg_ptr)__builtin_amdgcn_kernarg_segment_ptr(); F.out = args.out; F.ws = args.ws;
    for (int u = F.tid(); u < (LDS_BYTES - LDSCTL_OFF) / 4; u += NWAVES * 64) ((LAS unsigned*)(F.lds + LDSCTL_OFF))[u] = 0u;
    __syncthreads();
    XcdBarrier bar; bar.bar = (unsigned*)(F.ctl() + CW_BAR); bar.x = 0; bar.st = nullptr;
    if (N_LAUNCHES == 1) bar = xcd_barrier_post((unsigned*)(F.ctl() + CW_BAR), F.MISC + 8, F.tid() == 0);
#define GRID_BAR() do { if (N_LAUNCHES == 1) xcd_barrier(bar, F.tid() == 0); } while (0)
    const int lo = args.ph_lo, hi = args.ph_hi;
#define IN(k) (lo <= (k) && (k) < hi)
#ifndef PROBE_PHASE
#define PROBE_PHASE -1
#endif
    unsigned long long tsA = 0, tsB = 0; pg8::Tm tm{0, 0};
#define STAMP(k) do { if (PROBE_PHASE >= 0 && PROBE_WHICH == 0) { if ((k) == PROBE_PHASE) tsA = __builtin_amdgcn_s_memrealtime(); if ((k) == PROBE_PHASE + 1) tsB = __builtin_amdgcn_s_memrealtime(); } } while (0)
#define BOTH(k) (IN(k) && IN((k) + 1))
#ifndef PROBE_REP
#define PROBE_REP 0
#endif
#define REP(k) for (int rep_ = 0; rep_ < (((PROBE_REP >> (k)) & 1) ? 2 : 1); ++rep_)

#ifndef SKIP_P0
#undef CURPH
#define CURPH 0
    STAMP(0);
    if (IN(0)) REP(0) { p0_prologue(F); if (BOTH(0)) GRID_BAR(); }
#endif
#undef CURPH
#define CURPH 1
    STAMP(1);
    if (IN(1)) REP(1) {
        pg8::Gemm g{F.XB(), F.WGU1(), MP, 2 * DFF, DM}; pg8::StaticOrder S; S.init(MP, 2 * DFF, F.G, (int)blockIdx.x);
        pg8::EpiSwiglu E{F.HB(), DFF}; pg8::rs_cache_fill(F.lds + RING_OFF, S, F.SSQ(), F.wave);
        pg8::gemm_phase<pg8::EpiSwiglu, pg8::StaticOrder, true, true>(F.lds + RING_OFF, g, S, E, F.wave, tm);
        if (PROBE_WHICH != 0 && PROBE_PHASE == 1) { tsA = 0; tsB = (PROBE_WHICH == 1) ? tm.k : tm.e; } tm.k = 0; tm.e = 0;
        { const unsigned long long ts0_ = (PROBE_WHICH == 3) ? __builtin_amdgcn_s_memrealtime() : 0ull;
        { SEpiSwiglu SE{F.HB(), F.SSQ()}; small_gemm<DM, 1, SEpiSwiglu>(F, F.XB(), DM, F.WGU1(), DFF / 32, SE); }
          if (PROBE_WHICH == 3 && PROBE_PHASE == CURPH) { asm volatile("s_waitcnt vmcnt(0)" ::: "memory"); tsA = ts0_; tsB = __builtin_amdgcn_s_memrealtime(); } }
        if (BOTH(1)) GRID_BAR();
    }
#undef CURPH
#define CURPH 2
    STAMP(2);
    if (IN(2)) REP(2) {
        pg8::Gemm g{F.HB(), F.WD1(), MP, DM, DFF}; pg8::StaticOrder S; S.init(MP, DM, F.G, (int)blockIdx.x);
        pg8::EpiResid<1> E{nullptr, nullptr, F.XB(), F.SSQ(), 0.5f};
        pg8::gemm_phase<pg8::EpiResid<1>, pg8::StaticOrder, true, true>(F.lds + RING_OFF, g, S, E, F.wave, tm);
        if (PROBE_WHICH != 0 && PROBE_PHASE == 2) { tsA = 0; tsB = (PROBE_WHICH == 1) ? tm.k : tm.e; } tm.k = 0; tm.e = 0;
        { const unsigned long long ts0_ = (PROBE_WHICH == 3) ? __builtin_amdgcn_s_memrealtime() : 0ull;
        { SEpiResid<1> SE{nullptr, nullptr, F.XB(), F.SSQ(), 0.5f}; small_gemm<DFF, 8, SEpiResid<1>>(F, F.HB(), DFF, F.WD1(), DM / 64, SE); }
          if (PROBE_WHICH == 3 && PROBE_PHASE == CURPH) { asm volatile("s_waitcnt vmcnt(0)" ::: "memory"); tsA = ts0_; tsB = __builtin_amdgcn_s_memrealtime(); } }
        if (BOTH(2)) GRID_BAR();
    }
#undef CURPH
#define CURPH 3
    STAMP(3);
    if (IN(3)) REP(3) {
        pg8::Gemm g{F.XB(), F.WINT(), MP, INW, DM}; pg8::StaticOrder S; S.init(MP, INW, F.G, (int)blockIdx.x);
        pg8::EpiScaleBf16 E{F.PROJ(), INW}; pg8::rs_cache_fill(F.lds + RING_OFF, S, F.SSQ(), F.wave);
        pg8::gemm_phase<pg8::EpiScaleBf16, pg8::StaticOrder, true, true>(F.lds + RING_OFF, g, S, E, F.wave, tm);
        if (PROBE_WHICH != 0 && PROBE_PHASE == 3) { tsA = 0; tsB = (PROBE_WHICH == 1) ? tm.k : tm.e; } tm.k = 0; tm.e = 0;
        { const unsigned long long ts0_ = (PROBE_WHICH == 3) ? __builtin_amdgcn_s_memrealtime() : 0ull;
        { SEpiScale SE{F.PROJ(), INW, F.SSQ()}; small_gemm<DM, 4, SEpiScale>(F, F.XB(), DM, F.WINT(), INW / 64, SE); }
          if (PROBE_WHICH == 3 && PROBE_PHASE == CURPH) { asm volatile("s_waitcnt vmcnt(0)" ::: "memory"); tsA = ts0_; tsB = __builtin_amdgcn_s_memrealtime(); } }
        if (BOTH(3)) GRID_BAR();
    }
#undef CURPH
#define CURPH 4
    STAMP(4);
    if (IN(4)) REP(4) {
#ifndef SKIP_ATTN
        if (PROBE_WHICH == 4 && PROBE_PHASE == 4) tsA = __builtin_amdgcn_s_memrealtime();
        REP(8) for (int it = blockIdx.x; it < BATCH * (SEQ / WIN); it += F.G) attn_prompt_item(F, it);
#endif
        if (PROBE_WHICH == 4 && PROBE_PHASE == 4) tsB = __builtin_amdgcn_s_memrealtime();
        if (PROBE_WHICH == 5 && PROBE_PHASE == 4) tsA = __builtin_amdgcn_s_memrealtime();
#ifndef SKIP_LRU1
        REP(9) for (int it = blockIdx.x; it < BATCH * NCHUNK; it += F.G) lru_prompt_item<1>(F, it);
#endif
#ifndef SKIP_SAMPLE
        __syncthreads();
        if (PROBE_WHICH == 5 && PROBE_PHASE == 4) tsB = __builtin_amdgcn_s_memrealtime();
        if (PROBE_WHICH == 6 && PROBE_PHASE == 4) tsA = __builtin_amdgcn_s_memrealtime();
        REP(10) for (int it = blockIdx.x; it < 3 * DEC_B; it += F.G) { if (it < DEC_B) sample_lru_item(F, it); else sample_attn_item(F, (it - DEC_B) >> 1, (it - DEC_B) & 1); }
#endif
        if (PROBE_WHICH == 6 && PROBE_PHASE == 4) tsB = __builtin_amdgcn_s_memrealtime();
        if (PROBE_WHICH == 7 && PROBE_PHASE == 4) tsA = __builtin_amdgcn_s_memrealtime();
        if (BOTH(4)) GRID_BAR();
        if (PROBE_WHICH == 7 && PROBE_PHASE == 4) tsB = __builtin_amdgcn_s_memrealtime();
    }
#undef CURPH
#define CURPH 5
    STAMP(5);
    if (IN(5)) REP(5) {
        sample_attn_norm(F);
#ifndef SKIP_LRU2
        for (int it = blockIdx.x; it < BATCH * NCHUNK; it += F.G) lru_prompt_item<2>(F, it);
#endif
        if (BOTH(5)) GRID_BAR();
    }
#undef CURPH
#define CURPH 6
    STAMP(6);
    if (IN(6)) {
        pg8::Gemm g{F.CAT(), F.WOUT(), MP, DM, DM}; pg8::StaticOrder S; S.init(MP, DM, F.G, (int)blockIdx.x);
        pg8::EpiResidMix E{F.XB(), F.SSQ()}; pg8::mix_cache_fill(F.lds + RING_OFF, S, F.SSQL(), F.SSQA(), F.wave);
        pg8::gemm_phase<pg8::EpiResidMix, pg8::StaticOrder, true, true>(F.lds + RING_OFF, g, S, E, F.wave, tm);
        if (PROBE_WHICH != 0 && PROBE_PHASE == 6) { tsA = 0; tsB = (PROBE_WHICH == 1) ? tm.k : tm.e; } tm.k = 0; tm.e = 0;
        { const unsigned long long ts0_ = (PROBE_WHICH == 3) ? __builtin_amdgcn_s_memrealtime() : 0ull;
        { SEpiResid<1> SE{nullptr, nullptr, F.XB(), F.SSQ(), 1.0f}; small_gemm<DM, 8, SEpiResid<1>>(F, F.CAT(), DM, F.WOUT(), DM / 64, SE); }
          if (PROBE_WHICH == 3 && PROBE_PHASE == CURPH) { asm volatile("s_waitcnt vmcnt(0)" ::: "memory"); tsA = ts0_; tsB = __builtin_amdgcn_s_memrealtime(); } }
        if (BOTH(6)) GRID_BAR();
    }
#undef CURPH
#define CURPH 7
    STAMP(7);
    if (IN(7)) REP(7) {
        pg8::Gemm g{F.XB(), F.WGU2(), MP, 2 * DFF, DM}; pg8::StaticOrder S; S.init(MP, 2 * DFF, F.G, (int)blockIdx.x);
        pg8::EpiSwiglu E{F.HB(), DFF}; pg8::rs_cache_fill(F.lds + RING_OFF, S, F.SSQ(), F.wave);
        pg8::gemm_phase<pg8::EpiSwiglu, pg8::StaticOrder, true, true>(F.lds + RING_OFF, g, S, E, F.wave, tm);
        if (PROBE_WHICH != 0 && PROBE_PHASE == 7) { tsA = 0; tsB = (PROBE_WHICH == 1) ? tm.k : tm.e; } tm.k = 0; tm.e = 0;
        { const unsigned long long ts0_ = (PROBE_WHICH == 3) ? __builtin_amdgcn_s_memrealtime() : 0ull;
        { SEpiSwiglu SE{F.HB(), F.SSQ()}; small_gemm<DM, 1, SEpiSwiglu>(F, F.XB(), DM, F.WGU2(), DFF / 32, SE); }
          if (PROBE_WHICH == 3 && PROBE_PHASE == CURPH) { asm volatile("s_waitcnt vmcnt(0)" ::: "memory"); tsA = ts0_; tsB = __builtin_amdgcn_s_memrealtime(); } }
        if (BOTH(7)) GRID_BAR();
    }
#undef CURPH
#define CURPH 8
    STAMP(8);
    if (IN(8)) {
        pg8::Gemm g{F.HB(), F.WD2(), MP, DM, DFF}; pg8::StaticOrder S; S.init(MP, DM, F.G, (int)blockIdx.x);
        pg8::EpiResid<2> E{nullptr, F.out, F.XB(), nullptr, 0.5f};
        pg8::gemm_phase<pg8::EpiResid<2>, pg8::StaticOrder, true, true>(F.lds + RING_OFF, g, S, E, F.wave, tm);
        if (PROBE_WHICH != 0 && PROBE_PHASE == 8) { tsA = 0; tsB = (PROBE_WHICH == 1) ? tm.k : tm.e; } tm.k = 0; tm.e = 0;
        { const unsigned long long ts0_ = (PROBE_WHICH == 3) ? __builtin_amdgcn_s_memrealtime() : 0ull;
        { SEpiResid<2> SE{nullptr, F.out, F.XB(), nullptr, 0.5f}; small_gemm<DFF, 8, SEpiResid<2>>(F, F.HB(), DFF, F.WD2(), DM / 64, SE); }
          if (PROBE_WHICH == 3 && PROBE_PHASE == CURPH) { asm volatile("s_waitcnt vmcnt(0)" ::: "memory"); tsA = ts0_; tsB = __builtin_amdgcn_s_memrealtime(); } }
    }
    STAMP(9);
    if (PROBE_PHASE >= 0 && blockIdx.x == 0) { asm volatile("s_waitcnt vmcnt(0)" ::: "memory"); const unsigned long long te = __builtin_amdgcn_s_memrealtime(), d = 4 * (tsB - tsA); while (__builtin_amdgcn_s_memrealtime() - te < d) __builtin_amdgcn_s_sleep(8); }
#undef IN
#undef BOTH
}

extern "C" void kernel_launch(void* const* d_in, const int* in_sizes, int n_in, void* d_out, int out_size, void* d_ws, size_t ws_size, hipStream_t stream) {
    static int grid = 0;
    if (grid == 0) {
        if (n_in != 29 || in_sizes[0] != MP * DM || (size_t)out_size != O_END || ws_size < WS_END) { fprintf(stderr, "kernel_launch: unexpected shapes (n_in %d in0 %d out %d ws %zu); nothing launched\n", n_in, n_in > 0 ? in_sizes[0] : -1, out_size, ws_size); grid = -1; return; }
        int dev = 0, cus = 0, per_cu = 0;
        if (hipGetDevice(&dev) != hipSuccess || hipDeviceGetAttribute(&cus, hipDeviceAttributeMultiprocessorCount, dev) != hipSuccess) { fprintf(stderr, "kernel_launch: device query failed\n"); grid = -1; return; }
        if (hipFuncSetAttribute((const void*)hymba_fwd, hipFuncAttributeMaxDynamicSharedMemorySize, LDS_BYTES) != hipSuccess) { fprintf(stderr, "kernel_launch: hipFuncSetAttribute failed\n"); grid = -1; return; }
        if (hipOccupancyMaxActiveBlocksPerMultiprocessor(&per_cu, (const void*)hymba_fwd, NWAVES * 64, LDS_BYTES) != hipSuccess || per_cu < 1) { fprintf(stderr, "kernel_launch: occupancy query reports %d workgroups per CU\n", per_cu); per_cu = 1; }
        (void)hipGetLastError();
        grid = cus;
    }
    if (grid < 0) return;
    if (hipMemsetAsync((char*)d_ws + WS_CTL, 0, CTL_ZERO_BYTES, stream) != hipSuccess) { fprintf(stderr, "kernel_launch: memset failed\n"); return; }
    Args a{};
    for (int i = 0; i < 29; ++i) a.in[i] = (const float*)d_in[i];
    a.out = (float*)d_out; a.ws = (unsigned char*)d_ws;
    if (N_LAUNCHES == 1) {
        a.ph_lo = 0; a.ph_hi = N_PHASES; a.li = 0;
        hipLaunchKernelGGL(hymba_fwd, dim3(grid), dim3(NWAVES * 64), LDS_BYTES, stream, a);
    } else {
        for (int li = 0; li < N_PHASES; ++li) { a.ph_lo = li; a.ph_hi = li + 1; a.li = li; hipLaunchKernelGGL(hymba_fwd, dim3(grid), dim3(NWAVES * 64), LDS_BYTES, stream, a); }
    }
    const hipError_t le = hipPeekAtLastError();
    if (le != hipSuccess) fprintf(stderr, "kernel_launch: launch failed: %s\n", hipGetErrorName(le));
}
```

```cpp
#include <hip/hip_runtime.h>
#include <cstdio>
#include <cstdint>
#include <cmath>
namespace pg8 {
#define PG8_LAS __attribute__((address_space(3)))
typedef unsigned short bf16_t;
typedef short bf16x8 __attribute__((ext_vector_type(8)));
typedef float f32x4 __attribute__((ext_vector_type(4)));
typedef unsigned u32x4 __attribute__((ext_vector_type(4)));
constexpr int BM = 256, BK = 64, HALF = 128, HTB = HALF * BK * 2  , STAGE_BYTES = 8 * HTB, NXCD = 8, WGM = 8;

__host__ __device__ __forceinline__ int lds_byte(int r, int c) { const int st = (r >> 4) * 2 + (c >> 5), rr = r & 15, cc = c & 31, ob = rr * 64 + cc * 2; return st * 1024 + (ob ^ (((ob >> 9) & 1) << 5)); }
__host__ __device__ __forceinline__ void stage_rc(int b, int& R, int& C) { const int st = b / 1024, sb = b % 1024, swz = sb ^ (((sb >> 9) & 1) << 5); R = (st >> 1) * 16 + swz / 64; C = (st & 1) * 32 + (swz % 64) / 2; }
__host__ __device__ __forceinline__ int perm32(int rho) { const int n = rho >> 4, i = rho & 15; return 8 * (i >> 2) + 4 * n + (i & 3); }

struct Unit { int pm, pn; };
struct Gemm { const bf16_t* A; const bf16_t* Bt; int M, N, K; };

struct StaticOrder {
    int nM, nN, nwg, G, c;
    __host__ __device__ void init(int M, int N, int G_, int c_) { nM = M / BM; nN = N / BM; nwg = nM * nN; G = G_; c = c_; }
    __host__ __device__ bool next(int i, Unit& u) const {
        const long L = (long)i * G + c; if (L >= nwg) return false;
        int wgid = (int)L; { const int q = nwg / NXCD, r = nwg % NXCD, xcd = wgid % NXCD, off = wgid / NXCD; wgid = (xcd < r ? xcd * (q + 1) : r * (q + 1) + (xcd - r) * q) + off; }
        const int nig = WGM * nN, gid = wgid / nig, fm = gid * WGM, gsz = (nM - fm) < WGM ? (nM - fm) : WGM;
        u.pm = fm + ((wgid % nig) % gsz); u.pn = (wgid % nig) / gsz; return true;
    }
    __device__ __forceinline__ void a_ready(const Unit&) const {}
    __device__ __forceinline__ void done(const Unit&) const {}
};

__device__ __forceinline__ unsigned cvt_pk_bf16(float lo, float hi) { unsigned r; asm volatile("v_cvt_pk_bf16_f32 %0, %1, %2" : "=v"(r) : "v"(lo), "v"(hi)); return r; }
#ifndef PROBE_WHICH
#define PROBE_WHICH 0
#endif
constexpr bool TM_ON = PROBE_WHICH != 0;
struct Tm { unsigned long long k, e; };
__device__ __forceinline__ int pg8_lane_id() { int l; asm volatile("v_mbcnt_lo_u32_b32 %0, -1, 0\n\tv_mbcnt_hi_u32_b32 %0, -1, %0" : "=v"(l)); return l; }
typedef float f32x2 __attribute__((ext_vector_type(2)));
typedef unsigned u32x2 __attribute__((ext_vector_type(2)));
constexpr float RMS_EPS = 1e-6f;
__device__ __forceinline__ float row_rs(const float* ssq, int r) {
    const f32x4* p = (const f32x4*)(ssq + (size_t)r * 16);
    const f32x4 a = p[0], b = p[1], c = p[2], d = p[3];
    const float s = ((a[0] + a[1]) + (a[2] + a[3])) + ((b[0] + b[1]) + (b[2] + b[3])) + ((c[0] + c[1]) + (c[2] + c[3])) + ((d[0] + d[1]) + (d[2] + d[3]));
    return __builtin_amdgcn_rsqf(s * (1.0f / 1024.0f) + RMS_EPS);
}
__device__ __forceinline__ float silu_f(float g) { return g * __builtin_amdgcn_rcpf(1.0f + __builtin_amdgcn_exp2f(g * -1.4426950408889634f)); }

constexpr int RS_CACHE_OFF = STAGE_BYTES;
template <class Sched> __device__ __forceinline__ void rs_cache_fill(PG8_LAS unsigned char* lds, const Sched& S, const float* ssq, int wid) {
    PG8_LAS float* rsl = (PG8_LAS float*)(lds + RS_CACHE_OFF); Unit u; const int tid_ = wid * 64 + pg8_lane_id(), t = tid_ & 255, hf = tid_ >> 8;
    for (int i = hf; S.next(i, u); i += 2) rsl[i * 256 + t] = row_rs(ssq, u.pm * BM + t);
    __syncthreads();
}
struct EpiSwiglu {
    static constexpr bool PERM = true, AFTER_DRAIN = false, MID = false;
    bf16_t* H; int ldh;
    __device__ __forceinline__ void operator()(const f32x4 (&acc)[2][2][4][2], const Unit& u, int wr, int wc, int fr, int fq, int ui, PG8_LAS unsigned char* lds) const {
        const int row0 = u.pm * BM + wr * 64 + fr, col0 = u.pn * HALF + wc * 32 + 8 * fq;
        const PG8_LAS float* rsl = (const PG8_LAS float*)(lds + RS_CACHE_OFF) + ui * 256 + wr * 64 + fr;
#pragma unroll
        for (int ai = 0; ai < 2; ++ai)
#pragma unroll
            for (int m = 0; m < 4; ++m) {
                const int r = row0 + ai * HALF + m * 16; const float rs = rsl[ai * HALF + m * 16];
                float hv[8];
#pragma unroll
                for (int n = 0; n < 2; ++n)
#pragma unroll
                    for (int e = 0; e < 4; ++e) hv[n * 4 + e] = silu_f(acc[ai][0][m][n][e] * rs) * (acc[ai][1][m][n][e] * rs);
                u32x4 w; w.x = cvt_pk_bf16(hv[0], hv[1]); w.y = cvt_pk_bf16(hv[2], hv[3]); w.z = cvt_pk_bf16(hv[4], hv[5]); w.w = cvt_pk_bf16(hv[6], hv[7]);
                *(u32x4*)(H + (size_t)r * ldh + col0) = w;
            }
    }
};
struct EpiScaleBf16 {
    static constexpr bool PERM = true, AFTER_DRAIN = false, MID = false;
    bf16_t* O; int ldc;
    __device__ __forceinline__ void operator()(const f32x4 (&acc)[2][2][4][2], const Unit& u, int wr, int wc, int fr, int fq, int ui, PG8_LAS unsigned char* lds) const {
        const int row0 = u.pm * BM + wr * 64 + fr, col0 = u.pn * BM + wc * 32 + 8 * fq;
        const PG8_LAS float* rsl = (const PG8_LAS float*)(lds + RS_CACHE_OFF) + ui * 256 + wr * 64 + fr;
#pragma unroll
        for (int ai = 0; ai < 2; ++ai)
#pragma unroll
            for (int m = 0; m < 4; ++m) {
                const int r = row0 + ai * HALF + m * 16; const float rs = rsl[ai * HALF + m * 16];
#pragma unroll
                for (int bj = 0; bj < 2; ++bj) {
                    const f32x4 v0 = acc[ai][bj][m][0] * rs, v1 = acc[ai][bj][m][1] * rs;
                    u32x4 w; w.x = cvt_pk_bf16(v0[0], v0[1]); w.y = cvt_pk_bf16(v0[2], v0[3]); w.z = cvt_pk_bf16(v1[0], v1[1]); w.w = cvt_pk_bf16(v1[2], v1[3]);
                    *(u32x4*)(O + (size_t)r * ldc + col0 + bj * HALF) = w;
                }
            }
    }
};
__device__ __forceinline__ f32x4 bf4_to_f32(u32x2 w) { f32x4 r; r[0] = __builtin_bit_cast(float, w.x << 16); r[1] = __builtin_bit_cast(float, w.x & 0xffff0000u); r[2] = __builtin_bit_cast(float, w.y << 16); r[3] = __builtin_bit_cast(float, w.y & 0xffff0000u); return r; }
template <int MODE> struct EpiResid {
    static constexpr bool PERM = true, AFTER_DRAIN = false, MID = false;
    const float* basef; float* out; bf16_t* xb; float* ssq; float scale;
    __device__ __forceinline__ void operator()(const f32x4 (&acc)[2][2][4][2], const Unit& u, int wr, int wc, int fr, int fq, int ui, PG8_LAS unsigned char* lds) const {
        const int row0 = u.pm * BM + wr * 64 + fr, col0 = u.pn * BM + wc * 32 + 8 * fq;
#pragma unroll
        for (int ai = 0; ai < 2; ++ai) {
            f32x4 pre[4][2][2];
#pragma unroll
            for (int m = 0; m < 4; ++m) { const size_t off = (size_t)(row0 + ai * HALF + m * 16) * 1024 + col0;
#pragma unroll
                for (int bj = 0; bj < 2; ++bj) {
                    if (MODE == 0) { pre[m][bj][0] = *(const f32x4*)(basef + off + bj * HALF); pre[m][bj][1] = *(const f32x4*)(basef + off + bj * HALF + 4); }
                    else { const u32x4 w = *(const u32x4*)(xb + off + bj * HALF); pre[m][bj][0] = bf4_to_f32((u32x2){w.x, w.y}); pre[m][bj][1] = bf4_to_f32((u32x2){w.z, w.w}); } } }
#pragma unroll
            for (int m = 0; m < 4; ++m) { const int r = row0 + ai * HALF + m * 16; const size_t off = (size_t)r * 1024 + col0; float s = 0.f;
#pragma unroll
                for (int bj = 0; bj < 2; ++bj) {
                    const f32x4 o0 = pre[m][bj][0] + acc[ai][bj][m][0] * scale, o1 = pre[m][bj][1] + acc[ai][bj][m][1] * scale;
                    if (MODE == 2) { *(f32x4*)(out + off + bj * HALF) = o0; *(f32x4*)(out + off + bj * HALF + 4) = o1; }
                    else { s += ((o0[0] * o0[0] + o0[1] * o0[1]) + (o0[2] * o0[2] + o0[3] * o0[3])) + ((o1[0] * o1[0] + o1[1] * o1[1]) + (o1[2] * o1[2] + o1[3] * o1[3]));
                        u32x4 w; w.x = cvt_pk_bf16(o0[0], o0[1]); w.y = cvt_pk_bf16(o0[2], o0[3]); w.z = cvt_pk_bf16(o1[0], o1[1]); w.w = cvt_pk_bf16(o1[2], o1[3]); *(u32x4*)(xb + off + bj * HALF) = w; }
                }
                if (MODE != 2) { s += __shfl_xor(s, 16); s += __shfl_xor(s, 32); if (fq == 0) ssq[(size_t)r * 16 + u.pn * 4 + wc] = s; }
            }
        }
    }
};
template <class Sched> __device__ __forceinline__ void mix_cache_fill(PG8_LAS unsigned char* lds, const Sched& S, const float* ssql, const float* ssqa, int wid) {
    PG8_LAS f32x2* c2 = (PG8_LAS f32x2*)(lds + RS_CACHE_OFF); Unit u; const int tid_ = wid * 64 + pg8_lane_id(), t = tid_ & 255, hf = tid_ >> 8;
    for (int i = hf; S.next(i, u); i += 2) { const size_t r = (size_t)u.pm * BM + t;
        const f32x4* pl = (const f32x4*)(ssql + r * 8); const f32x4* pa = (const f32x4*)(ssqa + r * 8); const f32x4 l0 = pl[0], l1 = pl[1], a0 = pa[0], a1 = pa[1];
        const float rl = __builtin_amdgcn_rsqf((((l0[0] + l0[1]) + (l0[2] + l0[3])) + ((l1[0] + l1[1]) + (l1[2] + l1[3]))) * (1.0f / 512.0f) + RMS_EPS);
        const float ra = __builtin_amdgcn_rsqf((((a0[0] + a0[1]) + (a0[2] + a0[3])) + ((a1[0] + a1[1]) + (a1[2] + a1[3]))) * (1.0f / 512.0f) + RMS_EPS);
        c2[i * 256 + t] = (f32x2){rl * __builtin_amdgcn_rcpf(ra), ra}; }
    __syncthreads();
}
struct EpiResidMix {
    static constexpr bool PERM = true, AFTER_DRAIN = false, MID = true;
    bf16_t* xb; float* ssq;
    __device__ __forceinline__ void mid(f32x4 (&acc)[2][2][4][2], int wr, int fr, int ui, PG8_LAS unsigned char* lds) const {
        const PG8_LAS f32x2* c2 = (const PG8_LAS f32x2*)(lds + RS_CACHE_OFF) + ui * 256 + wr * 64 + fr;
#pragma unroll
        for (int ai = 0; ai < 2; ++ai)
#pragma unroll
            for (int m = 0; m < 4; ++m) { const float q = c2[ai * HALF + m * 16].x;
#pragma unroll
                for (int bj = 0; bj < 2; ++bj)
#pragma unroll
                    for (int n = 0; n < 2; ++n) acc[ai][bj][m][n] *= q; }
    }
    __device__ __forceinline__ void operator()(const f32x4 (&acc)[2][2][4][2], const Unit& u, int wr, int wc, int fr, int fq, int ui, PG8_LAS unsigned char* lds) const {
        const int row0 = u.pm * BM + wr * 64 + fr, col0 = u.pn * BM + wc * 32 + 8 * fq;
        const PG8_LAS f32x2* c2 = (const PG8_LAS f32x2*)(lds + RS_CACHE_OFF) + ui * 256 + wr * 64 + fr;
#pragma unroll
        for (int ai = 0; ai < 2; ++ai) {
            u32x4 pre[4][2];
#pragma unroll
            for (int m = 0; m < 4; ++m) { const size_t off = (size_t)(row0 + ai * HALF + m * 16) * 1024 + col0;
#pragma unroll
                for (int bj = 0; bj < 2; ++bj) pre[m][bj] = *(const u32x4*)(xb + off + bj * HALF); }
#pragma unroll
            for (int m = 0; m < 4; ++m) { const int r = row0 + ai * HALF + m * 16; const size_t off = (size_t)r * 1024 + col0; float s = 0.f; const float ra = c2[ai * HALF + m * 16].y;
#pragma unroll
                for (int bj = 0; bj < 2; ++bj) {
                    const f32x4 o0 = bf4_to_f32((u32x2){pre[m][bj].x, pre[m][bj].y}) + acc[ai][bj][m][0] * ra, o1 = bf4_to_f32((u32x2){pre[m][bj].z, pre[m][bj].w}) + acc[ai][bj][m][1] * ra;
                    s += ((o0[0] * o0[0] + o0[1] * o0[1]) + (o0[2] * o0[2] + o0[3] * o0[3])) + ((o1[0] * o1[0] + o1[1] * o1[1]) + (o1[2] * o1[2] + o1[3] * o1[3]));
                    u32x4 w; w.x = cvt_pk_bf16(o0[0], o0[1]); w.y = cvt_pk_bf16(o0[2], o0[3]); w.z = cvt_pk_bf16(o1[0], o1[1]); w.w = cvt_pk_bf16(o1[2], o1[3]); *(u32x4*)(xb + off + bj * HALF) = w;
                }
                s += __shfl_xor(s, 16); s += __shfl_xor(s, 32); if (fq == 0) ssq[(size_t)r * 16 + u.pn * 4 + wc] = s;
            }
        }
    }
};
template <class Epi, class Sched, bool ALIGN_EPI = false, bool SP2 = false>
__device__ __forceinline__ void gemm_phase(PG8_LAS unsigned char* lds, const Gemm g, const Sched& S, const Epi& E, int wid_in, Tm& tm) {
    const int wid = wid_in, lane = pg8_lane_id(), tid = wid * 64 + lane, wr = wid >> 2, wc = wid & 3, fr = lane & 15, fq = lane >> 4;
    const int K = g.K, nt = K / BK;
    unsigned voffA[2], voffB[2];
#pragma unroll
    for (int i = 0; i < 2; ++i) { int R, C; stage_rc(tid * 16 + i * 8192, R, C); const int Rb = Epi::PERM ? ((R & ~31) + perm32(R & 31)) : R;
        voffA[i] = (unsigned)(R * K + C) * 2u; voffB[i] = (unsigned)(Rb * K + C) * 2u; }
    const size_t kstep = (size_t)(BK * 2);
    const size_t hstep = (size_t)HALF * K * 2;
    const size_t tstep = 2 * hstep;
    const unsigned ldsw = (unsigned)wid * 1024u;
    const int aoff = lds_byte(wr * 64 + fr, fq * 8), boff = lds_byte(wc * 32 + fr, fq * 8);
#define PG8_SA(b, h) (((b) * 2 + (h)) * HTB)
#define PG8_SB(b, h) ((4 + (b) * 2 + (h)) * HTB)
#define PG8_STAGE(bufoff, gbase, voff) do { _Pragma("unroll") for (int _i = 0; _i < 2; ++_i) \
        __builtin_amdgcn_global_load_lds((const unsigned*)((const char*)(gbase) + (voff)[_i]), (PG8_LAS unsigned*)(lds + (bufoff) + ldsw + _i * 8192), 16, 0, 0); } while (0)
#define PG8_LDA(dst, b, h) do { _Pragma("unroll") for (int m = 0; m < 4; ++m) _Pragma("unroll") for (int k = 0; k < 2; ++k) dst[m][k] = *(const PG8_LAS bf16x8*)(lds + PG8_SA(b, h) + aoff + m * 2048 + k * 1024); } while (0)
#define PG8_LDB(dst, b, h) do { _Pragma("unroll") for (int n = 0; n < 2; ++n) _Pragma("unroll") for (int k = 0; k < 2; ++k) dst[n][k] = *(const PG8_LAS bf16x8*)(lds + PG8_SB(b, h) + boff + n * 2048 + k * 1024); } while (0)
#define PG8_MMA(ai, bj, At, Bt) do { __builtin_amdgcn_s_setprio(1); _Pragma("unroll") for (int m = 0; m < 4; ++m) _Pragma("unroll") for (int n = 0; n < 2; ++n) _Pragma("unroll") for (int k = 0; k < 2; ++k) \
        acc[ai][bj][m][n] = __builtin_amdgcn_mfma_f32_16x16x32_bf16(Bt[n][k], At[m][k], acc[ai][bj][m][n], 0, 0, 0); __builtin_amdgcn_s_setprio(0); } while (0)
#define PG8_WAIT_V(n) asm volatile("s_waitcnt vmcnt(" #n ")" ::: "memory")
#define PG8_WAIT_L(n) asm volatile("s_waitcnt lgkmcnt(" #n ")" ::: "memory")
#define PG8_BAR __builtin_amdgcn_s_barrier()
#define PG8_SCHED __builtin_amdgcn_sched_barrier(0)
    Unit cur, nxt; int ui = 0;
    if (!S.next(0, cur)) return;
    f32x4 acc[2][2][4][2];
#pragma unroll
    for (int a = 0; a < 2; ++a)
#pragma unroll
        for (int b = 0; b < 2; ++b)
#pragma unroll
            for (int m = 0; m < 4; ++m)
#pragma unroll
                for (int n = 0; n < 2; ++n) acc[a][b][m][n] = (f32x4){0.f, 0.f, 0.f, 0.f};
    bf16x8 At[4][2], B0[2][2], B1[2][2];
    const char* cA = (const char*)g.A + (size_t)cur.pm * tstep; const char* cB = (const char*)g.Bt + (size_t)cur.pn * tstep;
    S.a_ready(cur);
    if constexpr (SP2) {
        PG8_STAGE(PG8_SB(0, 0), cB, voffB); PG8_STAGE(PG8_SB(0, 1), cB + hstep, voffB); PG8_STAGE(PG8_SA(0, 0), cA, voffA); PG8_STAGE(PG8_SA(0, 1), cA + hstep, voffA);
        if (wr == 1) PG8_BAR;
        PG8_WAIT_V(2); PG8_BAR;
        PG8_STAGE(PG8_SB(1, 0), cB + kstep, voffB); PG8_STAGE(PG8_SA(1, 0), cA + kstep, voffA); PG8_STAGE(PG8_SB(1, 1), cB + hstep + kstep, voffB);
        PG8_WAIT_V(6); PG8_BAR;
    } else {
        PG8_STAGE(PG8_SB(0, 0), cB, voffB); PG8_STAGE(PG8_SA(0, 0), cA, voffA); PG8_STAGE(PG8_SB(0, 1), cB + hstep, voffB); PG8_STAGE(PG8_SA(0, 1), cA + hstep, voffA);
        if (wr == 1) PG8_BAR;
        PG8_WAIT_V(4); PG8_BAR;
        PG8_STAGE(PG8_SB(1, 0), cB + kstep, voffB); PG8_STAGE(PG8_SA(1, 0), cA + kstep, voffA); PG8_STAGE(PG8_SB(1, 1), cB + hstep + kstep, voffB);
        PG8_WAIT_V(6); PG8_BAR;
    }
    for (;;) {
        const bool has_next = S.next(ui + 1, nxt);
        const unsigned long long tm_a = TM_ON ? __builtin_amdgcn_s_memrealtime() : 0ull;
        const char* nA = has_next ? (const char*)g.A + (size_t)nxt.pm * tstep : cA; const char* nB = has_next ? (const char*)g.Bt + (size_t)nxt.pn * tstep : cB;
        for (int t = 0; t < nt; t += 2) {
            if constexpr (Epi::MID) { if (t == nt / 2) E.mid(acc, wr, fr, ui, lds); }
            const bool last = (t == nt - 2);
            const char* a1 = cA + (size_t)(t + 1) * kstep;
            const char* a2 = last ? nA : cA + (size_t)(t + 2) * kstep; const char* b2 = last ? nB : cB + (size_t)(t + 2) * kstep;
            const char* a3 = a2 + kstep; const char* b3 = b2 + kstep;
            if (last && has_next) S.a_ready(nxt);
            if constexpr (SP2) {
            PG8_LDB(B0, 0, 0); PG8_LDB(B1, 0, 1); PG8_SCHED; PG8_LDA(At, 0, 0); PG8_STAGE(PG8_SA(1, 1), a1 + hstep, voffA);
            PG8_WAIT_V(8); PG8_WAIT_L(0); PG8_BAR; PG8_MMA(0, 0, At, B0); PG8_MMA(0, 1, At, B1); PG8_BAR; PG8_SCHED;
            PG8_LDA(At, 0, 1); PG8_STAGE(PG8_SB(0, 0), b2, voffB); PG8_STAGE(PG8_SB(0, 1), b2 + hstep, voffB); PG8_STAGE(PG8_SA(0, 0), a2, voffA);
            PG8_WAIT_V(8); PG8_WAIT_L(0); PG8_BAR; PG8_MMA(1, 0, At, B0); PG8_MMA(1, 1, At, B1); PG8_BAR; PG8_SCHED;
            PG8_LDB(B0, 1, 0); PG8_LDB(B1, 1, 1); PG8_SCHED; PG8_LDA(At, 1, 0); PG8_STAGE(PG8_SA(0, 1), a2 + hstep, voffA);
            PG8_WAIT_V(8); PG8_WAIT_L(0); PG8_BAR; PG8_MMA(0, 0, At, B0); PG8_MMA(0, 1, At, B1); PG8_BAR; PG8_SCHED;
            PG8_LDA(At, 1, 1); PG8_STAGE(PG8_SB(1, 0), b3, voffB); PG8_STAGE(PG8_SB(1, 1), b3 + hstep, voffB); PG8_STAGE(PG8_SA(1, 0), a3, voffA);
            PG8_WAIT_V(8); PG8_WAIT_L(0); PG8_BAR; PG8_MMA(1, 0, At, B0); PG8_MMA(1, 1, At, B1); PG8_BAR; PG8_SCHED;
            } else {
            PG8_LDB(B0, 0, 0); PG8_SCHED; PG8_LDA(At, 0, 0); PG8_STAGE(PG8_SA(1, 1), a1 + hstep, voffA);
            PG8_WAIT_L(8); PG8_BAR; PG8_WAIT_L(0); PG8_MMA(0, 0, At, B0); PG8_BAR; PG8_SCHED;
            PG8_LDB(B1, 0, 1); PG8_STAGE(PG8_SB(0, 0), b2, voffB);
            PG8_BAR; PG8_WAIT_L(0); PG8_MMA(0, 1, At, B1); PG8_BAR;
            PG8_LDA(At, 0, 1); PG8_STAGE(PG8_SA(0, 0), a2, voffA);
            PG8_BAR; PG8_WAIT_L(0); PG8_MMA(1, 0, At, B0); PG8_BAR; PG8_SCHED;
            PG8_STAGE(PG8_SB(0, 1), b2 + hstep, voffB);
            PG8_WAIT_V(6); PG8_BAR; PG8_MMA(1, 1, At, B1); PG8_BAR;
            PG8_LDB(B0, 1, 0); PG8_SCHED; PG8_LDA(At, 1, 0); PG8_STAGE(PG8_SA(0, 1), a2 + hstep, voffA);
            PG8_WAIT_L(8); PG8_BAR; PG8_WAIT_L(0); PG8_MMA(0, 0, At, B0); PG8_BAR; PG8_SCHED;
            PG8_LDB(B1, 1, 1); PG8_STAGE(PG8_SB(1, 0), b3, voffB);
            PG8_BAR; PG8_WAIT_L(0); PG8_MMA(0, 1, At, B1); PG8_BAR;
            PG8_LDA(At, 1, 1); PG8_STAGE(PG8_SA(1, 0), a3, voffA);
            PG8_BAR; PG8_WAIT_L(0); PG8_MMA(1, 0, At, B0); PG8_BAR; PG8_SCHED;
            PG8_STAGE(PG8_SB(1, 1), b3 + hstep, voffB);
            PG8_WAIT_V(6); PG8_BAR; PG8_MMA(1, 1, At, B1); PG8_BAR;
            }
        }
        const unsigned long long tm_b = TM_ON ? __builtin_amdgcn_s_memrealtime() : 0ull;
        if constexpr (ALIGN_EPI) { if (wr == 0) PG8_BAR; }
        if constexpr (!Epi::AFTER_DRAIN) { E(acc, cur, wr, wc, fr, fq, ui, lds); S.done(cur); }
        if (TM_ON) { const unsigned long long tm_c = __builtin_amdgcn_s_memrealtime(); tm.k += tm_b - tm_a; tm.e += tm_c - tm_b; }
        if (!has_next) break;
#pragma unroll
        for (int a = 0; a < 2; ++a)
#pragma unroll
            for (int b = 0; b < 2; ++b)
#pragma unroll
                for (int m = 0; m < 4; ++m)
#pragma unroll
                    for (int n = 0; n < 2; ++n) acc[a][b][m][n] = (f32x4){0.f, 0.f, 0.f, 0.f};
        cur = nxt; cA = nA; cB = nB; ++ui;
        if constexpr (ALIGN_EPI) { if (wr == 1) PG8_BAR; }
    }
    PG8_WAIT_V(0);
    if constexpr (!ALIGN_EPI) { if (wr == 0) PG8_BAR; }
    PG8_BAR;
    if constexpr (Epi::AFTER_DRAIN) { E.fused(acc, cur, wr, wc, fr, fq, lds, wid, lane); S.done(cur); }
#undef PG8_SA
#undef PG8_SB
#undef PG8_STAGE
#undef PG8_LDA
#undef PG8_LDB
#undef PG8_MMA
#undef PG8_WAIT_V
#undef PG8_WAIT_L
#undef PG8_BAR
#undef PG8_SCHED
}
}

constexpr int NWAVES = 8;
constexpr int DM = 1024, BATCH = 4, SEQ = 8192, MP = BATCH * SEQ, DEC_B = 128, DEC_T = 4, MS = DEC_B * DEC_T, MT = MP + MS;
constexpr int LRU_W = 512, NH = 8, NKV = 2, HD = 64, DFF = 2816, INW = 1792, WIN = 128, PAST = 16384;
constexpr int C_XL = 0, C_GATE = 512, C_Q = 1024, C_K = 1536, C_V = 1664;
constexpr int NCHUNK = 64, CHUNK = SEQ / NCHUNK;
constexpr float EPS = 1e-6f, LOG2E = 1.4426950408889634f;
constexpr size_t O_YP = 0, O_YS = 33554432, O_PH = 34078720, O_PC = 34080768, O_PK = 34086912, O_PV = 34152448, O_SH = 34217984, O_SC = 34283520, O_SK = 34480128, O_SV = 36577280, O_END = 38674432;
constexpr size_t MiB = 1u << 20;
constexpr size_t WS_CTL = 0, CTL_ZERO_BYTES = 64 * 1024;
constexpr size_t WS_WGU1 = 2 * MiB, WS_WD1 = 13 * MiB, WS_WIN = 19 * MiB, WS_WOUT = 23 * MiB, WS_WGU2 = 25 * MiB, WS_WD2 = 36 * MiB;
constexpr size_t WS_ROPE = 42 * MiB;
constexpr size_t WS_SSQ = 45 * MiB;
constexpr size_t WS_LSUM = 48 * MiB;
constexpr size_t WS_WFRAG = 49 * MiB;
constexpr size_t WS_XB = 50 * MiB;
constexpr size_t WS_CAT = 115 * MiB;
constexpr size_t WS_PROJ = 180 * MiB;
constexpr size_t WS_H = 294 * MiB;
constexpr size_t WS_SSQL = 474 * MiB, WS_SSQA = 475 * MiB;
constexpr size_t WS_SOA = 476 * MiB, WS_SSQS = 477 * MiB;
constexpr size_t WS_END = 478 * MiB;
constexpr int ROPE_ROWS = SEQ + DEC_T;
constexpr int CW_TMO = 0, CW_BAR = 4096, CW_DYN = 8192;
constexpr int RING_OFF = 0, RING_BYTES = 131072;
constexpr int SCR_BYTES = 147456;
constexpr int LDSCTL_OFF = SCR_BYTES, MISC_OFF = LDSCTL_OFF + 64;
constexpr int LDS_BYTES = SCR_BYTES + 512;

#define GAS __attribute__((address_space(1)))
#define LAS __attribute__((address_space(3)))
typedef unsigned short bf16;
typedef unsigned v4u __attribute__((ext_vector_type(4)));
typedef unsigned v2u __attribute__((ext_vector_type(2)));
typedef float f32x4 __attribute__((ext_vector_type(4)));
typedef float f32x16 __attribute__((ext_vector_type(16)));
typedef short bf16x8 __attribute__((ext_vector_type(8)));
typedef GAS unsigned gu32;
#define RLX_AGENT __ATOMIC_RELAXED, __HIP_MEMORY_SCOPE_AGENT
__device__ __forceinline__ int lane_id() { int l; asm volatile("v_mbcnt_lo_u32_b32 %0, -1, 0\n\tv_mbcnt_hi_u32_b32 %0, -1, %0" : "=v"(l)); return l; }
#define LDS_WAIT() asm volatile("s_waitcnt lgkmcnt(0)" ::: "memory")
#define VM_WAIT() asm volatile("s_waitcnt vmcnt(0)" ::: "memory")
__device__ __forceinline__ unsigned f2bf(float f) { unsigned u = __builtin_bit_cast(unsigned, f); return (u + 0x7fffu + ((u >> 16) & 1u)) >> 16; }
__device__ __forceinline__ unsigned pk2(float lo, float hi) { return f2bf(lo) | (f2bf(hi) << 16); }
__device__ __forceinline__ float bflo(unsigned w) { return __builtin_bit_cast(float, w << 16); }
__device__ __forceinline__ float bfhi(unsigned w) { return __builtin_bit_cast(float, w & 0xffff0000u); }
__device__ __forceinline__ float bf1(bf16 v) { return __builtin_bit_cast(float, (unsigned)v << 16); }
typedef float f32x2_t __attribute__((ext_vector_type(2))); typedef __bf16 bf16x2_t __attribute__((ext_vector_type(2)));
__device__ __forceinline__ unsigned cvtpk(float lo, float hi) { f32x2_t v = {lo, hi}; bf16x2_t b = __builtin_convertvector(v, bf16x2_t); return __builtin_bit_cast(unsigned, b); }
__device__ __forceinline__ float wave_sum(float v) {
#pragma unroll
    for (int o = 1; o < 64; o <<= 1) v += __shfl_xor(v, o);
    return v;
}
__device__ __forceinline__ float wave_max(float v) {
#pragma unroll
    for (int o = 1; o < 64; o <<= 1) v = fmaxf(v, __shfl_xor(v, o));
    return v;
}
__device__ __forceinline__ float sigmoid_f(float x) { return __builtin_amdgcn_rcpf(1.0f + __builtin_amdgcn_exp2f(-x * LOG2E)); }
__device__ __forceinline__ float gelu_tanh(float x) {
    const float y = 0.7978845608028654f * (x + 0.044715f * x * x * x);
    const float e = __builtin_amdgcn_exp2f(2.0f * LOG2E * y);
    const float th = 1.0f - 2.0f * __builtin_amdgcn_rcpf(e + 1.0f);
    return 0.5f * x * (1.0f + th);
}
__device__ __forceinline__ float one_minus_exp(float t) {
    const float ser = -t * (1.0f + t * (0.5f + t * (0.16666667f + t * (0.041666668f + t * 0.0083333338f))));
    const float dir = 1.0f - __builtin_amdgcn_exp2f(t * LOG2E);
    return t > -0.25f ? ser : dir;
}
__device__ __forceinline__ float dot2bf(unsigned a, unsigned b, float c) { return __builtin_amdgcn_fdot2_f32_bf16(__builtin_bit_cast(bf16x2_t, a), __builtin_bit_cast(bf16x2_t, b), c, false); }
#define XB_TMO      128
#define XB_XCNT(j)  (256  + 64 * (j))
#define XB_XSUB(j)  (1280 + 64 * (j))
#define XB_XGEN(j)  (2304 + 64 * (j))
#define XB_TOP      3328
#define XB_TOPGEN   3392
#define XCD_BAR_WORDS 3456
#define XB_SPIN_CAP (1u << 18)

__device__ __forceinline__ unsigned xb_ld(unsigned* p)              { return __hip_atomic_load(p, __ATOMIC_RELAXED, __HIP_MEMORY_SCOPE_AGENT); }
__device__ __forceinline__ unsigned xb_add(unsigned* p, unsigned v) { return __hip_atomic_fetch_add(p, v, __ATOMIC_RELAXED, __HIP_MEMORY_SCOPE_AGENT); }
__device__ __forceinline__ unsigned xb_xcc_id() { return (unsigned)__builtin_amdgcn_s_getreg((3 << 11) | 20) & 0xFu; }
#define XB_SPIN(cond, bar) do { unsigned _sp = 0; while (cond) { __builtin_amdgcn_s_sleep(1); \
    if ((++_sp & 255u) == 0u) { if (xb_ld(&(bar)[XB_TMO])) break; if (_sp > XB_SPIN_CAP) { atomicAdd(&(bar)[XB_TMO], 1u); break; } } } } while (0)

struct XcdBarrier {
    unsigned* bar; unsigned x;
    volatile LAS unsigned* st;
};

__device__ __forceinline__ XcdBarrier xcd_barrier_post(unsigned* bar, volatile LAS unsigned* st, bool leader) {
    XcdBarrier b; b.bar = bar; b.x = xb_xcc_id(); b.st = st;
    if (leader) (void)xb_add(&bar[XB_XCNT(b.x)], 1u);
    return b;
}
__device__ __forceinline__ void xcd_barrier_complete(unsigned* bar, unsigned x, unsigned& nloc, unsigned& nx) {
    const unsigned G = gridDim.x * gridDim.y * gridDim.z;
    unsigned sum, cnt, mine, sp = 0u;
    for (;;) {
        sum = 0u; cnt = 0u; mine = 0u;
#pragma unroll
        for (unsigned j = 0; j < 16; ++j) { const unsigned c = xb_ld(&bar[XB_XCNT(j)]); sum += c; cnt += (c > 0u) ? 1u : 0u; mine = (j == x) ? c : mine; }
        if (sum == G) break;
        __builtin_amdgcn_s_sleep(1);
        if ((++sp & 255u) == 0u) { if (xb_ld(&bar[XB_TMO])) break; if (sp > XB_SPIN_CAP) { atomicAdd(&bar[XB_TMO], 1u); break; } }
    }
    nloc = mine > 0u ? mine : 1u; nx = cnt > 0u ? cnt : 1u;
}

__device__ __forceinline__ void xcd_barrier(const XcdBarrier& b, bool leader) {
    asm volatile("s_waitcnt vmcnt(0)" ::: "memory");
    __syncthreads();
    if (leader) {
        unsigned* bar = b.bar;
        __builtin_amdgcn_s_waitcnt(0);
        unsigned nloc = b.st[0], nx = b.st[1];
        if (nloc == 0u) { xcd_barrier_complete(bar, b.x, nloc, nx); b.st[0] = nloc; b.st[1] = nx; }
        const unsigned old = xb_add(&bar[XB_XSUB(b.x)], 1u);
        const unsigned gen = old / nloc;
        if (old + 1u == (gen + 1u) * nloc) {
            __builtin_amdgcn_fence(__ATOMIC_RELEASE, "agent");
            asm volatile("s_waitcnt vmcnt(0)" ::: "memory");
            const unsigned og = xb_add(&bar[XB_TOP], 1u);
            const unsigned tg = og / nx;
            if (og + 1u == (tg + 1u) * nx) xb_add(&bar[XB_TOPGEN], 1u);
            else XB_SPIN(xb_ld(&bar[XB_TOPGEN]) == tg, bar);
            __builtin_amdgcn_fence(__ATOMIC_ACQUIRE, "agent");
            xb_add(&bar[XB_XGEN(b.x)], 1u);
            asm volatile("s_waitcnt vmcnt(0)" ::: "memory");
        } else {
            XB_SPIN(xb_ld(&bar[XB_XGEN(b.x)]) == gen, bar);
            __builtin_amdgcn_fence(__ATOMIC_ACQUIRE, "agent");
            asm volatile("s_waitcnt vmcnt(0)" ::: "memory");
        }
    }
    __syncthreads();
}

typedef const void __attribute__((address_space(4)))* kernarg_ptr;
struct Frame {
    LAS unsigned char* lds;
    volatile LAS unsigned* MISC;
    int wave;
    __device__ __forceinline__ int lane() const { return lane_id(); }
    __device__ __forceinline__ int tid() const { return wave * 64 + lane_id(); }
    int vcu, G;
    kernarg_ptr kp;
    float* out; unsigned char* ws;
    __device__ __forceinline__ const float* inp(int i) const { kernarg_ptr k = kp; asm volatile("" : "+s"(k)); return ((const float* const __attribute__((address_space(4)))*)k)[i]; }
    __device__ __forceinline__ gu32* ctl() const { return (gu32*)(ws + WS_CTL); }
    __device__ __forceinline__ bf16* WGU1() const { return (bf16*)(ws + WS_WGU1); }
    __device__ __forceinline__ bf16* WD1() const { return (bf16*)(ws + WS_WD1); }
    __device__ __forceinline__ bf16* WINT() const { return (bf16*)(ws + WS_WIN); }
    __device__ __forceinline__ bf16* WOUT() const { return (bf16*)(ws + WS_WOUT); }
    __device__ __forceinline__ bf16* WGU2() const { return (bf16*)(ws + WS_WGU2); }
    __device__ __forceinline__ bf16* WD2() const { return (bf16*)(ws + WS_WD2); }
    __device__ __forceinline__ float* ROPEC() const { return (float*)(ws + WS_ROPE); }
    __device__ __forceinline__ float* ROPES() const { return (float*)(ws + WS_ROPE) + ROPE_ROWS * 32; }
    __device__ __forceinline__ float* SSQ() const { return (float*)(ws + WS_SSQ); }
    __device__ __forceinline__ float* LSUM() const { return (float*)(ws + WS_LSUM); }
    __device__ __forceinline__ float* SSQL() const { return (float*)(ws + WS_SSQL); }
    __device__ __forceinline__ float* SSQA() const { return (float*)(ws + WS_SSQA); }
    __device__ __forceinline__ float* SOA() const { return (float*)(ws + WS_SOA); }
    __device__ __forceinline__ float* SSQS() const { return (float*)(ws + WS_SSQS); }
    __device__ __forceinline__ bf16* WFRAG() const { return (bf16*)(ws + WS_WFRAG); }
    __device__ __forceinline__ bf16* XB() const { return (bf16*)(ws + WS_XB); }
    __device__ __forceinline__ bf16* CAT() const { return (bf16*)(ws + WS_CAT); }
    __device__ __forceinline__ bf16* PROJ() const { return (bf16*)(ws + WS_PROJ); }
    __device__ __forceinline__ bf16* HB() const { return (bf16*)(ws + WS_H); }
};
enum { I_XP = 0, I_XS, I_SH, I_SC, I_CK, I_CV, I_F1N, I_F1G, I_F1U, I_F1D, I_MN, I_WIN, I_CW, I_CB, I_WA, I_BA, I_WX, I_BX, I_LAM, I_QN, I_KN, I_SINK, I_LON, I_AON, I_WOUT, I_F2N, I_F2G, I_F2U, I_F2D };

template <int MODE> __device__ __forceinline__ void p0_transpose_item(const float* W, const float* gain, int K, int N, bf16* WT, LAS float* scr, int item, int lane) {
    const int nblk = N / 32, kb = item / nblk, nb = item % nblk, k0 = 64 * kb, n0 = 32 * nb;
    f32x4 tv[8];
#pragma unroll
    for (int i = 0; i < 8; ++i) { const int kk = 8 * i + (lane >> 3); tv[i] = __builtin_nontemporal_load((const f32x4*)(W + (size_t)(k0 + kk) * N + n0 + 4 * (lane & 7))); }
#pragma unroll
    for (int i = 0; i < 8; ++i) { const int kk = 8 * i + (lane >> 3); f32x4 v = tv[i]; if (gain) v *= gain[k0 + kk];
        LAS float* d = scr + kk * 33 + 4 * (lane & 7); d[0] = v[0]; d[1] = v[1]; d[2] = v[2]; d[3] = v[3]; }
    LDS_WAIT(); asm volatile("" ::: "memory");
    const int c = lane & 7;
    const int rb = (MODE == 0) ? n0 : ((n0 >> 7) * 256 + (MODE - 1) * 128 + (n0 & 127));
#pragma unroll
    for (int j = 0; j < 4; ++j) { const int n = (lane >> 3) + 8 * j; const LAS float* s = scr + (8 * c) * 33 + n;
        v4u o; o.x = pk2(s[0 * 33], s[1 * 33]); o.y = pk2(s[2 * 33], s[3 * 33]); o.z = pk2(s[4 * 33], s[5 * 33]); o.w = pk2(s[6 * 33], s[7 * 33]);
        *(GAS v4u*)(WT + (size_t)(rb + n) * K + k0 + 8 * c) = o; }
    LDS_WAIT(); asm volatile("" ::: "memory");
}
template <int NR> __device__ __forceinline__ void p0_rows(Frame& F, int m, int step, int lane) {
    f32x4 v[NR][4]; bool ok[NR];
#pragma unroll
    for (int q = 0; q < NR; ++q) { const int r = m + q * step; ok[q] = r < MT; const int rr = ok[q] ? r : m;
        const GAS f32x4* xr = (const GAS f32x4*)((rr < MP) ? F.inp(I_XP) + (size_t)rr * DM : F.inp(I_XS) + (size_t)(rr - MP) * DM) + lane;
#pragma unroll
        for (int j = 0; j < 4; ++j) v[q][j] = __builtin_nontemporal_load(xr + 64 * j); }
#pragma unroll
    for (int q = 0; q < NR; ++q) { const int r = m + q * step; float s = 0.f;
#pragma unroll
        for (int j = 0; j < 4; ++j) s += (v[q][j].x * v[q][j].x + v[q][j].y * v[q][j].y) + (v[q][j].z * v[q][j].z + v[q][j].w * v[q][j].w);
        s = wave_sum(s);
        if (ok[q]) { GAS unsigned long long* o8 = (GAS unsigned long long*)(F.XB() + (size_t)r * DM) + lane;
#pragma unroll
            for (int j = 0; j < 4; ++j) o8[64 * j] = (unsigned long long)pk2(v[q][j].x, v[q][j].y) | ((unsigned long long)pk2(v[q][j].z, v[q][j].w) << 32);
            if (lane < 16) F.SSQ()[(size_t)r * 16 + lane] = (lane == 0) ? s : 0.f; } }
}
template <int SET> __device__ __forceinline__ void convert_weights(Frame& F, int slot, int nslots) {
    LAS float* scr = (LAS float*)(F.lds + RING_OFF + F.wave * 16384);
    constexpr int I_GU = (DM / 64) * (DFF / 32), I_D = (DFF / 64) * (DM / 32), I_IN = (DM / 64) * (INW / 32), I_OUT = (DM / 64) * (DM / 32);
    constexpr int NITEMS = SET == 0 ? 2 * I_GU + I_IN : SET == 1 ? I_D : I_OUT + 2 * I_GU + I_D;
    const int ln = F.lane();
    for (int it = slot; it < NITEMS; it += nslots) {
        int r = it;
        if (SET == 0) {
            if (r < I_GU) { p0_transpose_item<1>(F.inp(I_F1G), F.inp(I_F1N), DM, DFF, F.WGU1(), scr, r, ln); continue; } r -= I_GU;
            if (r < I_GU) { p0_transpose_item<2>(F.inp(I_F1U), F.inp(I_F1N), DM, DFF, F.WGU1(), scr, r, ln); continue; } r -= I_GU;
            p0_transpose_item<0>(F.inp(I_WIN), F.inp(I_MN), DM, INW, F.WINT(), scr, r, ln);
        } else if (SET == 1) {
            p0_transpose_item<0>(F.inp(I_F1D), nullptr, DFF, DM, F.WD1(), scr, r, ln);
        } else {
            if (r < I_OUT) { const int k0 = 64 * (r / (DM / 32));
                p0_transpose_item<0>(F.inp(I_WOUT), k0 < 512 ? F.inp(I_LON) : F.inp(I_AON) - 512, DM, DM, F.WOUT(), scr, r, ln); continue; } r -= I_OUT;
            if (r < I_GU) { p0_transpose_item<1>(F.inp(I_F2G), F.inp(I_F2N), DM, DFF, F.WGU2(), scr, r, ln); continue; } r -= I_GU;
            if (r < I_GU) { p0_transpose_item<2>(F.inp(I_F2U), F.inp(I_F2N), DM, DFF, F.WGU2(), scr, r, ln); continue; } r -= I_GU;
            p0_transpose_item<0>(F.inp(I_F2D), nullptr, DFF, DM, F.WD2(), scr, r, ln);
        }
    }
}
__device__ __forceinline__ void p0_prologue(Frame& F) {
    const int gw = F.vcu * NWAVES + F.wave, NGW = F.G * NWAVES;
    convert_weights<0>(F, gw, NGW);
    { const int ln = F.lane(); for (int m = gw; m < MP; m += 4 * NGW) p0_rows<4>(F, m, NGW, ln);
      for (int m = MP + gw; m < MT; m += NGW) p0_rows<1>(F, m, NGW, ln); }
    for (int e = F.vcu * (NWAVES * 64) + F.tid(); e < 8 * 2 * 2 * 4 * 64; e += F.G * NWAVES * 64) {
        const int ln = e & 63, ks = (e >> 6) & 3, ct = (e >> 8) & 1, gate = (e >> 9) & 1, blk = e >> 10, ql = ln & 31, hh = ln >> 5;
        const float* pw = (gate ? F.inp(I_WX) : F.inp(I_WA)) + (size_t)(blk * 64 + 16 * ks + 8 * hh) * 64 + 32 * ct + ql;
        v4u o; o.x = pk2(pw[0], pw[64]); o.y = pk2(pw[128], pw[192]); o.z = pk2(pw[256], pw[320]); o.w = pk2(pw[384], pw[448]);
        *(v4u*)(F.WFRAG() + (size_t)e * 8) = o;
    }
    const int gt = F.vcu * (NWAVES * 64) + F.tid(), NGT = F.G * NWAVES * 64;
    for (int e = gt; e < ROPE_ROWS * 32; e += NGT) {
        const int pi = e >> 5, i = e & 31; const int pos = pi < SEQ ? pi : PAST + (pi - SEQ);
        const float invf = (float)exp(-(double)i * (9.210340371976184 / 32.0));
        const float ang = (float)pos * invf; const double a = (double)ang;
        F.ROPEC()[e] = (float)cos(a); F.ROPES()[e] = (float)sin(a);
    }
}

constexpr int LW_XRAW = 0, LW_XCS = 35 * 128, LW_GS = LW_XCS + 32 * 144, LW_OUT = LW_GS + 32 * 128, LW_BYTES = LW_OUT + 32 * 128;
static_assert(8 * LW_BYTES <= SCR_BYTES, "lru LDS");
#define LWAIT() asm volatile("s_waitcnt lgkmcnt(0)" ::: "memory")
template <int PASS> __device__ __forceinline__ void lru_prompt_item(Frame& F, int item) {
    int lane_ = F.lane(); asm volatile("" : "+v"(lane_));
    const int lane0 = lane_, w = F.wave;
    const int b = item / NCHUNK, chunk = item % NCHUNK, t0 = chunk * CHUNK;
    LAS unsigned char* wl = F.lds + w * LW_BYTES;
    float ba[2], bx[2], c8[2];
    { const int ql = lane0 & 31;
#pragma unroll
    for (int ct = 0; ct < 2; ++ct) { const int c = 64 * w + 32 * ct + ql; ba[ct] = F.inp(I_BA)[c]; bx[ct] = F.inp(I_BX)[c];
        const float lam = F.inp(I_LAM)[c]; c8[ct] = -8.0f * LOG2E * (fmaxf(-lam, 0.f) + log1pf(expf(-fabsf(lam)))); } }
    float hst[2] = {0.f, 0.f}, Pst[2] = {1.f, 1.f};
    if (PASS == 2) {
        const float* ls = F.LSUM() + ((size_t)b * NCHUNK * 512 + 64 * w + (lane0 & 31)) * 2; float h0 = 0.f, h1 = 0.f;
#pragma unroll 8
        for (int j = 0; j < chunk; ++j) { const f32x2_t p0 = *(const f32x2_t*)(ls + (size_t)j * 1024), p1 = *(const f32x2_t*)(ls + (size_t)j * 1024 + 64); h0 = p0.x * h0 + p0.y; h1 = p1.x * h1 + p1.y; }
        hst[0] = h0; hst[1] = h1;
    }
    v4u xv[5], gv[4];
    for (int sub = 0; sub < CHUNK / 32; ++sub) {
        const int ts = t0 + sub * 32;
        int lq_ = lane0; asm volatile("" : "+v"(lq_));
        const int lane = lq_, ql = lane & 31, hh = lane >> 5;
        LAS unsigned char* xraw = wl + LW_XRAW; LAS unsigned char* xcs = wl + LW_XCS; LAS unsigned char* gs = wl + LW_GS; LAS unsigned char* outs = wl + LW_OUT;
        const bf16* wfr = F.WFRAG() + (size_t)w * (2 * 2 * 4 * 64 * 8) + lane * 8;
        const bf16* pbase = F.PROJ() + (size_t)(b * SEQ) * INW + 64 * w;
#define LRU_FETCH(tsx) do { _Pragma("unroll") for (int i = 0; i < 5; ++i) { const int idx = lane + 64 * i, row = idx >> 3, ch = idx & 7, t = (tsx) - 3 + row; xv[i] = (v4u){0u, 0u, 0u, 0u}; \
                if (row < 35 && t >= 0) xv[i] = *(const v4u*)(pbase + (size_t)t * INW + C_XL + 8 * ch); } \
            if (PASS == 2) { _Pragma("unroll") for (int i = 0; i < 4; ++i) { const int idx = lane + 64 * i, row = idx >> 3, ch = idx & 7; gv[i] = *(const v4u*)(pbase + (size_t)((tsx) + row) * INW + C_GATE + 8 * ch); } } } while (0)
#ifndef LRU_PREFETCH
#define LRU_PREFETCH 0
#endif
        if (sub == 0 || !LRU_PREFETCH) LRU_FETCH(ts);
        {
#pragma unroll
            for (int i = 0; i < 5; ++i) { const int idx = lane + 64 * i, row = idx >> 3, ch = idx & 7; if (row < 35) *(LAS v4u*)(xraw + row * 128 + 16 * ch) = xv[i]; }
            if (PASS == 2) {
#pragma unroll
                for (int i = 0; i < 4; ++i) { const int idx = lane + 64 * i, row = idx >> 3, ch = idx & 7; *(LAS v4u*)(gs + row * 128 + 16 * ch) = gv[i]; }
            }
        }
        LWAIT();
        {
            const int cch = 64 * w + lane;
            const LAS bf16* xr = (const LAS bf16*)xraw + lane; LAS bf16* xo = (LAS bf16*)xcs + lane;
            const float* cwp = F.inp(I_CW) + cch; const float cw0 = cwp[0], cw1 = cwp[512], cw2 = cwp[1024], cw3 = cwp[1536], cb = F.inp(I_CB)[cch];
            float xm3 = bf1(xr[0]), xm2 = bf1(xr[64]), xm1 = bf1(xr[128]);
#pragma unroll 8
            for (int tt = 0; tt < 32; ++tt) { const float x = bf1(xr[(tt + 3) * 64]);
                xo[tt * 72] = (bf16)f2bf(cb + cw0 * xm3 + cw1 * xm2 + cw2 * xm1 + cw3 * x); xm3 = xm2; xm2 = xm1; xm1 = x; }
            if (PASS == 2 && chunk == NCHUNK - 1 && sub == CHUNK / 32 - 1) {
                F.out[O_PC + (b * 3 + 0) * 512 + cch] = xm3; F.out[O_PC + (b * 3 + 1) * 512 + cch] = xm2; F.out[O_PC + (b * 3 + 2) * 512 + cch] = xm1; }
        }
        LWAIT();
        if (LRU_PREFETCH && sub + 1 < CHUNK / 32) LRU_FETCH(ts + 32);
        bf16x8 af[4];
#pragma unroll
        for (int ks = 0; ks < 4; ++ks) af[ks] = *(const LAS bf16x8*)(xcs + ql * 144 + (16 * ks + 8 * hh) * 2);
        float ssv[16];
#pragma unroll
        for (int r = 0; r < 16; ++r) ssv[r] = 0.f;
#pragma unroll
        for (int ct = 0; ct < 2; ++ct) {
            f32x16 ra = {0.f, 0.f, 0.f, 0.f, 0.f, 0.f, 0.f, 0.f, 0.f, 0.f, 0.f, 0.f, 0.f, 0.f, 0.f, 0.f}, rx = ra;
            {   bf16x8 wa4[4], wx4[4];
#pragma unroll
                for (int ks = 0; ks < 4; ++ks) { wa4[ks] = *(const bf16x8*)(wfr + (size_t)((0 * 2 + ct) * 4 + ks) * 512); wx4[ks] = *(const bf16x8*)(wfr + (size_t)((1 * 2 + ct) * 4 + ks) * 512); }
#pragma unroll
                for (int ks = 0; ks < 4; ++ks) { ra = __builtin_amdgcn_mfma_f32_32x32x16_bf16(af[ks], wa4[ks], ra, 0, 0, 0); rx = __builtin_amdgcn_mfma_f32_32x32x16_bf16(af[ks], wx4[ks], rx, 0, 0, 0); } }
            const int cl = 32 * ct + ql;
            float av[16], uv[16];
#pragma unroll
            for (int r = 0; r < 16; ++r) { const int tk = (r & 3) + 8 * (r >> 2) + 4 * hh;
                const float rg = sigmoid_f(ra[r] + ba[ct]), ig = sigmoid_f(rx[r] + bx[ct]);
                av[r] = __builtin_amdgcn_exp2f(c8[ct] * rg);
                const float mult = __builtin_amdgcn_sqrtf(fmaxf(1.0f - av[r] * av[r], 0.f));
                uv[r] = mult * ig * bf1(*((const LAS bf16*)(xcs + tk * 144) + cl)); }
            float Ag[4], Ug[4], Ap[4], Up[4], st[4];
#pragma unroll
            for (int g = 0; g < 4; ++g) { Ag[g] = (av[4 * g] * av[4 * g + 1]) * (av[4 * g + 2] * av[4 * g + 3]);
                Ug[g] = ((uv[4 * g] * av[4 * g + 1] + uv[4 * g + 1]) * av[4 * g + 2] + uv[4 * g + 2]) * av[4 * g + 3] + uv[4 * g + 3];
                Ap[g] = __shfl_xor(Ag[g], 32); Up[g] = __shfl_xor(Ug[g], 32); }
            float carry = hst[ct], pp = Pst[ct];
#pragma unroll
            for (int g = 0; g < 4; ++g) { const float Alo = hh ? Ap[g] : Ag[g], Ulo = hh ? Up[g] : Ug[g], Ahi = hh ? Ag[g] : Ap[g], Uhi = hh ? Ug[g] : Up[g];
                const float s_lo = carry; carry = Alo * carry + Ulo; const float s_hi = carry; carry = Ahi * carry + Uhi; st[g] = hh ? s_hi : s_lo; pp *= Alo * Ahi; }
            hst[ct] = carry; Pst[ct] = pp;
            if (PASS == 2) {
#pragma unroll
                for (int g = 0; g < 4; ++g) { float hc = st[g];
#pragma unroll
                    for (int e = 0; e < 4; ++e) { const int r = 4 * g + e, tk = e + 8 * g + 4 * hh; hc = av[r] * hc + uv[r];
                        const float o = hc * gelu_tanh(bf1(*((const LAS bf16*)(gs + tk * 128) + cl)));
                        ssv[r] += o * o; *((LAS bf16*)(outs + tk * 128) + cl) = (bf16)f2bf(o); } }
            }
        }
        if (PASS == 2) {
            float* sq = F.SSQL() + (size_t)(b * SEQ + ts) * 8 + w;
#pragma unroll
            for (int r = 0; r < 16; ++r) { float v = ssv[r];
                v += __shfl_xor(v, 1); v += __shfl_xor(v, 2); v += __shfl_xor(v, 4); v += __shfl_xor(v, 8); v += __shfl_xor(v, 16);
                if (ql == 0) sq[((r & 3) + 8 * (r >> 2) + 4 * hh) * 8] = v; }
            LWAIT();
            bf16* cbase = F.CAT() + (size_t)(b * SEQ + ts) * DM + 64 * w;
#pragma unroll
            for (int i = 0; i < 4; ++i) { const int idx = lane + 64 * i, row = idx >> 3, ch = idx & 7; *(v4u*)(cbase + (size_t)row * DM + 8 * ch) = *(const LAS v4u*)(outs + row * 128 + 16 * ch); }
            LWAIT();
        }
    }
    if ((lane0 & 32) == 0) {
#pragma unroll
        for (int ct = 0; ct < 2; ++ct) { const int c = 64 * w + 32 * ct + (lane0 & 31);
            if (PASS == 1) *(f32x2_t*)(F.LSUM() + (((size_t)b * NCHUNK + chunk) * 512 + c) * 2) = (f32x2_t){Pst[ct], hst[ct]};
            if (PASS == 2 && chunk == NCHUNK - 1) F.out[O_PH + b * 512 + c] = hst[ct]; }
    }
}

constexpr int KS_STRIDE = 144, KS_KVH = 256 * KS_STRIDE;
constexpr int VT_STRIDE = 528, VT_KVH = 64 * VT_STRIDE;
constexpr int AT_KS = 0, AT_VT = 2 * KS_KVH, AT_END = AT_VT + 2 * VT_KVH;
static_assert(AT_END <= SCR_BYTES, "attention LDS");
__device__ __forceinline__ int vt_pos(int key) { const int o = key & 15; return (key & ~15) + 8 * ((o >> 2) & 1) + (o & 3) + 4 * (o >> 3); }
__device__ __forceinline__ void attn_prompt_item(Frame& F, int item) {
    const int b = item / (SEQ / WIN), blk = item % (SEQ / WIN);
    int tid_ = F.tid(); asm volatile("" : "+v"(tid_));
    const int tid = tid_, lane = tid & 63, w = F.wave;
    LAS unsigned char* Ks = F.lds + AT_KS; LAS unsigned char* Vt = F.lds + AT_VT;
    {
        const bool lastb = (blk == SEQ / WIN - 1);
        const float* kn = F.inp(I_KN);
        v4u kr[8];
#pragma unroll
        for (int i = 0; i < 8; ++i) { const int idx = tid + 512 * i, key = idx >> 4, cc = idx & 15, tb = blk * WIN - WIN + key;
            kr[i] = (v4u){0u, 0u, 0u, 0u}; if (tb >= 0) kr[i] = *(const v4u*)(F.PROJ() + (size_t)(b * SEQ + tb) * INW + C_K + 8 * cc); }
#pragma unroll
        for (int i = 0; i < 8; ++i) { const int idx = tid + 512 * i, key = idx >> 4, cc = idx & 15, kvh = cc >> 3, c = cc & 7, tb = blk * WIN - WIN + key, tbc = tb < 0 ? 0 : tb;
            float x[8] = {bflo(kr[i].x), bfhi(kr[i].x), bflo(kr[i].y), bfhi(kr[i].y), bflo(kr[i].z), bfhi(kr[i].z), bflo(kr[i].w), bfhi(kr[i].w)};
            float ss = 0.f;
#pragma unroll
            for (int j = 0; j < 8; ++j) ss += x[j] * x[j];
            ss += __shfl_xor(ss, 1); ss += __shfl_xor(ss, 2); ss += __shfl_xor(ss, 4);
            const float rs = __builtin_amdgcn_rsqf(ss * (1.0f / 64.0f) + EPS);
            const f32x4 g0 = *(const f32x4*)(kn + 8 * c), g1 = *(const f32x4*)(kn + 8 * c + 4);
            const f32x4 c0 = *(const f32x4*)(F.ROPEC() + (size_t)tbc * 32 + 8 * (c & 3)), c1 = *(const f32x4*)(F.ROPEC() + (size_t)tbc * 32 + 8 * (c & 3) + 4);
            const f32x4 s0 = *(const f32x4*)(F.ROPES() + (size_t)tbc * 32 + 8 * (c & 3)), s1 = *(const f32x4*)(F.ROPES() + (size_t)tbc * 32 + 8 * (c & 3) + 4);
            float o[8];
#pragma unroll
            for (int j = 0; j < 8; ++j) { const float xn = x[j] * rs * (j < 4 ? g0[j] : g1[j - 4]); const float other = __shfl_xor(xn, 4);
                const float cc2 = j < 4 ? c0[j] : c1[j - 4], sv = j < 4 ? s0[j] : s1[j - 4];
                o[j] = (c < 4) ? (xn * cc2 - other * sv) : (xn * cc2 + other * sv); }
            v4u w4; w4.x = cvtpk(o[0], o[1]); w4.y = cvtpk(o[2], o[3]); w4.z = cvtpk(o[4], o[5]); w4.w = cvtpk(o[6], o[7]);
            *(LAS v4u*)(Ks + kvh * KS_KVH + key * KS_STRIDE + 16 * c) = w4;
            if (lastb && key >= WIN) { float* ok = F.out + O_PK + ((size_t)(b * WIN + key - WIN) * NKV + kvh) * HD + 8 * c;
                *(f32x4*)(ok) = (f32x4){o[0], o[1], o[2], o[3]}; *(f32x4*)(ok + 4) = (f32x4){o[4], o[5], o[6], o[7]}; }
        }
        asm volatile("" ::: "memory");
        v4u vr[8];
#pragma unroll
        for (int i = 0; i < 8; ++i) { const int idx = tid + 512 * i, key = idx >> 4, cc = idx & 15, tb = blk * WIN - WIN + key;
            vr[i] = (v4u){0u, 0u, 0u, 0u}; if (tb >= 0) vr[i] = *(const v4u*)(F.PROJ() + (size_t)(b * SEQ + tb) * INW + C_V + 8 * cc); }
#pragma unroll
        for (int i = 0; i < 8; ++i) { const int idx = tid + 512 * i, key = idx >> 4, cc = idx & 15, kvh = cc >> 3, c = cc & 7;
            LAS bf16* vcol = (LAS bf16*)(Vt + kvh * VT_KVH) + (8 * c) * (VT_STRIDE / 2) + vt_pos(key);
            const unsigned q4[4] = {vr[i].x, vr[i].y, vr[i].z, vr[i].w};
#pragma unroll
            for (int e = 0; e < 4; ++e) { vcol[(2 * e) * (VT_STRIDE / 2)] = (bf16)(q4[e] & 0xffffu); vcol[(2 * e + 1) * (VT_STRIDE / 2)] = (bf16)(q4[e] >> 16); }
            if (lastb && key >= WIN) { float* ov = F.out + O_PV + ((size_t)(b * WIN + key - WIN) * NKV + kvh) * HD + 8 * c;
                *(f32x4*)(ov) = (f32x4){bflo(vr[i].x), bfhi(vr[i].x), bflo(vr[i].y), bfhi(vr[i].y)}; *(f32x4*)(ov + 4) = (f32x4){bflo(vr[i].z), bfhi(vr[i].z), bflo(vr[i].w), bfhi(vr[i].w)}; }
        }
    }
    __syncthreads();
    const int hh = lane >> 5, ql = lane & 31, kvh = w >> 2;
    const float sinkl2 = F.inp(I_SINK)[w] * LOG2E;
    const float QS = 0.125f * LOG2E;
    const float* qn = F.inp(I_QN);
    v4u qraw[4]; f32x4 csv[2][2], snv[2][2];
#define ATT_FETCHQ(sx) do { const int t_ = blk * WIN + 32 * (sx) + ql; const bf16* qp_ = F.PROJ() + ((size_t)b * SEQ + t_) * INW + C_Q + w * 64 + 8 * hh; \
        _Pragma("unroll") for (int ds = 0; ds < 4; ++ds) qraw[ds] = *(const v4u*)(qp_ + 16 * ds); \
        _Pragma("unroll") for (int ds = 0; ds < 2; ++ds) { const float* c_ = F.ROPEC() + (size_t)t_ * 32 + 16 * ds + 8 * hh; const float* s_ = F.ROPES() + (size_t)t_ * 32 + 16 * ds + 8 * hh; \
            csv[ds][0] = *(const f32x4*)c_; csv[ds][1] = *(const f32x4*)(c_ + 4); snv[ds][0] = *(const f32x4*)s_; snv[ds][1] = *(const f32x4*)(s_ + 4); } } while (0)
#ifndef ATT_PREFETCH
#define ATT_PREFETCH 0
#endif
    if (ATT_PREFETCH) ATT_FETCHQ(0);
    for (int s = 0; s < 4; ++s) {
        const int qi = 32 * s + ql, t = blk * WIN + qi; const size_t row = (size_t)b * SEQ + t;
        if (!ATT_PREFETCH) ATT_FETCHQ(s);
        bf16x8 qf[4];
        {
            float qv[4][8]; float ss = 0.f;
#pragma unroll
            for (int ds = 0; ds < 4; ++ds) { const v4u r4 = qraw[ds];
                qv[ds][0] = bflo(r4.x); qv[ds][1] = bfhi(r4.x); qv[ds][2] = bflo(r4.y); qv[ds][3] = bfhi(r4.y); qv[ds][4] = bflo(r4.z); qv[ds][5] = bfhi(r4.z); qv[ds][6] = bflo(r4.w); qv[ds][7] = bfhi(r4.w); }
#pragma unroll
            for (int ds = 0; ds < 4; ++ds)
#pragma unroll
                for (int j = 0; j < 8; ++j) ss += qv[ds][j] * qv[ds][j];
            ss += __shfl_xor(ss, 32);
            const float rs = __builtin_amdgcn_rsqf(ss * (1.0f / 64.0f) + EPS);
#pragma unroll
            for (int ds = 0; ds < 2; ++ds)
#pragma unroll
                for (int j = 0; j < 8; ++j) { const int i = 16 * ds + 8 * hh + j; const float x1 = qv[ds][j] * rs * qn[i], x2 = qv[ds + 2][j] * rs * qn[i + 32], cc = csv[ds][j >> 2][j & 3], sv = snv[ds][j >> 2][j & 3];
                    qv[ds][j] = (x1 * cc - x2 * sv) * QS; qv[ds + 2][j] = (x2 * cc + x1 * sv) * QS; }
#pragma unroll
            for (int ds = 0; ds < 4; ++ds) { v4u o; o.x = cvtpk(qv[ds][0], qv[ds][1]); o.y = cvtpk(qv[ds][2], qv[ds][3]); o.z = cvtpk(qv[ds][4], qv[ds][5]); o.w = cvtpk(qv[ds][6], qv[ds][7]); qf[ds] = __builtin_bit_cast(bf16x8, o); }
        }
        if (ATT_PREFETCH && s + 1 < 4) ATT_FETCHQ(s + 1);
        f32x16 p[5];
#pragma unroll
        for (int kt = 0; kt < 5; ++kt) {
            const LAS unsigned char* kp = Ks + kvh * KS_KVH + (32 * (s + kt) + ql) * KS_STRIDE + 16 * hh;
            f32x16 acc = {0.f, 0.f, 0.f, 0.f, 0.f, 0.f, 0.f, 0.f, 0.f, 0.f, 0.f, 0.f, 0.f, 0.f, 0.f, 0.f};
#pragma unroll
            for (int ds = 0; ds < 4; ++ds) { const bf16x8 kfr = *(const LAS bf16x8*)(kp + 32 * ds); acc = __builtin_amdgcn_mfma_f32_32x32x16_bf16(kfr, qf[ds], acc, 0, 0, 0); }
            p[kt] = acc;
        }
        float mx = -INFINITY;
#pragma unroll
        for (int kt = 0; kt < 5; ++kt) {
            if (kt == 0 || kt == 4 || blk == 0) {
#pragma unroll
                for (int r = 0; r < 16; ++r) { const int kj = 32 * (s + kt) + (r & 3) + 8 * (r >> 2) + 4 * hh;
                    const bool valid = (kj > qi) && (kj <= qi + WIN) && (blk > 0 || kj >= WIN);
                    const float v = valid ? p[kt][r] : -INFINITY; p[kt][r] = v; mx = fmaxf(mx, v); }
            } else {
#pragma unroll
                for (int r = 0; r < 16; ++r) mx = fmaxf(mx, p[kt][r]);
            }
        }
        mx = fmaxf(mx, __shfl_xor(mx, 32)); mx = fmaxf(mx, sinkl2);
        float sum = 0.f;
#pragma unroll
        for (int kt = 0; kt < 5; ++kt)
#pragma unroll
            for (int r = 0; r < 16; ++r) { const float e = __builtin_amdgcn_exp2f(p[kt][r] - mx); p[kt][r] = e; sum += e; }
        sum += __shfl_xor(sum, 32);
        const float inv = __builtin_amdgcn_rcpf(sum + __builtin_amdgcn_exp2f(sinkl2 - mx));
        f32x16 o0 = {0.f, 0.f, 0.f, 0.f, 0.f, 0.f, 0.f, 0.f, 0.f, 0.f, 0.f, 0.f, 0.f, 0.f, 0.f, 0.f}, o1 = o0;
#pragma unroll
        for (int kt = 0; kt < 5; ++kt)
#pragma unroll
            for (int ss2 = 0; ss2 < 2; ++ss2) {
                v4u pw; pw.x = cvtpk(p[kt][8 * ss2 + 0], p[kt][8 * ss2 + 1]); pw.y = cvtpk(p[kt][8 * ss2 + 2], p[kt][8 * ss2 + 3]); pw.z = cvtpk(p[kt][8 * ss2 + 4], p[kt][8 * ss2 + 5]); pw.w = cvtpk(p[kt][8 * ss2 + 6], p[kt][8 * ss2 + 7]);
                const bf16x8 pf = __builtin_bit_cast(bf16x8, pw);
                const LAS unsigned char* vp = Vt + kvh * VT_KVH + ql * VT_STRIDE + (16 * (2 * (s + kt) + ss2) + 8 * hh) * 2;
                const bf16x8 v0 = *(const LAS bf16x8*)(vp), v1 = *(const LAS bf16x8*)(vp + 32 * VT_STRIDE);
                o0 = __builtin_amdgcn_mfma_f32_32x32x16_bf16(v0, pf, o0, 0, 0, 0);
                o1 = __builtin_amdgcn_mfma_f32_32x32x16_bf16(v1, pf, o1, 0, 0, 0);
            }
        float hsq = 0.f;
#pragma unroll
        for (int r = 0; r < 16; ++r) { o0[r] *= inv; o1[r] *= inv; hsq += o0[r] * o0[r] + o1[r] * o1[r]; }
        hsq += __shfl_xor(hsq, 32);
        if (hh == 0) F.SSQA()[row * 8 + w] = hsq;
        bf16* crow = F.CAT() + row * DM + 512 + w * 64;
#pragma unroll
        for (int g = 0; g < 4; ++g) { const int d0 = 8 * g + 4 * hh;
            v2u a, c2; a.x = cvtpk(o0[4 * g], o0[4 * g + 1]); a.y = cvtpk(o0[4 * g + 2], o0[4 * g + 3]);
            c2.x = cvtpk(o1[4 * g], o1[4 * g + 1]); c2.y = cvtpk(o1[4 * g + 2], o1[4 * g + 3]);
            *(v2u*)(crow + d0) = a; *(v2u*)(crow + 32 + d0) = c2; }
    }
    __syncthreads();
}

__device__ __forceinline__ void sample_lru_item(Frame& F, int b) {
    int tid_ = F.tid(); asm volatile("" : "+v"(tid_));
    const int tid = tid_, lane = tid & 63, w = F.wave;
    const size_t row0 = (size_t)MP + (size_t)b * DEC_T;
    {
        const int c = tid, blk = w, cj = c & 63;
        LAS float* xcs = (LAS float*)F.lds;
        LAS float* red = xcs + 4 * 512;
        const float cw0 = F.inp(I_CW)[c], cw1 = F.inp(I_CW)[512 + c], cw2 = F.inp(I_CW)[1024 + c], cw3 = F.inp(I_CW)[1536 + c], cb = F.inp(I_CB)[c];
        const float lam = F.inp(I_LAM)[c];
        const float c8 = -8.0f * (fmaxf(-lam, 0.f) + log1pf(expf(-fabsf(lam))));
        float xs[7];
#pragma unroll
        for (int j = 0; j < 3; ++j) xs[j] = F.inp(I_SC)[((size_t)b * 3 + j) * 512 + c];
#pragma unroll
        for (int t = 0; t < 4; ++t) xs[3 + t] = bf1(F.PROJ()[(row0 + t) * INW + c]);
#pragma unroll
        for (int t = 0; t < 4; ++t) xcs[t * 512 + c] = cb + cw0 * xs[t] + cw1 * xs[t + 1] + cw2 * xs[t + 2] + cw3 * xs[t + 3];
        __syncthreads();
        float rp[4], ip[4];
#pragma unroll
        for (int t = 0; t < 4; ++t) { rp[t] = F.inp(I_BA)[c]; ip[t] = F.inp(I_BX)[c]; }
        const float* wap = F.inp(I_WA) + (size_t)(blk * 64) * 64 + cj; const float* wxp = F.inp(I_WX) + (size_t)(blk * 64) * 64 + cj;
#pragma unroll 16
        for (int k = 0; k < 64; ++k) { const float wa = wap[k * 64], wx = wxp[k * 64];
#pragma unroll
            for (int t = 0; t < 4; ++t) { const float xv = xcs[t * 512 + blk * 64 + k]; rp[t] += xv * wa; ip[t] += xv * wx; } }
        float h = F.inp(I_SH)[(size_t)b * 512 + c]; float ov[4];
#pragma unroll
        for (int t = 0; t < 4; ++t) {
            const float r = sigmoid_f(rp[t]), ig = sigmoid_f(ip[t]);
            const float la = c8 * r, a = __builtin_amdgcn_exp2f(la * LOG2E);
            const float mult = __builtin_amdgcn_sqrtf(one_minus_exp(2.0f * la));
            h = a * h + mult * ig * xcs[t * 512 + c];
            const float g = bf1(F.PROJ()[(row0 + t) * INW + C_GATE + c]);
            ov[t] = h * gelu_tanh(g);
            const float s = wave_sum(ov[t] * ov[t]); if (lane == 0) red[t * 8 + w] = s;
        }
        F.out[O_SH + (size_t)b * 512 + c] = h;
#pragma unroll
        for (int j = 0; j < 3; ++j) F.out[O_SC + ((size_t)b * 3 + j) * 512 + c] = xs[4 + j];
        __syncthreads();
#pragma unroll
        for (int t = 0; t < 4; ++t) { float s = 0.f;
#pragma unroll
            for (int w2 = 0; w2 < 8; ++w2) s += red[t * 8 + w2];
            F.CAT()[(row0 + t) * DM + c] = (bf16)f2bf(ov[t] * __builtin_amdgcn_rsqf(s * (1.0f / 512.0f) + EPS)); }
        __syncthreads();
    }
}
constexpr int SA_KROW = 68, SA_KC = 0, SA_VC = 132 * SA_KROW * 4, SA_QS = SA_VC + 132 * 64 * 4, SA_END = SA_QS + 8 * 64 * 4;
__device__ __forceinline__ void sample_attn_item(Frame& F, int b, int kvh) {
    int tid_ = F.tid(); asm volatile("" : "+v"(tid_));
    const int tid = tid_, lane = tid & 63, w = F.wave;
    const size_t row0 = (size_t)MP + (size_t)b * DEC_T;
    LAS float* Kc = (LAS float*)(F.lds + SA_KC); LAS float* Vc = (LAS float*)(F.lds + SA_VC); LAS float* qs = (LAS float*)(F.lds + SA_QS);
    {
        const float* ck = F.inp(I_CK) + (size_t)b * WIN * 128 + kvh * 64; const float* cv = F.inp(I_CV) + (size_t)b * WIN * 128 + kvh * 64;
        float* ok = F.out + O_SK + (size_t)b * WIN * 128 + kvh * 64; float* ov = F.out + O_SV + (size_t)b * WIN * 128 + kvh * 64;
#pragma unroll
        for (int i = 0; i < 4; ++i) { const int idx = tid + 512 * i, j = idx >> 4, d4 = (idx & 15) * 4;
            const f32x4 kv = *(const f32x4*)(ck + (size_t)j * 128 + d4), vv = *(const f32x4*)(cv + (size_t)j * 128 + d4);
            *(LAS f32x4*)(Kc + j * SA_KROW + d4) = kv; *(LAS f32x4*)(Vc + j * 64 + d4) = vv;
            if (j >= DEC_T) { *(f32x4*)(ok + (size_t)(j - DEC_T) * 128 + d4) = kv; *(f32x4*)(ov + (size_t)(j - DEC_T) * 128 + d4) = vv; } }
        if (w < DEC_T) {
            const int t = w, i = lane & 31;
            const bf16* pr = F.PROJ() + (row0 + t) * INW;
            const float k1 = bf1(pr[C_K + kvh * 64 + i]), k2 = bf1(pr[C_K + kvh * 64 + 32 + i]);
            float ss = k1 * k1 + k2 * k2;
#pragma unroll
            for (int o = 1; o < 32; o <<= 1) ss += __shfl_xor(ss, o);
            const float rs = __builtin_amdgcn_rsqf(ss * (1.0f / 64.0f) + EPS);
            const float x1 = k1 * rs * F.inp(I_KN)[i], x2 = k2 * rs * F.inp(I_KN)[i + 32];
            const float cc = F.ROPEC()[(size_t)(SEQ + t) * 32 + i], sv = F.ROPES()[(size_t)(SEQ + t) * 32 + i];
            const float o1 = x1 * cc - x2 * sv, o2 = x2 * cc + x1 * sv;
            const float v1 = bf1(pr[C_V + kvh * 64 + i]), v2 = bf1(pr[C_V + kvh * 64 + 32 + i]);
            if (lane < 32) {
                Kc[(WIN + t) * SA_KROW + i] = o1; Kc[(WIN + t) * SA_KROW + 32 + i] = o2; Vc[(WIN + t) * 64 + i] = v1; Vc[(WIN + t) * 64 + 32 + i] = v2;
                const size_t oo = (size_t)(WIN - DEC_T + t) * 128;
                ok[oo + i] = o1; ok[oo + 32 + i] = o2; ov[oo + i] = v1; ov[oo + 32 + i] = v2; }
        }
    }
    __syncthreads();
    const int head = kvh * 4 + (w & 3);
    const float sinkl2 = F.inp(I_SINK)[head] * LOG2E;
#pragma unroll
    for (int tt = 0; tt < 2; ++tt) {
        const int t = 2 * (w >> 2) + tt;
        {
            const float x = bf1(F.PROJ()[(row0 + t) * INW + C_Q + head * 64 + lane]);
            const float ss = wave_sum(x * x);
            const float xn = x * __builtin_amdgcn_rsqf(ss * (1.0f / 64.0f) + EPS) * F.inp(I_QN)[lane];
            const float other = __shfl_xor(xn, 32);
            const int i = lane & 31; const float cc = F.ROPEC()[(size_t)(SEQ + t) * 32 + i], sv = F.ROPES()[(size_t)(SEQ + t) * 32 + i];
            const float qo = (lane < 32) ? (xn * cc - other * sv) : (xn * cc + other * sv);
            qs[w * 64 + lane] = qo * (0.125f * LOG2E);
        }
        LDS_WAIT(); asm volatile("" ::: "memory");
        const int j0 = t + 1 + lane, j1 = j0 + 64;
        float s0 = 0.f, s1 = 0.f;
        const LAS f32x4* q4 = (const LAS f32x4*)(qs + w * 64);
        const LAS f32x4* k0 = (const LAS f32x4*)(Kc + j0 * SA_KROW); const LAS f32x4* k1 = (const LAS f32x4*)(Kc + j1 * SA_KROW);
#pragma unroll
        for (int d4 = 0; d4 < 16; ++d4) { const f32x4 q = q4[d4], a = k0[d4], c = k1[d4];
            s0 += q[0] * a[0] + q[1] * a[1] + q[2] * a[2] + q[3] * a[3]; s1 += q[0] * c[0] + q[1] * c[1] + q[2] * c[2] + q[3] * c[3]; }
        float mx = wave_max(fmaxf(s0, s1)); mx = fmaxf(mx, sinkl2);
        const float p0 = __builtin_amdgcn_exp2f(s0 - mx), p1 = __builtin_amdgcn_exp2f(s1 - mx);
        const float l = wave_sum(p0 + p1) + __builtin_amdgcn_exp2f(sinkl2 - mx);
        float o = 0.f;
#pragma unroll 8
        for (int jj = 0; jj < 64; ++jj) { const float pa = __shfl(p0, jj), pb = __shfl(p1, jj); o += pa * Vc[(t + 1 + jj) * 64 + lane] + pb * Vc[(t + 65 + jj) * 64 + lane]; }
        o *= __builtin_amdgcn_rcpf(l);
        F.SOA()[((size_t)b * DEC_T + t) * 512 + head * 64 + lane] = o;
        const float hq = wave_sum(o * o); if (lane == 0) F.SSQS()[((size_t)b * DEC_T + t) * 8 + head] = hq;
    }
    __syncthreads();
}
__device__ __forceinline__ void sample_attn_norm(Frame& F) {
    const int lane = F.lane(), gw = blockIdx.x * NWAVES + F.wave;
    for (int r = gw; r < MS; r += F.G * NWAVES) {
        const f32x4* sp = (const f32x4*)(F.SSQS() + (size_t)r * 8); const f32x4 s0 = sp[0], s1 = sp[1];
        const float rs = __builtin_amdgcn_rsqf((((s0[0] + s0[1]) + (s0[2] + s0[3])) + ((s1[0] + s1[1]) + (s1[2] + s1[3]))) * (1.0f / 512.0f) + EPS);
        const f32x4* op = (const f32x4*)(F.SOA() + (size_t)r * 512 + lane * 8); const f32x4 a = op[0], c = op[1];
        v4u o; o.x = cvtpk(a[0] * rs, a[1] * rs); o.y = cvtpk(a[2] * rs, a[3] * rs); o.z = cvtpk(c[0] * rs, c[1] * rs); o.w = cvtpk(c[2] * rs, c[3] * rs);
        *(v4u*)(F.CAT() + ((size_t)MP + r) * DM + 512 + lane * 8) = o;
    }
}

struct SEpiSwiglu {
    bf16* H; const float* ssq;
    __device__ __forceinline__ int brow0(int cb) const { const int hc0 = 32 * cb; return (hc0 >> 7) * 256 + (hc0 & 127); }
    __device__ __forceinline__ int brow1(int cb) const { return brow0(cb) + 128; }
    __device__ __forceinline__ void operator()(const f32x16& a0, const f32x16& a1, int r, int cb, int h) const {
        const float rs = pg8::row_rs(ssq, r);
#pragma unroll
        for (int g = 0; g < 4; ++g) { float hv[4];
#pragma unroll
            for (int e = 0; e < 4; ++e) hv[e] = pg8::silu_f(a0[4 * g + e] * rs) * (a1[4 * g + e] * rs);
            v2u w; w.x = cvtpk(hv[0], hv[1]); w.y = cvtpk(hv[2], hv[3]); *(v2u*)(H + (size_t)r * DFF + 32 * cb + 8 * g + 4 * h) = w; }
    }
};
struct SEpiScale {
    bf16* O; int ldc; const float* ssq;
    __device__ __forceinline__ int brow0(int cb) const { return 64 * cb; }
    __device__ __forceinline__ int brow1(int cb) const { return 64 * cb + 32; }
    __device__ __forceinline__ void operator()(const f32x16& a0, const f32x16& a1, int r, int cb, int h) const {
        const float rs = pg8::row_rs(ssq, r);
#pragma unroll
        for (int g = 0; g < 4; ++g) {
            v2u w; w.x = cvtpk(a0[4 * g] * rs, a0[4 * g + 1] * rs); w.y = cvtpk(a0[4 * g + 2] * rs, a0[4 * g + 3] * rs); *(v2u*)(O + (size_t)r * ldc + 64 * cb + 8 * g + 4 * h) = w;
            v2u x; x.x = cvtpk(a1[4 * g] * rs, a1[4 * g + 1] * rs); x.y = cvtpk(a1[4 * g + 2] * rs, a1[4 * g + 3] * rs); *(v2u*)(O + (size_t)r * ldc + 64 * cb + 32 + 8 * g + 4 * h) = x; }
    }
};
template <int MODE> struct SEpiResid {
    const float* basef; float* out; bf16* xb; float* ssq; float scale;
    __device__ __forceinline__ int brow0(int cb) const { return 64 * cb; }
    __device__ __forceinline__ int brow1(int cb) const { return 64 * cb + 32; }
    __device__ __forceinline__ void operator()(const f32x16& a0, const f32x16& a1, int r, int cb, int h) const {
        float s = 0.f;
#pragma unroll
        for (int a = 0; a < 2; ++a)
#pragma unroll
            for (int g = 0; g < 4; ++g) { const size_t off = (size_t)r * DM + 64 * cb + 32 * a + 8 * g + 4 * h;
                f32x4 b; if (MODE == 0) b = *(const f32x4*)(basef + off); else b = pg8::bf4_to_f32(*(const v2u*)(xb + off));
                const f32x4 v = a == 0 ? (f32x4){a0[4 * g], a0[4 * g + 1], a0[4 * g + 2], a0[4 * g + 3]} : (f32x4){a1[4 * g], a1[4 * g + 1], a1[4 * g + 2], a1[4 * g + 3]};
                const f32x4 o = b + v * scale;
                if (MODE == 2) *(f32x4*)(out + off) = o;
                else { s += (o[0] * o[0] + o[1] * o[1]) + (o[2] * o[2] + o[3] * o[3]); v2u w; w.x = cvtpk(o[0], o[1]); w.y = cvtpk(o[2], o[3]); *(v2u*)(xb + off) = w; } }
        if (MODE != 2) { s += __shfl_xor(s, 32); if (h == 0) ssq[(size_t)r * 16 + cb] = s; }
    }
};
constexpr int SG_ROWB = 144, SG_TILE = 32 * SG_ROWB, SG_WAVE = 3 * SG_TILE;
static_assert(8 * SG_WAVE <= SCR_BYTES, "small gemm LDS");
template <int K, int KS, class Epi> __device__ __forceinline__ void small_gemm(Frame& F, const bf16* A, int lda, const bf16* Bt, int ncb, const Epi& E, unsigned* dyn) {
    int lane_ = F.lane(); asm volatile("" : "+v"(lane_));
    const int lane = lane_, w = F.wave, ql = lane & 31, h = lane >> 5, lr = lane >> 3, ch = lane & 7;
    const int nitems = 16 * ncb * KS;
    constexpr int NBT = K / 64, NB_LO = NBT / KS, NB_REM = NBT % KS;
    LAS unsigned char* tl = F.lds + w * SG_WAVE;
    LAS float* red = (LAS float*)F.lds;
    for (;;) {
        if (F.tid() == 0) F.MISC[0] = __hip_atomic_fetch_add(dyn, 1u, __ATOMIC_RELAXED, __HIP_MEMORY_SCOPE_AGENT);
        __syncthreads();
        const int base = (int)F.MISC[0] * NWAVES;
        __syncthreads();
        if (base >= nitems) break;
        const int it = base + w; const bool valid = it < nitems;
        const int tile = it / KS, ks = it % KS, rb = tile & 15, cb = tile >> 4;
        f32x16 acc0 = {0.f, 0.f, 0.f, 0.f, 0.f, 0.f, 0.f, 0.f, 0.f, 0.f, 0.f, 0.f, 0.f, 0.f, 0.f, 0.f}, acc1 = acc0;
        const int r = MP + 32 * rb + ql;
        if (valid) {
            const int nb = NB_LO + (ks < NB_REM ? 1 : 0), kb0 = 64 * (ks * NB_LO + (ks < NB_REM ? ks : NB_REM));
            const bf16* ga = A + (size_t)(MP + 32 * rb + lr) * lda + kb0 + 8 * ch;
            const bf16* g0 = Bt + (size_t)(E.brow0(cb) + lr) * K + kb0 + 8 * ch;
            const bf16* g1 = Bt + (size_t)(E.brow1(cb) + lr) * K + kb0 + 8 * ch;
            v4u ra[4], r0[4], r1[4], sa[4], s0[4], s1[4];
#define SG_LD1(dst, ptr) asm volatile("global_load_dwordx4 %0, %1, off" : "=v"(dst) : "v"(ptr) : "memory")
#define SG_FETCH(RA, R0, R1, bb) do { _Pragma("unroll") for (int i = 0; i < 4; ++i) { SG_LD1(RA[i], ga + (size_t)(8 * i) * lda + 64 * (bb)); SG_LD1(R0[i], g0 + (size_t)(8 * i) * K + 64 * (bb)); SG_LD1(R1[i], g1 + (size_t)(8 * i) * K + 64 * (bb)); } } while (0)
#define SG_WAIT(N, RA, R0, R1) asm volatile("s_waitcnt vmcnt(" #N ")" : "+v"(RA[0]), "+v"(RA[1]), "+v"(RA[2]), "+v"(RA[3]), "+v"(R0[0]), "+v"(R0[1]), "+v"(R0[2]), "+v"(R0[3]), "+v"(R1[0]), "+v"(R1[1]), "+v"(R1[2]), "+v"(R1[3]) :: "memory")
#define SG_PARK(RA, R0, R1) do { _Pragma("unroll") for (int i = 0; i < 4; ++i) { const int off = (lr + 8 * i) * SG_ROWB + 16 * ch; *(LAS v4u*)(tl + off) = RA[i]; *(LAS v4u*)(tl + SG_TILE + off) = R0[i]; *(LAS v4u*)(tl + 2 * SG_TILE + off) = R1[i]; } } while (0)
#define SG_MMA() do { _Pragma("unroll") for (int sI = 0; sI < 4; ++sI) { const int fo = ql * SG_ROWB + 32 * sI + 16 * h; \
                    const bf16x8 af = *(const LAS bf16x8*)(tl + fo), bf0 = *(const LAS bf16x8*)(tl + SG_TILE + fo), bf1v = *(const LAS bf16x8*)(tl + 2 * SG_TILE + fo); \
                    acc0 = __builtin_amdgcn_mfma_f32_32x32x16_bf16(bf0, af, acc0, 0, 0, 0); acc1 = __builtin_amdgcn_mfma_f32_32x32x16_bf16(bf1v, af, acc1, 0, 0, 0); } } while (0)
            asm volatile("s_waitcnt vmcnt(0)" ::: "memory");
            SG_FETCH(ra, r0, r1, 0);
            if (nb > 1) SG_FETCH(sa, s0, s1, 1);
            int b = 0;
            for (; b + 3 < nb; b += 2) {
                SG_WAIT(12, ra, r0, r1); SG_PARK(ra, r0, r1); SG_FETCH(ra, r0, r1, b + 2); SG_MMA();
                SG_WAIT(12, sa, s0, s1); SG_PARK(sa, s0, s1); SG_FETCH(sa, s0, s1, b + 3); SG_MMA();
            }
            SG_WAIT(0, ra, r0, r1); if (b + 1 < nb) SG_WAIT(0, sa, s0, s1);
            SG_PARK(ra, r0, r1); if (b + 2 < nb) SG_FETCH(ra, r0, r1, b + 2); SG_MMA();
            if (b + 1 < nb) { SG_PARK(sa, s0, s1); SG_MMA(); }
            if (b + 2 < nb) { SG_WAIT(0, ra, r0, r1); SG_PARK(ra, r0, r1); SG_MMA(); }
#undef SG_LD1
#undef SG_FETCH
#undef SG_WAIT
#undef SG_PARK
#undef SG_MMA
        }
        if (KS > 1) {
            __syncthreads();
#pragma unroll
            for (int q = 0; q < 16; ++q) { red[((w * 2 + 0) * 16 + q) * 64 + lane] = acc0[q]; red[((w * 2 + 1) * 16 + q) * 64 + lane] = acc1[q]; }
            __syncthreads();
            if (valid && ks == 0) {
#pragma unroll
                for (int j = 1; j < KS; ++j)
#pragma unroll
                    for (int q = 0; q < 16; ++q) { acc0[q] += red[(((w + j) * 2 + 0) * 16 + q) * 64 + lane]; acc1[q] += red[(((w + j) * 2 + 1) * 16 + q) * 64 + lane]; }
            }
        }
        if (valid && ks == 0) E(acc0, acc1, r, cb, h);
        if (KS > 1) __syncthreads();
    }
}

#ifndef MK_N_LAUNCHES
#define MK_N_LAUNCHES 1
#endif
constexpr int N_PHASES = 9;
constexpr int N_LAUNCHES = MK_N_LAUNCHES;
struct Args { const float* in[29]; float* out; unsigned char* ws; int ph_lo, ph_hi, li, pad; };
__global__ void __launch_bounds__(NWAVES * 64, 2) hymba_fwd(Args args) {
    extern __shared__ __attribute__((aligned(16))) unsigned char lds[];
    Frame F;
    F.lds = (LAS unsigned char*)lds;
    F.MISC = (volatile LAS unsigned*)(F.lds + MISC_OFF);
    F.wave = __builtin_amdgcn_readfirstlane((int)threadIdx.x >> 6);
    F.G = gridDim.x; { const int bx = blockIdx.x; F.vcu = (F.G % 8 == 0) ? (bx % 8) * (F.G / 8) + bx / 8 : bx; }
    F.kp = (kernarg_ptr)__builtin_amdgcn_kernarg_segment_ptr(); F.out = args.out; F.ws = args.ws;
    for (int u = F.tid(); u < (LDS_BYTES - LDSCTL_OFF) / 4; u += NWAVES * 64) ((LAS unsigned*)(F.lds + LDSCTL_OFF))[u] = 0u;
    __syncthreads();
    XcdBarrier bar; bar.bar = (unsigned*)(F.ctl() + CW_BAR); bar.x = 0; bar.st = nullptr;
    if (N_LAUNCHES == 1) bar = xcd_barrier_post((unsigned*)(F.ctl() + CW_BAR), F.MISC + 8, F.tid() == 0);
#define GRID_BAR() do { if (N_LAUNCHES == 1) xcd_barrier(bar, F.tid() == 0); } while (0)
    const int lo = args.ph_lo, hi = args.ph_hi;
#define IN(k) (lo <= (k) && (k) < hi)
#ifndef PROBE_PHASE
#define PROBE_PHASE -1
#endif
#ifndef PROBE_BLOCK
#define PROBE_BLOCK 0
#endif
    unsigned long long tsA = 0, tsB = 0; pg8::Tm tm{0, 0};
#define STAMP(k) do { if (PROBE_WHICH == 8 && (k) == PROBE_PHASE) tsA = __builtin_amdgcn_s_memrealtime(); if (PROBE_PHASE >= 0 && PROBE_WHICH == 0) { if ((k) == PROBE_PHASE) tsA = __builtin_amdgcn_s_memrealtime(); if ((k) == PROBE_PHASE + 1) tsB = __builtin_amdgcn_s_memrealtime(); } } while (0)
#define BOTH(k) (IN(k) && IN((k) + 1))
#ifndef PROBE_REP
#define PROBE_REP 0
#endif
#define REP(k) for (int rep_ = 0; rep_ < (((PROBE_REP >> (k)) & 1) ? 2 : 1); ++rep_)

#ifndef SKIP_P0
#undef CURPH
#define CURPH 0
    STAMP(0);
    if (IN(0)) REP(0) { p0_prologue(F); { if (PROBE_WHICH == 8 && PROBE_PHASE == 0) tsB = __builtin_amdgcn_s_memrealtime(); if (PROBE_WHICH == 7 && PROBE_PHASE == 0) tsA = __builtin_amdgcn_s_memrealtime(); if (BOTH(0)) GRID_BAR(); if (PROBE_WHICH == 7 && PROBE_PHASE == 0) tsB = __builtin_amdgcn_s_memrealtime(); } }
#endif
#undef CURPH
#define CURPH 1
    STAMP(1);
    if (IN(1)) REP(1) {
        pg8::Gemm g{F.XB(), F.WGU1(), MP, 2 * DFF, DM}; pg8::StaticOrder S; S.init(MP, 2 * DFF, F.G, (int)blockIdx.x);
        pg8::EpiSwiglu E{F.HB(), DFF}; pg8::rs_cache_fill(F.lds + RING_OFF, S, F.SSQ(), F.wave);
        pg8::gemm_phase<pg8::EpiSwiglu, pg8::StaticOrder, true, true>(F.lds + RING_OFF, g, S, E, F.wave, tm);
        if ((PROBE_WHICH == 1 || PROBE_WHICH == 2) && PROBE_PHASE == 1) { tsA = 0; tsB = (PROBE_WHICH == 1) ? tm.k : tm.e; } tm.k = 0; tm.e = 0;
        { constexpr int FIRST = (16 * (DFF / 32) + NWAVES - 1) / NWAVES;
          if ((int)F.G > FIRST) { if ((int)blockIdx.x >= FIRST) convert_weights<1>(F, ((int)blockIdx.x - FIRST) * NWAVES + F.wave, ((int)F.G - FIRST) * NWAVES); }
          else convert_weights<1>(F, (int)blockIdx.x * NWAVES + F.wave, (int)F.G * NWAVES);
          __syncthreads(); }
        { const unsigned long long ts0_ = (PROBE_WHICH == 3) ? __builtin_amdgcn_s_memrealtime() : 0ull;
        { SEpiSwiglu SE{F.HB(), F.SSQ()}; small_gemm<DM, 1, SEpiSwiglu>(F, F.XB(), DM, F.WGU1(), DFF / 32, SE, (unsigned*)(F.ctl() + CW_DYN + 64 * 1)); }
          if (PROBE_WHICH == 3 && PROBE_PHASE == CURPH) { asm volatile("s_waitcnt vmcnt(0)" ::: "memory"); tsA = ts0_; tsB = __builtin_amdgcn_s_memrealtime(); } }
        { if (PROBE_WHICH == 8 && PROBE_PHASE == 1) tsB = __builtin_amdgcn_s_memrealtime(); if (PROBE_WHICH == 7 && PROBE_PHASE == 1) tsA = __builtin_amdgcn_s_memrealtime(); if (BOTH(1)) GRID_BAR(); if (PROBE_WHICH == 7 && PROBE_PHASE == 1) tsB = __builtin_amdgcn_s_memrealtime(); }
    }
#undef CURPH
#define CURPH 2
    STAMP(2);
    if (IN(2)) REP(2) {
        pg8::Gemm g{F.HB(), F.WD1(), MP, DM, DFF}; pg8::StaticOrder S; S.init(MP, DM, F.G, (int)blockIdx.x);
        pg8::EpiResid<1> E{nullptr, nullptr, F.XB(), F.SSQ(), 0.5f};
        pg8::gemm_phase<pg8::EpiResid<1>, pg8::StaticOrder, true, true>(F.lds + RING_OFF, g, S, E, F.wave, tm);
        if ((PROBE_WHICH == 1 || PROBE_WHICH == 2) && PROBE_PHASE == 2) { tsA = 0; tsB = (PROBE_WHICH == 1) ? tm.k : tm.e; } tm.k = 0; tm.e = 0;
        { const unsigned long long ts0_ = (PROBE_WHICH == 3) ? __builtin_amdgcn_s_memrealtime() : 0ull;
        { SEpiResid<1> SE{nullptr, nullptr, F.XB(), F.SSQ(), 0.5f}; small_gemm<DFF, 8, SEpiResid<1>>(F, F.HB(), DFF, F.WD1(), DM / 64, SE, (unsigned*)(F.ctl() + CW_DYN + 64 * 2)); }
          if (PROBE_WHICH == 3 && PROBE_PHASE == CURPH) { asm volatile("s_waitcnt vmcnt(0)" ::: "memory"); tsA = ts0_; tsB = __builtin_amdgcn_s_memrealtime(); } }
        { if (PROBE_WHICH == 8 && PROBE_PHASE == 2) tsB = __builtin_amdgcn_s_memrealtime(); if (PROBE_WHICH == 7 && PROBE_PHASE == 2) tsA = __builtin_amdgcn_s_memrealtime(); if (BOTH(2)) GRID_BAR(); if (PROBE_WHICH == 7 && PROBE_PHASE == 2) tsB = __builtin_amdgcn_s_memrealtime(); }
    }
#undef CURPH
#define CURPH 3
    STAMP(3);
    if (IN(3)) REP(3) {
        pg8::Gemm g{F.XB(), F.WINT(), MP, INW, DM}; pg8::StaticOrder S; S.init(MP, INW, F.G, (int)blockIdx.x);
        pg8::EpiScaleBf16 E{F.PROJ(), INW}; pg8::rs_cache_fill(F.lds + RING_OFF, S, F.SSQ(), F.wave);
        pg8::gemm_phase<pg8::EpiScaleBf16, pg8::StaticOrder, true, true>(F.lds + RING_OFF, g, S, E, F.wave, tm);
        if ((PROBE_WHICH == 1 || PROBE_WHICH == 2) && PROBE_PHASE == 3) { tsA = 0; tsB = (PROBE_WHICH == 1) ? tm.k : tm.e; } tm.k = 0; tm.e = 0;
        { const int NU = (MP / 256) * (INW / 256), light0 = NU % (int)F.G;
          if (light0 != 0) { if ((int)blockIdx.x >= light0) convert_weights<2>(F, ((int)blockIdx.x - light0) * NWAVES + F.wave, ((int)F.G - light0) * NWAVES); }
          else convert_weights<2>(F, (int)blockIdx.x * NWAVES + F.wave, (int)F.G * NWAVES);
          __syncthreads(); }
        { const unsigned long long ts0_ = (PROBE_WHICH == 3) ? __builtin_amdgcn_s_memrealtime() : 0ull;
        { SEpiScale SE{F.PROJ(), INW, F.SSQ()}; small_gemm<DM, 4, SEpiScale>(F, F.XB(), DM, F.WINT(), INW / 64, SE, (unsigned*)(F.ctl() + CW_DYN + 64 * 3)); }
          if (PROBE_WHICH == 3 && PROBE_PHASE == CURPH) { asm volatile("s_waitcnt vmcnt(0)" ::: "memory"); tsA = ts0_; tsB = __builtin_amdgcn_s_memrealtime(); } }
        { if (PROBE_WHICH == 8 && PROBE_PHASE == 3) tsB = __builtin_amdgcn_s_memrealtime(); if (PROBE_WHICH == 7 && PROBE_PHASE == 3) tsA = __builtin_amdgcn_s_memrealtime(); if (BOTH(3)) GRID_BAR(); if (PROBE_WHICH == 7 && PROBE_PHASE == 3) tsB = __builtin_amdgcn_s_memrealtime(); }
    }
#undef CURPH
#define CURPH 4
    STAMP(4);
    if (IN(4)) REP(4) {
#ifndef SKIP_ATTN
        if (PROBE_WHICH == 4 && PROBE_PHASE == 4) tsA = __builtin_amdgcn_s_memrealtime();
        REP(8) for (int it = blockIdx.x; it < BATCH * (SEQ / WIN); it += F.G) attn_prompt_item(F, it);
#endif
        if (PROBE_WHICH == 4 && PROBE_PHASE == 4) tsB = __builtin_amdgcn_s_memrealtime();
        if (PROBE_WHICH == 5 && PROBE_PHASE == 4) tsA = __builtin_amdgcn_s_memrealtime();
#ifndef SKIP_LRU1
        REP(9) for (int it = blockIdx.x; it < BATCH * NCHUNK; it += F.G) lru_prompt_item<1>(F, it);
#endif
#ifndef SKIP_SAMPLE
        __syncthreads();
        if (PROBE_WHICH == 5 && PROBE_PHASE == 4) tsB = __builtin_amdgcn_s_memrealtime();
        if (PROBE_WHICH == 6 && PROBE_PHASE == 4) tsA = __builtin_amdgcn_s_memrealtime();
        REP(10) for (int it = blockIdx.x; it < 3 * DEC_B; it += F.G) { if (it < DEC_B) sample_lru_item(F, it); else sample_attn_item(F, (it - DEC_B) >> 1, (it - DEC_B) & 1); }
#endif
        if (PROBE_WHICH == 6 && PROBE_PHASE == 4) tsB = __builtin_amdgcn_s_memrealtime();
        if (PROBE_WHICH == 7 && PROBE_PHASE == 4) tsA = __builtin_amdgcn_s_memrealtime();
        if (BOTH(4)) GRID_BAR();
        if (PROBE_WHICH == 7 && PROBE_PHASE == 4) tsB = __builtin_amdgcn_s_memrealtime();
    }
#undef CURPH
#define CURPH 5
    STAMP(5);
    if (IN(5)) REP(5) {
        sample_attn_norm(F);
#ifndef SKIP_LRU2
        for (int it = blockIdx.x; it < BATCH * NCHUNK; it += F.G) lru_prompt_item<2>(F, it);
#endif
        { if (PROBE_WHICH == 8 && PROBE_PHASE == 5) tsB = __builtin_amdgcn_s_memrealtime(); if (PROBE_WHICH == 7 && PROBE_PHASE == 5) tsA = __builtin_amdgcn_s_memrealtime(); if (BOTH(5)) GRID_BAR(); if (PROBE_WHICH == 7 && PROBE_PHASE == 5) tsB = __builtin_amdgcn_s_memrealtime(); }
    }
#undef CURPH
#define CURPH 6
    STAMP(6);
    if (IN(6)) {
        pg8::Gemm g{F.CAT(), F.WOUT(), MP, DM, DM}; pg8::StaticOrder S; S.init(MP, DM, F.G, (int)blockIdx.x);
        pg8::EpiResidMix E{F.XB(), F.SSQ()}; pg8::mix_cache_fill(F.lds + RING_OFF, S, F.SSQL(), F.SSQA(), F.wave);
        pg8::gemm_phase<pg8::EpiResidMix, pg8::StaticOrder, true, true>(F.lds + RING_OFF, g, S, E, F.wave, tm);
        if ((PROBE_WHICH == 1 || PROBE_WHICH == 2) && PROBE_PHASE == 6) { tsA = 0; tsB = (PROBE_WHICH == 1) ? tm.k : tm.e; } tm.k = 0; tm.e = 0;
        { const unsigned long long ts0_ = (PROBE_WHICH == 3) ? __builtin_amdgcn_s_memrealtime() : 0ull;
        { SEpiResid<1> SE{nullptr, nullptr, F.XB(), F.SSQ(), 1.0f}; small_gemm<DM, 8, SEpiResid<1>>(F, F.CAT(), DM, F.WOUT(), DM / 64, SE, (unsigned*)(F.ctl() + CW_DYN + 64 * 6)); }
          if (PROBE_WHICH == 3 && PROBE_PHASE == CURPH) { asm volatile("s_waitcnt vmcnt(0)" ::: "memory"); tsA = ts0_; tsB = __builtin_amdgcn_s_memrealtime(); } }
        { if (PROBE_WHICH == 8 && PROBE_PHASE == 6) tsB = __builtin_amdgcn_s_memrealtime(); if (PROBE_WHICH == 7 && PROBE_PHASE == 6) tsA = __builtin_amdgcn_s_memrealtime(); if (BOTH(6)) GRID_BAR(); if (PROBE_WHICH == 7 && PROBE_PHASE == 6) tsB = __builtin_amdgcn_s_memrealtime(); }
    }
#undef CURPH
#define CURPH 7
    STAMP(7);
    if (IN(7)) REP(7) {
        pg8::Gemm g{F.XB(), F.WGU2(), MP, 2 * DFF, DM}; pg8::StaticOrder S; S.init(MP, 2 * DFF, F.G, (int)blockIdx.x);
        pg8::EpiSwiglu E{F.HB(), DFF}; pg8::rs_cache_fill(F.lds + RING_OFF, S, F.SSQ(), F.wave);
        pg8::gemm_phase<pg8::EpiSwiglu, pg8::StaticOrder, true, true>(F.lds + RING_OFF, g, S, E, F.wave, tm);
        if ((PROBE_WHICH == 1 || PROBE_WHICH == 2) && PROBE_PHASE == 7) { tsA = 0; tsB = (PROBE_WHICH == 1) ? tm.k : tm.e; } tm.k = 0; tm.e = 0;
        { const unsigned long long ts0_ = (PROBE_WHICH == 3) ? __builtin_amdgcn_s_memrealtime() : 0ull;
        { SEpiSwiglu SE{F.HB(), F.SSQ()}; small_gemm<DM, 1, SEpiSwiglu>(F, F.XB(), DM, F.WGU2(), DFF / 32, SE, (unsigned*)(F.ctl() + CW_DYN + 64 * 7)); }
          if (PROBE_WHICH == 3 && PROBE_PHASE == CURPH) { asm volatile("s_waitcnt vmcnt(0)" ::: "memory"); tsA = ts0_; tsB = __builtin_amdgcn_s_memrealtime(); } }
        { if (PROBE_WHICH == 8 && PROBE_PHASE == 7) tsB = __builtin_amdgcn_s_memrealtime(); if (PROBE_WHICH == 7 && PROBE_PHASE == 7) tsA = __builtin_amdgcn_s_memrealtime(); if (BOTH(7)) GRID_BAR(); if (PROBE_WHICH == 7 && PROBE_PHASE == 7) tsB = __builtin_amdgcn_s_memrealtime(); }
    }
#undef CURPH
#define CURPH 8
    STAMP(8);
    if (IN(8)) {
        pg8::Gemm g{F.HB(), F.WD2(), MP, DM, DFF}; pg8::StaticOrder S; S.init(MP, DM, F.G, (int)blockIdx.x);
        pg8::EpiResid<2> E{nullptr, F.out, F.XB(), nullptr, 0.5f};
        pg8::gemm_phase<pg8::EpiResid<2>, pg8::StaticOrder, true, true>(F.lds + RING_OFF, g, S, E, F.wave, tm);
        if ((PROBE_WHICH == 1 || PROBE_WHICH == 2) && PROBE_PHASE == 8) { tsA = 0; tsB = (PROBE_WHICH == 1) ? tm.k : tm.e; } tm.k = 0; tm.e = 0;
        { const unsigned long long ts0_ = (PROBE_WHICH == 3) ? __builtin_amdgcn_s_memrealtime() : 0ull;
        { SEpiResid<2> SE{nullptr, F.out, F.XB(), nullptr, 0.5f}; small_gemm<DFF, 8, SEpiResid<2>>(F, F.HB(), DFF, F.WD2(), DM / 64, SE, (unsigned*)(F.ctl() + CW_DYN + 64 * 8)); }
          if (PROBE_WHICH == 3 && PROBE_PHASE == CURPH) { asm volatile("s_waitcnt vmcnt(0)" ::: "memory"); tsA = ts0_; tsB = __builtin_amdgcn_s_memrealtime(); } }
    }
    STAMP(9);
    if (PROBE_PHASE >= 0 && blockIdx.x == PROBE_BLOCK) { asm volatile("s_waitcnt vmcnt(0)" ::: "memory"); const unsigned long long te = __builtin_amdgcn_s_memrealtime(), d = 4 * (tsB - tsA); while (__builtin_amdgcn_s_memrealtime() - te < d) __builtin_amdgcn_s_sleep(8); }
#undef IN
#undef BOTH
}

extern "C" void kernel_launch(void* const* d_in, const int* in_sizes, int n_in, void* d_out, int out_size, void* d_ws, size_t ws_size, hipStream_t stream) {
    static int grid = 0;
    if (grid == 0) {
        if (n_in != 29 || in_sizes[0] != MP * DM || (size_t)out_size != O_END || ws_size < WS_END) { fprintf(stderr, "kernel_launch: unexpected shapes (n_in %d in0 %d out %d ws %zu); nothing launched\n", n_in, n_in > 0 ? in_sizes[0] : -1, out_size, ws_size); grid = -1; return; }
        int dev = 0, cus = 0, per_cu = 0;
        if (hipGetDevice(&dev) != hipSuccess || hipDeviceGetAttribute(&cus, hipDeviceAttributeMultiprocessorCount, dev) != hipSuccess) { fprintf(stderr, "kernel_launch: device query failed\n"); grid = -1; return; }
        if (hipFuncSetAttribute((const void*)hymba_fwd, hipFuncAttributeMaxDynamicSharedMemorySize, LDS_BYTES) != hipSuccess) { fprintf(stderr, "kernel_launch: hipFuncSetAttribute failed\n"); grid = -1; return; }
        if (hipOccupancyMaxActiveBlocksPerMultiprocessor(&per_cu, (const void*)hymba_fwd, NWAVES * 64, LDS_BYTES) != hipSuccess || per_cu < 1) { fprintf(stderr, "kernel_launch: occupancy query reports %d workgroups per CU\n", per_cu); per_cu = 1; }
        (void)hipGetLastError();
        grid = cus;
    }
    if (grid < 0) return;
    if (hipMemsetAsync((char*)d_ws + WS_CTL, 0, CTL_ZERO_BYTES, stream) != hipSuccess) { fprintf(stderr, "kernel_launch: memset failed\n"); return; }
    Args a{};
    for (int i = 0; i < 29; ++i) a.in[i] = (const float*)d_in[i];
    a.out = (float*)d_out; a.ws = (unsigned char*)d_ws;
    if (N_LAUNCHES == 1) {
        a.ph_lo = 0; a.ph_hi = N_PHASES; a.li = 0;
        hipLaunchKernelGGL(hymba_fwd, dim3(grid), dim3(NWAVES * 64), LDS_BYTES, stream, a);
    } else {
        for (int li = 0; li < N_PHASES; ++li) { a.ph_lo = li; a.ph_hi = li + 1; a.li = li; hipLaunchKernelGGL(hymba_fwd, dim3(grid), dim3(NWAVES * 64), LDS_BYTES, stream, a); }
    }
    const hipError_t le = hipPeekAtLastError();
    if (le != hipSuccess) fprintf(stderr, "kernel_launch: launch failed: %s\n", hipGetErrorName(le));
}
```

```cpp
#include <hip/hip_runtime.h>
#include <cstdio>
#include <cstdint>
#include <cmath>
namespace pg8 {
#define PG8_LAS __attribute__((address_space(3)))
typedef unsigned short bf16_t;
typedef short bf16x8 __attribute__((ext_vector_type(8)));
typedef float f32x4 __attribute__((ext_vector_type(4)));
typedef unsigned u32x4 __attribute__((ext_vector_type(4)));
constexpr int BM = 256, BK = 64, HALF = 128, HTB = HALF * BK * 2  , STAGE_BYTES = 8 * HTB, NXCD = 8, WGM = 8;

__host__ __device__ __forceinline__ int lds_byte(int r, int c) { const int st = (r >> 4) * 2 + (c >> 5), rr = r & 15, cc = c & 31, ob = rr * 64 + cc * 2; return st * 1024 + (ob ^ (((ob >> 9) & 1) << 5)); }
__host__ __device__ __forceinline__ void stage_rc(int b, int& R, int& C) { const int st = b / 1024, sb = b % 1024, swz = sb ^ (((sb >> 9) & 1) << 5); R = (st >> 1) * 16 + swz / 64; C = (st & 1) * 32 + (swz % 64) / 2; }
__host__ __device__ __forceinline__ int perm32(int rho) { const int n = rho >> 4, i = rho & 15; return 8 * (i >> 2) + 4 * n + (i & 3); }

struct Unit { int pm, pn; };
struct Gemm { const bf16_t* A; const bf16_t* Bt; int M, N, K; };

struct StaticOrder {
    int nM, nN, nwg, G, c;
    __host__ __device__ void init(int M, int N, int G_, int c_) { nM = M / BM; nN = N / BM; nwg = nM * nN; G = G_; c = c_; }
    __host__ __device__ bool next(int i, Unit& u) const {
        const long L = (long)i * G + c; if (L >= nwg) return false;
        int wgid = (int)L; { const int q = nwg / NXCD, r = nwg % NXCD, xcd = wgid % NXCD, off = wgid / NXCD; wgid = (xcd < r ? xcd * (q + 1) : r * (q + 1) + (xcd - r) * q) + off; }
        const int nig = WGM * nN, gid = wgid / nig, fm = gid * WGM, gsz = (nM - fm) < WGM ? (nM - fm) : WGM;
        u.pm = fm + ((wgid % nig) % gsz); u.pn = (wgid % nig) / gsz; return true;
    }
    __device__ __forceinline__ void a_ready(const Unit&) const {}
    __device__ __forceinline__ void done(const Unit&) const {}
};

__device__ __forceinline__ unsigned cvt_pk_bf16(float lo, float hi) { unsigned r; asm volatile("v_cvt_pk_bf16_f32 %0, %1, %2" : "=v"(r) : "v"(lo), "v"(hi)); return r; }
#ifndef PROBE_WHICH
#define PROBE_WHICH 0
#endif
constexpr bool TM_ON = PROBE_WHICH != 0;
struct Tm { unsigned long long k, e; };
__device__ __forceinline__ int pg8_lane_id() { int l; asm volatile("v_mbcnt_lo_u32_b32 %0, -1, 0\n\tv_mbcnt_hi_u32_b32 %0, -1, %0" : "=v"(l)); return l; }
typedef float f32x2 __attribute__((ext_vector_type(2)));
typedef unsigned u32x2 __attribute__((ext_vector_type(2)));
constexpr float RMS_EPS = 1e-6f;
__device__ __forceinline__ float row_rs(const float* ssq, int r) {
    const f32x4* p = (const f32x4*)(ssq + (size_t)r * 16);
    const f32x4 a = p[0], b = p[1], c = p[2], d = p[3];
    const float s = ((a[0] + a[1]) + (a[2] + a[3])) + ((b[0] + b[1]) + (b[2] + b[3])) + ((c[0] + c[1]) + (c[2] + c[3])) + ((d[0] + d[1]) + (d[2] + d[3]));
    return __builtin_amdgcn_rsqf(s * (1.0f / 1024.0f) + RMS_EPS);
}
__device__ __forceinline__ float silu_f(float g) { return g * __builtin_amdgcn_rcpf(1.0f + __builtin_amdgcn_exp2f(g * -1.4426950408889634f)); }

constexpr int RS_CACHE_OFF = STAGE_BYTES;
template <class Sched> __device__ __forceinline__ void rs_cache_fill(PG8_LAS unsigned char* lds, const Sched& S, const float* ssq, int wid) {
    PG8_LAS float* rsl = (PG8_LAS float*)(lds + RS_CACHE_OFF); Unit u; const int tid_ = wid * 64 + pg8_lane_id(), t = tid_ & 255, hf = tid_ >> 8;
    for (int i = hf; S.next(i, u); i += 2) rsl[i * 256 + t] = row_rs(ssq, u.pm * BM + t);
    __syncthreads();
}
struct EpiSwiglu {
    static constexpr bool PERM = true, AFTER_DRAIN = false, MID = false;
    bf16_t* H; int ldh;
    __device__ __forceinline__ void operator()(const f32x4 (&acc)[2][2][4][2], const Unit& u, int wr, int wc, int fr, int fq, int ui, PG8_LAS unsigned char* lds) const {
        const int row0 = u.pm * BM + wr * 64 + fr, col0 = u.pn * HALF + wc * 32 + 8 * fq;
        const PG8_LAS float* rsl = (const PG8_LAS float*)(lds + RS_CACHE_OFF) + ui * 256 + wr * 64 + fr;
#pragma unroll
        for (int ai = 0; ai < 2; ++ai)
#pragma unroll
            for (int m = 0; m < 4; ++m) {
                const int r = row0 + ai * HALF + m * 16; const float rs = rsl[ai * HALF + m * 16];
                const f32x2 c1 = {rs * -1.4426950408889634f, rs * -1.4426950408889634f}, w2 = {rs * rs, rs * rs}, one = {1.0f, 1.0f};
                float hv[8];
#pragma unroll
                for (int n = 0; n < 2; ++n)
#pragma unroll
                    for (int e2 = 0; e2 < 2; ++e2) { const f32x2 g = {acc[ai][0][m][n][2 * e2], acc[ai][0][m][n][2 * e2 + 1]}, u = {acc[ai][1][m][n][2 * e2], acc[ai][1][m][n][2 * e2 + 1]};
                        const f32x2 t = g * c1; f32x2 ex; ex.x = __builtin_amdgcn_exp2f(t.x); ex.y = __builtin_amdgcn_exp2f(t.y);
                        const f32x2 d = ex + one; f32x2 rc; rc.x = __builtin_amdgcn_rcpf(d.x); rc.y = __builtin_amdgcn_rcpf(d.y);
                        const f32x2 hh2 = (g * u) * (w2 * rc); hv[n * 4 + 2 * e2] = hh2.x; hv[n * 4 + 2 * e2 + 1] = hh2.y; }
                u32x4 w; w.x = cvt_pk_bf16(hv[0], hv[1]); w.y = cvt_pk_bf16(hv[2], hv[3]); w.z = cvt_pk_bf16(hv[4], hv[5]); w.w = cvt_pk_bf16(hv[6], hv[7]);
                *(u32x4*)(H + (size_t)r * ldh + col0) = w;
            }
    }
};
struct EpiScaleBf16 {
    static constexpr bool PERM = true, AFTER_DRAIN = false, MID = false;
    bf16_t* O; int ldc;
    __device__ __forceinline__ void operator()(const f32x4 (&acc)[2][2][4][2], const Unit& u, int wr, int wc, int fr, int fq, int ui, PG8_LAS unsigned char* lds) const {
        const int row0 = u.pm * BM + wr * 64 + fr, col0 = u.pn * BM + wc * 32 + 8 * fq;
        const PG8_LAS float* rsl = (const PG8_LAS float*)(lds + RS_CACHE_OFF) + ui * 256 + wr * 64 + fr;
#pragma unroll
        for (int ai = 0; ai < 2; ++ai)
#pragma unroll
            for (int m = 0; m < 4; ++m) {
                const int r = row0 + ai * HALF + m * 16; const float rs = rsl[ai * HALF + m * 16];
#pragma unroll
                for (int bj = 0; bj < 2; ++bj) {
                    const f32x4 v0 = acc[ai][bj][m][0] * rs, v1 = acc[ai][bj][m][1] * rs;
                    u32x4 w; w.x = cvt_pk_bf16(v0[0], v0[1]); w.y = cvt_pk_bf16(v0[2], v0[3]); w.z = cvt_pk_bf16(v1[0], v1[1]); w.w = cvt_pk_bf16(v1[2], v1[3]);
                    *(u32x4*)(O + (size_t)r * ldc + col0 + bj * HALF) = w;
                }
            }
    }
};
__device__ __forceinline__ f32x4 bf4_to_f32(u32x2 w) { f32x4 r; r[0] = __builtin_bit_cast(float, w.x << 16); r[1] = __builtin_bit_cast(float, w.x & 0xffff0000u); r[2] = __builtin_bit_cast(float, w.y << 16); r[3] = __builtin_bit_cast(float, w.y & 0xffff0000u); return r; }
template <int MODE> struct EpiResid {
    static constexpr bool PERM = true, AFTER_DRAIN = false, MID = false;
    const float* basef; float* out; bf16_t* xb; float* ssq; float scale;
    __device__ __forceinline__ void operator()(const f32x4 (&acc)[2][2][4][2], const Unit& u, int wr, int wc, int fr, int fq, int ui, PG8_LAS unsigned char* lds) const {
        const int row0 = u.pm * BM + wr * 64 + fr, col0 = u.pn * BM + wc * 32 + 8 * fq;
#pragma unroll
        for (int ai = 0; ai < 2; ++ai) {
            f32x4 pre[4][2][2];
#pragma unroll
            for (int m = 0; m < 4; ++m) { const size_t off = (size_t)(row0 + ai * HALF + m * 16) * 1024 + col0;
#pragma unroll
                for (int bj = 0; bj < 2; ++bj) {
                    if (MODE == 0) { pre[m][bj][0] = *(const f32x4*)(basef + off + bj * HALF); pre[m][bj][1] = *(const f32x4*)(basef + off + bj * HALF + 4); }
                    else { const u32x4 w = *(const u32x4*)(xb + off + bj * HALF); pre[m][bj][0] = bf4_to_f32((u32x2){w.x, w.y}); pre[m][bj][1] = bf4_to_f32((u32x2){w.z, w.w}); } } }
#pragma unroll
            for (int m = 0; m < 4; ++m) { const int r = row0 + ai * HALF + m * 16; const size_t off = (size_t)r * 1024 + col0; float s = 0.f;
#pragma unroll
                for (int bj = 0; bj < 2; ++bj) {
                    const f32x4 o0 = pre[m][bj][0] + acc[ai][bj][m][0] * scale, o1 = pre[m][bj][1] + acc[ai][bj][m][1] * scale;
                    if (MODE == 2) { *(f32x4*)(out + off + bj * HALF) = o0; *(f32x4*)(out + off + bj * HALF + 4) = o1; }
                    else { s += ((o0[0] * o0[0] + o0[1] * o0[1]) + (o0[2] * o0[2] + o0[3] * o0[3])) + ((o1[0] * o1[0] + o1[1] * o1[1]) + (o1[2] * o1[2] + o1[3] * o1[3]));
                        u32x4 w; w.x = cvt_pk_bf16(o0[0], o0[1]); w.y = cvt_pk_bf16(o0[2], o0[3]); w.z = cvt_pk_bf16(o1[0], o1[1]); w.w = cvt_pk_bf16(o1[2], o1[3]); *(u32x4*)(xb + off + bj * HALF) = w; }
                }
                if (MODE != 2) { s += __shfl_xor(s, 16); s += __shfl_xor(s, 32); if (fq == 0) ssq[(size_t)r * 16 + u.pn * 4 + wc] = s; }
            }
        }
    }
};
template <class Sched> __device__ __forceinline__ void mix_cache_fill(PG8_LAS unsigned char* lds, const Sched& S, const float* ssql, const float* ssqa, int wid) {
    PG8_LAS f32x2* c2 = (PG8_LAS f32x2*)(lds + RS_CACHE_OFF); Unit u; const int tid_ = wid * 64 + pg8_lane_id(), t = tid_ & 255, hf = tid_ >> 8;
    for (int i = hf; S.next(i, u); i += 2) { const size_t r = (size_t)u.pm * BM + t;
        const f32x4* pl = (const f32x4*)(ssql + r * 8); const f32x4* pa = (const f32x4*)(ssqa + r * 8); const f32x4 l0 = pl[0], l1 = pl[1], a0 = pa[0], a1 = pa[1];
        const float rl = __builtin_amdgcn_rsqf((((l0[0] + l0[1]) + (l0[2] + l0[3])) + ((l1[0] + l1[1]) + (l1[2] + l1[3]))) * (1.0f / 512.0f) + RMS_EPS);
        const float ra = __builtin_amdgcn_rsqf((((a0[0] + a0[1]) + (a0[2] + a0[3])) + ((a1[0] + a1[1]) + (a1[2] + a1[3]))) * (1.0f / 512.0f) + RMS_EPS);
        c2[i * 256 + t] = (f32x2){rl * __builtin_amdgcn_rcpf(ra), ra}; }
    __syncthreads();
}
struct EpiResidMix {
    static constexpr bool PERM = true, AFTER_DRAIN = false, MID = true;
    bf16_t* xb; float* ssq;
    __device__ __forceinline__ void mid(f32x4 (&acc)[2][2][4][2], int wr, int fr, int ui, PG8_LAS unsigned char* lds) const {
        const PG8_LAS f32x2* c2 = (const PG8_LAS f32x2*)(lds + RS_CACHE_OFF) + ui * 256 + wr * 64 + fr;
#pragma unroll
        for (int ai = 0; ai < 2; ++ai)
#pragma unroll
            for (int m = 0; m < 4; ++m) { const float q = c2[ai * HALF + m * 16].x;
#pragma unroll
                for (int bj = 0; bj < 2; ++bj)
#pragma unroll
                    for (int n = 0; n < 2; ++n) acc[ai][bj][m][n] *= q; }
    }
    __device__ __forceinline__ void operator()(const f32x4 (&acc)[2][2][4][2], const Unit& u, int wr, int wc, int fr, int fq, int ui, PG8_LAS unsigned char* lds) const {
        const int row0 = u.pm * BM + wr * 64 + fr, col0 = u.pn * BM + wc * 32 + 8 * fq;
        const PG8_LAS f32x2* c2 = (const PG8_LAS f32x2*)(lds + RS_CACHE_OFF) + ui * 256 + wr * 64 + fr;
#pragma unroll
        for (int ai = 0; ai < 2; ++ai) {
            u32x4 pre[4][2];
#pragma unroll
            for (int m = 0; m < 4; ++m) { const size_t off = (size_t)(row0 + ai * HALF + m * 16) * 1024 + col0;
#pragma unroll
                for (int bj = 0; bj < 2; ++bj) pre[m][bj] = *(const u32x4*)(xb + off + bj * HALF); }
#pragma unroll
            for (int m = 0; m < 4; ++m) { const int r = row0 + ai * HALF + m * 16; const size_t off = (size_t)r * 1024 + col0; float s = 0.f; const float ra = c2[ai * HALF + m * 16].y;
#pragma unroll
                for (int bj = 0; bj < 2; ++bj) {
                    const f32x4 o0 = bf4_to_f32((u32x2){pre[m][bj].x, pre[m][bj].y}) + acc[ai][bj][m][0] * ra, o1 = bf4_to_f32((u32x2){pre[m][bj].z, pre[m][bj].w}) + acc[ai][bj][m][1] * ra;
                    s += ((o0[0] * o0[0] + o0[1] * o0[1]) + (o0[2] * o0[2] + o0[3] * o0[3])) + ((o1[0] * o1[0] + o1[1] * o1[1]) + (o1[2] * o1[2] + o1[3] * o1[3]));
                    u32x4 w; w.x = cvt_pk_bf16(o0[0], o0[1]); w.y = cvt_pk_bf16(o0[2], o0[3]); w.z = cvt_pk_bf16(o1[0], o1[1]); w.w = cvt_pk_bf16(o1[2], o1[3]); *(u32x4*)(xb + off + bj * HALF) = w;
                }
                s += __shfl_xor(s, 16); s += __shfl_xor(s, 32); if (fq == 0) ssq[(size_t)r * 16 + u.pn * 4 + wc] = s;
            }
        }
    }
};
template <class Epi, class Sched, bool ALIGN_EPI = false, bool SP2 = false>
__device__ __forceinline__ void gemm_phase(PG8_LAS unsigned char* lds, const Gemm g, const Sched& S, const Epi& E, int wid_in, Tm& tm) {
    const int wid = wid_in, lane = pg8_lane_id(), tid = wid * 64 + lane, wr = wid >> 2, wc = wid & 3, fr = lane & 15, fq = lane >> 4;
    const int K = g.K, nt = K / BK;
    unsigned voffA[2], voffB[2];
#pragma unroll
    for (int i = 0; i < 2; ++i) { int R, C; stage_rc(tid * 16 + i * 8192, R, C); const int Rb = Epi::PERM ? ((R & ~31) + perm32(R & 31)) : R;
        voffA[i] = (unsigned)(R * K + C) * 2u; voffB[i] = (unsigned)(Rb * K + C) * 2u; }
    const size_t kstep = (size_t)(BK * 2);
    const size_t hstep = (size_t)HALF * K * 2;
    const size_t tstep = 2 * hstep;
    const unsigned ldsw = (unsigned)wid * 1024u;
    const int aoff = lds_byte(wr * 64 + fr, fq * 8), boff = lds_byte(wc * 32 + fr, fq * 8);
#define PG8_SA(b, h) (((b) * 2 + (h)) * HTB)
#define PG8_SB(b, h) ((4 + (b) * 2 + (h)) * HTB)
#define PG8_STAGE(bufoff, gbase, voff) do { _Pragma("unroll") for (int _i = 0; _i < 2; ++_i) \
        __builtin_amdgcn_global_load_lds((const unsigned*)((const char*)(gbase) + (voff)[_i]), (PG8_LAS unsigned*)(lds + (bufoff) + ldsw + _i * 8192), 16, 0, 0); } while (0)
#define PG8_LDA(dst, b, h) do { _Pragma("unroll") for (int m = 0; m < 4; ++m) _Pragma("unroll") for (int k = 0; k < 2; ++k) dst[m][k] = *(const PG8_LAS bf16x8*)(lds + PG8_SA(b, h) + aoff + m * 2048 + k * 1024); } while (0)
#define PG8_LDB(dst, b, h) do { _Pragma("unroll") for (int n = 0; n < 2; ++n) _Pragma("unroll") for (int k = 0; k < 2; ++k) dst[n][k] = *(const PG8_LAS bf16x8*)(lds + PG8_SB(b, h) + boff + n * 2048 + k * 1024); } while (0)
#define PG8_MMA(ai, bj, At, Bt) do { __builtin_amdgcn_s_setprio(1); _Pragma("unroll") for (int m = 0; m < 4; ++m) _Pragma("unroll") for (int n = 0; n < 2; ++n) _Pragma("unroll") for (int k = 0; k < 2; ++k) \
        acc[ai][bj][m][n] = __builtin_amdgcn_mfma_f32_16x16x32_bf16(Bt[n][k], At[m][k], acc[ai][bj][m][n], 0, 0, 0); __builtin_amdgcn_s_setprio(0); } while (0)
#define PG8_WAIT_V(n) asm volatile("s_waitcnt vmcnt(" #n ")" ::: "memory")
#define PG8_WAIT_L(n) asm volatile("s_waitcnt lgkmcnt(" #n ")" ::: "memory")
#define PG8_BAR __builtin_amdgcn_s_barrier()
#define PG8_SCHED __builtin_amdgcn_sched_barrier(0)
    Unit cur, nxt; int ui = 0;
    if (!S.next(0, cur)) return;
    f32x4 acc[2][2][4][2];
#pragma unroll
    for (int a = 0; a < 2; ++a)
#pragma unroll
        for (int b = 0; b < 2; ++b)
#pragma unroll
            for (int m = 0; m < 4; ++m)
#pragma unroll
                for (int n = 0; n < 2; ++n) acc[a][b][m][n] = (f32x4){0.f, 0.f, 0.f, 0.f};
    bf16x8 At[4][2], B0[2][2], B1[2][2];
    const char* cA = (const char*)g.A + (size_t)cur.pm * tstep; const char* cB = (const char*)g.Bt + (size_t)cur.pn * tstep;
    S.a_ready(cur);
    if constexpr (SP2) {
        PG8_STAGE(PG8_SB(0, 0), cB, voffB); PG8_STAGE(PG8_SB(0, 1), cB + hstep, voffB); PG8_STAGE(PG8_SA(0, 0), cA, voffA); PG8_STAGE(PG8_SA(0, 1), cA + hstep, voffA);
        if (wr == 1) PG8_BAR;
        PG8_WAIT_V(2); PG8_BAR;
        PG8_STAGE(PG8_SB(1, 0), cB + kstep, voffB); PG8_STAGE(PG8_SA(1, 0), cA + kstep, voffA); PG8_STAGE(PG8_SB(1, 1), cB + hstep + kstep, voffB);
        PG8_WAIT_V(6); PG8_BAR;
    } else {
        PG8_STAGE(PG8_SB(0, 0), cB, voffB); PG8_STAGE(PG8_SA(0, 0), cA, voffA); PG8_STAGE(PG8_SB(0, 1), cB + hstep, voffB); PG8_STAGE(PG8_SA(0, 1), cA + hstep, voffA);
        if (wr == 1) PG8_BAR;
        PG8_WAIT_V(4); PG8_BAR;
        PG8_STAGE(PG8_SB(1, 0), cB + kstep, voffB); PG8_STAGE(PG8_SA(1, 0), cA + kstep, voffA); PG8_STAGE(PG8_SB(1, 1), cB + hstep + kstep, voffB);
        PG8_WAIT_V(6); PG8_BAR;
    }
    for (;;) {
        const bool has_next = S.next(ui + 1, nxt);
        const unsigned long long tm_a = TM_ON ? __builtin_amdgcn_s_memrealtime() : 0ull;
        const char* nA = has_next ? (const char*)g.A + (size_t)nxt.pm * tstep : cA; const char* nB = has_next ? (const char*)g.Bt + (size_t)nxt.pn * tstep : cB;
        for (int t = 0; t < nt; t += 2) {
            if constexpr (Epi::MID) { if (t == nt / 2) E.mid(acc, wr, fr, ui, lds); }
            const bool last = (t == nt - 2);
            const char* a1 = cA + (size_t)(t + 1) * kstep;
            const char* a2 = last ? nA : cA + (size_t)(t + 2) * kstep; const char* b2 = last ? nB : cB + (size_t)(t + 2) * kstep;
            const char* a3 = a2 + kstep; const char* b3 = b2 + kstep;
            if (last && has_next) S.a_ready(nxt);
            if constexpr (SP2) {
            PG8_LDB(B0, 0, 0); PG8_LDB(B1, 0, 1); PG8_SCHED; PG8_LDA(At, 0, 0); PG8_STAGE(PG8_SA(1, 1), a1 + hstep, voffA);
            PG8_WAIT_V(8); PG8_WAIT_L(0); PG8_BAR; PG8_MMA(0, 0, At, B0); PG8_MMA(0, 1, At, B1); PG8_BAR; PG8_SCHED;
            PG8_LDA(At, 0, 1); PG8_STAGE(PG8_SB(0, 0), b2, voffB); PG8_STAGE(PG8_SB(0, 1), b2 + hstep, voffB); PG8_STAGE(PG8_SA(0, 0), a2, voffA);
            PG8_WAIT_V(8); PG8_WAIT_L(0); PG8_BAR; PG8_MMA(1, 0, At, B0); PG8_MMA(1, 1, At, B1); PG8_BAR; PG8_SCHED;
            PG8_LDB(B0, 1, 0); PG8_LDB(B1, 1, 1); PG8_SCHED; PG8_LDA(At, 1, 0); PG8_STAGE(PG8_SA(0, 1), a2 + hstep, voffA);
            PG8_WAIT_V(8); PG8_WAIT_L(0); PG8_BAR; PG8_MMA(0, 0, At, B0); PG8_MMA(0, 1, At, B1); PG8_BAR; PG8_SCHED;
            PG8_LDA(At, 1, 1); PG8_STAGE(PG8_SB(1, 0), b3, voffB); PG8_STAGE(PG8_SB(1, 1), b3 + hstep, voffB); PG8_STAGE(PG8_SA(1, 0), a3, voffA);
            PG8_WAIT_V(8); PG8_WAIT_L(0); PG8_BAR; PG8_MMA(1, 0, At, B0); PG8_MMA(1, 1, At, B1); PG8_BAR; PG8_SCHED;
            } else {
            PG8_LDB(B0, 0, 0); PG8_SCHED; PG8_LDA(At, 0, 0); PG8_STAGE(PG8_SA(1, 1), a1 + hstep, voffA);
            PG8_WAIT_L(8); PG8_BAR; PG8_WAIT_L(0); PG8_MMA(0, 0, At, B0); PG8_BAR; PG8_SCHED;
            PG8_LDB(B1, 0, 1); PG8_STAGE(PG8_SB(0, 0), b2, voffB);
            PG8_BAR; PG8_WAIT_L(0); PG8_MMA(0, 1, At, B1); PG8_BAR;
            PG8_LDA(At, 0, 1); PG8_STAGE(PG8_SA(0, 0), a2, voffA);
            PG8_BAR; PG8_WAIT_L(0); PG8_MMA(1, 0, At, B0); PG8_BAR; PG8_SCHED;
            PG8_STAGE(PG8_SB(0, 1), b2 + hstep, voffB);
            PG8_WAIT_V(6); PG8_BAR; PG8_MMA(1, 1, At, B1); PG8_BAR;
            PG8_LDB(B0, 1, 0); PG8_SCHED; PG8_LDA(At, 1, 0); PG8_STAGE(PG8_SA(0, 1), a2 + hstep, voffA);
            PG8_WAIT_L(8); PG8_BAR; PG8_WAIT_L(0); PG8_MMA(0, 0, At, B0); PG8_BAR; PG8_SCHED;
            PG8_LDB(B1, 1, 1); PG8_STAGE(PG8_SB(1, 0), b3, voffB);
            PG8_BAR; PG8_WAIT_L(0); PG8_MMA(0, 1, At, B1); PG8_BAR;
            PG8_LDA(At, 1, 1); PG8_STAGE(PG8_SA(1, 0), a3, voffA);
            PG8_BAR; PG8_WAIT_L(0); PG8_MMA(1, 0, At, B0); PG8_BAR; PG8_SCHED;
            PG8_STAGE(PG8_SB(1, 1), b3 + hstep, voffB);
            PG8_WAIT_V(6); PG8_BAR; PG8_MMA(1, 1, At, B1); PG8_BAR;
            }
        }
        const unsigned long long tm_b = TM_ON ? __builtin_amdgcn_s_memrealtime() : 0ull;
        if constexpr (ALIGN_EPI) { if (wr == 0) PG8_BAR; }
        if constexpr (!Epi::AFTER_DRAIN) { E(acc, cur, wr, wc, fr, fq, ui, lds); S.done(cur); }
        if (TM_ON) { const unsigned long long tm_c = __builtin_amdgcn_s_memrealtime(); tm.k += tm_b - tm_a; tm.e += tm_c - tm_b; }
        if (!has_next) break;
#pragma unroll
        for (int a = 0; a < 2; ++a)
#pragma unroll
            for (int b = 0; b < 2; ++b)
#pragma unroll
                for (int m = 0; m < 4; ++m)
#pragma unroll
                    for (int n = 0; n < 2; ++n) acc[a][b][m][n] = (f32x4){0.f, 0.f, 0.f, 0.f};
        cur = nxt; cA = nA; cB = nB; ++ui;
        if constexpr (ALIGN_EPI) { if (wr == 1) PG8_BAR; }
    }
    PG8_WAIT_V(0);
    if constexpr (!ALIGN_EPI) { if (wr == 0) PG8_BAR; }
    PG8_BAR;
    if constexpr (Epi::AFTER_DRAIN) { E.fused(acc, cur, wr, wc, fr, fq, lds, wid, lane); S.done(cur); }
#undef PG8_SA
#undef PG8_SB
#undef PG8_STAGE
#undef PG8_LDA
#undef PG8_LDB
#undef PG8_MMA
#undef PG8_WAIT_V
#undef PG8_WAIT_L
#undef PG8_BAR
#undef PG8_SCHED
}
}

constexpr int NWAVES = 8;
constexpr int DM = 1024, BATCH = 4, SEQ = 8192, MP = BATCH * SEQ, DEC_B = 128, DEC_T = 4, MS = DEC_B * DEC_T, MT = MP + MS;
constexpr int LRU_W = 512, NH = 8, NKV = 2, HD = 64, DFF = 2816, INW = 1792, WIN = 128, PAST = 16384;
constexpr int C_XL = 0, C_GATE = 512, C_Q = 1024, C_K = 1536, C_V = 1664;
constexpr int NCHUNK = 64, CHUNK = SEQ / NCHUNK;
constexpr float EPS = 1e-6f, LOG2E = 1.4426950408889634f;
constexpr size_t O_YP = 0, O_YS = 33554432, O_PH = 34078720, O_PC = 34080768, O_PK = 34086912, O_PV = 34152448, O_SH = 34217984, O_SC = 34283520, O_SK = 34480128, O_SV = 36577280, O_END = 38674432;
constexpr size_t MiB = 1u << 20;
constexpr size_t WS_CTL = 0, CTL_ZERO_BYTES = 64 * 1024;
constexpr size_t WS_WGU1 = 2 * MiB, WS_WD1 = 13 * MiB, WS_WIN = 19 * MiB, WS_WOUT = 23 * MiB, WS_WGU2 = 25 * MiB, WS_WD2 = 36 * MiB;
constexpr size_t WS_ROPE = 42 * MiB;
constexpr size_t WS_SSQ = 45 * MiB;
constexpr size_t WS_LSUM = 48 * MiB;
constexpr size_t WS_WFRAG = 49 * MiB;
constexpr size_t WS_XB = 50 * MiB;
constexpr size_t WS_CAT = 115 * MiB;
constexpr size_t WS_PROJ = 180 * MiB;
constexpr size_t WS_H = 294 * MiB;
constexpr size_t WS_SSQL = 474 * MiB, WS_SSQA = 475 * MiB;
constexpr size_t WS_SOA = 476 * MiB, WS_SSQS = 477 * MiB;
constexpr size_t WS_END = 478 * MiB;
constexpr int ROPE_ROWS = SEQ + DEC_T;
constexpr int CW_TMO = 0, CW_BAR = 4096, CW_DYN = 8192;
constexpr int RING_OFF = 0, RING_BYTES = 131072;
constexpr int SCR_BYTES = 147456;
constexpr int LDSCTL_OFF = SCR_BYTES, MISC_OFF = LDSCTL_OFF + 64;
constexpr int LDS_BYTES = SCR_BYTES + 512;

#define GAS __attribute__((address_space(1)))
#define LAS __attribute__((address_space(3)))
typedef unsigned short bf16;
typedef unsigned v4u __attribute__((ext_vector_type(4)));
typedef unsigned v2u __attribute__((ext_vector_type(2)));
typedef float f32x4 __attribute__((ext_vector_type(4)));
typedef float f32x16 __attribute__((ext_vector_type(16)));
typedef short bf16x8 __attribute__((ext_vector_type(8)));
typedef GAS unsigned gu32;
#define RLX_AGENT __ATOMIC_RELAXED, __HIP_MEMORY_SCOPE_AGENT
__device__ __forceinline__ int lane_id() { int l; asm volatile("v_mbcnt_lo_u32_b32 %0, -1, 0\n\tv_mbcnt_hi_u32_b32 %0, -1, %0" : "=v"(l)); return l; }
#define LDS_WAIT() asm volatile("s_waitcnt lgkmcnt(0)" ::: "memory")
#define VM_WAIT() asm volatile("s_waitcnt vmcnt(0)" ::: "memory")
__device__ __forceinline__ unsigned f2bf(float f) { unsigned u = __builtin_bit_cast(unsigned, f); return (u + 0x7fffu + ((u >> 16) & 1u)) >> 16; }
__device__ __forceinline__ unsigned pk2(float lo, float hi) { return f2bf(lo) | (f2bf(hi) << 16); }
__device__ __forceinline__ float bflo(unsigned w) { return __builtin_bit_cast(float, w << 16); }
__device__ __forceinline__ float bfhi(unsigned w) { return __builtin_bit_cast(float, w & 0xffff0000u); }
__device__ __forceinline__ float bf1(bf16 v) { return __builtin_bit_cast(float, (unsigned)v << 16); }
typedef float f32x2_t __attribute__((ext_vector_type(2))); typedef __bf16 bf16x2_t __attribute__((ext_vector_type(2)));
__device__ __forceinline__ unsigned cvtpk(float lo, float hi) { f32x2_t v = {lo, hi}; bf16x2_t b = __builtin_convertvector(v, bf16x2_t); return __builtin_bit_cast(unsigned, b); }
__device__ __forceinline__ float wave_sum(float v) {
#pragma unroll
    for (int o = 1; o < 64; o <<= 1) v += __shfl_xor(v, o);
    return v;
}
__device__ __forceinline__ float wave_max(float v) {
#pragma unroll
    for (int o = 1; o < 64; o <<= 1) v = fmaxf(v, __shfl_xor(v, o));
    return v;
}
__device__ __forceinline__ float sigmoid_f(float x) { return __builtin_amdgcn_rcpf(1.0f + __builtin_amdgcn_exp2f(-x * LOG2E)); }
__device__ __forceinline__ float gelu_tanh(float x) {
    const float z = x * (x * x * (2.0f * 0.7978845608028654f * 0.044715f * -LOG2E) + (2.0f * 0.7978845608028654f * -LOG2E));
    return x * __builtin_amdgcn_rcpf(1.0f + __builtin_amdgcn_exp2f(z));
}
__device__ __forceinline__ float one_minus_exp(float t) {
    const float ser = -t * (1.0f + t * (0.5f + t * (0.16666667f + t * (0.041666668f + t * 0.0083333338f))));
    const float dir = 1.0f - __builtin_amdgcn_exp2f(t * LOG2E);
    return t > -0.25f ? ser : dir;
}
__device__ __forceinline__ float dot2bf(unsigned a, unsigned b, float c) { return __builtin_amdgcn_fdot2_f32_bf16(__builtin_bit_cast(bf16x2_t, a), __builtin_bit_cast(bf16x2_t, b), c, false); }
#define XB_TMO      128
#define XB_XCNT(j)  (256  + 64 * (j))
#define XB_XSUB(j)  (1280 + 64 * (j))
#define XB_XGEN(j)  (2304 + 64 * (j))
#define XB_TOP      3328
#define XB_TOPGEN   3392
#define XCD_BAR_WORDS 3456
#define XB_SPIN_CAP (1u << 18)

__device__ __forceinline__ unsigned xb_ld(unsigned* p)              { return __hip_atomic_load(p, __ATOMIC_RELAXED, __HIP_MEMORY_SCOPE_AGENT); }
__device__ __forceinline__ unsigned xb_add(unsigned* p, unsigned v) { return __hip_atomic_fetch_add(p, v, __ATOMIC_RELAXED, __HIP_MEMORY_SCOPE_AGENT); }
__device__ __forceinline__ unsigned xb_xcc_id() { return (unsigned)__builtin_amdgcn_s_getreg((3 << 11) | 20) & 0xFu; }
#define XB_SPIN(cond, bar) do { unsigned _sp = 0; while (cond) { __builtin_amdgcn_s_sleep(1); \
    if ((++_sp & 255u) == 0u) { if (xb_ld(&(bar)[XB_TMO])) break; if (_sp > XB_SPIN_CAP) { atomicAdd(&(bar)[XB_TMO], 1u); break; } } } } while (0)

struct XcdBarrier {
    unsigned* bar; unsigned x;
    volatile LAS unsigned* st;
};

__device__ __forceinline__ XcdBarrier xcd_barrier_post(unsigned* bar, volatile LAS unsigned* st, bool leader) {
    XcdBarrier b; b.bar = bar; b.x = xb_xcc_id(); b.st = st;
    if (leader) (void)xb_add(&bar[XB_XCNT(b.x)], 1u);
    return b;
}
__device__ __forceinline__ void xcd_barrier_complete(unsigned* bar, unsigned x, unsigned& nloc, unsigned& nx) {
    const unsigned G = gridDim.x * gridDim.y * gridDim.z;
    unsigned sum, cnt, mine, sp = 0u;
    for (;;) {
        sum = 0u; cnt = 0u; mine = 0u;
#pragma unroll
        for (unsigned j = 0; j < 16; ++j) { const unsigned c = xb_ld(&bar[XB_XCNT(j)]); sum += c; cnt += (c > 0u) ? 1u : 0u; mine = (j == x) ? c : mine; }
        if (sum == G) break;
        __builtin_amdgcn_s_sleep(1);
        if ((++sp & 255u) == 0u) { if (xb_ld(&bar[XB_TMO])) break; if (sp > XB_SPIN_CAP) { atomicAdd(&bar[XB_TMO], 1u); break; } }
    }
    nloc = mine > 0u ? mine : 1u; nx = cnt > 0u ? cnt : 1u;
}

__device__ __forceinline__ void xcd_barrier(const XcdBarrier& b, bool leader) {
    asm volatile("s_waitcnt vmcnt(0)" ::: "memory");
    __syncthreads();
    if (leader) {
        unsigned* bar = b.bar;
        __builtin_amdgcn_s_waitcnt(0);
        unsigned nloc = b.st[0], nx = b.st[1];
        if (nloc == 0u) { xcd_barrier_complete(bar, b.x, nloc, nx); b.st[0] = nloc; b.st[1] = nx; }
        const unsigned old = xb_add(&bar[XB_XSUB(b.x)], 1u);
        const unsigned gen = old / nloc;
        if (old + 1u == (gen + 1u) * nloc) {
            __builtin_amdgcn_fence(__ATOMIC_RELEASE, "agent");
            asm volatile("s_waitcnt vmcnt(0)" ::: "memory");
            const unsigned og = xb_add(&bar[XB_TOP], 1u);
            const unsigned tg = og / nx;
            if (og + 1u == (tg + 1u) * nx) xb_add(&bar[XB_TOPGEN], 1u);
            else XB_SPIN(xb_ld(&bar[XB_TOPGEN]) == tg, bar);
            __builtin_amdgcn_fence(__ATOMIC_ACQUIRE, "agent");
            xb_add(&bar[XB_XGEN(b.x)], 1u);
            asm volatile("s_waitcnt vmcnt(0)" ::: "memory");
        } else {
            XB_SPIN(xb_ld(&bar[XB_XGEN(b.x)]) == gen, bar);
            __builtin_amdgcn_fence(__ATOMIC_ACQUIRE, "agent");
            asm volatile("s_waitcnt vmcnt(0)" ::: "memory");
        }
    }
    __syncthreads();
}

typedef const void __attribute__((address_space(4)))* kernarg_ptr;
struct Frame {
    LAS unsigned char* lds;
    volatile LAS unsigned* MISC;
    int wave;
    __device__ __forceinline__ int lane() const { return lane_id(); }
    __device__ __forceinline__ int tid() const { return wave * 64 + lane_id(); }
    int vcu, G;
    kernarg_ptr kp;
    float* out; unsigned char* ws;
    __device__ __forceinline__ const float* inp(int i) const { kernarg_ptr k = kp; asm volatile("" : "+s"(k)); return ((const float* const __attribute__((address_space(4)))*)k)[i]; }
    __device__ __forceinline__ gu32* ctl() const { return (gu32*)(ws + WS_CTL); }
    __device__ __forceinline__ bf16* WGU1() const { return (bf16*)(ws + WS_WGU1); }
    __device__ __forceinline__ bf16* WD1() const { return (bf16*)(ws + WS_WD1); }
    __device__ __forceinline__ bf16* WINT() const { return (bf16*)(ws + WS_WIN); }
    __device__ __forceinline__ bf16* WOUT() const { return (bf16*)(ws + WS_WOUT); }
    __device__ __forceinline__ bf16* WGU2() const { return (bf16*)(ws + WS_WGU2); }
    __device__ __forceinline__ bf16* WD2() const { return (bf16*)(ws + WS_WD2); }
    __device__ __forceinline__ float* ROPEC() const { return (float*)(ws + WS_ROPE); }
    __device__ __forceinline__ float* ROPES() const { return (float*)(ws + WS_ROPE) + ROPE_ROWS * 32; }
    __device__ __forceinline__ float* SSQ() const { return (float*)(ws + WS_SSQ); }
    __device__ __forceinline__ float* LSUM() const { return (float*)(ws + WS_LSUM); }
    __device__ __forceinline__ float* SSQL() const { return (float*)(ws + WS_SSQL); }
    __device__ __forceinline__ float* SSQA() const { return (float*)(ws + WS_SSQA); }
    __device__ __forceinline__ float* SOA() const { return (float*)(ws + WS_SOA); }
    __device__ __forceinline__ float* SSQS() const { return (float*)(ws + WS_SSQS); }
    __device__ __forceinline__ bf16* WFRAG() const { return (bf16*)(ws + WS_WFRAG); }
    __device__ __forceinline__ bf16* XB() const { return (bf16*)(ws + WS_XB); }
    __device__ __forceinline__ bf16* CAT() const { return (bf16*)(ws + WS_CAT); }
    __device__ __forceinline__ bf16* PROJ() const { return (bf16*)(ws + WS_PROJ); }
    __device__ __forceinline__ bf16* HB() const { return (bf16*)(ws + WS_H); }
};
enum { I_XP = 0, I_XS, I_SH, I_SC, I_CK, I_CV, I_F1N, I_F1G, I_F1U, I_F1D, I_MN, I_WIN, I_CW, I_CB, I_WA, I_BA, I_WX, I_BX, I_LAM, I_QN, I_KN, I_SINK, I_LON, I_AON, I_WOUT, I_F2N, I_F2G, I_F2U, I_F2D };

template <int MODE> __device__ __forceinline__ void p0_transpose_item(const float* W, const float* gain, int K, int N, bf16* WT, LAS float* scr, int item, int lane) {
    const int nblk = N / 32, kb = item / nblk, nb = item % nblk, k0 = 64 * kb, n0 = 32 * nb;
    f32x4 tv[8];
#pragma unroll
    for (int i = 0; i < 8; ++i) { const int kk = 8 * i + (lane >> 3); tv[i] = __builtin_nontemporal_load((const f32x4*)(W + (size_t)(k0 + kk) * N + n0 + 4 * (lane & 7))); }
#pragma unroll
    for (int i = 0; i < 8; ++i) { const int kk = 8 * i + (lane >> 3); f32x4 v = tv[i]; if (gain) v *= gain[k0 + kk];
        LAS float* d = scr + kk * 33 + 4 * (lane & 7); d[0] = v[0]; d[1] = v[1]; d[2] = v[2]; d[3] = v[3]; }
    LDS_WAIT(); asm volatile("" ::: "memory");
    const int c = lane & 7;
    const int rb = (MODE == 0) ? n0 : ((n0 >> 7) * 256 + (MODE - 1) * 128 + (n0 & 127));
#pragma unroll
    for (int j = 0; j < 4; ++j) { const int n = (lane >> 3) + 8 * j; const LAS float* s = scr + (8 * c) * 33 + n;
        v4u o; o.x = pk2(s[0 * 33], s[1 * 33]); o.y = pk2(s[2 * 33], s[3 * 33]); o.z = pk2(s[4 * 33], s[5 * 33]); o.w = pk2(s[6 * 33], s[7 * 33]);
        *(GAS v4u*)(WT + (size_t)(rb + n) * K + k0 + 8 * c) = o; }
    LDS_WAIT(); asm volatile("" ::: "memory");
}
template <int NR> __device__ __forceinline__ void p0_rows(Frame& F, int m, int step, int lane) {
    f32x4 v[NR][4]; bool ok[NR];
#pragma unroll
    for (int q = 0; q < NR; ++q) { const int r = m + q * step; ok[q] = r < MT; const int rr = ok[q] ? r : m;
        const GAS f32x4* xr = (const GAS f32x4*)((rr < MP) ? F.inp(I_XP) + (size_t)rr * DM : F.inp(I_XS) + (size_t)(rr - MP) * DM) + lane;
#pragma unroll
        for (int j = 0; j < 4; ++j) v[q][j] = __builtin_nontemporal_load(xr + 64 * j); }
#pragma unroll
    for (int q = 0; q < NR; ++q) { const int r = m + q * step; float s = 0.f;
#pragma unroll
        for (int j = 0; j < 4; ++j) s += (v[q][j].x * v[q][j].x + v[q][j].y * v[q][j].y) + (v[q][j].z * v[q][j].z + v[q][j].w * v[q][j].w);
        s = wave_sum(s);
        if (ok[q]) { GAS unsigned long long* o8 = (GAS unsigned long long*)(F.XB() + (size_t)r * DM) + lane;
#pragma unroll
            for (int j = 0; j < 4; ++j) o8[64 * j] = (unsigned long long)pk2(v[q][j].x, v[q][j].y) | ((unsigned long long)pk2(v[q][j].z, v[q][j].w) << 32);
            if (lane < 16) F.SSQ()[(size_t)r * 16 + lane] = (lane == 0) ? s : 0.f; } }
}
template <int SET> __device__ __forceinline__ void convert_weights(Frame& F, int slot, int nslots) {
    LAS float* scr = (LAS float*)(F.lds + RING_OFF + F.wave * 16384);
    constexpr int I_GU = (DM / 64) * (DFF / 32), I_D = (DFF / 64) * (DM / 32), I_IN = (DM / 64) * (INW / 32), I_OUT = (DM / 64) * (DM / 32);
    constexpr int NITEMS = SET == 0 ? 2 * I_GU + I_IN : SET == 1 ? I_D : I_OUT + 2 * I_GU + I_D;
    const int ln = F.lane();
    for (int it = slot; it < NITEMS; it += nslots) {
        int r = it;
        if (SET == 0) {
            if (r < I_GU) { p0_transpose_item<1>(F.inp(I_F1G), F.inp(I_F1N), DM, DFF, F.WGU1(), scr, r, ln); continue; } r -= I_GU;
            if (r < I_GU) { p0_transpose_item<2>(F.inp(I_F1U), F.inp(I_F1N), DM, DFF, F.WGU1(), scr, r, ln); continue; } r -= I_GU;
            p0_transpose_item<0>(F.inp(I_WIN), F.inp(I_MN), DM, INW, F.WINT(), scr, r, ln);
        } else if (SET == 1) {
            p0_transpose_item<0>(F.inp(I_F1D), nullptr, DFF, DM, F.WD1(), scr, r, ln);
        } else {
            if (r < I_OUT) { const int k0 = 64 * (r / (DM / 32));
                p0_transpose_item<0>(F.inp(I_WOUT), k0 < 512 ? F.inp(I_LON) : F.inp(I_AON) - 512, DM, DM, F.WOUT(), scr, r, ln); continue; } r -= I_OUT;
            if (r < I_GU) { p0_transpose_item<1>(F.inp(I_F2G), F.inp(I_F2N), DM, DFF, F.WGU2(), scr, r, ln); continue; } r -= I_GU;
            if (r < I_GU) { p0_transpose_item<2>(F.inp(I_F2U), F.inp(I_F2N), DM, DFF, F.WGU2(), scr, r, ln); continue; } r -= I_GU;
            p0_transpose_item<0>(F.inp(I_F2D), nullptr, DFF, DM, F.WD2(), scr, r, ln);
        }
    }
}
__device__ __forceinline__ void p0_prologue(Frame& F) {
    const int gw = F.vcu * NWAVES + F.wave, NGW = F.G * NWAVES;
    convert_weights<0>(F, gw, NGW);
    { const int ln = F.lane(); for (int m = gw; m < MP; m += 4 * NGW) p0_rows<4>(F, m, NGW, ln);
      for (int m = MP + gw; m < MT; m += NGW) p0_rows<1>(F, m, NGW, ln); }
    for (int e = F.vcu * (NWAVES * 64) + F.tid(); e < 8 * 2 * 2 * 4 * 64; e += F.G * NWAVES * 64) {
        const int ln = e & 63, ks = (e >> 6) & 3, ct = (e >> 8) & 1, gate = (e >> 9) & 1, blk = e >> 10, ql = ln & 31, hh = ln >> 5;
        const float* pw = (gate ? F.inp(I_WX) : F.inp(I_WA)) + (size_t)(blk * 64 + 16 * ks + 8 * hh) * 64 + 32 * ct + ql;
        v4u o; o.x = pk2(pw[0], pw[64]); o.y = pk2(pw[128], pw[192]); o.z = pk2(pw[256], pw[320]); o.w = pk2(pw[384], pw[448]);
        *(v4u*)(F.WFRAG() + (size_t)e * 8) = o;
    }
    const int gt = F.vcu * (NWAVES * 64) + F.tid(), NGT = F.G * NWAVES * 64;
    for (int e = gt; e < ROPE_ROWS * 32; e += NGT) {
        const int pi = e >> 5, i = e & 31; const int pos = pi < SEQ ? pi : PAST + (pi - SEQ);
        const float invf = (float)exp(-(double)i * (9.210340371976184 / 32.0));
        const float ang = (float)pos * invf; const double a = (double)ang;
        F.ROPEC()[e] = (float)cos(a); F.ROPES()[e] = (float)sin(a);
    }
}

constexpr int LW_XRAW = 0, LW_XCS = 35 * 128, LW_GS = LW_XCS + 32 * 144, LW_OUT = LW_GS + 32 * 128, LW_BYTES = LW_OUT + 32 * 128;
static_assert(8 * LW_BYTES <= SCR_BYTES, "lru LDS");
#define LWAIT() asm volatile("s_waitcnt lgkmcnt(0)" ::: "memory")
template <int PASS> __device__ __forceinline__ void lru_prompt_item(Frame& F, int item) {
    int lane_ = F.lane(); asm volatile("" : "+v"(lane_));
    const int lane0 = lane_, w = F.wave;
    const int b = item / NCHUNK, chunk = item % NCHUNK, t0 = chunk * CHUNK;
    LAS unsigned char* wl = F.lds + w * LW_BYTES;
    float ba[2], bx[2], c8[2];
    { const int ql = lane0 & 31;
#pragma unroll
    for (int ct = 0; ct < 2; ++ct) { const int c = 64 * w + 32 * ct + ql; ba[ct] = F.inp(I_BA)[c]; bx[ct] = F.inp(I_BX)[c];
        const float lam = F.inp(I_LAM)[c]; c8[ct] = -8.0f * LOG2E * (fmaxf(-lam, 0.f) + log1pf(expf(-fabsf(lam)))); } }
    float hst[2] = {0.f, 0.f}, Pst[2] = {1.f, 1.f};
    if (PASS == 2) {
        const float* ls = F.LSUM() + ((size_t)b * NCHUNK * 512 + 64 * w + (lane0 & 31)) * 2; float h0 = 0.f, h1 = 0.f;
#pragma unroll 32
        for (int j = 0; j < chunk; ++j) { const f32x2_t p0 = *(const f32x2_t*)(ls + (size_t)j * 1024), p1 = *(const f32x2_t*)(ls + (size_t)j * 1024 + 64); h0 = p0.x * h0 + p0.y; h1 = p1.x * h1 + p1.y; }
        hst[0] = h0; hst[1] = h1;
    }
    v4u xv[5], gv[4];
    for (int sub = 0; sub < CHUNK / 32; ++sub) {
        const int ts = t0 + sub * 32;
        int lq_ = lane0; asm volatile("" : "+v"(lq_));
        const int lane = lq_, ql = lane & 31, hh = lane >> 5;
        LAS unsigned char* xraw = wl + LW_XRAW; LAS unsigned char* xcs = wl + LW_XCS; LAS unsigned char* gs = wl + LW_GS; LAS unsigned char* outs = wl + LW_OUT;
        const bf16* wfr = F.WFRAG() + (size_t)w * (2 * 2 * 4 * 64 * 8) + lane * 8;
        const bf16* pbase = F.PROJ() + (size_t)(b * SEQ) * INW + 64 * w;
#define LRU_FETCH(tsx) do { _Pragma("unroll") for (int i = 0; i < 5; ++i) { const int idx = lane + 64 * i, row = idx >> 3, ch = idx & 7, t = (tsx) - 3 + row; xv[i] = (v4u){0u, 0u, 0u, 0u}; \
                if (row < 35 && t >= 0) xv[i] = *(const v4u*)(pbase + (size_t)t * INW + C_XL + 8 * ch); } \
            if (PASS == 2) { _Pragma("unroll") for (int i = 0; i < 4; ++i) { const int idx = lane + 64 * i, row = idx >> 3, ch = idx & 7; gv[i] = *(const v4u*)(pbase + (size_t)((tsx) + row) * INW + C_GATE + 8 * ch); } } } while (0)
#ifndef LRU_PREFETCH
#define LRU_PREFETCH 0
#endif
        if (sub == 0 || !LRU_PREFETCH) LRU_FETCH(ts);
        {
#pragma unroll
            for (int i = 0; i < 5; ++i) { const int idx = lane + 64 * i, row = idx >> 3, ch = idx & 7; if (row < 35) *(LAS v4u*)(xraw + row * 128 + 16 * ch) = xv[i]; }
            if (PASS == 2) {
#pragma unroll
                for (int i = 0; i < 4; ++i) { const int idx = lane + 64 * i, row = idx >> 3, ch = idx & 7; *(LAS v4u*)(gs + row * 128 + 16 * ch) = gv[i]; }
            }
        }
        LWAIT();
        {
            const int cch = 64 * w + lane;
            const LAS bf16* xr = (const LAS bf16*)xraw + lane; LAS bf16* xo = (LAS bf16*)xcs + lane;
            const float* cwp = F.inp(I_CW) + cch; const float cw0 = cwp[0], cw1 = cwp[512], cw2 = cwp[1024], cw3 = cwp[1536], cb = F.inp(I_CB)[cch];
            float xm3 = bf1(xr[0]), xm2 = bf1(xr[64]), xm1 = bf1(xr[128]);
#pragma unroll 8
            for (int tt = 0; tt < 32; ++tt) { const float x = bf1(xr[(tt + 3) * 64]);
                xo[tt * 72] = (bf16)f2bf(cb + cw0 * xm3 + cw1 * xm2 + cw2 * xm1 + cw3 * x); xm3 = xm2; xm2 = xm1; xm1 = x; }
            if (PASS == 2 && chunk == NCHUNK - 1 && sub == CHUNK / 32 - 1) {
                F.out[O_PC + (b * 3 + 0) * 512 + cch] = xm3; F.out[O_PC + (b * 3 + 1) * 512 + cch] = xm2; F.out[O_PC + (b * 3 + 2) * 512 + cch] = xm1; }
        }
        LWAIT();
        if (LRU_PREFETCH && sub + 1 < CHUNK / 32) LRU_FETCH(ts + 32);
        bf16x8 af[4];
#pragma unroll
        for (int ks = 0; ks < 4; ++ks) af[ks] = *(const LAS bf16x8*)(xcs + ql * 144 + (16 * ks + 8 * hh) * 2);
        float ssv[16];
#pragma unroll
        for (int r = 0; r < 16; ++r) ssv[r] = 0.f;
#pragma unroll
        for (int ct = 0; ct < 2; ++ct) {
            f32x16 ra = {0.f, 0.f, 0.f, 0.f, 0.f, 0.f, 0.f, 0.f, 0.f, 0.f, 0.f, 0.f, 0.f, 0.f, 0.f, 0.f}, rx = ra;
            {   bf16x8 wa4[4], wx4[4];
#pragma unroll
                for (int ks = 0; ks < 4; ++ks) { wa4[ks] = *(const bf16x8*)(wfr + (size_t)((0 * 2 + ct) * 4 + ks) * 512); wx4[ks] = *(const bf16x8*)(wfr + (size_t)((1 * 2 + ct) * 4 + ks) * 512); }
#pragma unroll
                for (int ks = 0; ks < 4; ++ks) { ra = __builtin_amdgcn_mfma_f32_32x32x16_bf16(af[ks], wa4[ks], ra, 0, 0, 0); rx = __builtin_amdgcn_mfma_f32_32x32x16_bf16(af[ks], wx4[ks], rx, 0, 0, 0); } }
            const int cl = 32 * ct + ql;
            float av[16], uv[16];
            {
                const f32x2_t nl = {-LOG2E, -LOG2E}, bal = {ba[ct] * -LOG2E, ba[ct] * -LOG2E}, bxl = {bx[ct] * -LOG2E, bx[ct] * -LOG2E}, c8v = {c8[ct], c8[ct]}, one = {1.0f, 1.0f}, zero = {0.f, 0.f};
#pragma unroll
                for (int r = 0; r < 16; r += 2) { const int tk = (r & 3) + 8 * (r >> 2) + 4 * hh;
                    const f32x2_t ra2 = {ra[r], ra[r + 1]}, rx2 = {rx[r], rx[r + 1]};
                    const f32x2_t ta = ra2 * nl + bal, tx = rx2 * nl + bxl;
                    f32x2_t ea, ex; ea.x = __builtin_amdgcn_exp2f(ta.x); ea.y = __builtin_amdgcn_exp2f(ta.y); ex.x = __builtin_amdgcn_exp2f(tx.x); ex.y = __builtin_amdgcn_exp2f(tx.y);
                    const f32x2_t da = ea + one, dx = ex + one;
                    f32x2_t rg, ig; rg.x = __builtin_amdgcn_rcpf(da.x); rg.y = __builtin_amdgcn_rcpf(da.y); ig.x = __builtin_amdgcn_rcpf(dx.x); ig.y = __builtin_amdgcn_rcpf(dx.y);
                    const f32x2_t la = c8v * rg; f32x2_t a2; a2.x = __builtin_amdgcn_exp2f(la.x); a2.y = __builtin_amdgcn_exp2f(la.y);
                    f32x2_t om = one - a2 * a2; om = __builtin_elementwise_max(om, zero);
                    f32x2_t mu; mu.x = __builtin_amdgcn_sqrtf(om.x); mu.y = __builtin_amdgcn_sqrtf(om.y);
                    const f32x2_t xc2 = {bf1(*((const LAS bf16*)(xcs + tk * 144) + cl)), bf1(*((const LAS bf16*)(xcs + (tk + 1) * 144) + cl))};
                    const f32x2_t u2 = (mu * ig) * xc2;
                    av[r] = a2.x; av[r + 1] = a2.y; uv[r] = u2.x; uv[r + 1] = u2.y; }
            }
            float Ag[4], Ug[4], Ap[4], Up[4], st[4];
#pragma unroll
            for (int g = 0; g < 4; ++g) { Ag[g] = (av[4 * g] * av[4 * g + 1]) * (av[4 * g + 2] * av[4 * g + 3]);
                Ug[g] = ((uv[4 * g] * av[4 * g + 1] + uv[4 * g + 1]) * av[4 * g + 2] + uv[4 * g + 2]) * av[4 * g + 3] + uv[4 * g + 3];
                Ap[g] = __shfl_xor(Ag[g], 32); Up[g] = __shfl_xor(Ug[g], 32); }
            float carry = hst[ct], pp = Pst[ct];
#pragma unroll
            for (int g = 0; g < 4; ++g) { const float Alo = hh ? Ap[g] : Ag[g], Ulo = hh ? Up[g] : Ug[g], Ahi = hh ? Ag[g] : Ap[g], Uhi = hh ? Ug[g] : Up[g];
                const float s_lo = carry; carry = Alo * carry + Ulo; const float s_hi = carry; carry = Ahi * carry + Uhi; st[g] = hh ? s_hi : s_lo; pp *= Alo * Ahi; }
            hst[ct] = carry; Pst[ct] = pp;
            if (PASS == 2) {
#pragma unroll
                for (int g = 0; g < 4; ++g) { float hc = st[g];
#pragma unroll
                    for (int e = 0; e < 4; ++e) { const int r = 4 * g + e, tk = e + 8 * g + 4 * hh; hc = av[r] * hc + uv[r];
                        const float o = hc * gelu_tanh(bf1(*((const LAS bf16*)(gs + tk * 128) + cl)));
                        ssv[r] += o * o; *((LAS bf16*)(outs + tk * 128) + cl) = (bf16)f2bf(o); } }
            }
        }
        if (PASS == 2) {
            float* sq = F.SSQL() + (size_t)(b * SEQ + ts) * 8 + w;
#pragma unroll
            for (int r = 0; r < 16; ++r) { float v = ssv[r];
                v += __shfl_xor(v, 1); v += __shfl_xor(v, 2); v += __shfl_xor(v, 4); v += __shfl_xor(v, 8); v += __shfl_xor(v, 16);
                if (ql == 0) sq[((r & 3) + 8 * (r >> 2) + 4 * hh) * 8] = v; }
            LWAIT();
            bf16* cbase = F.CAT() + (size_t)(b * SEQ + ts) * DM + 64 * w;
#pragma unroll
            for (int i = 0; i < 4; ++i) { const int idx = lane + 64 * i, row = idx >> 3, ch = idx & 7; *(v4u*)(cbase + (size_t)row * DM + 8 * ch) = *(const LAS v4u*)(outs + row * 128 + 16 * ch); }
            LWAIT();
        }
    }
    if ((lane0 & 32) == 0) {
#pragma unroll
        for (int ct = 0; ct < 2; ++ct) { const int c = 64 * w + 32 * ct + (lane0 & 31);
            if (PASS == 1) *(f32x2_t*)(F.LSUM() + (((size_t)b * NCHUNK + chunk) * 512 + c) * 2) = (f32x2_t){Pst[ct], hst[ct]};
            if (PASS == 2 && chunk == NCHUNK - 1) F.out[O_PH + b * 512 + c] = hst[ct]; }
    }
}

constexpr int KS_STRIDE = 144, KS_KVH = 256 * KS_STRIDE;
constexpr int VT_STRIDE = 528, VT_KVH = 64 * VT_STRIDE;
constexpr int AT_KS = 0, AT_VT = 2 * KS_KVH, AT_END = AT_VT + 2 * VT_KVH;
static_assert(AT_END <= SCR_BYTES, "attention LDS");
__device__ __forceinline__ int vt_pos(int key) { const int o = key & 15; return (key & ~15) + 8 * ((o >> 2) & 1) + (o & 3) + 4 * (o >> 3); }
#define ATT_STAMP(k) do { if (PROBE_WHICH == 9) tst[k] = __builtin_amdgcn_s_memrealtime(); } while (0)
__device__ __forceinline__ void attn_prompt_item(Frame& F, int item, unsigned long long* tst) {
    const int b = item / (SEQ / WIN), blk = item % (SEQ / WIN);
    int tid_ = F.tid(); asm volatile("" : "+v"(tid_));
    const int tid = tid_, lane = tid & 63, w = F.wave;
    LAS unsigned char* Ks = F.lds + AT_KS; LAS unsigned char* Vt = F.lds + AT_VT;
    ATT_STAMP(0);
    {
        const bool lastb = (blk == SEQ / WIN - 1);
        const float* kn = F.inp(I_KN);
        v4u kr[8];
#pragma unroll
        for (int i = 0; i < 8; ++i) { const int idx = tid + 512 * i, key = idx >> 4, cc = idx & 15, tb = blk * WIN - WIN + key;
            kr[i] = (v4u){0u, 0u, 0u, 0u}; if (tb >= 0) kr[i] = *(const v4u*)(F.PROJ() + (size_t)(b * SEQ + tb) * INW + C_K + 8 * cc); }
#pragma unroll
        for (int i = 0; i < 8; ++i) { const int idx = tid + 512 * i, key = idx >> 4, cc = idx & 15, kvh = cc >> 3, c = cc & 7, tb = blk * WIN - WIN + key, tbc = tb < 0 ? 0 : tb;
            float x[8] = {bflo(kr[i].x), bfhi(kr[i].x), bflo(kr[i].y), bfhi(kr[i].y), bflo(kr[i].z), bfhi(kr[i].z), bflo(kr[i].w), bfhi(kr[i].w)};
            float ss = 0.f;
#pragma unroll
            for (int j = 0; j < 8; ++j) ss += x[j] * x[j];
            ss += __shfl_xor(ss, 1); ss += __shfl_xor(ss, 2); ss += __shfl_xor(ss, 4);
            const float rs = __builtin_amdgcn_rsqf(ss * (1.0f / 64.0f) + EPS);
            const f32x4 g0 = *(const f32x4*)(kn + 8 * c), g1 = *(const f32x4*)(kn + 8 * c + 4);
            const f32x4 c0 = *(const f32x4*)(F.ROPEC() + (size_t)tbc * 32 + 8 * (c & 3)), c1 = *(const f32x4*)(F.ROPEC() + (size_t)tbc * 32 + 8 * (c & 3) + 4);
            const f32x4 s0 = *(const f32x4*)(F.ROPES() + (size_t)tbc * 32 + 8 * (c & 3)), s1 = *(const f32x4*)(F.ROPES() + (size_t)tbc * 32 + 8 * (c & 3) + 4);
            float o[8];
#pragma unroll
            for (int j = 0; j < 8; ++j) { const float xn = x[j] * rs * (j < 4 ? g0[j] : g1[j - 4]); const float other = __shfl_xor(xn, 4);
                const float cc2 = j < 4 ? c0[j] : c1[j - 4], sv = j < 4 ? s0[j] : s1[j - 4];
                o[j] = (c < 4) ? (xn * cc2 - other * sv) : (xn * cc2 + other * sv); }
            v4u w4; w4.x = cvtpk(o[0], o[1]); w4.y = cvtpk(o[2], o[3]); w4.z = cvtpk(o[4], o[5]); w4.w = cvtpk(o[6], o[7]);
            *(LAS v4u*)(Ks + kvh * KS_KVH + key * KS_STRIDE + 16 * c) = w4;
            if (lastb && key >= WIN) { float* ok = F.out + O_PK + ((size_t)(b * WIN + key - WIN) * NKV + kvh) * HD + 8 * c;
                *(f32x4*)(ok) = (f32x4){o[0], o[1], o[2], o[3]}; *(f32x4*)(ok + 4) = (f32x4){o[4], o[5], o[6], o[7]}; }
        }
        asm volatile("" ::: "memory");
        v4u vr[8];
#pragma unroll
        for (int i = 0; i < 8; ++i) { const int idx = tid + 512 * i, key = idx >> 4, cc = idx & 15, tb = blk * WIN - WIN + key;
            vr[i] = (v4u){0u, 0u, 0u, 0u}; if (tb >= 0) vr[i] = *(const v4u*)(F.PROJ() + (size_t)(b * SEQ + tb) * INW + C_V + 8 * cc); }
#pragma unroll
        for (int i = 0; i < 8; ++i) { const int idx = tid + 512 * i, key = idx >> 4, cc = idx & 15, kvh = cc >> 3, c = cc & 7;
            LAS bf16* vcol = (LAS bf16*)(Vt + kvh * VT_KVH) + (8 * c) * (VT_STRIDE / 2) + vt_pos(key);
            const unsigned q4[4] = {vr[i].x, vr[i].y, vr[i].z, vr[i].w};
#pragma unroll
            for (int e = 0; e < 4; ++e) { vcol[(2 * e) * (VT_STRIDE / 2)] = (bf16)(q4[e] & 0xffffu); vcol[(2 * e + 1) * (VT_STRIDE / 2)] = (bf16)(q4[e] >> 16); }
            if (lastb && key >= WIN) { float* ov = F.out + O_PV + ((size_t)(b * WIN + key - WIN) * NKV + kvh) * HD + 8 * c;
                *(f32x4*)(ov) = (f32x4){bflo(vr[i].x), bfhi(vr[i].x), bflo(vr[i].y), bfhi(vr[i].y)}; *(f32x4*)(ov + 4) = (f32x4){bflo(vr[i].z), bfhi(vr[i].z), bflo(vr[i].w), bfhi(vr[i].w)}; }
        }
    }
    __syncthreads();
    ATT_STAMP(1);
    const int hh = lane >> 5, ql = lane & 31, kvh = w >> 2;
    const float sinkl2 = F.inp(I_SINK)[w] * LOG2E;
    const float QS = 0.125f * LOG2E;
    const float* qn = F.inp(I_QN);
    v4u qraw[4]; f32x4 csv[2][2], snv[2][2];
#define ATT_FETCHQ(sx) do { const int t_ = blk * WIN + 32 * (sx) + ql; const bf16* qp_ = F.PROJ() + ((size_t)b * SEQ + t_) * INW + C_Q + w * 64 + 8 * hh; \
        _Pragma("unroll") for (int ds = 0; ds < 4; ++ds) qraw[ds] = *(const v4u*)(qp_ + 16 * ds); \
        _Pragma("unroll") for (int ds = 0; ds < 2; ++ds) { const float* c_ = F.ROPEC() + (size_t)t_ * 32 + 16 * ds + 8 * hh; const float* s_ = F.ROPES() + (size_t)t_ * 32 + 16 * ds + 8 * hh; \
            csv[ds][0] = *(const f32x4*)c_; csv[ds][1] = *(const f32x4*)(c_ + 4); snv[ds][0] = *(const f32x4*)s_; snv[ds][1] = *(const f32x4*)(s_ + 4); } } while (0)
#ifndef ATT_PREFETCH
#define ATT_PREFETCH 0
#endif
    if (ATT_PREFETCH) ATT_FETCHQ(0);
    for (int s = 0; s < 4; ++s) {
        const int qi = 32 * s + ql, t = blk * WIN + qi; const size_t row = (size_t)b * SEQ + t;
        if (!ATT_PREFETCH) ATT_FETCHQ(s);
        bf16x8 qf[4];
        {
            float qv[4][8]; float ss = 0.f;
#pragma unroll
            for (int ds = 0; ds < 4; ++ds) { const v4u r4 = qraw[ds];
                qv[ds][0] = bflo(r4.x); qv[ds][1] = bfhi(r4.x); qv[ds][2] = bflo(r4.y); qv[ds][3] = bfhi(r4.y); qv[ds][4] = bflo(r4.z); qv[ds][5] = bfhi(r4.z); qv[ds][6] = bflo(r4.w); qv[ds][7] = bfhi(r4.w); }
#pragma unroll
            for (int ds = 0; ds < 4; ++ds)
#pragma unroll
                for (int j = 0; j < 8; ++j) ss += qv[ds][j] * qv[ds][j];
            ss += __shfl_xor(ss, 32);
            const float rs = __builtin_amdgcn_rsqf(ss * (1.0f / 64.0f) + EPS);
#pragma unroll
            for (int ds = 0; ds < 2; ++ds)
#pragma unroll
                for (int j = 0; j < 8; ++j) { const int i = 16 * ds + 8 * hh + j; const float x1 = qv[ds][j] * rs * qn[i], x2 = qv[ds + 2][j] * rs * qn[i + 32], cc = csv[ds][j >> 2][j & 3], sv = snv[ds][j >> 2][j & 3];
                    qv[ds][j] = (x1 * cc - x2 * sv) * QS; qv[ds + 2][j] = (x2 * cc + x1 * sv) * QS; }
#pragma unroll
            for (int ds = 0; ds < 4; ++ds) { v4u o; o.x = cvtpk(qv[ds][0], qv[ds][1]); o.y = cvtpk(qv[ds][2], qv[ds][3]); o.z = cvtpk(qv[ds][4], qv[ds][5]); o.w = cvtpk(qv[ds][6], qv[ds][7]); qf[ds] = __builtin_bit_cast(bf16x8, o); }
        }
        if (ATT_PREFETCH && s + 1 < 4) ATT_FETCHQ(s + 1);
        f32x16 p[5];
#pragma unroll
        for (int kt = 0; kt < 5; ++kt) {
            const LAS unsigned char* kp = Ks + kvh * KS_KVH + (32 * (s + kt) + ql) * KS_STRIDE + 16 * hh;
            f32x16 acc = {0.f, 0.f, 0.f, 0.f, 0.f, 0.f, 0.f, 0.f, 0.f, 0.f, 0.f, 0.f, 0.f, 0.f, 0.f, 0.f};
#pragma unroll
            for (int ds = 0; ds < 4; ++ds) { const bf16x8 kfr = *(const LAS bf16x8*)(kp + 32 * ds); acc = __builtin_amdgcn_mfma_f32_32x32x16_bf16(kfr, qf[ds], acc, 0, 0, 0); }
            p[kt] = acc;
        }
        float mx = -INFINITY;
#pragma unroll
        for (int kt = 0; kt < 5; ++kt) {
            if (kt == 0 || kt == 4 || blk == 0) {
#pragma unroll
                for (int r = 0; r < 16; ++r) { const int kj = 32 * (s + kt) + (r & 3) + 8 * (r >> 2) + 4 * hh;
                    const bool valid = (kj > qi) && (kj <= qi + WIN) && (blk > 0 || kj >= WIN);
                    const float v = valid ? p[kt][r] : -INFINITY; p[kt][r] = v; mx = fmaxf(mx, v); }
            } else {
#pragma unroll
                for (int r = 0; r < 16; ++r) mx = fmaxf(mx, p[kt][r]);
            }
        }
        mx = fmaxf(mx, __shfl_xor(mx, 32)); mx = fmaxf(mx, sinkl2);
        float sum = 0.f;
#pragma unroll
        for (int kt = 0; kt < 5; ++kt)
#pragma unroll
            for (int r = 0; r < 16; ++r) { const float e = __builtin_amdgcn_exp2f(p[kt][r] - mx); p[kt][r] = e; sum += e; }
        sum += __shfl_xor(sum, 32);
        const float inv = __builtin_amdgcn_rcpf(sum + __builtin_amdgcn_exp2f(sinkl2 - mx));
        f32x16 o0 = {0.f, 0.f, 0.f, 0.f, 0.f, 0.f, 0.f, 0.f, 0.f, 0.f, 0.f, 0.f, 0.f, 0.f, 0.f, 0.f}, o1 = o0;
#pragma unroll
        for (int kt = 0; kt < 5; ++kt)
#pragma unroll
            for (int ss2 = 0; ss2 < 2; ++ss2) {
                v4u pw; pw.x = cvtpk(p[kt][8 * ss2 + 0], p[kt][8 * ss2 + 1]); pw.y = cvtpk(p[kt][8 * ss2 + 2], p[kt][8 * ss2 + 3]); pw.z = cvtpk(p[kt][8 * ss2 + 4], p[kt][8 * ss2 + 5]); pw.w = cvtpk(p[kt][8 * ss2 + 6], p[kt][8 * ss2 + 7]);
                const bf16x8 pf = __builtin_bit_cast(bf16x8, pw);
                const LAS unsigned char* vp = Vt + kvh * VT_KVH + ql * VT_STRIDE + (16 * (2 * (s + kt) + ss2) + 8 * hh) * 2;
                const bf16x8 v0 = *(const LAS bf16x8*)(vp), v1 = *(const LAS bf16x8*)(vp + 32 * VT_STRIDE);
                o0 = __builtin_amdgcn_mfma_f32_32x32x16_bf16(v0, pf, o0, 0, 0, 0);
                o1 = __builtin_amdgcn_mfma_f32_32x32x16_bf16(v1, pf, o1, 0, 0, 0);
            }
        float hsq = 0.f;
#pragma unroll
        for (int r = 0; r < 16; ++r) { o0[r] *= inv; o1[r] *= inv; hsq += o0[r] * o0[r] + o1[r] * o1[r]; }
        hsq += __shfl_xor(hsq, 32);
        if (hh == 0) F.SSQA()[row * 8 + w] = hsq;
        bf16* crow = F.CAT() + row * DM + 512 + w * 64;
#pragma unroll
        for (int g = 0; g < 4; ++g) { const int d0 = 8 * g + 4 * hh;
            v2u a, c2; a.x = cvtpk(o0[4 * g], o0[4 * g + 1]); a.y = cvtpk(o0[4 * g + 2], o0[4 * g + 3]);
            c2.x = cvtpk(o1[4 * g], o1[4 * g + 1]); c2.y = cvtpk(o1[4 * g + 2], o1[4 * g + 3]);
            *(v2u*)(crow + d0) = a; *(v2u*)(crow + 32 + d0) = c2; }
    }
    ATT_STAMP(2);
    __syncthreads();
}

__device__ __forceinline__ void sample_lru_item(Frame& F, int b) {
    int tid_ = F.tid(); asm volatile("" : "+v"(tid_));
    const int tid = tid_, lane = tid & 63, w = F.wave;
    const size_t row0 = (size_t)MP + (size_t)b * DEC_T;
    {
        const int c = tid, blk = w, cj = c & 63;
        LAS float* xcs = (LAS float*)F.lds;
        LAS float* red = xcs + 4 * 512;
        const float cw0 = F.inp(I_CW)[c], cw1 = F.inp(I_CW)[512 + c], cw2 = F.inp(I_CW)[1024 + c], cw3 = F.inp(I_CW)[1536 + c], cb = F.inp(I_CB)[c];
        const float lam = F.inp(I_LAM)[c];
        const float c8 = -8.0f * (fmaxf(-lam, 0.f) + log1pf(expf(-fabsf(lam))));
        float xs[7];
#pragma unroll
        for (int j = 0; j < 3; ++j) xs[j] = F.inp(I_SC)[((size_t)b * 3 + j) * 512 + c];
#pragma unroll
        for (int t = 0; t < 4; ++t) xs[3 + t] = bf1(F.PROJ()[(row0 + t) * INW + c]);
#pragma unroll
        for (int t = 0; t < 4; ++t) xcs[t * 512 + c] = cb + cw0 * xs[t] + cw1 * xs[t + 1] + cw2 * xs[t + 2] + cw3 * xs[t + 3];
        __syncthreads();
        float rp[4], ip[4];
#pragma unroll
        for (int t = 0; t < 4; ++t) { rp[t] = F.inp(I_BA)[c]; ip[t] = F.inp(I_BX)[c]; }
        const float* wap = F.inp(I_WA) + (size_t)(blk * 64) * 64 + cj; const float* wxp = F.inp(I_WX) + (size_t)(blk * 64) * 64 + cj;
#pragma unroll 16
        for (int k = 0; k < 64; ++k) { const float wa = wap[k * 64], wx = wxp[k * 64];
#pragma unroll
            for (int t = 0; t < 4; ++t) { const float xv = xcs[t * 512 + blk * 64 + k]; rp[t] += xv * wa; ip[t] += xv * wx; } }
        float h = F.inp(I_SH)[(size_t)b * 512 + c]; float ov[4];
#pragma unroll
        for (int t = 0; t < 4; ++t) {
            const float r = sigmoid_f(rp[t]), ig = sigmoid_f(ip[t]);
            const float la = c8 * r, a = __builtin_amdgcn_exp2f(la * LOG2E);
            const float mult = __builtin_amdgcn_sqrtf(one_minus_exp(2.0f * la));
            h = a * h + mult * ig * xcs[t * 512 + c];
            const float g = bf1(F.PROJ()[(row0 + t) * INW + C_GATE + c]);
            ov[t] = h * gelu_tanh(g);
            const float s = wave_sum(ov[t] * ov[t]); if (lane == 0) red[t * 8 + w] = s;
        }
        F.out[O_SH + (size_t)b * 512 + c] = h;
#pragma unroll
        for (int j = 0; j < 3; ++j) F.out[O_SC + ((size_t)b * 3 + j) * 512 + c] = xs[4 + j];
        __syncthreads();
#pragma unroll
        for (int t = 0; t < 4; ++t) { float s = 0.f;
#pragma unroll
            for (int w2 = 0; w2 < 8; ++w2) s += red[t * 8 + w2];
            F.CAT()[(row0 + t) * DM + c] = (bf16)f2bf(ov[t] * __builtin_amdgcn_rsqf(s * (1.0f / 512.0f) + EPS)); }
        __syncthreads();
    }
}
constexpr int SA_KROW = 68, SA_KC = 0, SA_VC = 132 * SA_KROW * 4, SA_QS = SA_VC + 132 * 64 * 4, SA_END = SA_QS + 8 * 64 * 4;
__device__ __forceinline__ void sample_attn_item(Frame& F, int b, int kvh) {
    int tid_ = F.tid(); asm volatile("" : "+v"(tid_));
    const int tid = tid_, lane = tid & 63, w = F.wave;
    const size_t row0 = (size_t)MP + (size_t)b * DEC_T;
    LAS float* Kc = (LAS float*)(F.lds + SA_KC); LAS float* Vc = (LAS float*)(F.lds + SA_VC); LAS float* qs = (LAS float*)(F.lds + SA_QS);
    {
        const float* ck = F.inp(I_CK) + (size_t)b * WIN * 128 + kvh * 64; const float* cv = F.inp(I_CV) + (size_t)b * WIN * 128 + kvh * 64;
        float* ok = F.out + O_SK + (size_t)b * WIN * 128 + kvh * 64; float* ov = F.out + O_SV + (size_t)b * WIN * 128 + kvh * 64;
#pragma unroll
        for (int i = 0; i < 4; ++i) { const int idx = tid + 512 * i, j = idx >> 4, d4 = (idx & 15) * 4;
            const f32x4 kv = *(const f32x4*)(ck + (size_t)j * 128 + d4), vv = *(const f32x4*)(cv + (size_t)j * 128 + d4);
            *(LAS f32x4*)(Kc + j * SA_KROW + d4) = kv; *(LAS f32x4*)(Vc + j * 64 + d4) = vv;
            if (j >= DEC_T) { *(f32x4*)(ok + (size_t)(j - DEC_T) * 128 + d4) = kv; *(f32x4*)(ov + (size_t)(j - DEC_T) * 128 + d4) = vv; } }
        if (w < DEC_T) {
            const int t = w, i = lane & 31;
            const bf16* pr = F.PROJ() + (row0 + t) * INW;
            const float k1 = bf1(pr[C_K + kvh * 64 + i]), k2 = bf1(pr[C_K + kvh * 64 + 32 + i]);
            float ss = k1 * k1 + k2 * k2;
#pragma unroll
            for (int o = 1; o < 32; o <<= 1) ss += __shfl_xor(ss, o);
            const float rs = __builtin_amdgcn_rsqf(ss * (1.0f / 64.0f) + EPS);
            const float x1 = k1 * rs * F.inp(I_KN)[i], x2 = k2 * rs * F.inp(I_KN)[i + 32];
            const float cc = F.ROPEC()[(size_t)(SEQ + t) * 32 + i], sv = F.ROPES()[(size_t)(SEQ + t) * 32 + i];
            const float o1 = x1 * cc - x2 * sv, o2 = x2 * cc + x1 * sv;
            const float v1 = bf1(pr[C_V + kvh * 64 + i]), v2 = bf1(pr[C_V + kvh * 64 + 32 + i]);
            if (lane < 32) {
                Kc[(WIN + t) * SA_KROW + i] = o1; Kc[(WIN + t) * SA_KROW + 32 + i] = o2; Vc[(WIN + t) * 64 + i] = v1; Vc[(WIN + t) * 64 + 32 + i] = v2;
                const size_t oo = (size_t)(WIN - DEC_T + t) * 128;
                ok[oo + i] = o1; ok[oo + 32 + i] = o2; ov[oo + i] = v1; ov[oo + 32 + i] = v2; }
        }
    }
    __syncthreads();
    const int head = kvh * 4 + (w & 3);
    const float sinkl2 = F.inp(I_SINK)[head] * LOG2E;
#pragma unroll
    for (int tt = 0; tt < 2; ++tt) {
        const int t = 2 * (w >> 2) + tt;
        {
            const float x = bf1(F.PROJ()[(row0 + t) * INW + C_Q + head * 64 + lane]);
            const float ss = wave_sum(x * x);
            const float xn = x * __builtin_amdgcn_rsqf(ss * (1.0f / 64.0f) + EPS) * F.inp(I_QN)[lane];
            const float other = __shfl_xor(xn, 32);
            const int i = lane & 31; const float cc = F.ROPEC()[(size_t)(SEQ + t) * 32 + i], sv = F.ROPES()[(size_t)(SEQ + t) * 32 + i];
            const float qo = (lane < 32) ? (xn * cc - other * sv) : (xn * cc + other * sv);
            qs[w * 64 + lane] = qo * (0.125f * LOG2E);
        }
        LDS_WAIT(); asm volatile("" ::: "memory");
        const int j0 = t + 1 + lane, j1 = j0 + 64;
        float s0 = 0.f, s1 = 0.f;
        const LAS f32x4* q4 = (const LAS f32x4*)(qs + w * 64);
        const LAS f32x4* k0 = (const LAS f32x4*)(Kc + j0 * SA_KROW); const LAS f32x4* k1 = (const LAS f32x4*)(Kc + j1 * SA_KROW);
#pragma unroll
        for (int d4 = 0; d4 < 16; ++d4) { const f32x4 q = q4[d4], a = k0[d4], c = k1[d4];
            s0 += q[0] * a[0] + q[1] * a[1] + q[2] * a[2] + q[3] * a[3]; s1 += q[0] * c[0] + q[1] * c[1] + q[2] * c[2] + q[3] * c[3]; }
        float mx = wave_max(fmaxf(s0, s1)); mx = fmaxf(mx, sinkl2);
        const float p0 = __builtin_amdgcn_exp2f(s0 - mx), p1 = __builtin_amdgcn_exp2f(s1 - mx);
        const float l = wave_sum(p0 + p1) + __builtin_amdgcn_exp2f(sinkl2 - mx);
        float o = 0.f;
#pragma unroll 8
        for (int jj = 0; jj < 64; ++jj) { const float pa = __shfl(p0, jj), pb = __shfl(p1, jj); o += pa * Vc[(t + 1 + jj) * 64 + lane] + pb * Vc[(t + 65 + jj) * 64 + lane]; }
        o *= __builtin_amdgcn_rcpf(l);
        F.SOA()[((size_t)b * DEC_T + t) * 512 + head * 64 + lane] = o;
        const float hq = wave_sum(o * o); if (lane == 0) F.SSQS()[((size_t)b * DEC_T + t) * 8 + head] = hq;
    }
    __syncthreads();
}
__device__ __forceinline__ void sample_attn_norm(Frame& F) {
    const int lane = F.lane(), gw = blockIdx.x * NWAVES + F.wave;
    for (int r = gw; r < MS; r += F.G * NWAVES) {
        const f32x4* sp = (const f32x4*)(F.SSQS() + (size_t)r * 8); const f32x4 s0 = sp[0], s1 = sp[1];
        const float rs = __builtin_amdgcn_rsqf((((s0[0] + s0[1]) + (s0[2] + s0[3])) + ((s1[0] + s1[1]) + (s1[2] + s1[3]))) * (1.0f / 512.0f) + EPS);
        const f32x4* op = (const f32x4*)(F.SOA() + (size_t)r * 512 + lane * 8); const f32x4 a = op[0], c = op[1];
        v4u o; o.x = cvtpk(a[0] * rs, a[1] * rs); o.y = cvtpk(a[2] * rs, a[3] * rs); o.z = cvtpk(c[0] * rs, c[1] * rs); o.w = cvtpk(c[2] * rs, c[3] * rs);
        *(v4u*)(F.CAT() + ((size_t)MP + r) * DM + 512 + lane * 8) = o;
    }
}

struct SEpiSwiglu {
    bf16* H; const float* ssq;
    __device__ __forceinline__ int brow0(int cb) const { const int hc0 = 32 * cb; return (hc0 >> 7) * 256 + (hc0 & 127); }
    __device__ __forceinline__ int brow1(int cb) const { return brow0(cb) + 128; }
    __device__ __forceinline__ void operator()(const f32x16& a0, const f32x16& a1, int r, int cb, int h) const {
        const float rs = pg8::row_rs(ssq, r);
#pragma unroll
        for (int g = 0; g < 4; ++g) { float hv[4];
#pragma unroll
            for (int e = 0; e < 4; ++e) hv[e] = pg8::silu_f(a0[4 * g + e] * rs) * (a1[4 * g + e] * rs);
            v2u w; w.x = cvtpk(hv[0], hv[1]); w.y = cvtpk(hv[2], hv[3]); *(v2u*)(H + (size_t)r * DFF + 32 * cb + 8 * g + 4 * h) = w; }
    }
};
struct SEpiScale {
    bf16* O; int ldc; const float* ssq;
    __device__ __forceinline__ int brow0(int cb) const { return 64 * cb; }
    __device__ __forceinline__ int brow1(int cb) const { return 64 * cb + 32; }
    __device__ __forceinline__ void operator()(const f32x16& a0, const f32x16& a1, int r, int cb, int h) const {
        const float rs = pg8::row_rs(ssq, r);
#pragma unroll
        for (int g = 0; g < 4; ++g) {
            v2u w; w.x = cvtpk(a0[4 * g] * rs, a0[4 * g + 1] * rs); w.y = cvtpk(a0[4 * g + 2] * rs, a0[4 * g + 3] * rs); *(v2u*)(O + (size_t)r * ldc + 64 * cb + 8 * g + 4 * h) = w;
            v2u x; x.x = cvtpk(a1[4 * g] * rs, a1[4 * g + 1] * rs); x.y = cvtpk(a1[4 * g + 2] * rs, a1[4 * g + 3] * rs); *(v2u*)(O + (size_t)r * ldc + 64 * cb + 32 + 8 * g + 4 * h) = x; }
    }
};
template <int MODE> struct SEpiResid {
    const float* basef; float* out; bf16* xb; float* ssq; float scale;
    __device__ __forceinline__ int brow0(int cb) const { return 64 * cb; }
    __device__ __forceinline__ int brow1(int cb) const { return 64 * cb + 32; }
    __device__ __forceinline__ void operator()(const f32x16& a0, const f32x16& a1, int r, int cb, int h) const {
        float s = 0.f;
#pragma unroll
        for (int a = 0; a < 2; ++a)
#pragma unroll
            for (int g = 0; g < 4; ++g) { const size_t off = (size_t)r * DM + 64 * cb + 32 * a + 8 * g + 4 * h;
                f32x4 b; if (MODE == 0) b = *(const f32x4*)(basef + off); else b = pg8::bf4_to_f32(*(const v2u*)(xb + off));
                const f32x4 v = a == 0 ? (f32x4){a0[4 * g], a0[4 * g + 1], a0[4 * g + 2], a0[4 * g + 3]} : (f32x4){a1[4 * g], a1[4 * g + 1], a1[4 * g + 2], a1[4 * g + 3]};
                const f32x4 o = b + v * scale;
                if (MODE == 2) *(f32x4*)(out + off) = o;
                else { s += (o[0] * o[0] + o[1] * o[1]) + (o[2] * o[2] + o[3] * o[3]); v2u w; w.x = cvtpk(o[0], o[1]); w.y = cvtpk(o[2], o[3]); *(v2u*)(xb + off) = w; } }
        if (MODE != 2) { s += __shfl_xor(s, 32); if (h == 0) ssq[(size_t)r * 16 + cb] = s; }
    }
};
constexpr int SG_ROWB = 144, SG_TILE = 32 * SG_ROWB, SG_WAVE = 3 * SG_TILE;
static_assert(8 * SG_WAVE <= SCR_BYTES, "small gemm LDS");
template <int K, int KS, class Epi> __device__ __forceinline__ void small_gemm(Frame& F, const bf16* A, int lda, const bf16* Bt, int ncb, const Epi& E, unsigned* dyn) {
    int lane_ = F.lane(); asm volatile("" : "+v"(lane_));
    const int lane = lane_, w = F.wave, ql = lane & 31, h = lane >> 5, lr = lane >> 3, ch = lane & 7;
    const int nitems = 16 * ncb * KS;
    constexpr int NBT = K / 64, NB_LO = NBT / KS, NB_REM = NBT % KS;
    LAS unsigned char* tl = F.lds + w * SG_WAVE;
    LAS float* red = (LAS float*)F.lds;
    for (;;) {
        if (F.tid() == 0) F.MISC[0] = __hip_atomic_fetch_add(dyn, 1u, __ATOMIC_RELAXED, __HIP_MEMORY_SCOPE_AGENT);
        __syncthreads();
        const int base = (int)F.MISC[0] * NWAVES;
        __syncthreads();
        if (base >= nitems) break;
        const int it = base + w; const bool valid = it < nitems;
        const int tile = it / KS, ks = it % KS, rb = tile & 15, cb = tile >> 4;
        f32x16 acc0 = {0.f, 0.f, 0.f, 0.f, 0.f, 0.f, 0.f, 0.f, 0.f, 0.f, 0.f, 0.f, 0.f, 0.f, 0.f, 0.f}, acc1 = acc0;
        const int r = MP + 32 * rb + ql;
        if (valid) {
            const int nb = NB_LO + (ks < NB_REM ? 1 : 0), kb0 = 64 * (ks * NB_LO + (ks < NB_REM ? ks : NB_REM));
            const bf16* ga = A + (size_t)(MP + 32 * rb + lr) * lda + kb0 + 8 * ch;
            const bf16* g0 = Bt + (size_t)(E.brow0(cb) + lr) * K + kb0 + 8 * ch;
            const bf16* g1 = Bt + (size_t)(E.brow1(cb) + lr) * K + kb0 + 8 * ch;
            v4u ra[4], r0[4], r1[4], sa[4], s0[4], s1[4];
#define SG_LD1(dst, ptr) asm volatile("global_load_dwordx4 %0, %1, off" : "=v"(dst) : "v"(ptr) : "memory")
#define SG_FETCH(RA, R0, R1, bb) do { _Pragma("unroll") for (int i = 0; i < 4; ++i) { SG_LD1(RA[i], ga + (size_t)(8 * i) * lda + 64 * (bb)); SG_LD1(R0[i], g0 + (size_t)(8 * i) * K + 64 * (bb)); SG_LD1(R1[i], g1 + (size_t)(8 * i) * K + 64 * (bb)); } } while (0)
#define SG_WAIT(N, RA, R0, R1) asm volatile("s_waitcnt vmcnt(" #N ")" : "+v"(RA[0]), "+v"(RA[1]), "+v"(RA[2]), "+v"(RA[3]), "+v"(R0[0]), "+v"(R0[1]), "+v"(R0[2]), "+v"(R0[3]), "+v"(R1[0]), "+v"(R1[1]), "+v"(R1[2]), "+v"(R1[3]) :: "memory")
#define SG_PARK(RA, R0, R1) do { _Pragma("unroll") for (int i = 0; i < 4; ++i) { const int off = (lr + 8 * i) * SG_ROWB + 16 * ch; *(LAS v4u*)(tl + off) = RA[i]; *(LAS v4u*)(tl + SG_TILE + off) = R0[i]; *(LAS v4u*)(tl + 2 * SG_TILE + off) = R1[i]; } } while (0)
#define SG_MMA() do { _Pragma("unroll") for (int sI = 0; sI < 4; ++sI) { const int fo = ql * SG_ROWB + 32 * sI + 16 * h; \
                    const bf16x8 af = *(const LAS bf16x8*)(tl + fo), bf0 = *(const LAS bf16x8*)(tl + SG_TILE + fo), bf1v = *(const LAS bf16x8*)(tl + 2 * SG_TILE + fo); \
                    acc0 = __builtin_amdgcn_mfma_f32_32x32x16_bf16(bf0, af, acc0, 0, 0, 0); acc1 = __builtin_amdgcn_mfma_f32_32x32x16_bf16(bf1v, af, acc1, 0, 0, 0); } } while (0)
            asm volatile("s_waitcnt vmcnt(0)" ::: "memory");
            SG_FETCH(ra, r0, r1, 0);
            if (nb > 1) SG_FETCH(sa, s0, s1, 1);
            int b = 0;
            for (; b + 3 < nb; b += 2) {
                SG_WAIT(12, ra, r0, r1); SG_PARK(ra, r0, r1); SG_FETCH(ra, r0, r1, b + 2); SG_MMA();
                SG_WAIT(12, sa, s0, s1); SG_PARK(sa, s0, s1); SG_FETCH(sa, s0, s1, b + 3); SG_MMA();
            }
            SG_WAIT(0, ra, r0, r1); if (b + 1 < nb) SG_WAIT(0, sa, s0, s1);
            SG_PARK(ra, r0, r1); if (b + 2 < nb) SG_FETCH(ra, r0, r1, b + 2); SG_MMA();
            if (b + 1 < nb) { SG_PARK(sa, s0, s1); SG_MMA(); }
            if (b + 2 < nb) { SG_WAIT(0, ra, r0, r1); SG_PARK(ra, r0, r1); SG_MMA(); }
#undef SG_LD1
#undef SG_FETCH
#undef SG_WAIT
#undef SG_PARK
#undef SG_MMA
        }
        if (KS > 1) {
            __syncthreads();
#pragma unroll
            for (int q = 0; q < 16; ++q) { red[((w * 2 + 0) * 16 + q) * 64 + lane] = acc0[q]; red[((w * 2 + 1) * 16 + q) * 64 + lane] = acc1[q]; }
            __syncthreads();
            if (valid && ks == 0) {
#pragma unroll
                for (int j = 1; j < KS; ++j)
#pragma unroll
                    for (int q = 0; q < 16; ++q) { acc0[q] += red[(((w + j) * 2 + 0) * 16 + q) * 64 + lane]; acc1[q] += red[(((w + j) * 2 + 1) * 16 + q) * 64 + lane]; }
            }
        }
        if (valid && ks == 0) E(acc0, acc1, r, cb, h);
        if (KS > 1) __syncthreads();
    }
}

#ifndef MK_N_LAUNCHES
#define MK_N_LAUNCHES 1
#endif
constexpr int N_PHASES = 9;
constexpr int N_LAUNCHES = MK_N_LAUNCHES;
struct Args { const float* in[29]; float* out; unsigned char* ws; int ph_lo, ph_hi, li, pad; };
__global__ void __launch_bounds__(NWAVES * 64, 2) hymba_fwd(Args args) {
    extern __shared__ __attribute__((aligned(16))) unsigned char lds[];
    Frame F;
    F.lds = (LAS unsigned char*)lds;
    F.MISC = (volatile LAS unsigned*)(F.lds + MISC_OFF);
    F.wave = __builtin_amdgcn_readfirstlane((int)threadIdx.x >> 6);
    F.G = gridDim.x; { const int bx = blockIdx.x; F.vcu = (F.G % 8 == 0) ? (bx % 8) * (F.G / 8) + bx / 8 : bx; }
    F.kp = (kernarg_ptr)__builtin_amdgcn_kernarg_segment_ptr(); F.out = args.out; F.ws = args.ws;
    for (int u = F.tid(); u < (LDS_BYTES - LDSCTL_OFF) / 4; u += NWAVES * 64) ((LAS unsigned*)(F.lds + LDSCTL_OFF))[u] = 0u;
    __syncthreads();
    XcdBarrier bar; bar.bar = (unsigned*)(F.ctl() + CW_BAR); bar.x = 0; bar.st = nullptr;
    if (N_LAUNCHES == 1) bar = xcd_barrier_post((unsigned*)(F.ctl() + CW_BAR), F.MISC + 8, F.tid() == 0);
#define GRID_BAR() do { if (N_LAUNCHES == 1) xcd_barrier(bar, F.tid() == 0); } while (0)
    const int lo = args.ph_lo, hi = args.ph_hi;
#define IN(k) (lo <= (k) && (k) < hi)
#ifndef PROBE_PHASE
#define PROBE_PHASE -1
#endif
#ifndef PROBE_BLOCK
#define PROBE_BLOCK 0
#endif
#ifndef PROBE_BLOCK2
#define PROBE_BLOCK2 0
#endif
    unsigned long long tsA = 0, tsB = 0; pg8::Tm tm{0, 0};
#define STAMP(k) do { if (PROBE_WHICH == 8 && (k) == PROBE_PHASE) tsA = __builtin_amdgcn_s_memrealtime(); if (PROBE_PHASE >= 0 && PROBE_WHICH == 0) { if ((k) == PROBE_PHASE) tsA = __builtin_amdgcn_s_memrealtime(); if ((k) == PROBE_PHASE + 1) tsB = __builtin_amdgcn_s_memrealtime(); } } while (0)
#define BOTH(k) (IN(k) && IN((k) + 1))
#ifndef PROBE_REP
#define PROBE_REP 0
#endif
#define REP(k) for (int rep_ = 0; rep_ < (((PROBE_REP >> (k)) & 1) ? 2 : 1); ++rep_)

#ifndef SKIP_P0
#undef CURPH
#define CURPH 0
    STAMP(0);
    if (IN(0)) REP(0) { p0_prologue(F); { if (PROBE_WHICH == 8 && PROBE_PHASE == 0) tsB = __builtin_amdgcn_s_memrealtime(); if (PROBE_WHICH == 7 && PROBE_PHASE == 0) tsA = __builtin_amdgcn_s_memrealtime(); if (BOTH(0)) GRID_BAR(); if (PROBE_WHICH == 7 && PROBE_PHASE == 0) tsB = __builtin_amdgcn_s_memrealtime(); } }
#endif
#undef CURPH
#define CURPH 1
    STAMP(1);
    if (IN(1)) REP(1) {
        pg8::Gemm g{F.XB(), F.WGU1(), MP, 2 * DFF, DM}; pg8::StaticOrder S; S.init(MP, 2 * DFF, F.G, (int)blockIdx.x);
        pg8::EpiSwiglu E{F.HB(), DFF}; pg8::rs_cache_fill(F.lds + RING_OFF, S, F.SSQ(), F.wave);
        pg8::gemm_phase<pg8::EpiSwiglu, pg8::StaticOrder, true, true>(F.lds + RING_OFF, g, S, E, F.wave, tm);
        if ((PROBE_WHICH == 1 || PROBE_WHICH == 2) && PROBE_PHASE == 1) { tsA = 0; tsB = (PROBE_WHICH == 1) ? tm.k : tm.e; } tm.k = 0; tm.e = 0;
        { constexpr int FIRST = (16 * (DFF / 32) + NWAVES - 1) / NWAVES;
          if ((int)F.G > FIRST) { if ((int)blockIdx.x >= FIRST) convert_weights<1>(F, ((int)blockIdx.x - FIRST) * NWAVES + F.wave, ((int)F.G - FIRST) * NWAVES); }
          else convert_weights<1>(F, (int)blockIdx.x * NWAVES + F.wave, (int)F.G * NWAVES);
          __syncthreads(); }
        { const unsigned long long ts0_ = (PROBE_WHICH == 3) ? __builtin_amdgcn_s_memrealtime() : 0ull;
        { SEpiSwiglu SE{F.HB(), F.SSQ()}; small_gemm<DM, 1, SEpiSwiglu>(F, F.XB(), DM, F.WGU1(), DFF / 32, SE, (unsigned*)(F.ctl() + CW_DYN + 64 * 1)); }
          if (PROBE_WHICH == 3 && PROBE_PHASE == CURPH) { asm volatile("s_waitcnt vmcnt(0)" ::: "memory"); tsA = ts0_; tsB = __builtin_amdgcn_s_memrealtime(); } }
        { if (PROBE_WHICH == 8 && PROBE_PHASE == 1) tsB = __builtin_amdgcn_s_memrealtime(); if (PROBE_WHICH == 7 && PROBE_PHASE == 1) tsA = __builtin_amdgcn_s_memrealtime(); if (BOTH(1)) GRID_BAR(); if (PROBE_WHICH == 7 && PROBE_PHASE == 1) tsB = __builtin_amdgcn_s_memrealtime(); }
    }
#undef CURPH
#define CURPH 2
    STAMP(2);
    if (IN(2)) REP(2) {
        pg8::Gemm g{F.HB(), F.WD1(), MP, DM, DFF}; pg8::StaticOrder S; S.init(MP, DM, F.G, (int)blockIdx.x);
        pg8::EpiResid<1> E{nullptr, nullptr, F.XB(), F.SSQ(), 0.5f};
        pg8::gemm_phase<pg8::EpiResid<1>, pg8::StaticOrder, true, true>(F.lds + RING_OFF, g, S, E, F.wave, tm);
        if ((PROBE_WHICH == 1 || PROBE_WHICH == 2) && PROBE_PHASE == 2) { tsA = 0; tsB = (PROBE_WHICH == 1) ? tm.k : tm.e; } tm.k = 0; tm.e = 0;
        { const unsigned long long ts0_ = (PROBE_WHICH == 3) ? __builtin_amdgcn_s_memrealtime() : 0ull;
        { SEpiResid<1> SE{nullptr, nullptr, F.XB(), F.SSQ(), 0.5f}; small_gemm<DFF, 8, SEpiResid<1>>(F, F.HB(), DFF, F.WD1(), DM / 64, SE, (unsigned*)(F.ctl() + CW_DYN + 64 * 2)); }
          if (PROBE_WHICH == 3 && PROBE_PHASE == CURPH) { asm volatile("s_waitcnt vmcnt(0)" ::: "memory"); tsA = ts0_; tsB = __builtin_amdgcn_s_memrealtime(); } }
        { if (PROBE_WHICH == 8 && PROBE_PHASE == 2) tsB = __builtin_amdgcn_s_memrealtime(); if (PROBE_WHICH == 7 && PROBE_PHASE == 2) tsA = __builtin_amdgcn_s_memrealtime(); if (BOTH(2)) GRID_BAR(); if (PROBE_WHICH == 7 && PROBE_PHASE == 2) tsB = __builtin_amdgcn_s_memrealtime(); }
    }
#undef CURPH
#define CURPH 3
    STAMP(3);
    if (IN(3)) REP(3) {
        pg8::Gemm g{F.XB(), F.WINT(), MP, INW, DM}; pg8::StaticOrder S; S.init(MP, INW, F.G, (int)blockIdx.x);
        pg8::EpiScaleBf16 E{F.PROJ(), INW}; pg8::rs_cache_fill(F.lds + RING_OFF, S, F.SSQ(), F.wave);
        pg8::gemm_phase<pg8::EpiScaleBf16, pg8::StaticOrder, true, true>(F.lds + RING_OFF, g, S, E, F.wave, tm);
        if ((PROBE_WHICH == 1 || PROBE_WHICH == 2) && PROBE_PHASE == 3) { tsA = 0; tsB = (PROBE_WHICH == 1) ? tm.k : tm.e; } tm.k = 0; tm.e = 0;
        { const int NU = (MP / 256) * (INW / 256), light0 = NU % (int)F.G;
          if (light0 != 0) { if ((int)blockIdx.x >= light0) convert_weights<2>(F, ((int)blockIdx.x - light0) * NWAVES + F.wave, ((int)F.G - light0) * NWAVES); }
          else convert_weights<2>(F, (int)blockIdx.x * NWAVES + F.wave, (int)F.G * NWAVES);
          __syncthreads(); }
        { const unsigned long long ts0_ = (PROBE_WHICH == 3) ? __builtin_amdgcn_s_memrealtime() : 0ull;
        { SEpiScale SE{F.PROJ(), INW, F.SSQ()}; small_gemm<DM, 4, SEpiScale>(F, F.XB(), DM, F.WINT(), INW / 64, SE, (unsigned*)(F.ctl() + CW_DYN + 64 * 3)); }
          if (PROBE_WHICH == 3 && PROBE_PHASE == CURPH) { asm volatile("s_waitcnt vmcnt(0)" ::: "memory"); tsA = ts0_; tsB = __builtin_amdgcn_s_memrealtime(); } }
        { if (PROBE_WHICH == 8 && PROBE_PHASE == 3) tsB = __builtin_amdgcn_s_memrealtime(); if (PROBE_WHICH == 7 && PROBE_PHASE == 3) tsA = __builtin_amdgcn_s_memrealtime(); if (BOTH(3)) GRID_BAR(); if (PROBE_WHICH == 7 && PROBE_PHASE == 3) tsB = __builtin_amdgcn_s_memrealtime(); }
    }
#undef CURPH
#define CURPH 4
    STAMP(4);
    if (IN(4)) REP(4) {
#ifndef SKIP_ATTN
        if (PROBE_WHICH == 4 && PROBE_PHASE == 4) tsA = __builtin_amdgcn_s_memrealtime();
        REP(8) for (int it = blockIdx.x; it < BATCH * (SEQ / WIN); it += F.G) { unsigned long long tst[3] = {0, 0, 0}; attn_prompt_item(F, it, tst); if (PROBE_WHICH == 9 && PROBE_PHASE == 4) { tsA = tst[PROBE_BLOCK2]; tsB = tst[PROBE_BLOCK2 + 1]; } }
#endif
        if (PROBE_WHICH == 4 && PROBE_PHASE == 4) tsB = __builtin_amdgcn_s_memrealtime();
        if (PROBE_WHICH == 5 && PROBE_PHASE == 4) tsA = __builtin_amdgcn_s_memrealtime();
#ifndef SKIP_LRU1
        REP(9) for (int it = blockIdx.x; it < BATCH * NCHUNK; it += F.G) lru_prompt_item<1>(F, it);
#endif
#ifndef SKIP_SAMPLE
        __syncthreads();
        if (PROBE_WHICH == 5 && PROBE_PHASE == 4) tsB = __builtin_amdgcn_s_memrealtime();
        if (PROBE_WHICH == 6 && PROBE_PHASE == 4) tsA = __builtin_amdgcn_s_memrealtime();
        REP(10) for (int it = blockIdx.x; it < 3 * DEC_B; it += F.G) { if (it < DEC_B) sample_lru_item(F, it); else sample_attn_item(F, (it - DEC_B) >> 1, (it - DEC_B) & 1); }
#endif
        if (PROBE_WHICH == 6 && PROBE_PHASE == 4) tsB = __builtin_amdgcn_s_memrealtime();
        if (PROBE_WHICH == 7 && PROBE_PHASE == 4) tsA = __builtin_amdgcn_s_memrealtime();
        if (BOTH(4)) GRID_BAR();
        if (PROBE_WHICH == 7 && PROBE_PHASE == 4) tsB = __builtin_amdgcn_s_memrealtime();
    }
#undef CURPH
#define CURPH 5
    STAMP(5);
    if (IN(5)) REP(5) {
        sample_attn_norm(F);
#ifndef SKIP_LRU2
        for (int it = blockIdx.x; it < BATCH * NCHUNK; it += F.G) lru_prompt_item<2>(F, it);
#endif
        { if (PROBE_WHICH == 8 && PROBE_PHASE == 5) tsB = __builtin_amdgcn_s_memrealtime(); if (PROBE_WHICH == 7 && PROBE_PHASE == 5) tsA = __builtin_amdgcn_s_memrealtime(); if (BOTH(5)) GRID_BAR(); if (PROBE_WHICH == 7 && PROBE_PHASE == 5) tsB = __builtin_amdgcn_s_memrealtime(); }
    }
#undef CURPH
#define CURPH 6
    STAMP(6);
    if (IN(6)) {
        pg8::Gemm g{F.CAT(), F.WOUT(), MP, DM, DM}; pg8::StaticOrder S; S.init(MP, DM, F.G, (int)blockIdx.x);
        pg8::EpiResidMix E{F.XB(), F.SSQ()}; pg8::mix_cache_fill(F.lds + RING_OFF, S, F.SSQL(), F.SSQA(), F.wave);
        pg8::gemm_phase<pg8::EpiResidMix, pg8::StaticOrder, true, true>(F.lds + RING_OFF, g, S, E, F.wave, tm);
        if ((PROBE_WHICH == 1 || PROBE_WHICH == 2) && PROBE_PHASE == 6) { tsA = 0; tsB = (PROBE_WHICH == 1) ? tm.k : tm.e; } tm.k = 0; tm.e = 0;
        { const unsigned long long ts0_ = (PROBE_WHICH == 3) ? __builtin_amdgcn_s_memrealtime() : 0ull;
        { SEpiResid<1> SE{nullptr, nullptr, F.XB(), F.SSQ(), 1.0f}; small_gemm<DM, 8, SEpiResid<1>>(F, F.CAT(), DM, F.WOUT(), DM / 64, SE, (unsigned*)(F.ctl() + CW_DYN + 64 * 6)); }
          if (PROBE_WHICH == 3 && PROBE_PHASE == CURPH) { asm volatile("s_waitcnt vmcnt(0)" ::: "memory"); tsA = ts0_; tsB = __builtin_amdgcn_s_memrealtime(); } }
        { if (PROBE_WHICH == 8 && PROBE_PHASE == 6) tsB = __builtin_amdgcn_s_memrealtime(); if (PROBE_WHICH == 7 && PROBE_PHASE == 6) tsA = __builtin_amdgcn_s_memrealtime(); if (BOTH(6)) GRID_BAR(); if (PROBE_WHICH == 7 && PROBE_PHASE == 6) tsB = __builtin_amdgcn_s_memrealtime(); }
    }
#undef CURPH
#define CURPH 7
    STAMP(7);
    if (IN(7)) REP(7) {
        pg8::Gemm g{F.XB(), F.WGU2(), MP, 2 * DFF, DM}; pg8::StaticOrder S; S.init(MP, 2 * DFF, F.G, (int)blockIdx.x);
        pg8::EpiSwiglu E{F.HB(), DFF}; pg8::rs_cache_fill(F.lds + RING_OFF, S, F.SSQ(), F.wave);
        pg8::gemm_phase<pg8::EpiSwiglu, pg8::StaticOrder, true, true>(F.lds + RING_OFF, g, S, E, F.wave, tm);
        if ((PROBE_WHICH == 1 || PROBE_WHICH == 2) && PROBE_PHASE == 7) { tsA = 0; tsB = (PROBE_WHICH == 1) ? tm.k : tm.e; } tm.k = 0; tm.e = 0;
        { const unsigned long long ts0_ = (PROBE_WHICH == 3) ? __builtin_amdgcn_s_memrealtime() : 0ull;
        { SEpiSwiglu SE{F.HB(), F.SSQ()}; small_gemm<DM, 1, SEpiSwiglu>(F, F.XB(), DM, F.WGU2(), DFF / 32, SE, (unsigned*)(F.ctl() + CW_DYN + 64 * 7)); }
          if (PROBE_WHICH == 3 && PROBE_PHASE == CURPH) { asm volatile("s_waitcnt vmcnt(0)" ::: "memory"); tsA = ts0_; tsB = __builtin_amdgcn_s_memrealtime(); } }
        { if (PROBE_WHICH == 8 && PROBE_PHASE == 7) tsB = __builtin_amdgcn_s_memrealtime(); if (PROBE_WHICH == 7 && PROBE_PHASE == 7) tsA = __builtin_amdgcn_s_memrealtime(); if (BOTH(7)) GRID_BAR(); if (PROBE_WHICH == 7 && PROBE_PHASE == 7) tsB = __builtin_amdgcn_s_memrealtime(); }
    }
#undef CURPH
#define CURPH 8
    STAMP(8);
    if (IN(8)) {
        pg8::Gemm g{F.HB(), F.WD2(), MP, DM, DFF}; pg8::StaticOrder S; S.init(MP, DM, F.G, (int)blockIdx.x);
        pg8::EpiResid<2> E{nullptr, F.out, F.XB(), nullptr, 0.5f};
        pg8::gemm_phase<pg8::EpiResid<2>, pg8::StaticOrder, true, true>(F.lds + RING_OFF, g, S, E, F.wave, tm);
        if ((PROBE_WHICH == 1 || PROBE_WHICH == 2) && PROBE_PHASE == 8) { tsA = 0; tsB = (PROBE_WHICH == 1) ? tm.k : tm.e; } tm.k = 0; tm.e = 0;
        { const unsigned long long ts0_ = (PROBE_WHICH == 3) ? __builtin_amdgcn_s_memrealtime() : 0ull;
        { SEpiResid<2> SE{nullptr, F.out, F.XB(), nullptr, 0.5f}; small_gemm<DFF, 8, SEpiResid<2>>(F, F.HB(), DFF, F.WD2(), DM / 64, SE, (unsigned*)(F.ctl() + CW_DYN + 64 * 8)); }
          if (PROBE_WHICH == 3 && PROBE_PHASE == CURPH) { asm volatile("s_waitcnt vmcnt(0)" ::: "memory"); tsA = ts0_; tsB = __builtin_amdgcn_s_memrealtime(); } }
    }
    STAMP(9);
    if (PROBE_PHASE >= 0 && blockIdx.x == PROBE_BLOCK) { asm volatile("s_waitcnt vmcnt(0)" ::: "memory"); const unsigned long long te = __builtin_amdgcn_s_memrealtime(), d = 4 * (tsB - tsA); while (__builtin_amdgcn_s_memrealtime() - te < d) __builtin_amdgcn_s_sleep(8); }
#undef IN
#undef BOTH
}

extern "C" void kernel_launch(void* const* d_in, const int* in_sizes, int n_in, void* d_out, int out_size, void* d_ws, size_t ws_size, hipStream_t stream) {
    static int grid = 0;
    if (grid == 0) {
        if (n_in != 29 || in_sizes[0] != MP * DM || (size_t)out_size != O_END || ws_size < WS_END) { fprintf(stderr, "kernel_launch: unexpected shapes (n_in %d in0 %d out %d ws %zu); nothing launched\n", n_in, n_in > 0 ? in_sizes[0] : -1, out_size, ws_size); grid = -1; return; }
        int dev = 0, cus = 0, per_cu = 0;
        if (hipGetDevice(&dev) != hipSuccess || hipDeviceGetAttribute(&cus, hipDeviceAttributeMultiprocessorCount, dev) != hipSuccess) { fprintf(stderr, "kernel_launch: device query failed\n"); grid = -1; return; }
        if (hipFuncSetAttribute((const void*)hymba_fwd, hipFuncAttributeMaxDynamicSharedMemorySize, LDS_BYTES) != hipSuccess) { fprintf(stderr, "kernel_launch: hipFuncSetAttribute failed\n"); grid = -1; return; }
        if (hipOccupancyMaxActiveBlocksPerMultiprocessor(&per_cu, (const void*)hymba_fwd, NWAVES * 64, LDS_BYTES) != hipSuccess || per_cu < 1) { fprintf(stderr, "kernel_launch: occupancy query reports %d workgroups per CU\n", per_cu); per_cu = 1; }
        (void)hipGetLastError();
        grid = cus;
    }
    if (grid < 0) return;
    if (hipMemsetAsync((char*)d_ws + WS_CTL, 0, CTL_ZERO_BYTES, stream) != hipSuccess) { fprintf(stderr, "kernel_launch: memset failed\n"); return; }
    Args a{};
    for (int i = 0; i < 29; ++i) a.in[i] = (const float*)d_in[i];
    a.out = (float*)d_out; a.ws = (unsigned char*)d_ws;
    if (N_LAUNCHES == 1) {
        a.ph_lo = 0; a.ph_hi = N_PHASES; a.li = 0;
        hipLaunchKernelGGL(hymba_fwd, dim3(grid), dim3(NWAVES * 64), LDS_BYTES, stream, a);
    } else {
        for (int li = 0; li < N_PHASES; ++li) { a.ph_lo = li; a.ph_hi = li + 1; a.li = li; hipLaunchKernelGGL(hymba_fwd, dim3(grid), dim3(NWAVES * 64), LDS_BYTES, stream, a); }
    }
    const hipError_t le = hipPeekAtLastError();
    if (le != hipSuccess) fprintf(stderr, "kernel_launch: launch failed: %s\n", hipGetErrorName(le));
}
```

```cpp
#include <hip/hip_runtime.h>
#include <cstdio>
#include <cstdint>
#include <cmath>
namespace pg8 {
#define PG8_LAS __attribute__((address_space(3)))
typedef unsigned short bf16_t;
typedef short bf16x8 __attribute__((ext_vector_type(8)));
typedef float f32x4 __attribute__((ext_vector_type(4)));
typedef unsigned u32x4 __attribute__((ext_vector_type(4)));
constexpr int BM = 256, BK = 64, HALF = 128, HTB = HALF * BK * 2  , STAGE_BYTES = 8 * HTB, NXCD = 8, WGM = 8;

__host__ __device__ __forceinline__ int lds_byte(int r, int c) { const int st = (r >> 4) * 2 + (c >> 5), rr = r & 15, cc = c & 31, ob = rr * 64 + cc * 2; return st * 1024 + (ob ^ (((ob >> 9) & 1) << 5)); }
__host__ __device__ __forceinline__ void stage_rc(int b, int& R, int& C) { const int st = b / 1024, sb = b % 1024, swz = sb ^ (((sb >> 9) & 1) << 5); R = (st >> 1) * 16 + swz / 64; C = (st & 1) * 32 + (swz % 64) / 2; }
__host__ __device__ __forceinline__ int perm32(int rho) { const int n = rho >> 4, i = rho & 15; return 8 * (i >> 2) + 4 * n + (i & 3); }

struct Unit { int pm, pn; };
struct Gemm { const bf16_t* A; const bf16_t* Bt; int M, N, K; };

struct StaticOrder {
    int nM, nN, nwg, G, c, rev;
    __host__ __device__ void init(int M, int N, int G_, int c_, int rev_ = 0) { nM = M / BM; nN = N / BM; nwg = nM * nN; G = G_; c = c_; rev = (rev_ && nwg % G_ == 0) ? 1 : 0; }
    __host__ __device__ bool next(int i, Unit& u) const {
        if ((long)i * G + c >= nwg) return false;
        const long L = (long)(rev ? (nwg / G - 1 - i) : i) * G + c;
        int wgid = (int)L; { const int q = nwg / NXCD, r = nwg % NXCD, xcd = wgid % NXCD, off = wgid / NXCD; wgid = (xcd < r ? xcd * (q + 1) : r * (q + 1) + (xcd - r) * q) + off; }
        const int nig = WGM * nN, gid = wgid / nig, fm = gid * WGM, gsz = (nM - fm) < WGM ? (nM - fm) : WGM;
        u.pm = fm + ((wgid % nig) % gsz); u.pn = (wgid % nig) / gsz; return true;
    }
    __device__ __forceinline__ void a_ready(const Unit&) const {}
    __device__ __forceinline__ void done(const Unit&) const {}
};

__device__ __forceinline__ unsigned cvt_pk_bf16(float lo, float hi) { unsigned r; asm volatile("v_cvt_pk_bf16_f32 %0, %1, %2" : "=v"(r) : "v"(lo), "v"(hi)); return r; }
#ifndef PROBE_WHICH
#define PROBE_WHICH 0
#endif
constexpr bool TM_ON = PROBE_WHICH != 0;
struct Tm { unsigned long long k, e; };
__device__ __forceinline__ int pg8_lane_id() { int l; asm volatile("v_mbcnt_lo_u32_b32 %0, -1, 0\n\tv_mbcnt_hi_u32_b32 %0, -1, %0" : "=v"(l)); return l; }
typedef float f32x2 __attribute__((ext_vector_type(2)));
typedef unsigned u32x2 __attribute__((ext_vector_type(2)));
constexpr float RMS_EPS = 1e-6f;
__device__ __forceinline__ float row_rs(const float* ssq, int r) {
    const f32x4* p = (const f32x4*)(ssq + (size_t)r * 16);
    const f32x4 a = p[0], b = p[1], c = p[2], d = p[3];
    const float s = ((a[0] + a[1]) + (a[2] + a[3])) + ((b[0] + b[1]) + (b[2] + b[3])) + ((c[0] + c[1]) + (c[2] + c[3])) + ((d[0] + d[1]) + (d[2] + d[3]));
    return __builtin_amdgcn_rsqf(s * (1.0f / 1024.0f) + RMS_EPS);
}
__device__ __forceinline__ float silu_f(float g) { return g * __builtin_amdgcn_rcpf(1.0f + __builtin_amdgcn_exp2f(g * -1.4426950408889634f)); }

constexpr int RS_CACHE_OFF = STAGE_BYTES;
template <class Sched> __device__ __forceinline__ void rs_cache_fill(PG8_LAS unsigned char* lds, const Sched& S, const float* ssq, int wid) {
    PG8_LAS float* rsl = (PG8_LAS float*)(lds + RS_CACHE_OFF); Unit u; const int tid_ = wid * 64 + pg8_lane_id(), t = tid_ & 255, hf = tid_ >> 8;
    for (int i = hf; S.next(i, u); i += 2) rsl[i * 256 + t] = row_rs(ssq, u.pm * BM + t);
    __syncthreads();
}
struct EpiSwiglu {
    static constexpr bool PERM = true, AFTER_DRAIN = false, MID = false;
    bf16_t* H; int ldh;
    __device__ __forceinline__ void operator()(const f32x4 (&acc)[2][2][4][2], const Unit& u, int wr, int wc, int fr, int fq, int ui, PG8_LAS unsigned char* lds) const {
        const int row0 = u.pm * BM + wr * 64 + fr, col0 = u.pn * HALF + wc * 32 + 8 * fq;
        const PG8_LAS float* rsl = (const PG8_LAS float*)(lds + RS_CACHE_OFF) + ui * 256 + wr * 64 + fr;
#pragma unroll
        for (int ai = 0; ai < 2; ++ai)
#pragma unroll
            for (int m = 0; m < 4; ++m) {
                const int r = row0 + ai * HALF + m * 16; const float rs = rsl[ai * HALF + m * 16];
                const f32x2 c1 = {rs * -1.4426950408889634f, rs * -1.4426950408889634f}, w2 = {rs * rs, rs * rs}, one = {1.0f, 1.0f};
                float hv[8];
#pragma unroll
                for (int n = 0; n < 2; ++n)
#pragma unroll
                    for (int e2 = 0; e2 < 2; ++e2) { const f32x2 g = {acc[ai][0][m][n][2 * e2], acc[ai][0][m][n][2 * e2 + 1]}, u = {acc[ai][1][m][n][2 * e2], acc[ai][1][m][n][2 * e2 + 1]};
                        const f32x2 t = g * c1; f32x2 ex; ex.x = __builtin_amdgcn_exp2f(t.x); ex.y = __builtin_amdgcn_exp2f(t.y);
                        const f32x2 d = ex + one; f32x2 rc; rc.x = __builtin_amdgcn_rcpf(d.x); rc.y = __builtin_amdgcn_rcpf(d.y);
                        const f32x2 hh2 = (g * u) * (w2 * rc); hv[n * 4 + 2 * e2] = hh2.x; hv[n * 4 + 2 * e2 + 1] = hh2.y; }
                u32x4 w; w.x = cvt_pk_bf16(hv[0], hv[1]); w.y = cvt_pk_bf16(hv[2], hv[3]); w.z = cvt_pk_bf16(hv[4], hv[5]); w.w = cvt_pk_bf16(hv[6], hv[7]);
                *(u32x4*)(H + (size_t)r * ldh + col0) = w;
            }
    }
};
struct EpiScaleBf16 {
    static constexpr bool PERM = true, AFTER_DRAIN = false, MID = false;
    bf16_t* O; int ldc;
    __device__ __forceinline__ void operator()(const f32x4 (&acc)[2][2][4][2], const Unit& u, int wr, int wc, int fr, int fq, int ui, PG8_LAS unsigned char* lds) const {
        const int row0 = u.pm * BM + wr * 64 + fr, col0 = u.pn * BM + wc * 32 + 8 * fq;
        const PG8_LAS float* rsl = (const PG8_LAS float*)(lds + RS_CACHE_OFF) + ui * 256 + wr * 64 + fr;
#pragma unroll
        for (int ai = 0; ai < 2; ++ai)
#pragma unroll
            for (int m = 0; m < 4; ++m) {
                const int r = row0 + ai * HALF + m * 16; const float rs = rsl[ai * HALF + m * 16];
#pragma unroll
                for (int bj = 0; bj < 2; ++bj) {
                    const f32x4 v0 = acc[ai][bj][m][0] * rs, v1 = acc[ai][bj][m][1] * rs;
                    u32x4 w; w.x = cvt_pk_bf16(v0[0], v0[1]); w.y = cvt_pk_bf16(v0[2], v0[3]); w.z = cvt_pk_bf16(v1[0], v1[1]); w.w = cvt_pk_bf16(v1[2], v1[3]);
                    *(u32x4*)(O + (size_t)r * ldc + col0 + bj * HALF) = w;
                }
            }
    }
};
__device__ __forceinline__ f32x4 bf4_to_f32(u32x2 w) { f32x4 r; r[0] = __builtin_bit_cast(float, w.x << 16); r[1] = __builtin_bit_cast(float, w.x & 0xffff0000u); r[2] = __builtin_bit_cast(float, w.y << 16); r[3] = __builtin_bit_cast(float, w.y & 0xffff0000u); return r; }
template <int MODE> struct EpiResid {
    static constexpr bool PERM = true, AFTER_DRAIN = false, MID = false;
    const float* basef; float* out; bf16_t* xb; float* ssq; float scale;
    __device__ __forceinline__ void operator()(const f32x4 (&acc)[2][2][4][2], const Unit& u, int wr, int wc, int fr, int fq, int ui, PG8_LAS unsigned char* lds) const {
        const int row0 = u.pm * BM + wr * 64 + fr, col0 = u.pn * BM + wc * 32 + 8 * fq;
#pragma unroll
        for (int ai = 0; ai < 2; ++ai) {
            f32x4 pre[4][2][2];
#pragma unroll
            for (int m = 0; m < 4; ++m) { const size_t off = (size_t)(row0 + ai * HALF + m * 16) * 1024 + col0;
#pragma unroll
                for (int bj = 0; bj < 2; ++bj) {
                    if (MODE == 0) { pre[m][bj][0] = *(const f32x4*)(basef + off + bj * HALF); pre[m][bj][1] = *(const f32x4*)(basef + off + bj * HALF + 4); }
                    else { const u32x4 w = *(const u32x4*)(xb + off + bj * HALF); pre[m][bj][0] = bf4_to_f32((u32x2){w.x, w.y}); pre[m][bj][1] = bf4_to_f32((u32x2){w.z, w.w}); } } }
#pragma unroll
            for (int m = 0; m < 4; ++m) { const int r = row0 + ai * HALF + m * 16; const size_t off = (size_t)r * 1024 + col0; float s = 0.f;
#pragma unroll
                for (int bj = 0; bj < 2; ++bj) {
                    const f32x4 o0 = pre[m][bj][0] + acc[ai][bj][m][0] * scale, o1 = pre[m][bj][1] + acc[ai][bj][m][1] * scale;
                    if (MODE == 2) { *(f32x4*)(out + off + bj * HALF) = o0; *(f32x4*)(out + off + bj * HALF + 4) = o1; }
                    else { s += ((o0[0] * o0[0] + o0[1] * o0[1]) + (o0[2] * o0[2] + o0[3] * o0[3])) + ((o1[0] * o1[0] + o1[1] * o1[1]) + (o1[2] * o1[2] + o1[3] * o1[3]));
                        u32x4 w; w.x = cvt_pk_bf16(o0[0], o0[1]); w.y = cvt_pk_bf16(o0[2], o0[3]); w.z = cvt_pk_bf16(o1[0], o1[1]); w.w = cvt_pk_bf16(o1[2], o1[3]); *(u32x4*)(xb + off + bj * HALF) = w; }
                }
                if (MODE != 2) { s += __shfl_xor(s, 16); s += __shfl_xor(s, 32); if (fq == 0) ssq[(size_t)r * 16 + u.pn * 4 + wc] = s; }
            }
        }
    }
};
template <class Sched> __device__ __forceinline__ void mix_cache_fill(PG8_LAS unsigned char* lds, const Sched& S, const float* ssql, const float* ssqa, int wid) {
    PG8_LAS f32x2* c2 = (PG8_LAS f32x2*)(lds + RS_CACHE_OFF); Unit u; const int tid_ = wid * 64 + pg8_lane_id(), t = tid_ & 255, hf = tid_ >> 8;
    for (int i = hf; S.next(i, u); i += 2) { const size_t r = (size_t)u.pm * BM + t;
        const f32x4* pl = (const f32x4*)(ssql + r * 8); const f32x4* pa = (const f32x4*)(ssqa + r * 8); const f32x4 l0 = pl[0], l1 = pl[1], a0 = pa[0], a1 = pa[1];
        const float rl = __builtin_amdgcn_rsqf((((l0[0] + l0[1]) + (l0[2] + l0[3])) + ((l1[0] + l1[1]) + (l1[2] + l1[3]))) * (1.0f / 512.0f) + RMS_EPS);
        const float ra = __builtin_amdgcn_rsqf((((a0[0] + a0[1]) + (a0[2] + a0[3])) + ((a1[0] + a1[1]) + (a1[2] + a1[3]))) * (1.0f / 512.0f) + RMS_EPS);
        c2[i * 256 + t] = (f32x2){rl * __builtin_amdgcn_rcpf(ra), ra}; }
    __syncthreads();
}
struct EpiResidMix {
    static constexpr bool PERM = true, AFTER_DRAIN = false, MID = true;
    bf16_t* xb; float* ssq;
    __device__ __forceinline__ void mid(f32x4 (&acc)[2][2][4][2], int wr, int fr, int ui, PG8_LAS unsigned char* lds) const {
        const PG8_LAS f32x2* c2 = (const PG8_LAS f32x2*)(lds + RS_CACHE_OFF) + ui * 256 + wr * 64 + fr;
#pragma unroll
        for (int ai = 0; ai < 2; ++ai)
#pragma unroll
            for (int m = 0; m < 4; ++m) { const float q = c2[ai * HALF + m * 16].x;
#pragma unroll
                for (int bj = 0; bj < 2; ++bj)
#pragma unroll
                    for (int n = 0; n < 2; ++n) acc[ai][bj][m][n] *= q; }
    }
    __device__ __forceinline__ void operator()(const f32x4 (&acc)[2][2][4][2], const Unit& u, int wr, int wc, int fr, int fq, int ui, PG8_LAS unsigned char* lds) const {
        const int row0 = u.pm * BM + wr * 64 + fr, col0 = u.pn * BM + wc * 32 + 8 * fq;
        const PG8_LAS f32x2* c2 = (const PG8_LAS f32x2*)(lds + RS_CACHE_OFF) + ui * 256 + wr * 64 + fr;
#pragma unroll
        for (int ai = 0; ai < 2; ++ai) {
            u32x4 pre[4][2];
#pragma unroll
            for (int m = 0; m < 4; ++m) { const size_t off = (size_t)(row0 + ai * HALF + m * 16) * 1024 + col0;
#pragma unroll
                for (int bj = 0; bj < 2; ++bj) pre[m][bj] = *(const u32x4*)(xb + off + bj * HALF); }
#pragma unroll
            for (int m = 0; m < 4; ++m) { const int r = row0 + ai * HALF + m * 16; const size_t off = (size_t)r * 1024 + col0; float s = 0.f; const float ra = c2[ai * HALF + m * 16].y;
#pragma unroll
                for (int bj = 0; bj < 2; ++bj) {
                    const f32x4 o0 = bf4_to_f32((u32x2){pre[m][bj].x, pre[m][bj].y}) + acc[ai][bj][m][0] * ra, o1 = bf4_to_f32((u32x2){pre[m][bj].z, pre[m][bj].w}) + acc[ai][bj][m][1] * ra;
                    s += ((o0[0] * o0[0] + o0[1] * o0[1]) + (o0[2] * o0[2] + o0[3] * o0[3])) + ((o1[0] * o1[0] + o1[1] * o1[1]) + (o1[2] * o1[2] + o1[3] * o1[3]));
                    u32x4 w; w.x = cvt_pk_bf16(o0[0], o0[1]); w.y = cvt_pk_bf16(o0[2], o0[3]); w.z = cvt_pk_bf16(o1[0], o1[1]); w.w = cvt_pk_bf16(o1[2], o1[3]); *(u32x4*)(xb + off + bj * HALF) = w;
                }
                s += __shfl_xor(s, 16); s += __shfl_xor(s, 32); if (fq == 0) ssq[(size_t)r * 16 + u.pn * 4 + wc] = s;
            }
        }
    }
};
template <class Epi, class Sched, bool ALIGN_EPI = false, bool SP2 = false>
__device__ __forceinline__ void gemm_phase(PG8_LAS unsigned char* lds, const Gemm g, const Sched& S, const Epi& E, int wid_in, Tm& tm) {
    const int wid = wid_in, lane = pg8_lane_id(), tid = wid * 64 + lane, wr = wid >> 2, wc = wid & 3, fr = lane & 15, fq = lane >> 4;
    const int K = g.K, nt = K / BK;
    unsigned voffA[2], voffB[2];
#pragma unroll
    for (int i = 0; i < 2; ++i) { int R, C; stage_rc(tid * 16 + i * 8192, R, C); const int Rb = Epi::PERM ? ((R & ~31) + perm32(R & 31)) : R;
        voffA[i] = (unsigned)(R * K + C) * 2u; voffB[i] = (unsigned)(Rb * K + C) * 2u; }
    const size_t kstep = (size_t)(BK * 2);
    const size_t hstep = (size_t)HALF * K * 2;
    const size_t tstep = 2 * hstep;
    const unsigned ldsw = (unsigned)wid * 1024u;
    const int aoff = lds_byte(wr * 64 + fr, fq * 8), boff = lds_byte(wc * 32 + fr, fq * 8);
#define PG8_SA(b, h) (((b) * 2 + (h)) * HTB)
#define PG8_SB(b, h) ((4 + (b) * 2 + (h)) * HTB)
#define PG8_STAGE(bufoff, gbase, voff) do { _Pragma("unroll") for (int _i = 0; _i < 2; ++_i) \
        __builtin_amdgcn_global_load_lds((const unsigned*)((const char*)(gbase) + (voff)[_i]), (PG8_LAS unsigned*)(lds + (bufoff) + ldsw + _i * 8192), 16, 0, 0); } while (0)
#define PG8_LDA(dst, b, h) do { _Pragma("unroll") for (int m = 0; m < 4; ++m) _Pragma("unroll") for (int k = 0; k < 2; ++k) dst[m][k] = *(const PG8_LAS bf16x8*)(lds + PG8_SA(b, h) + aoff + m * 2048 + k * 1024); } while (0)
#define PG8_LDB(dst, b, h) do { _Pragma("unroll") for (int n = 0; n < 2; ++n) _Pragma("unroll") for (int k = 0; k < 2; ++k) dst[n][k] = *(const PG8_LAS bf16x8*)(lds + PG8_SB(b, h) + boff + n * 2048 + k * 1024); } while (0)
#define PG8_MMA(ai, bj, At, Bt) do { __builtin_amdgcn_s_setprio(1); _Pragma("unroll") for (int m = 0; m < 4; ++m) _Pragma("unroll") for (int n = 0; n < 2; ++n) _Pragma("unroll") for (int k = 0; k < 2; ++k) \
        acc[ai][bj][m][n] = __builtin_amdgcn_mfma_f32_16x16x32_bf16(Bt[n][k], At[m][k], acc[ai][bj][m][n], 0, 0, 0); __builtin_amdgcn_s_setprio(0); } while (0)
#define PG8_WAIT_V(n) asm volatile("s_waitcnt vmcnt(" #n ")" ::: "memory")
#define PG8_WAIT_L(n) asm volatile("s_waitcnt lgkmcnt(" #n ")" ::: "memory")
#define PG8_BAR __builtin_amdgcn_s_barrier()
#define PG8_SCHED __builtin_amdgcn_sched_barrier(0)
    Unit cur, nxt; int ui = 0;
    if (!S.next(0, cur)) return;
    f32x4 acc[2][2][4][2];
#pragma unroll
    for (int a = 0; a < 2; ++a)
#pragma unroll
        for (int b = 0; b < 2; ++b)
#pragma unroll
            for (int m = 0; m < 4; ++m)
#pragma unroll
                for (int n = 0; n < 2; ++n) acc[a][b][m][n] = (f32x4){0.f, 0.f, 0.f, 0.f};
    bf16x8 At[4][2], B0[2][2], B1[2][2];
    const char* cA = (const char*)g.A + (size_t)cur.pm * tstep; const char* cB = (const char*)g.Bt + (size_t)cur.pn * tstep;
    S.a_ready(cur);
    if constexpr (SP2) {
        PG8_STAGE(PG8_SB(0, 0), cB, voffB); PG8_STAGE(PG8_SB(0, 1), cB + hstep, voffB); PG8_STAGE(PG8_SA(0, 0), cA, voffA); PG8_STAGE(PG8_SA(0, 1), cA + hstep, voffA);
        if (wr == 1) PG8_BAR;
        PG8_WAIT_V(2); PG8_BAR;
        PG8_STAGE(PG8_SB(1, 0), cB + kstep, voffB); PG8_STAGE(PG8_SA(1, 0), cA + kstep, voffA); PG8_STAGE(PG8_SB(1, 1), cB + hstep + kstep, voffB);
        PG8_WAIT_V(6); PG8_BAR;
    } else {
        PG8_STAGE(PG8_SB(0, 0), cB, voffB); PG8_STAGE(PG8_SA(0, 0), cA, voffA); PG8_STAGE(PG8_SB(0, 1), cB + hstep, voffB); PG8_STAGE(PG8_SA(0, 1), cA + hstep, voffA);
        if (wr == 1) PG8_BAR;
        PG8_WAIT_V(4); PG8_BAR;
        PG8_STAGE(PG8_SB(1, 0), cB + kstep, voffB); PG8_STAGE(PG8_SA(1, 0), cA + kstep, voffA); PG8_STAGE(PG8_SB(1, 1), cB + hstep + kstep, voffB);
        PG8_WAIT_V(6); PG8_BAR;
    }
    for (;;) {
        const bool has_next = S.next(ui + 1, nxt);
        const unsigned long long tm_a = TM_ON ? __builtin_amdgcn_s_memrealtime() : 0ull;
        const char* nA = has_next ? (const char*)g.A + (size_t)nxt.pm * tstep : cA; const char* nB = has_next ? (const char*)g.Bt + (size_t)nxt.pn * tstep : cB;
        for (int t = 0; t < nt; t += 2) {
            if constexpr (Epi::MID) { if (t == nt / 2) E.mid(acc, wr, fr, ui, lds); }
            const bool last = (t == nt - 2);
            const char* a1 = cA + (size_t)(t + 1) * kstep;
            const char* a2 = last ? nA : cA + (size_t)(t + 2) * kstep; const char* b2 = last ? nB : cB + (size_t)(t + 2) * kstep;
            const char* a3 = a2 + kstep; const char* b3 = b2 + kstep;
            if (last && has_next) S.a_ready(nxt);
            if constexpr (SP2) {
            PG8_LDB(B0, 0, 0); PG8_LDB(B1, 0, 1); PG8_SCHED; PG8_LDA(At, 0, 0); PG8_STAGE(PG8_SA(1, 1), a1 + hstep, voffA);
            PG8_WAIT_V(8); PG8_WAIT_L(0); PG8_BAR; PG8_MMA(0, 0, At, B0); PG8_MMA(0, 1, At, B1); PG8_BAR; PG8_SCHED;
            PG8_LDA(At, 0, 1); PG8_STAGE(PG8_SB(0, 0), b2, voffB); PG8_STAGE(PG8_SB(0, 1), b2 + hstep, voffB); PG8_STAGE(PG8_SA(0, 0), a2, voffA);
            PG8_WAIT_V(8); PG8_WAIT_L(0); PG8_BAR; PG8_MMA(1, 0, At, B0); PG8_MMA(1, 1, At, B1); PG8_BAR; PG8_SCHED;
            PG8_LDB(B0, 1, 0); PG8_LDB(B1, 1, 1); PG8_SCHED; PG8_LDA(At, 1, 0); PG8_STAGE(PG8_SA(0, 1), a2 + hstep, voffA);
            PG8_WAIT_V(8); PG8_WAIT_L(0); PG8_BAR; PG8_MMA(0, 0, At, B0); PG8_MMA(0, 1, At, B1); PG8_BAR; PG8_SCHED;
            PG8_LDA(At, 1, 1); PG8_STAGE(PG8_SB(1, 0), b3, voffB); PG8_STAGE(PG8_SB(1, 1), b3 + hstep, voffB); PG8_STAGE(PG8_SA(1, 0), a3, voffA);
            PG8_WAIT_V(8); PG8_WAIT_L(0); PG8_BAR; PG8_MMA(1, 0, At, B0); PG8_MMA(1, 1, At, B1); PG8_BAR; PG8_SCHED;
            } else {
            PG8_LDB(B0, 0, 0); PG8_SCHED; PG8_LDA(At, 0, 0); PG8_STAGE(PG8_SA(1, 1), a1 + hstep, voffA);
            PG8_WAIT_L(8); PG8_BAR; PG8_WAIT_L(0); PG8_MMA(0, 0, At, B0); PG8_BAR; PG8_SCHED;
            PG8_LDB(B1, 0, 1); PG8_STAGE(PG8_SB(0, 0), b2, voffB);
            PG8_BAR; PG8_WAIT_L(0); PG8_MMA(0, 1, At, B1); PG8_BAR;
            PG8_LDA(At, 0, 1); PG8_STAGE(PG8_SA(0, 0), a2, voffA);
            PG8_BAR; PG8_WAIT_L(0); PG8_MMA(1, 0, At, B0); PG8_BAR; PG8_SCHED;
            PG8_STAGE(PG8_SB(0, 1), b2 + hstep, voffB);
            PG8_WAIT_V(6); PG8_BAR; PG8_MMA(1, 1, At, B1); PG8_BAR;
            PG8_LDB(B0, 1, 0); PG8_SCHED; PG8_LDA(At, 1, 0); PG8_STAGE(PG8_SA(0, 1), a2 + hstep, voffA);
            PG8_WAIT_L(8); PG8_BAR; PG8_WAIT_L(0); PG8_MMA(0, 0, At, B0); PG8_BAR; PG8_SCHED;
            PG8_LDB(B1, 1, 1); PG8_STAGE(PG8_SB(1, 0), b3, voffB);
            PG8_BAR; PG8_WAIT_L(0); PG8_MMA(0, 1, At, B1); PG8_BAR;
            PG8_LDA(At, 1, 1); PG8_STAGE(PG8_SA(1, 0), a3, voffA);
            PG8_BAR; PG8_WAIT_L(0); PG8_MMA(1, 0, At, B0); PG8_BAR; PG8_SCHED;
            PG8_STAGE(PG8_SB(1, 1), b3 + hstep, voffB);
            PG8_WAIT_V(6); PG8_BAR; PG8_MMA(1, 1, At, B1); PG8_BAR;
            }
        }
        const unsigned long long tm_b = TM_ON ? __builtin_amdgcn_s_memrealtime() : 0ull;
        if constexpr (ALIGN_EPI) { if (wr == 0) PG8_BAR; }
        if constexpr (!Epi::AFTER_DRAIN) { E(acc, cur, wr, wc, fr, fq, ui, lds); S.done(cur); }
        if (TM_ON) { const unsigned long long tm_c = __builtin_amdgcn_s_memrealtime(); tm.k += tm_b - tm_a; tm.e += tm_c - tm_b; }
        if (!has_next) break;
#pragma unroll
        for (int a = 0; a < 2; ++a)
#pragma unroll
            for (int b = 0; b < 2; ++b)
#pragma unroll
                for (int m = 0; m < 4; ++m)
#pragma unroll
                    for (int n = 0; n < 2; ++n) acc[a][b][m][n] = (f32x4){0.f, 0.f, 0.f, 0.f};
        cur = nxt; cA = nA; cB = nB; ++ui;
        if constexpr (ALIGN_EPI) { if (wr == 1) PG8_BAR; }
    }
    PG8_WAIT_V(0);
    if constexpr (!ALIGN_EPI) { if (wr == 0) PG8_BAR; }
    PG8_BAR;
    if constexpr (Epi::AFTER_DRAIN) { E.fused(acc, cur, wr, wc, fr, fq, lds, wid, lane); S.done(cur); }
#undef PG8_SA
#undef PG8_SB
#undef PG8_STAGE
#undef PG8_LDA
#undef PG8_LDB
#undef PG8_MMA
#undef PG8_WAIT_V
#undef PG8_WAIT_L
#undef PG8_BAR
#undef PG8_SCHED
}
}

constexpr int NWAVES = 8;
constexpr int DM = 1024, BATCH = 4, SEQ = 8192, MP = BATCH * SEQ, DEC_B = 128, DEC_T = 4, MS = DEC_B * DEC_T, MT = MP + MS;
constexpr int LRU_W = 512, NH = 8, NKV = 2, HD = 64, DFF = 2816, INW = 1792, WIN = 128, PAST = 16384;
constexpr int C_XL = 0, C_GATE = 512, C_Q = 1024, C_K = 1536, C_V = 1664;
constexpr int NCHUNK = 64, CHUNK = SEQ / NCHUNK;
constexpr float EPS = 1e-6f, LOG2E = 1.4426950408889634f;
constexpr size_t O_YP = 0, O_YS = 33554432, O_PH = 34078720, O_PC = 34080768, O_PK = 34086912, O_PV = 34152448, O_SH = 34217984, O_SC = 34283520, O_SK = 34480128, O_SV = 36577280, O_END = 38674432;
constexpr size_t MiB = 1u << 20;
constexpr size_t WS_CTL = 0, CTL_ZERO_BYTES = 64 * 1024;
constexpr size_t WS_WGU1 = 2 * MiB, WS_WD1 = 13 * MiB, WS_WIN = 19 * MiB, WS_WOUT = 23 * MiB, WS_WGU2 = 25 * MiB, WS_WD2 = 36 * MiB;
constexpr size_t WS_ROPE = 42 * MiB;
constexpr size_t WS_SSQ = 45 * MiB;
constexpr size_t WS_LSUM = 48 * MiB;
constexpr size_t WS_WFRAG = 49 * MiB;
constexpr size_t WS_XB = 50 * MiB;
constexpr size_t WS_CAT = 115 * MiB;
constexpr size_t WS_PROJ = 180 * MiB;
constexpr size_t WS_H = 294 * MiB;
constexpr size_t WS_SSQL = 474 * MiB, WS_SSQA = 475 * MiB;
constexpr size_t WS_SOA = 476 * MiB, WS_SSQS = 477 * MiB;
constexpr size_t WS_END = 478 * MiB;
constexpr int ROPE_ROWS = SEQ + DEC_T;
constexpr int CW_TMO = 0, CW_BAR = 4096, CW_DYN = 8192;
constexpr int RING_OFF = 0, RING_BYTES = 131072;
constexpr int SCR_BYTES = 147456;
constexpr int LDSCTL_OFF = SCR_BYTES, MISC_OFF = LDSCTL_OFF + 64;
constexpr int LDS_BYTES = SCR_BYTES + 512;

#define GAS __attribute__((address_space(1)))
#define LAS __attribute__((address_space(3)))
typedef unsigned short bf16;
typedef unsigned v4u __attribute__((ext_vector_type(4)));
typedef unsigned v2u __attribute__((ext_vector_type(2)));
typedef float f32x4 __attribute__((ext_vector_type(4)));
typedef float f32x16 __attribute__((ext_vector_type(16)));
typedef short bf16x8 __attribute__((ext_vector_type(8)));
typedef GAS unsigned gu32;
#define RLX_AGENT __ATOMIC_RELAXED, __HIP_MEMORY_SCOPE_AGENT
__device__ __forceinline__ int lane_id() { int l; asm volatile("v_mbcnt_lo_u32_b32 %0, -1, 0\n\tv_mbcnt_hi_u32_b32 %0, -1, %0" : "=v"(l)); return l; }
#define LDS_WAIT() asm volatile("s_waitcnt lgkmcnt(0)" ::: "memory")
#define VM_WAIT() asm volatile("s_waitcnt vmcnt(0)" ::: "memory")
__device__ __forceinline__ unsigned f2bf(float f) { unsigned u = __builtin_bit_cast(unsigned, f); return (u + 0x7fffu + ((u >> 16) & 1u)) >> 16; }
__device__ __forceinline__ unsigned pk2(float lo, float hi) { return f2bf(lo) | (f2bf(hi) << 16); }
__device__ __forceinline__ float bflo(unsigned w) { return __builtin_bit_cast(float, w << 16); }
__device__ __forceinline__ float bfhi(unsigned w) { return __builtin_bit_cast(float, w & 0xffff0000u); }
__device__ __forceinline__ float bf1(bf16 v) { return __builtin_bit_cast(float, (unsigned)v << 16); }
typedef float f32x2_t __attribute__((ext_vector_type(2))); typedef __bf16 bf16x2_t __attribute__((ext_vector_type(2)));
__device__ __forceinline__ unsigned cvtpk(float lo, float hi) { f32x2_t v = {lo, hi}; bf16x2_t b = __builtin_convertvector(v, bf16x2_t); return __builtin_bit_cast(unsigned, b); }
__device__ __forceinline__ float wave_sum(float v) {
#pragma unroll
    for (int o = 1; o < 64; o <<= 1) v += __shfl_xor(v, o);
    return v;
}
__device__ __forceinline__ float wave_max(float v) {
#pragma unroll
    for (int o = 1; o < 64; o <<= 1) v = fmaxf(v, __shfl_xor(v, o));
    return v;
}
__device__ __forceinline__ float sigmoid_f(float x) { return __builtin_amdgcn_rcpf(1.0f + __builtin_amdgcn_exp2f(-x * LOG2E)); }
__device__ __forceinline__ float gelu_tanh(float x) {
    const float z = x * (x * x * (2.0f * 0.7978845608028654f * 0.044715f * -LOG2E) + (2.0f * 0.7978845608028654f * -LOG2E));
    return x * __builtin_amdgcn_rcpf(1.0f + __builtin_amdgcn_exp2f(z));
}
__device__ __forceinline__ float one_minus_exp(float t) {
    const float ser = -t * (1.0f + t * (0.5f + t * (0.16666667f + t * (0.041666668f + t * 0.0083333338f))));
    const float dir = 1.0f - __builtin_amdgcn_exp2f(t * LOG2E);
    return t > -0.25f ? ser : dir;
}
__device__ __forceinline__ float dot2bf(unsigned a, unsigned b, float c) { return __builtin_amdgcn_fdot2_f32_bf16(__builtin_bit_cast(bf16x2_t, a), __builtin_bit_cast(bf16x2_t, b), c, false); }
#define XB_TMO      128
#define XB_XCNT(j)  (256  + 64 * (j))
#define XB_XSUB(j)  (1280 + 64 * (j))
#define XB_XGEN(j)  (2304 + 64 * (j))
#define XB_TOP      3328
#define XB_TOPGEN   3392
#define XCD_BAR_WORDS 3456
#define XB_SPIN_CAP (1u << 18)

__device__ __forceinline__ unsigned xb_ld(unsigned* p)              { return __hip_atomic_load(p, __ATOMIC_RELAXED, __HIP_MEMORY_SCOPE_AGENT); }
__device__ __forceinline__ unsigned xb_add(unsigned* p, unsigned v) { return __hip_atomic_fetch_add(p, v, __ATOMIC_RELAXED, __HIP_MEMORY_SCOPE_AGENT); }
__device__ __forceinline__ unsigned xb_xcc_id() { return (unsigned)__builtin_amdgcn_s_getreg((3 << 11) | 20) & 0xFu; }
#define XB_SPIN(cond, bar) do { unsigned _sp = 0; while (cond) { __builtin_amdgcn_s_sleep(1); \
    if ((++_sp & 255u) == 0u) { if (xb_ld(&(bar)[XB_TMO])) break; if (_sp > XB_SPIN_CAP) { atomicAdd(&(bar)[XB_TMO], 1u); break; } } } } while (0)

struct XcdBarrier {
    unsigned* bar; unsigned x;
    volatile LAS unsigned* st;
};

__device__ __forceinline__ XcdBarrier xcd_barrier_post(unsigned* bar, volatile LAS unsigned* st, bool leader) {
    XcdBarrier b; b.bar = bar; b.x = xb_xcc_id(); b.st = st;
    if (leader) (void)xb_add(&bar[XB_XCNT(b.x)], 1u);
    return b;
}
__device__ __forceinline__ void xcd_barrier_complete(unsigned* bar, unsigned x, unsigned& nloc, unsigned& nx) {
    const unsigned G = gridDim.x * gridDim.y * gridDim.z;
    unsigned sum, cnt, mine, sp = 0u;
    for (;;) {
        sum = 0u; cnt = 0u; mine = 0u;
#pragma unroll
        for (unsigned j = 0; j < 16; ++j) { const unsigned c = xb_ld(&bar[XB_XCNT(j)]); sum += c; cnt += (c > 0u) ? 1u : 0u; mine = (j == x) ? c : mine; }
        if (sum == G) break;
        __builtin_amdgcn_s_sleep(1);
        if ((++sp & 255u) == 0u) { if (xb_ld(&bar[XB_TMO])) break; if (sp > XB_SPIN_CAP) { atomicAdd(&bar[XB_TMO], 1u); break; } }
    }
    nloc = mine > 0u ? mine : 1u; nx = cnt > 0u ? cnt : 1u;
}

__device__ __forceinline__ void xcd_barrier(const XcdBarrier& b, bool leader) {
    asm volatile("s_waitcnt vmcnt(0)" ::: "memory");
    __syncthreads();
    if (leader) {
        unsigned* bar = b.bar;
        __builtin_amdgcn_s_waitcnt(0);
        unsigned nloc = b.st[0], nx = b.st[1];
        if (nloc == 0u) { xcd_barrier_complete(bar, b.x, nloc, nx); b.st[0] = nloc; b.st[1] = nx; }
        const unsigned old = xb_add(&bar[XB_XSUB(b.x)], 1u);
        const unsigned gen = old / nloc;
        if (old + 1u == (gen + 1u) * nloc) {
            __builtin_amdgcn_fence(__ATOMIC_RELEASE, "agent");
            asm volatile("s_waitcnt vmcnt(0)" ::: "memory");
            const unsigned og = xb_add(&bar[XB_TOP], 1u);
            const unsigned tg = og / nx;
            if (og + 1u == (tg + 1u) * nx) xb_add(&bar[XB_TOPGEN], 1u);
            else XB_SPIN(xb_ld(&bar[XB_TOPGEN]) == tg, bar);
            __builtin_amdgcn_fence(__ATOMIC_ACQUIRE, "agent");
            xb_add(&bar[XB_XGEN(b.x)], 1u);
            asm volatile("s_waitcnt vmcnt(0)" ::: "memory");
        } else {
            XB_SPIN(xb_ld(&bar[XB_XGEN(b.x)]) == gen, bar);
            __builtin_amdgcn_fence(__ATOMIC_ACQUIRE, "agent");
            asm volatile("s_waitcnt vmcnt(0)" ::: "memory");
        }
    }
    __syncthreads();
}

typedef const void __attribute__((address_space(4)))* kernarg_ptr;
struct Frame {
    LAS unsigned char* lds;
    volatile LAS unsigned* MISC;
    int wave;
    __device__ __forceinline__ int lane() const { return lane_id(); }
    __device__ __forceinline__ int tid() const { return wave * 64 + lane_id(); }
    int vcu, G;
    kernarg_ptr kp;
    float* out; unsigned char* ws;
    __device__ __forceinline__ const float* inp(int i) const { kernarg_ptr k = kp; asm volatile("" : "+s"(k)); return ((const float* const __attribute__((address_space(4)))*)k)[i]; }
    __device__ __forceinline__ gu32* ctl() const { return (gu32*)(ws + WS_CTL); }
    __device__ __forceinline__ bf16* WGU1() const { return (bf16*)(ws + WS_WGU1); }
    __device__ __forceinline__ bf16* WD1() const { return (bf16*)(ws + WS_WD1); }
    __device__ __forceinline__ bf16* WINT() const { return (bf16*)(ws + WS_WIN); }
    __device__ __forceinline__ bf16* WOUT() const { return (bf16*)(ws + WS_WOUT); }
    __device__ __forceinline__ bf16* WGU2() const { return (bf16*)(ws + WS_WGU2); }
    __device__ __forceinline__ bf16* WD2() const { return (bf16*)(ws + WS_WD2); }
    __device__ __forceinline__ float* ROPEC() const { return (float*)(ws + WS_ROPE); }
    __device__ __forceinline__ float* ROPES() const { return (float*)(ws + WS_ROPE) + ROPE_ROWS * 32; }
    __device__ __forceinline__ float* SSQ() const { return (float*)(ws + WS_SSQ); }
    __device__ __forceinline__ float* LSUM() const { return (float*)(ws + WS_LSUM); }
    __device__ __forceinline__ float* SSQL() const { return (float*)(ws + WS_SSQL); }
    __device__ __forceinline__ float* SSQA() const { return (float*)(ws + WS_SSQA); }
    __device__ __forceinline__ float* SOA() const { return (float*)(ws + WS_SOA); }
    __device__ __forceinline__ float* SSQS() const { return (float*)(ws + WS_SSQS); }
    __device__ __forceinline__ bf16* WFRAG() const { return (bf16*)(ws + WS_WFRAG); }
    __device__ __forceinline__ bf16* XB() const { return (bf16*)(ws + WS_XB); }
    __device__ __forceinline__ bf16* CAT() const { return (bf16*)(ws + WS_CAT); }
    __device__ __forceinline__ bf16* PROJ() const { return (bf16*)(ws + WS_PROJ); }
    __device__ __forceinline__ bf16* HB() const { return (bf16*)(ws + WS_H); }
};
enum { I_XP = 0, I_XS, I_SH, I_SC, I_CK, I_CV, I_F1N, I_F1G, I_F1U, I_F1D, I_MN, I_WIN, I_CW, I_CB, I_WA, I_BA, I_WX, I_BX, I_LAM, I_QN, I_KN, I_SINK, I_LON, I_AON, I_WOUT, I_F2N, I_F2G, I_F2U, I_F2D };

template <int MODE> __device__ __forceinline__ void p0_transpose_item(const float* W, const float* gain, int K, int N, bf16* WT, LAS float* scr, int item, int lane) {
    const int nblk = N / 32, kb = item / nblk, nb = item % nblk, k0 = 64 * kb, n0 = 32 * nb;
    f32x4 tv[8];
#pragma unroll
    for (int i = 0; i < 8; ++i) { const int kk = 8 * i + (lane >> 3); tv[i] = __builtin_nontemporal_load((const f32x4*)(W + (size_t)(k0 + kk) * N + n0 + 4 * (lane & 7))); }
#pragma unroll
    for (int i = 0; i < 8; ++i) { const int kk = 8 * i + (lane >> 3); f32x4 v = tv[i]; if (gain) v *= gain[k0 + kk];
        LAS float* d = scr + kk * 33 + 4 * (lane & 7); d[0] = v[0]; d[1] = v[1]; d[2] = v[2]; d[3] = v[3]; }
    LDS_WAIT(); asm volatile("" ::: "memory");
    const int c = lane & 7;
    const int rb = (MODE == 0) ? n0 : ((n0 >> 7) * 256 + (MODE - 1) * 128 + (n0 & 127));
#pragma unroll
    for (int j = 0; j < 4; ++j) { const int n = (lane >> 3) + 8 * j; const LAS float* s = scr + (8 * c) * 33 + n;
        v4u o; o.x = pk2(s[0 * 33], s[1 * 33]); o.y = pk2(s[2 * 33], s[3 * 33]); o.z = pk2(s[4 * 33], s[5 * 33]); o.w = pk2(s[6 * 33], s[7 * 33]);
        *(GAS v4u*)(WT + (size_t)(rb + n) * K + k0 + 8 * c) = o; }
    LDS_WAIT(); asm volatile("" ::: "memory");
}
template <int NR> __device__ __forceinline__ void p0_rows(Frame& F, int m, int step, int lane) {
    f32x4 v[NR][4]; bool ok[NR];
#pragma unroll
    for (int q = 0; q < NR; ++q) { const int r = m + q * step; ok[q] = r < MT; const int rr = ok[q] ? r : m;
        const GAS f32x4* xr = (const GAS f32x4*)((rr < MP) ? F.inp(I_XP) + (size_t)rr * DM : F.inp(I_XS) + (size_t)(rr - MP) * DM) + lane;
#pragma unroll
        for (int j = 0; j < 4; ++j) v[q][j] = __builtin_nontemporal_load(xr + 64 * j); }
#pragma unroll
    for (int q = 0; q < NR; ++q) { const int r = m + q * step; float s = 0.f;
#pragma unroll
        for (int j = 0; j < 4; ++j) s += (v[q][j].x * v[q][j].x + v[q][j].y * v[q][j].y) + (v[q][j].z * v[q][j].z + v[q][j].w * v[q][j].w);
        s = wave_sum(s);
        if (ok[q]) { GAS unsigned long long* o8 = (GAS unsigned long long*)(F.XB() + (size_t)r * DM) + lane;
#pragma unroll
            for (int j = 0; j < 4; ++j) o8[64 * j] = (unsigned long long)pk2(v[q][j].x, v[q][j].y) | ((unsigned long long)pk2(v[q][j].z, v[q][j].w) << 32);
            if (lane < 16) F.SSQ()[(size_t)r * 16 + lane] = (lane == 0) ? s : 0.f; } }
}
template <int SET> __device__ __forceinline__ void convert_weights(Frame& F, int slot, int nslots) {
    LAS float* scr = (LAS float*)(F.lds + RING_OFF + F.wave * 16384);
    constexpr int I_GU = (DM / 64) * (DFF / 32), I_D = (DFF / 64) * (DM / 32), I_IN = (DM / 64) * (INW / 32), I_OUT = (DM / 64) * (DM / 32);
    constexpr int NITEMS = SET == 0 ? 2 * I_GU + I_IN : SET == 1 ? I_D : I_OUT + 2 * I_GU + I_D;
    const int ln = F.lane();
    for (int it = slot; it < NITEMS; it += nslots) {
        int r = it;
        if (SET == 0) {
            if (r < I_GU) { p0_transpose_item<1>(F.inp(I_F1G), F.inp(I_F1N), DM, DFF, F.WGU1(), scr, r, ln); continue; } r -= I_GU;
            if (r < I_GU) { p0_transpose_item<2>(F.inp(I_F1U), F.inp(I_F1N), DM, DFF, F.WGU1(), scr, r, ln); continue; } r -= I_GU;
            p0_transpose_item<0>(F.inp(I_WIN), F.inp(I_MN), DM, INW, F.WINT(), scr, r, ln);
        } else if (SET == 1) {
            p0_transpose_item<0>(F.inp(I_F1D), nullptr, DFF, DM, F.WD1(), scr, r, ln);
        } else {
            if (r < I_OUT) { const int k0 = 64 * (r / (DM / 32));
                p0_transpose_item<0>(F.inp(I_WOUT), k0 < 512 ? F.inp(I_LON) : F.inp(I_AON) - 512, DM, DM, F.WOUT(), scr, r, ln); continue; } r -= I_OUT;
            if (r < I_GU) { p0_transpose_item<1>(F.inp(I_F2G), F.inp(I_F2N), DM, DFF, F.WGU2(), scr, r, ln); continue; } r -= I_GU;
            if (r < I_GU) { p0_transpose_item<2>(F.inp(I_F2U), F.inp(I_F2N), DM, DFF, F.WGU2(), scr, r, ln); continue; } r -= I_GU;
            p0_transpose_item<0>(F.inp(I_F2D), nullptr, DFF, DM, F.WD2(), scr, r, ln);
        }
    }
}
__device__ __forceinline__ void p0_prologue(Frame& F) {
    const int gw = F.vcu * NWAVES + F.wave, NGW = F.G * NWAVES;
    convert_weights<0>(F, gw, NGW);
    { const int ln = F.lane(); for (int m = gw; m < MP; m += 4 * NGW) p0_rows<4>(F, m, NGW, ln);
      for (int m = MP + gw; m < MT; m += NGW) p0_rows<1>(F, m, NGW, ln); }
    for (int e = F.vcu * (NWAVES * 64) + F.tid(); e < 8 * 2 * 2 * 4 * 64; e += F.G * NWAVES * 64) {
        const int ln = e & 63, ks = (e >> 6) & 3, ct = (e >> 8) & 1, gate = (e >> 9) & 1, blk = e >> 10, ql = ln & 31, hh = ln >> 5;
        const float* pw = (gate ? F.inp(I_WX) : F.inp(I_WA)) + (size_t)(blk * 64 + 16 * ks + 8 * hh) * 64 + 32 * ct + ql;
        v4u o; o.x = pk2(pw[0], pw[64]); o.y = pk2(pw[128], pw[192]); o.z = pk2(pw[256], pw[320]); o.w = pk2(pw[384], pw[448]);
        *(v4u*)(F.WFRAG() + (size_t)e * 8) = o;
    }
    const int gt = F.vcu * (NWAVES * 64) + F.tid(), NGT = F.G * NWAVES * 64;
    for (int e = gt; e < ROPE_ROWS * 32; e += NGT) {
        const int pi = e >> 5, i = e & 31; const int pos = pi < SEQ ? pi : PAST + (pi - SEQ);
        const float invf = (float)exp(-(double)i * (9.210340371976184 / 32.0));
        const float ang = (float)pos * invf; const double a = (double)ang;
        F.ROPEC()[e] = (float)cos(a); F.ROPES()[e] = (float)sin(a);
    }
}

constexpr int LW_XRAW = 0, LW_XCS = 35 * 128, LW_GS = LW_XCS + 32 * 144, LW_OUT = LW_GS + 32 * 128, LW_BYTES = LW_OUT + 32 * 128;
static_assert(8 * LW_BYTES <= SCR_BYTES, "lru LDS");
#define LWAIT() asm volatile("s_waitcnt lgkmcnt(0)" ::: "memory")
template <int PASS> __device__ __forceinline__ void lru_prompt_item(Frame& F, int item) {
    int lane_ = F.lane(); asm volatile("" : "+v"(lane_));
    const int lane0 = lane_, w = F.wave;
    const int b = item / NCHUNK, chunk = item % NCHUNK, t0 = chunk * CHUNK;
    LAS unsigned char* wl = F.lds + w * LW_BYTES;
    float ba[2], bx[2], c8[2];
    { const int ql = lane0 & 31;
#pragma unroll
    for (int ct = 0; ct < 2; ++ct) { const int c = 64 * w + 32 * ct + ql; ba[ct] = F.inp(I_BA)[c]; bx[ct] = F.inp(I_BX)[c];
        const float lam = F.inp(I_LAM)[c]; c8[ct] = -8.0f * LOG2E * (fmaxf(-lam, 0.f) + log1pf(expf(-fabsf(lam)))); } }
    float hst[2] = {0.f, 0.f}, Pst[2] = {1.f, 1.f};
    if (PASS == 2) {
        const float* ls = F.LSUM() + ((size_t)b * NCHUNK * 512 + 64 * w + (lane0 & 31)) * 2; float h0 = 0.f, h1 = 0.f;
#pragma unroll 32
        for (int j = 0; j < chunk; ++j) { const f32x2_t p0 = *(const f32x2_t*)(ls + (size_t)j * 1024), p1 = *(const f32x2_t*)(ls + (size_t)j * 1024 + 64); h0 = p0.x * h0 + p0.y; h1 = p1.x * h1 + p1.y; }
        hst[0] = h0; hst[1] = h1;
    }
    v4u xv[5], gv[4];
    for (int sub = 0; sub < CHUNK / 32; ++sub) {
        const int ts = t0 + sub * 32;
        int lq_ = lane0; asm volatile("" : "+v"(lq_));
        const int lane = lq_, ql = lane & 31, hh = lane >> 5;
        LAS unsigned char* xraw = wl + LW_XRAW; LAS unsigned char* xcs = wl + LW_XCS; LAS unsigned char* gs = wl + LW_GS; LAS unsigned char* outs = wl + LW_OUT;
        const bf16* wfr = F.WFRAG() + (size_t)w * (2 * 2 * 4 * 64 * 8) + lane * 8;
        const bf16* pbase = F.PROJ() + (size_t)(b * SEQ) * INW + 64 * w;
#define LRU_FETCH(tsx) do { _Pragma("unroll") for (int i = 0; i < 5; ++i) { const int idx = lane + 64 * i, row = idx >> 3, ch = idx & 7, t = (tsx) - 3 + row; xv[i] = (v4u){0u, 0u, 0u, 0u}; \
                if (row < 35 && t >= 0) xv[i] = *(const v4u*)(pbase + (size_t)t * INW + C_XL + 8 * ch); } \
            if (PASS == 2) { _Pragma("unroll") for (int i = 0; i < 4; ++i) { const int idx = lane + 64 * i, row = idx >> 3, ch = idx & 7; gv[i] = *(const v4u*)(pbase + (size_t)((tsx) + row) * INW + C_GATE + 8 * ch); } } } while (0)
#ifndef LRU_PREFETCH
#define LRU_PREFETCH 0
#endif
        if (sub == 0 || !LRU_PREFETCH) LRU_FETCH(ts);
        {
#pragma unroll
            for (int i = 0; i < 5; ++i) { const int idx = lane + 64 * i, row = idx >> 3, ch = idx & 7; if (row < 35) *(LAS v4u*)(xraw + row * 128 + 16 * ch) = xv[i]; }
            if (PASS == 2) {
#pragma unroll
                for (int i = 0; i < 4; ++i) { const int idx = lane + 64 * i, row = idx >> 3, ch = idx & 7; *(LAS v4u*)(gs + row * 128 + 16 * ch) = gv[i]; }
            }
        }
        LWAIT();
        {
            const int cch = 64 * w + lane;
            const LAS bf16* xr = (const LAS bf16*)xraw + lane; LAS bf16* xo = (LAS bf16*)xcs + lane;
            const float* cwp = F.inp(I_CW) + cch; const float cw0 = cwp[0], cw1 = cwp[512], cw2 = cwp[1024], cw3 = cwp[1536], cb = F.inp(I_CB)[cch];
            float xm3 = bf1(xr[0]), xm2 = bf1(xr[64]), xm1 = bf1(xr[128]);
#pragma unroll 8
            for (int tt = 0; tt < 32; ++tt) { const float x = bf1(xr[(tt + 3) * 64]);
                xo[tt * 72] = (bf16)f2bf(cb + cw0 * xm3 + cw1 * xm2 + cw2 * xm1 + cw3 * x); xm3 = xm2; xm2 = xm1; xm1 = x; }
            if (PASS == 2 && chunk == NCHUNK - 1 && sub == CHUNK / 32 - 1) {
                F.out[O_PC + (b * 3 + 0) * 512 + cch] = xm3; F.out[O_PC + (b * 3 + 1) * 512 + cch] = xm2; F.out[O_PC + (b * 3 + 2) * 512 + cch] = xm1; }
        }
        LWAIT();
        if (LRU_PREFETCH && sub + 1 < CHUNK / 32) LRU_FETCH(ts + 32);
        bf16x8 af[4];
#pragma unroll
        for (int ks = 0; ks < 4; ++ks) af[ks] = *(const LAS bf16x8*)(xcs + ql * 144 + (16 * ks + 8 * hh) * 2);
        float ssv[16];
#pragma unroll
        for (int r = 0; r < 16; ++r) ssv[r] = 0.f;
#pragma unroll
        for (int ct = 0; ct < 2; ++ct) {
            f32x16 ra = {0.f, 0.f, 0.f, 0.f, 0.f, 0.f, 0.f, 0.f, 0.f, 0.f, 0.f, 0.f, 0.f, 0.f, 0.f, 0.f}, rx = ra;
            {   bf16x8 wa4[4], wx4[4];
#pragma unroll
                for (int ks = 0; ks < 4; ++ks) { wa4[ks] = *(const bf16x8*)(wfr + (size_t)((0 * 2 + ct) * 4 + ks) * 512); wx4[ks] = *(const bf16x8*)(wfr + (size_t)((1 * 2 + ct) * 4 + ks) * 512); }
#pragma unroll
                for (int ks = 0; ks < 4; ++ks) { ra = __builtin_amdgcn_mfma_f32_32x32x16_bf16(af[ks], wa4[ks], ra, 0, 0, 0); rx = __builtin_amdgcn_mfma_f32_32x32x16_bf16(af[ks], wx4[ks], rx, 0, 0, 0); } }
            const int cl = 32 * ct + ql;
            float av[16], uv[16];
            {
                const f32x2_t nl = {-LOG2E, -LOG2E}, bal = {ba[ct] * -LOG2E, ba[ct] * -LOG2E}, bxl = {bx[ct] * -LOG2E, bx[ct] * -LOG2E}, c8v = {c8[ct], c8[ct]}, one = {1.0f, 1.0f}, zero = {0.f, 0.f};
#pragma unroll
                for (int r = 0; r < 16; r += 2) { const int tk = (r & 3) + 8 * (r >> 2) + 4 * hh;
                    const f32x2_t ra2 = {ra[r], ra[r + 1]}, rx2 = {rx[r], rx[r + 1]};
                    const f32x2_t ta = ra2 * nl + bal, tx = rx2 * nl + bxl;
                    f32x2_t ea, ex; ea.x = __builtin_amdgcn_exp2f(ta.x); ea.y = __builtin_amdgcn_exp2f(ta.y); ex.x = __builtin_amdgcn_exp2f(tx.x); ex.y = __builtin_amdgcn_exp2f(tx.y);
                    const f32x2_t da = ea + one, dx = ex + one;
                    f32x2_t rg, ig; rg.x = __builtin_amdgcn_rcpf(da.x); rg.y = __builtin_amdgcn_rcpf(da.y); ig.x = __builtin_amdgcn_rcpf(dx.x); ig.y = __builtin_amdgcn_rcpf(dx.y);
                    const f32x2_t la = c8v * rg; f32x2_t a2; a2.x = __builtin_amdgcn_exp2f(la.x); a2.y = __builtin_amdgcn_exp2f(la.y);
                    f32x2_t om = one - a2 * a2; om = __builtin_elementwise_max(om, zero);
                    f32x2_t mu; mu.x = __builtin_amdgcn_sqrtf(om.x); mu.y = __builtin_amdgcn_sqrtf(om.y);
                    const f32x2_t xc2 = {bf1(*((const LAS bf16*)(xcs + tk * 144) + cl)), bf1(*((const LAS bf16*)(xcs + (tk + 1) * 144) + cl))};
                    const f32x2_t u2 = (mu * ig) * xc2;
                    av[r] = a2.x; av[r + 1] = a2.y; uv[r] = u2.x; uv[r + 1] = u2.y; }
            }
            float Ag[4], Ug[4], Ap[4], Up[4], st[4];
#pragma unroll
            for (int g = 0; g < 4; ++g) { Ag[g] = (av[4 * g] * av[4 * g + 1]) * (av[4 * g + 2] * av[4 * g + 3]);
                Ug[g] = ((uv[4 * g] * av[4 * g + 1] + uv[4 * g + 1]) * av[4 * g + 2] + uv[4 * g + 2]) * av[4 * g + 3] + uv[4 * g + 3];
                Ap[g] = __shfl_xor(Ag[g], 32); Up[g] = __shfl_xor(Ug[g], 32); }
            float carry = hst[ct], pp = Pst[ct];
#pragma unroll
            for (int g = 0; g < 4; ++g) { const float Alo = hh ? Ap[g] : Ag[g], Ulo = hh ? Up[g] : Ug[g], Ahi = hh ? Ag[g] : Ap[g], Uhi = hh ? Ug[g] : Up[g];
                const float s_lo = carry; carry = Alo * carry + Ulo; const float s_hi = carry; carry = Ahi * carry + Uhi; st[g] = hh ? s_hi : s_lo; pp *= Alo * Ahi; }
            hst[ct] = carry; Pst[ct] = pp;
            if (PASS == 2) {
#pragma unroll
                for (int g = 0; g < 4; ++g) { float hc = st[g];
#pragma unroll
                    for (int e = 0; e < 4; ++e) { const int r = 4 * g + e, tk = e + 8 * g + 4 * hh; hc = av[r] * hc + uv[r];
                        const float o = hc * gelu_tanh(bf1(*((const LAS bf16*)(gs + tk * 128) + cl)));
                        ssv[r] += o * o; *((LAS bf16*)(outs + tk * 128) + cl) = (bf16)f2bf(o); } }
            }
        }
        if (PASS == 2) {
            float* sq = F.SSQL() + (size_t)(b * SEQ + ts) * 8 + w;
#pragma unroll
            for (int r = 0; r < 16; ++r) { float v = ssv[r];
                v += __shfl_xor(v, 1); v += __shfl_xor(v, 2); v += __shfl_xor(v, 4); v += __shfl_xor(v, 8); v += __shfl_xor(v, 16);
                if (ql == 0) sq[((r & 3) + 8 * (r >> 2) + 4 * hh) * 8] = v; }
            LWAIT();
            bf16* cbase = F.CAT() + (size_t)(b * SEQ + ts) * DM + 64 * w;
#pragma unroll
            for (int i = 0; i < 4; ++i) { const int idx = lane + 64 * i, row = idx >> 3, ch = idx & 7; *(v4u*)(cbase + (size_t)row * DM + 8 * ch) = *(const LAS v4u*)(outs + row * 128 + 16 * ch); }
            LWAIT();
        }
    }
    if ((lane0 & 32) == 0) {
#pragma unroll
        for (int ct = 0; ct < 2; ++ct) { const int c = 64 * w + 32 * ct + (lane0 & 31);
            if (PASS == 1) *(f32x2_t*)(F.LSUM() + (((size_t)b * NCHUNK + chunk) * 512 + c) * 2) = (f32x2_t){Pst[ct], hst[ct]};
            if (PASS == 2 && chunk == NCHUNK - 1) F.out[O_PH + b * 512 + c] = hst[ct]; }
    }
}

constexpr int KS_STRIDE = 144, KS_KVH = 256 * KS_STRIDE;
constexpr int VT_STRIDE = 528, VT_KVH = 64 * VT_STRIDE;
constexpr int AT_KS = 0, AT_VT = 2 * KS_KVH, AT_END = AT_VT + 2 * VT_KVH;
static_assert(AT_END <= SCR_BYTES, "attention LDS");
__device__ __forceinline__ int vt_pos(int key) { const int o = key & 15; return (key & ~15) + 8 * ((o >> 2) & 1) + (o & 3) + 4 * (o >> 3); }
#define ATT_STAMP(k) do { if (PROBE_WHICH == 9) tst[k] = __builtin_amdgcn_s_memrealtime(); } while (0)
__device__ __forceinline__ void attn_prompt_item(Frame& F, int item, unsigned long long* tst) {
    const int b = item / (SEQ / WIN), blk = item % (SEQ / WIN);
    int tid_ = F.tid(); asm volatile("" : "+v"(tid_));
    const int tid = tid_, lane = tid & 63, w = F.wave;
    LAS unsigned char* Ks = F.lds + AT_KS; LAS unsigned char* Vt = F.lds + AT_VT;
    ATT_STAMP(0);
    {
        const bool lastb = (blk == SEQ / WIN - 1);
        const float* kn = F.inp(I_KN);
        v4u kr[8];
#pragma unroll
        for (int i = 0; i < 8; ++i) { const int idx = tid + 512 * i, key = idx >> 4, cc = idx & 15, tb = blk * WIN - WIN + key;
            kr[i] = (v4u){0u, 0u, 0u, 0u}; if (tb >= 0) kr[i] = *(const v4u*)(F.PROJ() + (size_t)(b * SEQ + tb) * INW + C_K + 8 * cc); }
#pragma unroll
        for (int i = 0; i < 8; ++i) { const int idx = tid + 512 * i, key = idx >> 4, cc = idx & 15, kvh = cc >> 3, c = cc & 7, tb = blk * WIN - WIN + key, tbc = tb < 0 ? 0 : tb;
            float x[8] = {bflo(kr[i].x), bfhi(kr[i].x), bflo(kr[i].y), bfhi(kr[i].y), bflo(kr[i].z), bfhi(kr[i].z), bflo(kr[i].w), bfhi(kr[i].w)};
            float ss = 0.f;
#pragma unroll
            for (int j = 0; j < 8; ++j) ss += x[j] * x[j];
            ss += __shfl_xor(ss, 1); ss += __shfl_xor(ss, 2); ss += __shfl_xor(ss, 4);
            const float rs = __builtin_amdgcn_rsqf(ss * (1.0f / 64.0f) + EPS);
            const f32x4 g0 = *(const f32x4*)(kn + 8 * c), g1 = *(const f32x4*)(kn + 8 * c + 4);
            const f32x4 c0 = *(const f32x4*)(F.ROPEC() + (size_t)tbc * 32 + 8 * (c & 3)), c1 = *(const f32x4*)(F.ROPEC() + (size_t)tbc * 32 + 8 * (c & 3) + 4);
            const f32x4 s0 = *(const f32x4*)(F.ROPES() + (size_t)tbc * 32 + 8 * (c & 3)), s1 = *(const f32x4*)(F.ROPES() + (size_t)tbc * 32 + 8 * (c & 3) + 4);
            float o[8];
#pragma unroll
            for (int j = 0; j < 8; ++j) { const float xn = x[j] * rs * (j < 4 ? g0[j] : g1[j - 4]); const float other = __shfl_xor(xn, 4);
                const float cc2 = j < 4 ? c0[j] : c1[j - 4], sv = j < 4 ? s0[j] : s1[j - 4];
                o[j] = (c < 4) ? (xn * cc2 - other * sv) : (xn * cc2 + other * sv); }
            v4u w4; w4.x = cvtpk(o[0], o[1]); w4.y = cvtpk(o[2], o[3]); w4.z = cvtpk(o[4], o[5]); w4.w = cvtpk(o[6], o[7]);
            *(LAS v4u*)(Ks + kvh * KS_KVH + key * KS_STRIDE + 16 * c) = w4;
            if (lastb && key >= WIN) { float* ok = F.out + O_PK + ((size_t)(b * WIN + key - WIN) * NKV + kvh) * HD + 8 * c;
                *(f32x4*)(ok) = (f32x4){o[0], o[1], o[2], o[3]}; *(f32x4*)(ok + 4) = (f32x4){o[4], o[5], o[6], o[7]}; }
        }
        asm volatile("" ::: "memory");
        v4u vr[8];
#pragma unroll
        for (int i = 0; i < 8; ++i) { const int idx = tid + 512 * i, key = idx >> 4, cc = idx & 15, tb = blk * WIN - WIN + key;
            vr[i] = (v4u){0u, 0u, 0u, 0u}; if (tb >= 0) vr[i] = *(const v4u*)(F.PROJ() + (size_t)(b * SEQ + tb) * INW + C_V + 8 * cc); }
#pragma unroll
        for (int i = 0; i < 8; ++i) { const int idx = tid + 512 * i, key = idx >> 4, cc = idx & 15, kvh = cc >> 3, c = cc & 7;
            LAS bf16* vcol = (LAS bf16*)(Vt + kvh * VT_KVH) + (8 * c) * (VT_STRIDE / 2) + vt_pos(key);
            const unsigned q4[4] = {vr[i].x, vr[i].y, vr[i].z, vr[i].w};
#pragma unroll
            for (int e = 0; e < 4; ++e) { vcol[(2 * e) * (VT_STRIDE / 2)] = (bf16)(q4[e] & 0xffffu); vcol[(2 * e + 1) * (VT_STRIDE / 2)] = (bf16)(q4[e] >> 16); }
            if (lastb && key >= WIN) { float* ov = F.out + O_PV + ((size_t)(b * WIN + key - WIN) * NKV + kvh) * HD + 8 * c;
                *(f32x4*)(ov) = (f32x4){bflo(vr[i].x), bfhi(vr[i].x), bflo(vr[i].y), bfhi(vr[i].y)}; *(f32x4*)(ov + 4) = (f32x4){bflo(vr[i].z), bfhi(vr[i].z), bflo(vr[i].w), bfhi(vr[i].w)}; }
        }
    }
    __syncthreads();
    ATT_STAMP(1);
    const int hh = lane >> 5, ql = lane & 31, kvh = w >> 2;
    const float sinkl2 = F.inp(I_SINK)[w] * LOG2E;
    const float QS = 0.125f * LOG2E;
    const float* qn = F.inp(I_QN);
    v4u qraw[4]; f32x4 csv[2][2], snv[2][2];
#define ATT_FETCHQ(sx) do { const int t_ = blk * WIN + 32 * (sx) + ql; const bf16* qp_ = F.PROJ() + ((size_t)b * SEQ + t_) * INW + C_Q + w * 64 + 8 * hh; \
        _Pragma("unroll") for (int ds = 0; ds < 4; ++ds) qraw[ds] = *(const v4u*)(qp_ + 16 * ds); \
        _Pragma("unroll") for (int ds = 0; ds < 2; ++ds) { const float* c_ = F.ROPEC() + (size_t)t_ * 32 + 16 * ds + 8 * hh; const float* s_ = F.ROPES() + (size_t)t_ * 32 + 16 * ds + 8 * hh; \
            csv[ds][0] = *(const f32x4*)c_; csv[ds][1] = *(const f32x4*)(c_ + 4); snv[ds][0] = *(const f32x4*)s_; snv[ds][1] = *(const f32x4*)(s_ + 4); } } while (0)
#ifndef ATT_PREFETCH
#define ATT_PREFETCH 0
#endif
    if (ATT_PREFETCH) ATT_FETCHQ(0);
    for (int s = 0; s < 4; ++s) {
        const int qi = 32 * s + ql, t = blk * WIN + qi; const size_t row = (size_t)b * SEQ + t;
        if (!ATT_PREFETCH) ATT_FETCHQ(s);
        bf16x8 qf[4];
        {
            float qv[4][8]; float ss = 0.f;
#pragma unroll
            for (int ds = 0; ds < 4; ++ds) { const v4u r4 = qraw[ds];
                qv[ds][0] = bflo(r4.x); qv[ds][1] = bfhi(r4.x); qv[ds][2] = bflo(r4.y); qv[ds][3] = bfhi(r4.y); qv[ds][4] = bflo(r4.z); qv[ds][5] = bfhi(r4.z); qv[ds][6] = bflo(r4.w); qv[ds][7] = bfhi(r4.w); }
#pragma unroll
            for (int ds = 0; ds < 4; ++ds)
#pragma unroll
                for (int j = 0; j < 8; ++j) ss += qv[ds][j] * qv[ds][j];
            ss += __shfl_xor(ss, 32);
            const float rs = __builtin_amdgcn_rsqf(ss * (1.0f / 64.0f) + EPS);
#pragma unroll
            for (int ds = 0; ds < 2; ++ds)
#pragma unroll
                for (int j = 0; j < 8; ++j) { const int i = 16 * ds + 8 * hh + j; const float x1 = qv[ds][j] * rs * qn[i], x2 = qv[ds + 2][j] * rs * qn[i + 32], cc = csv[ds][j >> 2][j & 3], sv = snv[ds][j >> 2][j & 3];
                    qv[ds][j] = (x1 * cc - x2 * sv) * QS; qv[ds + 2][j] = (x2 * cc + x1 * sv) * QS; }
#pragma unroll
            for (int ds = 0; ds < 4; ++ds) { v4u o; o.x = cvtpk(qv[ds][0], qv[ds][1]); o.y = cvtpk(qv[ds][2], qv[ds][3]); o.z = cvtpk(qv[ds][4], qv[ds][5]); o.w = cvtpk(qv[ds][6], qv[ds][7]); qf[ds] = __builtin_bit_cast(bf16x8, o); }
        }
        if (ATT_PREFETCH && s + 1 < 4) ATT_FETCHQ(s + 1);
        f32x16 p[5];
#pragma unroll
        for (int kt = 0; kt < 5; ++kt) {
            const LAS unsigned char* kp = Ks + kvh * KS_KVH + (32 * (s + kt) + ql) * KS_STRIDE + 16 * hh;
            f32x16 acc = {0.f, 0.f, 0.f, 0.f, 0.f, 0.f, 0.f, 0.f, 0.f, 0.f, 0.f, 0.f, 0.f, 0.f, 0.f, 0.f};
#pragma unroll
            for (int ds = 0; ds < 4; ++ds) { const bf16x8 kfr = *(const LAS bf16x8*)(kp + 32 * ds); acc = __builtin_amdgcn_mfma_f32_32x32x16_bf16(kfr, qf[ds], acc, 0, 0, 0); }
            p[kt] = acc;
        }
        float mx = -INFINITY;
#pragma unroll
        for (int kt = 0; kt < 5; ++kt) {
            if (kt == 0 || kt == 4 || blk == 0) {
#pragma unroll
                for (int r = 0; r < 16; ++r) { const int kj = 32 * (s + kt) + (r & 3) + 8 * (r >> 2) + 4 * hh;
                    const bool valid = (kj > qi) && (kj <= qi + WIN) && (blk > 0 || kj >= WIN);
                    const float v = valid ? p[kt][r] : -INFINITY; p[kt][r] = v; mx = fmaxf(mx, v); }
            } else {
#pragma unroll
                for (int r = 0; r < 16; ++r) mx = fmaxf(mx, p[kt][r]);
            }
        }
        mx = fmaxf(mx, __shfl_xor(mx, 32)); mx = fmaxf(mx, sinkl2);
        float sum = 0.f;
#pragma unroll
        for (int kt = 0; kt < 5; ++kt)
#pragma unroll
            for (int r = 0; r < 16; ++r) { const float e = __builtin_amdgcn_exp2f(p[kt][r] - mx); p[kt][r] = e; sum += e; }
        sum += __shfl_xor(sum, 32);
        const float inv = __builtin_amdgcn_rcpf(sum + __builtin_amdgcn_exp2f(sinkl2 - mx));
        f32x16 o0 = {0.f, 0.f, 0.f, 0.f, 0.f, 0.f, 0.f, 0.f, 0.f, 0.f, 0.f, 0.f, 0.f, 0.f, 0.f, 0.f}, o1 = o0;
#pragma unroll
        for (int kt = 0; kt < 5; ++kt)
#pragma unroll
            for (int ss2 = 0; ss2 < 2; ++ss2) {
                v4u pw; pw.x = cvtpk(p[kt][8 * ss2 + 0], p[kt][8 * ss2 + 1]); pw.y = cvtpk(p[kt][8 * ss2 + 2], p[kt][8 * ss2 + 3]); pw.z = cvtpk(p[kt][8 * ss2 + 4], p[kt][8 * ss2 + 5]); pw.w = cvtpk(p[kt][8 * ss2 + 6], p[kt][8 * ss2 + 7]);
                const bf16x8 pf = __builtin_bit_cast(bf16x8, pw);
                const LAS unsigned char* vp = Vt + kvh * VT_KVH + ql * VT_STRIDE + (16 * (2 * (s + kt) + ss2) + 8 * hh) * 2;
                const bf16x8 v0 = *(const LAS bf16x8*)(vp), v1 = *(const LAS bf16x8*)(vp + 32 * VT_STRIDE);
                o0 = __builtin_amdgcn_mfma_f32_32x32x16_bf16(v0, pf, o0, 0, 0, 0);
                o1 = __builtin_amdgcn_mfma_f32_32x32x16_bf16(v1, pf, o1, 0, 0, 0);
            }
        float hsq = 0.f;
#pragma unroll
        for (int r = 0; r < 16; ++r) { o0[r] *= inv; o1[r] *= inv; hsq += o0[r] * o0[r] + o1[r] * o1[r]; }
        hsq += __shfl_xor(hsq, 32);
        if (hh == 0) F.SSQA()[row * 8 + w] = hsq;
        bf16* crow = F.CAT() + row * DM + 512 + w * 64;
#pragma unroll
        for (int g = 0; g < 4; ++g) { const int d0 = 8 * g + 4 * hh;
            v2u a, c2; a.x = cvtpk(o0[4 * g], o0[4 * g + 1]); a.y = cvtpk(o0[4 * g + 2], o0[4 * g + 3]);
            c2.x = cvtpk(o1[4 * g], o1[4 * g + 1]); c2.y = cvtpk(o1[4 * g + 2], o1[4 * g + 3]);
            *(v2u*)(crow + d0) = a; *(v2u*)(crow + 32 + d0) = c2; }
    }
    ATT_STAMP(2);
    __syncthreads();
}

__device__ __forceinline__ void sample_lru_item(Frame& F, int b) {
    int tid_ = F.tid(); asm volatile("" : "+v"(tid_));
    const int tid = tid_, lane = tid & 63, w = F.wave;
    const size_t row0 = (size_t)MP + (size_t)b * DEC_T;
    {
        const int c = tid, blk = w, cj = c & 63;
        LAS float* xcs = (LAS float*)F.lds;
        LAS float* red = xcs + 4 * 512;
        const float cw0 = F.inp(I_CW)[c], cw1 = F.inp(I_CW)[512 + c], cw2 = F.inp(I_CW)[1024 + c], cw3 = F.inp(I_CW)[1536 + c], cb = F.inp(I_CB)[c];
        const float lam = F.inp(I_LAM)[c];
        const float c8 = -8.0f * (fmaxf(-lam, 0.f) + log1pf(expf(-fabsf(lam))));
        float xs[7];
#pragma unroll
        for (int j = 0; j < 3; ++j) xs[j] = F.inp(I_SC)[((size_t)b * 3 + j) * 512 + c];
#pragma unroll
        for (int t = 0; t < 4; ++t) xs[3 + t] = bf1(F.PROJ()[(row0 + t) * INW + c]);
#pragma unroll
        for (int t = 0; t < 4; ++t) xcs[t * 512 + c] = cb + cw0 * xs[t] + cw1 * xs[t + 1] + cw2 * xs[t + 2] + cw3 * xs[t + 3];
        __syncthreads();
        float rp[4], ip[4];
#pragma unroll
        for (int t = 0; t < 4; ++t) { rp[t] = F.inp(I_BA)[c]; ip[t] = F.inp(I_BX)[c]; }
        const float* wap = F.inp(I_WA) + (size_t)(blk * 64) * 64 + cj; const float* wxp = F.inp(I_WX) + (size_t)(blk * 64) * 64 + cj;
#pragma unroll 16
        for (int k = 0; k < 64; ++k) { const float wa = wap[k * 64], wx = wxp[k * 64];
#pragma unroll
            for (int t = 0; t < 4; ++t) { const float xv = xcs[t * 512 + blk * 64 + k]; rp[t] += xv * wa; ip[t] += xv * wx; } }
        float h = F.inp(I_SH)[(size_t)b * 512 + c]; float ov[4];
#pragma unroll
        for (int t = 0; t < 4; ++t) {
            const float r = sigmoid_f(rp[t]), ig = sigmoid_f(ip[t]);
            const float la = c8 * r, a = __builtin_amdgcn_exp2f(la * LOG2E);
            const float mult = __builtin_amdgcn_sqrtf(one_minus_exp(2.0f * la));
            h = a * h + mult * ig * xcs[t * 512 + c];
            const float g = bf1(F.PROJ()[(row0 + t) * INW + C_GATE + c]);
            ov[t] = h * gelu_tanh(g);
            const float s = wave_sum(ov[t] * ov[t]); if (lane == 0) red[t * 8 + w] = s;
        }
        F.out[O_SH + (size_t)b * 512 + c] = h;
#pragma unroll
        for (int j = 0; j < 3; ++j) F.out[O_SC + ((size_t)b * 3 + j) * 512 + c] = xs[4 + j];
        __syncthreads();
#pragma unroll
        for (int t = 0; t < 4; ++t) { float s = 0.f;
#pragma unroll
            for (int w2 = 0; w2 < 8; ++w2) s += red[t * 8 + w2];
            F.CAT()[(row0 + t) * DM + c] = (bf16)f2bf(ov[t] * __builtin_amdgcn_rsqf(s * (1.0f / 512.0f) + EPS)); }
        __syncthreads();
    }
}
constexpr int SA_KROW = 68, SA_KC = 0, SA_VC = 132 * SA_KROW * 4, SA_QS = SA_VC + 132 * 64 * 4, SA_END = SA_QS + 8 * 64 * 4;
__device__ __forceinline__ void sample_attn_item(Frame& F, int b, int kvh) {
    int tid_ = F.tid(); asm volatile("" : "+v"(tid_));
    const int tid = tid_, lane = tid & 63, w = F.wave;
    const size_t row0 = (size_t)MP + (size_t)b * DEC_T;
    LAS float* Kc = (LAS float*)(F.lds + SA_KC); LAS float* Vc = (LAS float*)(F.lds + SA_VC); LAS float* qs = (LAS float*)(F.lds + SA_QS);
    {
        const float* ck = F.inp(I_CK) + (size_t)b * WIN * 128 + kvh * 64; const float* cv = F.inp(I_CV) + (size_t)b * WIN * 128 + kvh * 64;
        float* ok = F.out + O_SK + (size_t)b * WIN * 128 + kvh * 64; float* ov = F.out + O_SV + (size_t)b * WIN * 128 + kvh * 64;
#pragma unroll
        for (int i = 0; i < 4; ++i) { const int idx = tid + 512 * i, j = idx >> 4, d4 = (idx & 15) * 4;
            const f32x4 kv = *(const f32x4*)(ck + (size_t)j * 128 + d4), vv = *(const f32x4*)(cv + (size_t)j * 128 + d4);
            *(LAS f32x4*)(Kc + j * SA_KROW + d4) = kv; *(LAS f32x4*)(Vc + j * 64 + d4) = vv;
            if (j >= DEC_T) { *(f32x4*)(ok + (size_t)(j - DEC_T) * 128 + d4) = kv; *(f32x4*)(ov + (size_t)(j - DEC_T) * 128 + d4) = vv; } }
        if (w < DEC_T) {
            const int t = w, i = lane & 31;
            const bf16* pr = F.PROJ() + (row0 + t) * INW;
            const float k1 = bf1(pr[C_K + kvh * 64 + i]), k2 = bf1(pr[C_K + kvh * 64 + 32 + i]);
            float ss = k1 * k1 + k2 * k2;
#pragma unroll
            for (int o = 1; o < 32; o <<= 1) ss += __shfl_xor(ss, o);
            const float rs = __builtin_amdgcn_rsqf(ss * (1.0f / 64.0f) + EPS);
            const float x1 = k1 * rs * F.inp(I_KN)[i], x2 = k2 * rs * F.inp(I_KN)[i + 32];
            const float cc = F.ROPEC()[(size_t)(SEQ + t) * 32 + i], sv = F.ROPES()[(size_t)(SEQ + t) * 32 + i];
            const float o1 = x1 * cc - x2 * sv, o2 = x2 * cc + x1 * sv;
            const float v1 = bf1(pr[C_V + kvh * 64 + i]), v2 = bf1(pr[C_V + kvh * 64 + 32 + i]);
            if (lane < 32) {
                Kc[(WIN + t) * SA_KROW + i] = o1; Kc[(WIN + t) * SA_KROW + 32 + i] = o2; Vc[(WIN + t) * 64 + i] = v1; Vc[(WIN + t) * 64 + 32 + i] = v2;
                const size_t oo = (size_t)(WIN - DEC_T + t) * 128;
                ok[oo + i] = o1; ok[oo + 32 + i] = o2; ov[oo + i] = v1; ov[oo + 32 + i] = v2; }
        }
    }
    __syncthreads();
    const int head = kvh * 4 + (w & 3);
    const float sinkl2 = F.inp(I_SINK)[head] * LOG2E;
#pragma unroll
    for (int tt = 0; tt < 2; ++tt) {
        const int t = 2 * (w >> 2) + tt;
        {
            const float x = bf1(F.PROJ()[(row0 + t) * INW + C_Q + head * 64 + lane]);
            const float ss = wave_sum(x * x);
            const float xn = x * __builtin_amdgcn_rsqf(ss * (1.0f / 64.0f) + EPS) * F.inp(I_QN)[lane];
            const float other = __shfl_xor(xn, 32);
            const int i = lane & 31; const float cc = F.ROPEC()[(size_t)(SEQ + t) * 32 + i], sv = F.ROPES()[(size_t)(SEQ + t) * 32 + i];
            const float qo = (lane < 32) ? (xn * cc - other * sv) : (xn * cc + other * sv);
            qs[w * 64 + lane] = qo * (0.125f * LOG2E);
        }
        LDS_WAIT(); asm volatile("" ::: "memory");
        const int j0 = t + 1 + lane, j1 = j0 + 64;
        float s0 = 0.f, s1 = 0.f;
        const LAS f32x4* q4 = (const LAS f32x4*)(qs + w * 64);
        const LAS f32x4* k0 = (const LAS f32x4*)(Kc + j0 * SA_KROW); const LAS f32x4* k1 = (const LAS f32x4*)(Kc + j1 * SA_KROW);
#pragma unroll
        for (int d4 = 0; d4 < 16; ++d4) { const f32x4 q = q4[d4], a = k0[d4], c = k1[d4];
            s0 += q[0] * a[0] + q[1] * a[1] + q[2] * a[2] + q[3] * a[3]; s1 += q[0] * c[0] + q[1] * c[1] + q[2] * c[2] + q[3] * c[3]; }
        float mx = wave_max(fmaxf(s0, s1)); mx = fmaxf(mx, sinkl2);
        const float p0 = __builtin_amdgcn_exp2f(s0 - mx), p1 = __builtin_amdgcn_exp2f(s1 - mx);
        const float l = wave_sum(p0 + p1) + __builtin_amdgcn_exp2f(sinkl2 - mx);
        float o = 0.f;
#pragma unroll 8
        for (int jj = 0; jj < 64; ++jj) { const float pa = __shfl(p0, jj), pb = __shfl(p1, jj); o += pa * Vc[(t + 1 + jj) * 64 + lane] + pb * Vc[(t + 65 + jj) * 64 + lane]; }
        o *= __builtin_amdgcn_rcpf(l);
        F.SOA()[((size_t)b * DEC_T + t) * 512 + head * 64 + lane] = o;
        const float hq = wave_sum(o * o); if (lane == 0) F.SSQS()[((size_t)b * DEC_T + t) * 8 + head] = hq;
    }
    __syncthreads();
}
__device__ __forceinline__ void sample_attn_norm(Frame& F) {
    const int lane = F.lane(), gw = blockIdx.x * NWAVES + F.wave;
    for (int r = gw; r < MS; r += F.G * NWAVES) {
        const f32x4* sp = (const f32x4*)(F.SSQS() + (size_t)r * 8); const f32x4 s0 = sp[0], s1 = sp[1];
        const float rs = __builtin_amdgcn_rsqf((((s0[0] + s0[1]) + (s0[2] + s0[3])) + ((s1[0] + s1[1]) + (s1[2] + s1[3]))) * (1.0f / 512.0f) + EPS);
        const f32x4* op = (const f32x4*)(F.SOA() + (size_t)r * 512 + lane * 8); const f32x4 a = op[0], c = op[1];
        v4u o; o.x = cvtpk(a[0] * rs, a[1] * rs); o.y = cvtpk(a[2] * rs, a[3] * rs); o.z = cvtpk(c[0] * rs, c[1] * rs); o.w = cvtpk(c[2] * rs, c[3] * rs);
        *(v4u*)(F.CAT() + ((size_t)MP + r) * DM + 512 + lane * 8) = o;
    }
}

struct SEpiSwiglu {
    bf16* H; const float* ssq;
    __device__ __forceinline__ int brow0(int cb) const { const int hc0 = 32 * cb; return (hc0 >> 7) * 256 + (hc0 & 127); }
    __device__ __forceinline__ int brow1(int cb) const { return brow0(cb) + 128; }
    __device__ __forceinline__ void operator()(const f32x16& a0, const f32x16& a1, int r, int cb, int h) const {
        const float rs = pg8::row_rs(ssq, r);
#pragma unroll
        for (int g = 0; g < 4; ++g) { float hv[4];
#pragma unroll
            for (int e = 0; e < 4; ++e) hv[e] = pg8::silu_f(a0[4 * g + e] * rs) * (a1[4 * g + e] * rs);
            v2u w; w.x = cvtpk(hv[0], hv[1]); w.y = cvtpk(hv[2], hv[3]); *(v2u*)(H + (size_t)r * DFF + 32 * cb + 8 * g + 4 * h) = w; }
    }
};
struct SEpiScale {
    bf16* O; int ldc; const float* ssq;
    __device__ __forceinline__ int brow0(int cb) const { return 64 * cb; }
    __device__ __forceinline__ int brow1(int cb) const { return 64 * cb + 32; }
    __device__ __forceinline__ void operator()(const f32x16& a0, const f32x16& a1, int r, int cb, int h) const {
        const float rs = pg8::row_rs(ssq, r);
#pragma unroll
        for (int g = 0; g < 4; ++g) {
            v2u w; w.x = cvtpk(a0[4 * g] * rs, a0[4 * g + 1] * rs); w.y = cvtpk(a0[4 * g + 2] * rs, a0[4 * g + 3] * rs); *(v2u*)(O + (size_t)r * ldc + 64 * cb + 8 * g + 4 * h) = w;
            v2u x; x.x = cvtpk(a1[4 * g] * rs, a1[4 * g + 1] * rs); x.y = cvtpk(a1[4 * g + 2] * rs, a1[4 * g + 3] * rs); *(v2u*)(O + (size_t)r * ldc + 64 * cb + 32 + 8 * g + 4 * h) = x; }
    }
};
template <int MODE> struct SEpiResid {
    const float* basef; float* out; bf16* xb; float* ssq; float scale;
    __device__ __forceinline__ int brow0(int cb) const { return 64 * cb; }
    __device__ __forceinline__ int brow1(int cb) const { return 64 * cb + 32; }
    __device__ __forceinline__ void operator()(const f32x16& a0, const f32x16& a1, int r, int cb, int h) const {
        float s = 0.f;
#pragma unroll
        for (int a = 0; a < 2; ++a)
#pragma unroll
            for (int g = 0; g < 4; ++g) { const size_t off = (size_t)r * DM + 64 * cb + 32 * a + 8 * g + 4 * h;
                f32x4 b; if (MODE == 0) b = *(const f32x4*)(basef + off); else b = pg8::bf4_to_f32(*(const v2u*)(xb + off));
                const f32x4 v = a == 0 ? (f32x4){a0[4 * g], a0[4 * g + 1], a0[4 * g + 2], a0[4 * g + 3]} : (f32x4){a1[4 * g], a1[4 * g + 1], a1[4 * g + 2], a1[4 * g + 3]};
                const f32x4 o = b + v * scale;
                if (MODE == 2) *(f32x4*)(out + off) = o;
                else { s += (o[0] * o[0] + o[1] * o[1]) + (o[2] * o[2] + o[3] * o[3]); v2u w; w.x = cvtpk(o[0], o[1]); w.y = cvtpk(o[2], o[3]); *(v2u*)(xb + off) = w; } }
        if (MODE != 2) { s += __shfl_xor(s, 32); if (h == 0) ssq[(size_t)r * 16 + cb] = s; }
    }
};
constexpr int SG_ROWB = 144, SG_TILE = 32 * SG_ROWB, SG_WAVE = 3 * SG_TILE;
static_assert(8 * SG_WAVE <= SCR_BYTES, "small gemm LDS");
template <int K, int KS, class Epi> __device__ __forceinline__ void small_gemm(Frame& F, const bf16* A, int lda, const bf16* Bt, int ncb, const Epi& E, unsigned* dyn) {
    int lane_ = F.lane(); asm volatile("" : "+v"(lane_));
    const int lane = lane_, w = F.wave, ql = lane & 31, h = lane >> 5, lr = lane >> 3, ch = lane & 7;
    const int nitems = 16 * ncb * KS;
    constexpr int NBT = K / 64, NB_LO = NBT / KS, NB_REM = NBT % KS;
    LAS unsigned char* tl = F.lds + w * SG_WAVE;
    LAS float* red = (LAS float*)F.lds;
    for (;;) {
        if (F.tid() == 0) F.MISC[0] = __hip_atomic_fetch_add(dyn, 1u, __ATOMIC_RELAXED, __HIP_MEMORY_SCOPE_AGENT);
        __syncthreads();
        const int base = (int)F.MISC[0] * NWAVES;
        __syncthreads();
        if (base >= nitems) break;
        const int it = base + w; const bool valid = it < nitems;
        const int tile = it / KS, ks = it % KS, rb = tile & 15, cb = tile >> 4;
        f32x16 acc0 = {0.f, 0.f, 0.f, 0.f, 0.f, 0.f, 0.f, 0.f, 0.f, 0.f, 0.f, 0.f, 0.f, 0.f, 0.f, 0.f}, acc1 = acc0;
        const int r = MP + 32 * rb + ql;
        if (valid) {
            const int nb = NB_LO + (ks < NB_REM ? 1 : 0), kb0 = 64 * (ks * NB_LO + (ks < NB_REM ? ks : NB_REM));
            const bf16* ga = A + (size_t)(MP + 32 * rb + lr) * lda + kb0 + 8 * ch;
            const bf16* g0 = Bt + (size_t)(E.brow0(cb) + lr) * K + kb0 + 8 * ch;
            const bf16* g1 = Bt + (size_t)(E.brow1(cb) + lr) * K + kb0 + 8 * ch;
            v4u ra[4], r0[4], r1[4], sa[4], s0[4], s1[4];
#define SG_LD1(dst, ptr) asm volatile("global_load_dwordx4 %0, %1, off" : "=v"(dst) : "v"(ptr) : "memory")
#define SG_FETCH(RA, R0, R1, bb) do { _Pragma("unroll") for (int i = 0; i < 4; ++i) { SG_LD1(RA[i], ga + (size_t)(8 * i) * lda + 64 * (bb)); SG_LD1(R0[i], g0 + (size_t)(8 * i) * K + 64 * (bb)); SG_LD1(R1[i], g1 + (size_t)(8 * i) * K + 64 * (bb)); } } while (0)
#define SG_WAIT(N, RA, R0, R1) asm volatile("s_waitcnt vmcnt(" #N ")" : "+v"(RA[0]), "+v"(RA[1]), "+v"(RA[2]), "+v"(RA[3]), "+v"(R0[0]), "+v"(R0[1]), "+v"(R0[2]), "+v"(R0[3]), "+v"(R1[0]), "+v"(R1[1]), "+v"(R1[2]), "+v"(R1[3]) :: "memory")
#define SG_PARK(RA, R0, R1) do { _Pragma("unroll") for (int i = 0; i < 4; ++i) { const int off = (lr + 8 * i) * SG_ROWB + 16 * ch; *(LAS v4u*)(tl + off) = RA[i]; *(LAS v4u*)(tl + SG_TILE + off) = R0[i]; *(LAS v4u*)(tl + 2 * SG_TILE + off) = R1[i]; } } while (0)
#define SG_MMA() do { _Pragma("unroll") for (int sI = 0; sI < 4; ++sI) { const int fo = ql * SG_ROWB + 32 * sI + 16 * h; \
                    const bf16x8 af = *(const LAS bf16x8*)(tl + fo), bf0 = *(const LAS bf16x8*)(tl + SG_TILE + fo), bf1v = *(const LAS bf16x8*)(tl + 2 * SG_TILE + fo); \
                    acc0 = __builtin_amdgcn_mfma_f32_32x32x16_bf16(bf0, af, acc0, 0, 0, 0); acc1 = __builtin_amdgcn_mfma_f32_32x32x16_bf16(bf1v, af, acc1, 0, 0, 0); } } while (0)
            asm volatile("s_waitcnt vmcnt(0)" ::: "memory");
            SG_FETCH(ra, r0, r1, 0);
            if (nb > 1) SG_FETCH(sa, s0, s1, 1);
            int b = 0;
            for (; b + 3 < nb; b += 2) {
                SG_WAIT(12, ra, r0, r1); SG_PARK(ra, r0, r1); SG_FETCH(ra, r0, r1, b + 2); SG_MMA();
                SG_WAIT(12, sa, s0, s1); SG_PARK(sa, s0, s1); SG_FETCH(sa, s0, s1, b + 3); SG_MMA();
            }
            SG_WAIT(0, ra, r0, r1); if (b + 1 < nb) SG_WAIT(0, sa, s0, s1);
            SG_PARK(ra, r0, r1); if (b + 2 < nb) SG_FETCH(ra, r0, r1, b + 2); SG_MMA();
            if (b + 1 < nb) { SG_PARK(sa, s0, s1); SG_MMA(); }
            if (b + 2 < nb) { SG_WAIT(0, ra, r0, r1); SG_PARK(ra, r0, r1); SG_MMA(); }
#undef SG_LD1
#undef SG_FETCH
#undef SG_WAIT
#undef SG_PARK
#undef SG_MMA
        }
        if (KS > 1) {
            __syncthreads();
#pragma unroll
            for (int q = 0; q < 16; ++q) { red[((w * 2 + 0) * 16 + q) * 64 + lane] = acc0[q]; red[((w * 2 + 1) * 16 + q) * 64 + lane] = acc1[q]; }
            __syncthreads();
            if (valid && ks == 0) {
#pragma unroll
                for (int j = 1; j < KS; ++j)
#pragma unroll
                    for (int q = 0; q < 16; ++q) { acc0[q] += red[(((w + j) * 2 + 0) * 16 + q) * 64 + lane]; acc1[q] += red[(((w + j) * 2 + 1) * 16 + q) * 64 + lane]; }
            }
        }
        if (valid && ks == 0) E(acc0, acc1, r, cb, h);
        if (KS > 1) __syncthreads();
    }
}

#ifndef MK_N_LAUNCHES
#define MK_N_LAUNCHES 1
#endif
constexpr int N_PHASES = 9;
#ifndef REV_DOWN
#define REV_DOWN 1
#endif
constexpr int N_LAUNCHES = MK_N_LAUNCHES;
struct Args { const float* in[29]; float* out; unsigned char* ws; int ph_lo, ph_hi, li, pad; };
__global__ void __launch_bounds__(NWAVES * 64, 2) hymba_fwd(Args args) {
    extern __shared__ __attribute__((aligned(16))) unsigned char lds[];
    Frame F;
    F.lds = (LAS unsigned char*)lds;
    F.MISC = (volatile LAS unsigned*)(F.lds + MISC_OFF);
    F.wave = __builtin_amdgcn_readfirstlane((int)threadIdx.x >> 6);
    F.G = gridDim.x; { const int bx = blockIdx.x; F.vcu = (F.G % 8 == 0) ? (bx % 8) * (F.G / 8) + bx / 8 : bx; }
    F.kp = (kernarg_ptr)__builtin_amdgcn_kernarg_segment_ptr(); F.out = args.out; F.ws = args.ws;
    for (int u = F.tid(); u < (LDS_BYTES - LDSCTL_OFF) / 4; u += NWAVES * 64) ((LAS unsigned*)(F.lds + LDSCTL_OFF))[u] = 0u;
    __syncthreads();
    XcdBarrier bar; bar.bar = (unsigned*)(F.ctl() + CW_BAR); bar.x = 0; bar.st = nullptr;
    if (N_LAUNCHES == 1) bar = xcd_barrier_post((unsigned*)(F.ctl() + CW_BAR), F.MISC + 8, F.tid() == 0);
#define GRID_BAR() do { if (N_LAUNCHES == 1) xcd_barrier(bar, F.tid() == 0); } while (0)
    const int lo = args.ph_lo, hi = args.ph_hi;
#define IN(k) (lo <= (k) && (k) < hi)
#ifndef PROBE_PHASE
#define PROBE_PHASE -1
#endif
#ifndef PROBE_BLOCK
#define PROBE_BLOCK 0
#endif
#ifndef PROBE_BLOCK2
#define PROBE_BLOCK2 0
#endif
    unsigned long long tsA = 0, tsB = 0; pg8::Tm tm{0, 0};
#define STAMP(k) do { if (PROBE_WHICH == 8 && (k) == PROBE_PHASE) tsA = __builtin_amdgcn_s_memrealtime(); if (PROBE_PHASE >= 0 && PROBE_WHICH == 0) { if ((k) == PROBE_PHASE) tsA = __builtin_amdgcn_s_memrealtime(); if ((k) == PROBE_PHASE + 1) tsB = __builtin_amdgcn_s_memrealtime(); } } while (0)
#define BOTH(k) (IN(k) && IN((k) + 1))
#ifndef PROBE_REP
#define PROBE_REP 0
#endif
#define REP(k) for (int rep_ = 0; rep_ < (((PROBE_REP >> (k)) & 1) ? 2 : 1); ++rep_)

#ifndef SKIP_P0
#undef CURPH
#define CURPH 0
    STAMP(0);
    if (IN(0)) REP(0) { p0_prologue(F); { if (PROBE_WHICH == 8 && PROBE_PHASE == 0) tsB = __builtin_amdgcn_s_memrealtime(); if (PROBE_WHICH == 7 && PROBE_PHASE == 0) tsA = __builtin_amdgcn_s_memrealtime(); if (BOTH(0)) GRID_BAR(); if (PROBE_WHICH == 7 && PROBE_PHASE == 0) tsB = __builtin_amdgcn_s_memrealtime(); } }
#endif
#undef CURPH
#define CURPH 1
    STAMP(1);
    if (IN(1)) REP(1) {
        pg8::Gemm g{F.XB(), F.WGU1(), MP, 2 * DFF, DM}; pg8::StaticOrder S; S.init(MP, 2 * DFF, F.G, (int)blockIdx.x);
        pg8::EpiSwiglu E{F.HB(), DFF}; pg8::rs_cache_fill(F.lds + RING_OFF, S, F.SSQ(), F.wave);
        pg8::gemm_phase<pg8::EpiSwiglu, pg8::StaticOrder, true, true>(F.lds + RING_OFF, g, S, E, F.wave, tm);
        if ((PROBE_WHICH == 1 || PROBE_WHICH == 2) && PROBE_PHASE == 1) { tsA = 0; tsB = (PROBE_WHICH == 1) ? tm.k : tm.e; } tm.k = 0; tm.e = 0;
        { constexpr int FIRST = (16 * (DFF / 32) + NWAVES - 1) / NWAVES;
          if ((int)F.G > FIRST) { if ((int)blockIdx.x >= FIRST) convert_weights<1>(F, ((int)blockIdx.x - FIRST) * NWAVES + F.wave, ((int)F.G - FIRST) * NWAVES); }
          else convert_weights<1>(F, (int)blockIdx.x * NWAVES + F.wave, (int)F.G * NWAVES);
          __syncthreads(); }
        { const unsigned long long ts0_ = (PROBE_WHICH == 3) ? __builtin_amdgcn_s_memrealtime() : 0ull;
        { SEpiSwiglu SE{F.HB(), F.SSQ()}; small_gemm<DM, 1, SEpiSwiglu>(F, F.XB(), DM, F.WGU1(), DFF / 32, SE, (unsigned*)(F.ctl() + CW_DYN + 64 * 1)); }
          if (PROBE_WHICH == 3 && PROBE_PHASE == CURPH) { asm volatile("s_waitcnt vmcnt(0)" ::: "memory"); tsA = ts0_; tsB = __builtin_amdgcn_s_memrealtime(); } }
        { if (PROBE_WHICH == 8 && PROBE_PHASE == 1) tsB = __builtin_amdgcn_s_memrealtime(); if (PROBE_WHICH == 7 && PROBE_PHASE == 1) tsA = __builtin_amdgcn_s_memrealtime(); if (BOTH(1)) GRID_BAR(); if (PROBE_WHICH == 7 && PROBE_PHASE == 1) tsB = __builtin_amdgcn_s_memrealtime(); }
    }
#undef CURPH
#define CURPH 2
    STAMP(2);
    if (IN(2)) REP(2) {
        pg8::Gemm g{F.HB(), F.WD1(), MP, DM, DFF}; pg8::StaticOrder S; S.init(MP, DM, F.G, (int)blockIdx.x, REV_DOWN);
        pg8::EpiResid<1> E{nullptr, nullptr, F.XB(), F.SSQ(), 0.5f};
        pg8::gemm_phase<pg8::EpiResid<1>, pg8::StaticOrder, true, true>(F.lds + RING_OFF, g, S, E, F.wave, tm);
        if ((PROBE_WHICH == 1 || PROBE_WHICH == 2) && PROBE_PHASE == 2) { tsA = 0; tsB = (PROBE_WHICH == 1) ? tm.k : tm.e; } tm.k = 0; tm.e = 0;
        { const unsigned long long ts0_ = (PROBE_WHICH == 3) ? __builtin_amdgcn_s_memrealtime() : 0ull;
        { SEpiResid<1> SE{nullptr, nullptr, F.XB(), F.SSQ(), 0.5f}; small_gemm<DFF, 8, SEpiResid<1>>(F, F.HB(), DFF, F.WD1(), DM / 64, SE, (unsigned*)(F.ctl() + CW_DYN + 64 * 2)); }
          if (PROBE_WHICH == 3 && PROBE_PHASE == CURPH) { asm volatile("s_waitcnt vmcnt(0)" ::: "memory"); tsA = ts0_; tsB = __builtin_amdgcn_s_memrealtime(); } }
        { if (PROBE_WHICH == 8 && PROBE_PHASE == 2) tsB = __builtin_amdgcn_s_memrealtime(); if (PROBE_WHICH == 7 && PROBE_PHASE == 2) tsA = __builtin_amdgcn_s_memrealtime(); if (BOTH(2)) GRID_BAR(); if (PROBE_WHICH == 7 && PROBE_PHASE == 2) tsB = __builtin_amdgcn_s_memrealtime(); }
    }
#undef CURPH
#define CURPH 3
    STAMP(3);
    if (IN(3)) REP(3) {
        pg8::Gemm g{F.XB(), F.WINT(), MP, INW, DM}; pg8::StaticOrder S; S.init(MP, INW, F.G, (int)blockIdx.x);
        pg8::EpiScaleBf16 E{F.PROJ(), INW}; pg8::rs_cache_fill(F.lds + RING_OFF, S, F.SSQ(), F.wave);
        pg8::gemm_phase<pg8::EpiScaleBf16, pg8::StaticOrder, true, true>(F.lds + RING_OFF, g, S, E, F.wave, tm);
        if ((PROBE_WHICH == 1 || PROBE_WHICH == 2) && PROBE_PHASE == 3) { tsA = 0; tsB = (PROBE_WHICH == 1) ? tm.k : tm.e; } tm.k = 0; tm.e = 0;
        { const int NU = (MP / 256) * (INW / 256), light0 = NU % (int)F.G;
          if (light0 != 0) { if ((int)blockIdx.x >= light0) convert_weights<2>(F, ((int)blockIdx.x - light0) * NWAVES + F.wave, ((int)F.G - light0) * NWAVES); }
          else convert_weights<2>(F, (int)blockIdx.x * NWAVES + F.wave, (int)F.G * NWAVES);
          __syncthreads(); }
        { const unsigned long long ts0_ = (PROBE_WHICH == 3) ? __builtin_amdgcn_s_memrealtime() : 0ull;
        { SEpiScale SE{F.PROJ(), INW, F.SSQ()}; small_gemm<DM, 4, SEpiScale>(F, F.XB(), DM, F.WINT(), INW / 64, SE, (unsigned*)(F.ctl() + CW_DYN + 64 * 3)); }
          if (PROBE_WHICH == 3 && PROBE_PHASE == CURPH) { asm volatile("s_waitcnt vmcnt(0)" ::: "memory"); tsA = ts0_; tsB = __builtin_amdgcn_s_memrealtime(); } }
        { if (PROBE_WHICH == 8 && PROBE_PHASE == 3) tsB = __builtin_amdgcn_s_memrealtime(); if (PROBE_WHICH == 7 && PROBE_PHASE == 3) tsA = __builtin_amdgcn_s_memrealtime(); if (BOTH(3)) GRID_BAR(); if (PROBE_WHICH == 7 && PROBE_PHASE == 3) tsB = __builtin_amdgcn_s_memrealtime(); }
    }
#undef CURPH
#define CURPH 4
    STAMP(4);
    if (IN(4)) REP(4) {
#ifndef SKIP_ATTN
        if (PROBE_WHICH == 4 && PROBE_PHASE == 4) tsA = __builtin_amdgcn_s_memrealtime();
        REP(8) for (int it = blockIdx.x; it < BATCH * (SEQ / WIN); it += F.G) { unsigned long long tst[3] = {0, 0, 0}; attn_prompt_item(F, it, tst); if (PROBE_WHICH == 9 && PROBE_PHASE == 4) { tsA = tst[PROBE_BLOCK2]; tsB = tst[PROBE_BLOCK2 + 1]; } }
#endif
        if (PROBE_WHICH == 4 && PROBE_PHASE == 4) tsB = __builtin_amdgcn_s_memrealtime();
        if (PROBE_WHICH == 5 && PROBE_PHASE == 4) tsA = __builtin_amdgcn_s_memrealtime();
#ifndef SKIP_LRU1
        REP(9) for (int it = blockIdx.x; it < BATCH * NCHUNK; it += F.G) lru_prompt_item<1>(F, it);
#endif
#ifndef SKIP_SAMPLE
        __syncthreads();
        if (PROBE_WHICH == 5 && PROBE_PHASE == 4) tsB = __builtin_amdgcn_s_memrealtime();
        if (PROBE_WHICH == 6 && PROBE_PHASE == 4) tsA = __builtin_amdgcn_s_memrealtime();
        REP(10) for (int it = blockIdx.x; it < 3 * DEC_B; it += F.G) { if (it < DEC_B) sample_lru_item(F, it); else sample_attn_item(F, (it - DEC_B) >> 1, (it - DEC_B) & 1); }
#endif
        if (PROBE_WHICH == 6 && PROBE_PHASE == 4) tsB = __builtin_amdgcn_s_memrealtime();
        if (PROBE_WHICH == 7 && PROBE_PHASE == 4) tsA = __builtin_amdgcn_s_memrealtime();
        if (BOTH(4)) GRID_BAR();
        if (PROBE_WHICH == 7 && PROBE_PHASE == 4) tsB = __builtin_amdgcn_s_memrealtime();
    }
#undef CURPH
#define CURPH 5
    STAMP(5);
    if (IN(5)) REP(5) {
        sample_attn_norm(F);
#ifndef SKIP_LRU2
        for (int it = blockIdx.x; it < BATCH * NCHUNK; it += F.G) lru_prompt_item<2>(F, it);
#endif
        { if (PROBE_WHICH == 8 && PROBE_PHASE == 5) tsB = __builtin_amdgcn_s_memrealtime(); if (PROBE_WHICH == 7 && PROBE_PHASE == 5) tsA = __builtin_amdgcn_s_memrealtime(); if (BOTH(5)) GRID_BAR(); if (PROBE_WHICH == 7 && PROBE_PHASE == 5) tsB = __builtin_amdgcn_s_memrealtime(); }
    }
#undef CURPH
#define CURPH 6
    STAMP(6);
    if (IN(6)) {
        pg8::Gemm g{F.CAT(), F.WOUT(), MP, DM, DM}; pg8::StaticOrder S; S.init(MP, DM, F.G, (int)blockIdx.x);
        pg8::EpiResidMix E{F.XB(), F.SSQ()}; pg8::mix_cache_fill(F.lds + RING_OFF, S, F.SSQL(), F.SSQA(), F.wave);
        pg8::gemm_phase<pg8::EpiResidMix, pg8::StaticOrder, true, true>(F.lds + RING_OFF, g, S, E, F.wave, tm);
        if ((PROBE_WHICH == 1 || PROBE_WHICH == 2) && PROBE_PHASE == 6) { tsA = 0; tsB = (PROBE_WHICH == 1) ? tm.k : tm.e; } tm.k = 0; tm.e = 0;
        { const unsigned long long ts0_ = (PROBE_WHICH == 3) ? __builtin_amdgcn_s_memrealtime() : 0ull;
        { SEpiResid<1> SE{nullptr, nullptr, F.XB(), F.SSQ(), 1.0f}; small_gemm<DM, 8, SEpiResid<1>>(F, F.CAT(), DM, F.WOUT(), DM / 64, SE, (unsigned*)(F.ctl() + CW_DYN + 64 * 6)); }
          if (PROBE_WHICH == 3 && PROBE_PHASE == CURPH) { asm volatile("s_waitcnt vmcnt(0)" ::: "memory"); tsA = ts0_; tsB = __builtin_amdgcn_s_memrealtime(); } }
        { if (PROBE_WHICH == 8 && PROBE_PHASE == 6) tsB = __builtin_amdgcn_s_memrealtime(); if (PROBE_WHICH == 7 && PROBE_PHASE == 6) tsA = __builtin_amdgcn_s_memrealtime(); if (BOTH(6)) GRID_BAR(); if (PROBE_WHICH == 7 && PROBE_PHASE == 6) tsB = __builtin_amdgcn_s_memrealtime(); }
    }
#undef CURPH
#define CURPH 7
    STAMP(7);
    if (IN(7)) REP(7) {
        pg8::Gemm g{F.XB(), F.WGU2(), MP, 2 * DFF, DM}; pg8::StaticOrder S; S.init(MP, 2 * DFF, F.G, (int)blockIdx.x);
        pg8::EpiSwiglu E{F.HB(), DFF}; pg8::rs_cache_fill(F.lds + RING_OFF, S, F.SSQ(), F.wave);
        pg8::gemm_phase<pg8::EpiSwiglu, pg8::StaticOrder, true, true>(F.lds + RING_OFF, g, S, E, F.wave, tm);
        if ((PROBE_WHICH == 1 || PROBE_WHICH == 2) && PROBE_PHASE == 7) { tsA = 0; tsB = (PROBE_WHICH == 1) ? tm.k : tm.e; } tm.k = 0; tm.e = 0;
        { const unsigned long long ts0_ = (PROBE_WHICH == 3) ? __builtin_amdgcn_s_memrealtime() : 0ull;
        { SEpiSwiglu SE{F.HB(), F.SSQ()}; small_gemm<DM, 1, SEpiSwiglu>(F, F.XB(), DM, F.WGU2(), DFF / 32, SE, (unsigned*)(F.ctl() + CW_DYN + 64 * 7)); }
          if (PROBE_WHICH == 3 && PROBE_PHASE == CURPH) { asm volatile("s_waitcnt vmcnt(0)" ::: "memory"); tsA = ts0_; tsB = __builtin_amdgcn_s_memrealtime(); } }
        { if (PROBE_WHICH == 8 && PROBE_PHASE == 7) tsB = __builtin_amdgcn_s_memrealtime(); if (PROBE_WHICH == 7 && PROBE_PHASE == 7) tsA = __builtin_amdgcn_s_memrealtime(); if (BOTH(7)) GRID_BAR(); if (PROBE_WHICH == 7 && PROBE_PHASE == 7) tsB = __builtin_amdgcn_s_memrealtime(); }
    }
#undef CURPH
#define CURPH 8
    STAMP(8);
    if (IN(8)) {
        pg8::Gemm g{F.HB(), F.WD2(), MP, DM, DFF}; pg8::StaticOrder S; S.init(MP, DM, F.G, (int)blockIdx.x, REV_DOWN);
        pg8::EpiResid<2> E{nullptr, F.out, F.XB(), nullptr, 0.5f};
        pg8::gemm_phase<pg8::EpiResid<2>, pg8::StaticOrder, true, true>(F.lds + RING_OFF, g, S, E, F.wave, tm);
        if ((PROBE_WHICH == 1 || PROBE_WHICH == 2) && PROBE_PHASE == 8) { tsA = 0; tsB = (PROBE_WHICH == 1) ? tm.k : tm.e; } tm.k = 0; tm.e = 0;
        { const unsigned long long ts0_ = (PROBE_WHICH == 3) ? __builtin_amdgcn_s_memrealtime() : 0ull;
        { SEpiResid<2> SE{nullptr, F.out, F.XB(), nullptr, 0.5f}; small_gemm<DFF, 8, SEpiResid<2>>(F, F.HB(), DFF, F.WD2(), DM / 64, SE, (unsigned*)(F.ctl() + CW_DYN + 64 * 8)); }
          if (PROBE_WHICH == 3 && PROBE_PHASE == CURPH) { asm volatile("s_waitcnt vmcnt(0)" ::: "memory"); tsA = ts0_; tsB = __builtin_amdgcn_s_memrealtime(); } }
    }
    STAMP(9);
    if (PROBE_PHASE >= 0 && blockIdx.x == PROBE_BLOCK) { asm volatile("s_waitcnt vmcnt(0)" ::: "memory"); const unsigned long long te = __builtin_amdgcn_s_memrealtime(), d = 4 * (tsB - tsA); while (__builtin_amdgcn_s_memrealtime() - te < d) __builtin_amdgcn_s_sleep(8); }
#undef IN
#undef BOTH
}

extern "C" void kernel_launch(void* const* d_in, const int* in_sizes, int n_in, void* d_out, int out_size, void* d_ws, size_t ws_size, hipStream_t stream) {
    static int grid = 0;
    if (grid == 0) {
        if (n_in != 29 || in_sizes[0] != MP * DM || (size_t)out_size != O_END || ws_size < WS_END) { fprintf(stderr, "kernel_launch: unexpected shapes (n_in %d in0 %d out %d ws %zu); nothing launched\n", n_in, n_in > 0 ? in_sizes[0] : -1, out_size, ws_size); grid = -1; return; }
        int dev = 0, cus = 0, per_cu = 0;
        if (hipGetDevice(&dev) != hipSuccess || hipDeviceGetAttribute(&cus, hipDeviceAttributeMultiprocessorCount, dev) != hipSuccess) { fprintf(stderr, "kernel_launch: device query failed\n"); grid = -1; return; }
        if (hipFuncSetAttribute((const void*)hymba_fwd, hipFuncAttributeMaxDynamicSharedMemorySize, LDS_BYTES) != hipSuccess) { fprintf(stderr, "kernel_launch: hipFuncSetAttribute failed\n"); grid = -1; return; }
        if (hipOccupancyMaxActiveBlocksPerMultiprocessor(&per_cu, (const void*)hymba_fwd, NWAVES * 64, LDS_BYTES) != hipSuccess || per_cu < 1) { fprintf(stderr, "kernel_launch: occupancy query reports %d workgroups per CU\n", per_cu); per_cu = 1; }
        (void)hipGetLastError();
        grid = cus;
    }
    if (grid < 0) return;
    if (hipMemsetAsync((char*)d_ws + WS_CTL, 0, CTL_ZERO_BYTES, stream) != hipSuccess) { fprintf(stderr, "kernel_launch: memset failed\n"); return; }
    Args a{};
    for (int i = 0; i < 29; ++i) a.in[i] = (const float*)d_in[i];
    a.out = (float*)d_out; a.ws = (unsigned char*)d_ws;
    if (N_LAUNCHES == 1) {
        a.ph_lo = 0; a.ph_hi = N_PHASES; a.li = 0;
        hipLaunchKernelGGL(hymba_fwd, dim3(grid), dim3(NWAVES * 64), LDS_BYTES, stream, a);
    } else {
        for (int li = 0; li < N_PHASES; ++li) { a.ph_lo = li; a.ph_hi = li + 1; a.li = li; hipLaunchKernelGGL(hymba_fwd, dim3(grid), dim3(NWAVES * 64), LDS_BYTES, stream, a); }
    }
    const hipError_t le = hipPeekAtLastError();
    if (le != hipSuccess) fprintf(stderr, "kernel_launch: launch failed: %s\n", hipGetErrorName(le));
}
```
